# Optimizing an MI355X kernel written in HIP

```python
import math
import jax
import jax.numpy as jnp
from jax import lax
import numpy as np


D_MODEL = 1024
BATCH = 32
SEQ = 2048
DEPTH = 4

N_MIXERS = 3
NSA_HEADS = 16
NSA_GROUPS = 4
NSA_HPG = NSA_HEADS // NSA_GROUPS
HEAD_DIM = D_MODEL // NSA_HEADS
CMP_BLOCK = 32
CMP_STRIDE = 16
SEL_BLOCK = 64
SEL_TOP = 16
SEL_QCHUNK = 16
WINDOW = 512
WIN_QBLOCK = 128
ROPE_THETA = 10000.0
FORCE_SCORE = 1e6
NSA_Q_COLS = NSA_HEADS * HEAD_DIM
NSA_KV_COLS = NSA_GROUPS * HEAD_DIM
NSA_IN_COLS = NSA_Q_COLS + 6 * NSA_KV_COLS + 3 * NSA_HEADS
SC_WIDTH = 3
LRU_WIDTH = 1280
LRU_BLOCKS = 16
LRU_BW = LRU_WIDTH // LRU_BLOCKS
LRU_CONV = 4
LRU_C = 8.0
N_EXPERTS = 16
N_GROUPS = 4
EXPERTS_PER_GROUP = N_EXPERTS // N_GROUPS
TOP_GROUPS = 1
TOP_K = 2
D_FF = 1024
DN_ALPHA = (2.0 * DEPTH) ** 0.25
DN_BETA = (8.0 * DEPTH) ** -0.25
LN_EPS = 1e-5
NEG_INF = -1e30

N_NSA = (DEPTH + 2) // 3
N_SC = (DEPTH + 1) // 3
N_LRU = DEPTH // 3

kernel_name = 'hybrid_nsa_shortconv_rglru_moe'


def layer_norm(x, g, b):
    xf = x.astype(jnp.float32)
    mu = xf.mean(-1, keepdims=True)
    var = jnp.square(xf - mu).mean(-1, keepdims=True)
    y = (xf - mu) * lax.rsqrt(var + LN_EPS) * g.astype(jnp.float32) + b.astype(jnp.float32)
    return y.astype(x.dtype)


def rope(x, pos):
    half = x.shape[-1] // 2
    inv = ROPE_THETA ** (-jnp.arange(half, dtype=jnp.float32) / half)
    ang = pos.astype(jnp.float32)[..., None] * inv
    ang = ang.reshape(ang.shape[:2] + (1,) * (x.ndim - 3) + (half,))
    cos = jnp.cos(ang).astype(x.dtype)
    sin = jnp.sin(ang).astype(x.dtype)
    x1, x2 = x[..., :half], x[..., half:]
    return jnp.concatenate([x1 * cos - x2 * sin, x1 * sin + x2 * cos], axis=-1)


def masked_softmax(s, mask):
    s = jnp.where(mask, s, NEG_INF)
    p = jax.nn.softmax(s, axis=-1)
    return jnp.where(mask, p, 0.0)


def causal_dwconv(u, w, b):
    width = w.shape[0]
    S = u.shape[1]
    up = jnp.pad(u, ((0, 0), (width - 1, 0), (0, 0)))
    y = b
    for k in range(width):
        y = y + w[k] * up[:, k:k + S]
    return y


def nsa_mixer(x, pos, w_in, b_gate, pos_k, w1_k, w2_k, pos_v, w1_v, w2_v, w_out):
    B, S, _ = x.shape
    G, R, Dh = NSA_GROUPS, NSA_HPG, HEAD_DIM
    f32 = jnp.float32
    t = jnp.arange(S)
    split_at = [int(v) for v in np.cumsum([NSA_Q_COLS] + [NSA_KV_COLS] * 6)]
    q, kc, vc, ks, vs, kw, vw, gl = jnp.split(x @ w_in, split_at, axis=-1)
    q = rope(q.reshape(B, S, G, R, Dh), pos) * (Dh ** -0.5)
    kc = kc.reshape(B, S, G, Dh)
    vc = vc.reshape(B, S, G, Dh)
    ks = rope(ks.reshape(B, S, G, Dh), pos)
    vs = vs.reshape(B, S, G, Dh)
    kw = rope(kw.reshape(B, S, G, Dh), pos)
    vw = vw.reshape(B, S, G, Dh)
    gates = jax.nn.sigmoid(gl + b_gate).reshape(B, S, G, R, 3)

    n_cmp = (S - CMP_BLOCK) // CMP_STRIDE + 1
    cmp_start = np.arange(n_cmp) * CMP_STRIDE
    cmp_end = cmp_start + CMP_BLOCK - 1
    blk_idx = cmp_start[:, None] + np.arange(CMP_BLOCK)[None, :]

    def compress(tok, pe, w1, w2):
        blocks = tok[:, blk_idx] + pe[:, None, :]
        flat = blocks.transpose(0, 1, 3, 2, 4).reshape(B, n_cmp, G, CMP_BLOCK * Dh)
        return jax.nn.gelu(flat @ w1) @ w2

    k_cmp = rope(compress(kc, pos_k, w1_k, w2_k), pos[:, cmp_end])
    v_cmp = compress(vc, pos_v, w1_v, w2_v)
    s_cmp = jnp.einsum('bsgrd,bngd->bgrsn', q, k_cmp).astype(f32)
    p_cmp = masked_softmax(s_cmp, jnp.asarray(cmp_end)[None, :] <= t[:, None])
    o_cmp = jnp.einsum('bgrsn,bngd->bsgrd', p_cmp.astype(x.dtype), v_cmp)

    n_sel = S // SEL_BLOCK
    k_sel = min(SEL_TOP, n_sel)
    sel_start = np.arange(n_sel) * SEL_BLOCK
    overlap = jnp.asarray(((cmp_start[:, None] <= sel_start[None, :] + SEL_BLOCK - 1)
                           & (cmp_end[:, None] >= sel_start[None, :])).astype(np.float32))
    imp = jnp.einsum('bgrsn,nm->bgsm', p_cmp, overlap)
    blk_ar = jnp.arange(n_sel)
    rel = (t // SEL_BLOCK)[:, None] - blk_ar[None, :]
    imp = jnp.where(rel >= 0, imp, -1.0)
    forced = (blk_ar[None, :] == 0) | (rel == 0) | (rel == 1)
    imp = jnp.where(forced, FORCE_SCORE, imp)
    _, sel_idx = lax.top_k(imp, k_sel)

    ks_b = ks.reshape(B, n_sel, SEL_BLOCK, G, Dh).transpose(0, 3, 1, 2, 4)
    vs_b = vs.reshape(B, n_sel, SEL_BLOCK, G, Dh).transpose(0, 3, 1, 2, 4)
    n_qc = S // SEL_QCHUNK
    q_ch = q.reshape(B, n_qc, SEL_QCHUNK, G, R, Dh).swapaxes(0, 1)
    idx_ch = sel_idx.reshape(B, G, n_qc, SEL_QCHUNK, k_sel).transpose(2, 0, 1, 3, 4)
    t_ch = t.reshape(n_qc, SEL_QCHUNK)
    b_ar = jnp.arange(B)[:, None, None, None]
    g_ar = jnp.arange(G)[None, :, None, None]
    in_blk = jnp.arange(SEL_BLOCK)

    def sel_chunk(args):
        qc, ic, tc = args
        kg = ks_b[b_ar, g_ar, ic]
        vg = vs_b[b_ar, g_ar, ic]
        s = jnp.einsum('bqgrd,bgqkld->bgrqkl', qc, kg).astype(f32)
        key_pos = ic[..., None] * SEL_BLOCK + in_blk
        m = (key_pos <= tc[None, None, :, None, None])[:, :, None]
        p = masked_softmax(s.reshape(B, G, R, SEL_QCHUNK, -1), m.reshape(B, G, 1, SEL_QCHUNK, -1))
        return jnp.einsum('bgrqkl,bgqkld->bqgrd', p.reshape(s.shape).astype(x.dtype), vg)

    o_slc = lax.map(sel_chunk, (q_ch, idx_ch, t_ch)).swapaxes(0, 1).reshape(B, S, G, R, Dh)

    kw_p = jnp.pad(kw, ((0, 0), (WINDOW, 0), (0, 0), (0, 0)))
    vw_p = jnp.pad(vw, ((0, 0), (WINDOW, 0), (0, 0), (0, 0)))
    n_wb = S // WIN_QBLOCK
    q_wb = q.reshape(B, n_wb, WIN_QBLOCK, G, R, Dh).swapaxes(0, 1)
    span = WINDOW + WIN_QBLOCK

    def win_block(args):
        qb, blk = args
        start = blk * WIN_QBLOCK
        kb = lax.dynamic_slice_in_dim(kw_p, start, span, axis=1)
        vb = lax.dynamic_slice_in_dim(vw_p, start, span, axis=1)
        tq = start + jnp.arange(WIN_QBLOCK)
        tk = start - WINDOW + jnp.arange(span)
        d = tq[:, None] - tk[None, :]
        m = (d >= 0) & (d < WINDOW) & (tk[None, :] >= 0)
        s = jnp.einsum('bqgrd,bkgd->bgrqk', qb, kb).astype(f32)
        p = masked_softmax(s, m)
        return jnp.einsum('bgrqk,bkgd->bqgrd', p.astype(x.dtype), vb)

    o_win = lax.map(win_block, (q_wb, jnp.arange(n_wb))).swapaxes(0, 1).reshape(B, S, G, R, Dh)

    o = gates[..., 0:1] * o_cmp + gates[..., 1:2] * o_slc + gates[..., 2:3] * o_win
    return o.reshape(B, S, NSA_Q_COLS) @ w_out


def shortconv_mixer(x, w_in, conv_w, conv_b, w_out):
    u, bg, cg = jnp.split(x @ w_in, 3, axis=-1)
    z = causal_dwconv(cg * u, conv_w, conv_b)
    return (bg * z) @ w_out


def rglru_mixer(x, w_in, conv_w, conv_b, wa, ba, wx, bx, lam, w_out):
    B, S, _ = x.shape
    f32 = jnp.float32
    gate_br, rec = jnp.split(x @ w_in, 2, axis=-1)
    u = causal_dwconv(rec, conv_w, conv_b)
    ub = u.reshape(B, S, LRU_BLOCKS, LRU_BW)
    r = jax.nn.sigmoid(jnp.einsum('bshi,hij->bshj', ub, wa).reshape(B, S, LRU_WIDTH) + ba)
    ig = jax.nn.sigmoid(jnp.einsum('bshi,hij->bshj', ub, wx).reshape(B, S, LRU_WIDTH) + bx)
    log_a = LRU_C * r.astype(f32) * jax.nn.log_sigmoid(lam.astype(f32))
    a = jnp.exp(log_a)
    b_in = jnp.sqrt(-jnp.expm1(2.0 * log_a)) * (ig * u).astype(f32)

    def combine(c1, c2):
        a1, b1 = c1
        a2, b2 = c2
        return a1 * a2, a2 * b1 + b2

    _, h = lax.associative_scan(combine, (a, b_in), axis=1)
    y = jax.nn.gelu(gate_br) * h.astype(x.dtype)
    return y @ w_out


def moe_ffn(x, router_w, router_b, w_gate, w_up, w_down):
    B, S, D = x.shape
    f32 = jnp.float32
    xt = x.reshape(B * S, D)
    scores = jax.nn.sigmoid((xt @ router_w).astype(f32))
    biased = scores + router_b.astype(f32)
    grp = biased.reshape(-1, N_GROUPS, EXPERTS_PER_GROUP)
    grp_score = lax.top_k(grp, 2)[0].sum(-1)
    _, top_g = lax.top_k(grp_score, TOP_GROUPS)
    gmask = jax.nn.one_hot(top_g, N_GROUPS, dtype=f32).sum(-2) > 0
    emask = jnp.repeat(gmask, EXPERTS_PER_GROUP, axis=-1)
    _, top_e = lax.top_k(jnp.where(emask, biased, NEG_INF), TOP_K)
    w = jnp.take_along_axis(scores, top_e, axis=-1)
    w = w / w.sum(-1, keepdims=True)
    gate = (jax.nn.one_hot(top_e, N_EXPERTS, dtype=f32) * w[..., None]).sum(-2).astype(x.dtype)
    y = jnp.zeros_like(xt)
    for e in range(N_EXPERTS):
        hid = jax.nn.silu(xt @ w_gate[e]) * (xt @ w_up[e])
        y = y + gate[:, e:e + 1] * (hid @ w_down[e])
    return y.reshape(B, S, D)


def setup_inputs(seed: int = 0) -> dict:
    key = jax.random.key(seed)
    ks = jax.random.split(key, 40)
    f32 = jnp.float32

    def nrm(i, shape, scale):
        return jax.random.normal(ks[i], shape, f32) * scale

    D = D_MODEL
    x = nrm(0, (BATCH, SEQ, D), 1.0)
    offset = jax.random.randint(ks[1], (BATCH, 1), 0, 4096, dtype=jnp.int32)
    positions = offset + jnp.arange(SEQ, dtype=jnp.int32)[None, :]
    lru_u = jax.random.uniform(ks[24], (N_LRU, LRU_WIDTH), f32, minval=0.9, maxval=0.999)
    lru_s = lru_u ** (1.0 / LRU_C)
    return {
        'x': x,
        'positions': positions,
        'nsa_w_in': nrm(2, (N_NSA, D, NSA_IN_COLS), D ** -0.5),
        'nsa_b_gate': nrm(3, (N_NSA, 3 * NSA_HEADS), 0.1),
        'nsa_cmp_pos_k': nrm(4, (N_NSA, CMP_BLOCK, HEAD_DIM), 0.02),
        'nsa_cmp_w1_k': nrm(5, (N_NSA, CMP_BLOCK * HEAD_DIM, HEAD_DIM), (CMP_BLOCK * HEAD_DIM) ** -0.5),
        'nsa_cmp_w2_k': nrm(6, (N_NSA, HEAD_DIM, HEAD_DIM), HEAD_DIM ** -0.5),
        'nsa_cmp_pos_v': nrm(7, (N_NSA, CMP_BLOCK, HEAD_DIM), 0.02),
        'nsa_cmp_w1_v': nrm(8, (N_NSA, CMP_BLOCK * HEAD_DIM, HEAD_DIM), (CMP_BLOCK * HEAD_DIM) ** -0.5),
        'nsa_cmp_w2_v': nrm(9, (N_NSA, HEAD_DIM, HEAD_DIM), HEAD_DIM ** -0.5),
        'nsa_w_out': nrm(10, (N_NSA, NSA_Q_COLS, D), DN_BETA * NSA_Q_COLS ** -0.5),
        'sc_w_in': nrm(11, (N_SC, D, 3 * D), D ** -0.5),
        'sc_conv_w': nrm(12, (N_SC, SC_WIDTH, D), SC_WIDTH ** -0.5),
        'sc_conv_b': nrm(13, (N_SC, D), 0.01),
        'sc_w_out': nrm(14, (N_SC, D, D), DN_BETA * D ** -0.5),
        'lru_w_in': nrm(15, (N_LRU, D, 2 * LRU_WIDTH), D ** -0.5),
        'lru_conv_w': nrm(16, (N_LRU, LRU_CONV, LRU_WIDTH), LRU_CONV ** -0.5),
        'lru_conv_b': nrm(17, (N_LRU, LRU_WIDTH), 0.01),
        'lru_wa': nrm(18, (N_LRU, LRU_BLOCKS, LRU_BW, LRU_BW), LRU_BW ** -0.5),
        'lru_ba': nrm(19, (N_LRU, LRU_WIDTH), 0.1),
        'lru_wx': nrm(20, (N_LRU, LRU_BLOCKS, LRU_BW, LRU_BW), LRU_BW ** -0.5),
        'lru_bx': nrm(21, (N_LRU, LRU_WIDTH), 0.1),
        'lru_lambda': jnp.log(lru_s) - jnp.log1p(-lru_s),
        'lru_w_out': nrm(22, (N_LRU, LRU_WIDTH, D), DN_BETA * LRU_WIDTH ** -0.5),
        'router_w': nrm(25, (D, N_EXPERTS), D ** -0.5),
        'router_b': nrm(26, (N_EXPERTS,), 0.01),
        'moe_w_gate': nrm(27, (DEPTH, N_EXPERTS, D, D_FF), D ** -0.5),
        'moe_w_up': nrm(28, (DEPTH, N_EXPERTS, D, D_FF), D ** -0.5),
        'moe_w_down': nrm(29, (DEPTH, N_EXPERTS, D_FF, D), DN_BETA * D_FF ** -0.5),
        'ln_g': 1.0 + nrm(30, (DEPTH, 2, D), 0.02),
        'ln_b': nrm(31, (DEPTH, 2, D), 0.02),
    }


def reference(x, positions, nsa_w_in, nsa_b_gate, nsa_cmp_pos_k, nsa_cmp_w1_k, nsa_cmp_w2_k,
              nsa_cmp_pos_v, nsa_cmp_w1_v, nsa_cmp_w2_v, nsa_w_out, sc_w_in, sc_conv_w, sc_conv_b,
              sc_w_out, lru_w_in, lru_conv_w, lru_conv_b, lru_wa, lru_ba, lru_wx, lru_bx, lru_lambda,
              lru_w_out, router_w, router_b, moe_w_gate, moe_w_up, moe_w_down, ln_g, ln_b):
    for i in range(DEPTH):
        kind, j = i % N_MIXERS, i // N_MIXERS
        if kind == 0:
            m = nsa_mixer(x, positions, nsa_w_in[j], nsa_b_gate[j], nsa_cmp_pos_k[j], nsa_cmp_w1_k[j],
                          nsa_cmp_w2_k[j], nsa_cmp_pos_v[j], nsa_cmp_w1_v[j], nsa_cmp_w2_v[j], nsa_w_out[j])
        elif kind == 1:
            m = shortconv_mixer(x, sc_w_in[j], sc_conv_w[j], sc_conv_b[j], sc_w_out[j])
        else:
            m = rglru_mixer(x, lru_w_in[j], lru_conv_w[j], lru_conv_b[j], lru_wa[j], lru_ba[j],
                            lru_wx[j], lru_bx[j], lru_lambda[j], lru_w_out[j])
        x = layer_norm(DN_ALPHA * x + m, ln_g[i, 0], ln_b[i, 0])
        f = moe_ffn(x, router_w, router_b, moe_w_gate[i], moe_w_up[i], moe_w_down[i])
        x = layer_norm(DN_ALPHA * x + f, ln_g[i, 1], ln_b[i, 1])
    return x
```

```cpp
#include <hip/hip_runtime.h>
#include <stdint.h>
#include <stdio.h>

#define LAS __attribute__((address_space(3)))
typedef unsigned short bf16_t;
typedef short bf16x8 __attribute__((ext_vector_type(8)));
typedef float f32x4 __attribute__((ext_vector_type(4)));
typedef float f32x2 __attribute__((ext_vector_type(2)));
typedef unsigned u32x4 __attribute__((ext_vector_type(4)));
typedef unsigned u32x2 __attribute__((ext_vector_type(2)));
typedef int i32x8 __attribute__((ext_vector_type(8)));

constexpr int T_TOK = 65536, DM = 1024, SEQ = 2048, NBATCH = 32, DEPTH = 4;
constexpr int NTHR = 512;
constexpr int NSA_NP = 2816;
constexpr int LRU_W = 1280;
constexpr int NEXP = 16;
constexpr float DN_ALPHA = 1.6817928305074292f;
constexpr float LN_EPS = 1e-5f;
constexpr float NEGBIG = -1e30f;
constexpr float LOG2E = 1.4426950408889634f;

constexpr size_t KiB = 1024, MiB = 1024 * 1024;
constexpr size_t WS_CTL = 0;
constexpr size_t WS_ROUTE_E = 64 * KiB;
constexpr size_t WS_ROUTE_W = WS_ROUTE_E + 256 * KiB;
constexpr size_t WS_POS = WS_ROUTE_W + 512 * KiB;
constexpr size_t WS_CNT = WS_POS + 512 * KiB;
constexpr size_t WS_TILE = WS_CNT + 16 * KiB;
constexpr size_t WS_BIAS1 = WS_TILE + 16 * KiB;
constexpr size_t WS_INV = 1408 * KiB;
constexpr size_t WS_KCMP = 2 * MiB;
constexpr size_t WS_VCMPT = 4 * MiB;
constexpr size_t WS_CARRY = 6 * MiB;
constexpr size_t WS_GATES = 16 * MiB;
constexpr size_t WS_W = 28 * MiB;
constexpr size_t W_NSA_IN = WS_W;
constexpr size_t W_NSA_OUT = W_NSA_IN + 2 * (size_t)NSA_NP * 1024 * 2;
constexpr size_t W_SC_IN = W_NSA_OUT + 2 * (size_t)1024 * 1024 * 2;
constexpr size_t W_SC_OUT = W_SC_IN + (size_t)3072 * 1024 * 2;
constexpr size_t W_LRU_IN = W_SC_OUT + (size_t)1024 * 1024 * 2;
constexpr size_t W_LRU_G = W_LRU_IN + (size_t)2560 * 1024 * 2;
constexpr size_t W_LRU_OUT = W_LRU_G + (size_t)2560 * 1280 * 2;
constexpr size_t W_CMP1 = W_LRU_OUT + (size_t)1024 * 1280 * 2;
constexpr size_t W_END = W_CMP1 + 4 * (size_t)64 * 2048 * 2;
constexpr size_t WS_XA = 66 * MiB;
constexpr size_t WS_WMOE = WS_XA + 128 * MiB;
constexpr size_t WS_BIG = WS_WMOE + 96 * MiB;
constexpr size_t WS_END = WS_BIG + 642 * MiB;
static_assert(W_END <= WS_XA, "weights overflow");
constexpr size_t B_Q = WS_BIG, B_KC = B_Q + 128 * MiB, B_VC = B_KC + 32 * MiB, B_KS = B_VC + 32 * MiB, B_VST = B_KS + 32 * MiB, B_KW = B_VST + 32 * MiB,
                 B_VWT = B_KW + 32 * MiB, B_O = B_VWT + 32 * MiB;
constexpr size_t B_P = WS_BIG, B_BG = B_P + 128 * MiB, B_Y = B_BG + 128 * MiB;
constexpr size_t B_GG = WS_BIG, B_R1 = B_GG + 160 * MiB, B_R2 = B_R1 + 160 * MiB, B_R3 = B_R2 + 160 * MiB;
constexpr size_t B_MB = WS_BIG;
constexpr size_t B_XG = WS_BIG + 128 * MiB, B_HID = B_XG + 64 * MiB, B_YM = B_HID + 128 * MiB, B_WMOE = WS_WMOE;
constexpr size_t WMOE_GU = 0, WMOE_DN = (size_t)16 * 2048 * 1024;
constexpr float S8_X = 16.f, S8_WGU = 256.f, S8_H = 16.f, S8_WD = 512.f;

constexpr int LDS_BYTES = 163840;

__device__ __forceinline__ unsigned cvt_pk_bf16(float lo, float hi) { unsigned r; asm volatile("v_cvt_pk_bf16_f32 %0, %1, %2" : "=v"(r) : "v"(lo), "v"(hi)); return r; }
__device__ __forceinline__ float bf_lo(unsigned u) { return __uint_as_float(u << 16); }
__device__ __forceinline__ float bf_hi(unsigned u) { return __uint_as_float(u & 0xffff0000u); }
__device__ __forceinline__ float bf2f(bf16_t h) { return __uint_as_float(((unsigned)h) << 16); }
__device__ __forceinline__ bf16_t f2bf(float f) { return (bf16_t)(cvt_pk_bf16(f, 0.f) & 0xffffu); }
__device__ __forceinline__ float fast_exp2(float x) { return __builtin_amdgcn_exp2f(x); }
__device__ __forceinline__ float fast_exp(float x) { return __builtin_amdgcn_exp2f(x * LOG2E); }
__device__ __forceinline__ float fast_rcp(float x) { return __builtin_amdgcn_rcpf(x); }
__device__ __forceinline__ float sigmoidf_(float x) { return fast_rcp(1.f + fast_exp(-x)); }
__device__ __forceinline__ float gelu_tanh(float x) { const float u = 0.7978845608028654f * (x + 0.044715f * x * x * x); return x * fast_rcp(1.f + fast_exp(-2.f * u)); }
__device__ __forceinline__ float silu_(float x) { return x * fast_rcp(1.f + fast_exp(-x)); }
__device__ __forceinline__ void sincos_rad(float ang, float& s, float& c) {
    float r = ang * 0.15915494309189535f; r = __builtin_amdgcn_fractf(r); s = __builtin_amdgcn_sinf(r); c = __builtin_amdgcn_cosf(r); }
__device__ __forceinline__ float wave_sum(float v) {
#pragma unroll
    for (int o = 32; o >= 1; o >>= 1) v += __shfl_xor(v, o);
    return v; }
template <int CTRL> __device__ __forceinline__ float dpp_mov(float v) { return __builtin_bit_cast(float, __builtin_amdgcn_update_dpp(0, __builtin_bit_cast(int, v), CTRL, 0xf, 0xf, false)); }
template <int CTRL> __device__ __forceinline__ unsigned dpp_movu(unsigned v) { return (unsigned)__builtin_amdgcn_update_dpp(0, (int)v, CTRL, 0xf, 0xf, false); }
__device__ __forceinline__ float row16_sum(float v) { v += dpp_mov<0xB1>(v); v += dpp_mov<0x4E>(v); v += dpp_mov<0x141>(v); v += dpp_mov<0x140>(v); return v; }
__device__ __forceinline__ float wave_sum_dpp(float v) { v = row16_sum(v); v += __shfl_xor(v, 16); v += __shfl_xor(v, 32); return v; }
__device__ __forceinline__ int tid_opaque() { int t = threadIdx.x; asm volatile("" : "+v"(t)); return t; }
__device__ __forceinline__ u32x4 ld16(const void* p) { return *(const u32x4*)p; }
__device__ __forceinline__ void st16(void* p, u32x4 v) { *(u32x4*)p = v; }

#define XB_TMO      128
#define XB_XCNT(j)  (256  + 64 * (j))
#define XB_XSUB(j)  (1280 + 64 * (j))
#define XB_XGEN(j)  (2304 + 64 * (j))
#define XB_TOP      3328
#define XB_TOPGEN   3392
#define XCD_BAR_WORDS 3456
#define XB_SPIN_CAP (1u << 22)
__device__ __forceinline__ unsigned xb_ld(unsigned* p)              { return __hip_atomic_load(p, __ATOMIC_RELAXED, __HIP_MEMORY_SCOPE_AGENT); }
__device__ __forceinline__ unsigned xb_add(unsigned* p, unsigned v) { return __hip_atomic_fetch_add(p, v, __ATOMIC_RELAXED, __HIP_MEMORY_SCOPE_AGENT); }
__device__ __forceinline__ unsigned xb_xcc_id() { return (unsigned)__builtin_amdgcn_s_getreg((3 << 11) | 20) & 0xFu; }
#define XB_SPIN(cond, bar) do { unsigned _sp = 0; while (cond) { __builtin_amdgcn_s_sleep(1); \
    if ((++_sp & 255u) == 0u) { if (xb_ld(&(bar)[XB_TMO])) break; if (_sp > XB_SPIN_CAP) { atomicAdd(&(bar)[XB_TMO], 1u); break; } } } } while (0)
struct XcdBarrier { unsigned* bar; unsigned x; volatile LAS unsigned* st; };
__device__ __forceinline__ XcdBarrier xcd_barrier_post(unsigned* bar, volatile LAS unsigned* st) {
    XcdBarrier b; b.bar = bar; b.x = xb_xcc_id(); b.st = st;
    if (threadIdx.x == 0) (void)xb_add(&bar[XB_XCNT(b.x)], 1u);
    return b;
}
__device__ __forceinline__ void xcd_barrier_complete(unsigned* bar, unsigned x, unsigned& nloc, unsigned& nx) {
    const unsigned G = gridDim.x * gridDim.y * gridDim.z;
    unsigned sum, cnt, mine, sp = 0u;
    for (;;) {
        sum = 0u; cnt = 0u; mine = 0u;
#pragma unroll
        for (unsigned j = 0; j < 16; ++j) { const unsigned c = xb_ld(&bar[XB_XCNT(j)]); sum += c; cnt += (c > 0u) ? 1u : 0u; mine = (j == x) ? c : mine; }
        if (sum == G) break;
        __builtin_amdgcn_s_sleep(1);
        if ((++sp & 255u) == 0u) { if (xb_ld(&bar[XB_TMO])) break; if (sp > XB_SPIN_CAP) { atomicAdd(&bar[XB_TMO], 1u); break; } }
    }
    nloc = mine > 0u ? mine : 1u; nx = cnt > 0u ? cnt : 1u;
}
__device__ __forceinline__ void xcd_barrier(const XcdBarrier& b) {
    asm volatile("s_waitcnt vmcnt(0)" ::: "memory");
    __syncthreads();
    if (threadIdx.x == 0) {
        unsigned* bar = b.bar;
        __builtin_amdgcn_s_waitcnt(0);
        unsigned nloc = b.st[0], nx = b.st[1];
        if (nloc == 0u) { xcd_barrier_complete(bar, b.x, nloc, nx); b.st[0] = nloc; b.st[1] = nx; }
        const unsigned old = xb_add(&bar[XB_XSUB(b.x)], 1u);
        const unsigned gen = old / nloc;
        if (old + 1u == (gen + 1u) * nloc) {
            __builtin_amdgcn_fence(__ATOMIC_RELEASE, "agent");
            asm volatile("s_waitcnt vmcnt(0)" ::: "memory");
            const unsigned og = xb_add(&bar[XB_TOP], 1u);
            const unsigned tg = og / nx;
            if (og + 1u == (tg + 1u) * nx) xb_add(&bar[XB_TOPGEN], 1u);
            else XB_SPIN(xb_ld(&bar[XB_TOPGEN]) == tg, bar);
            __builtin_amdgcn_fence(__ATOMIC_ACQUIRE, "agent");
            xb_add(&bar[XB_XGEN(b.x)], 1u);
            asm volatile("s_waitcnt vmcnt(0)" ::: "memory");
        } else {
            XB_SPIN(xb_ld(&bar[XB_XGEN(b.x)]) == gen, bar);
            __builtin_amdgcn_fence(__ATOMIC_ACQUIRE, "agent");
            asm volatile("s_waitcnt vmcnt(0)" ::: "memory");
        }
    }
    __syncthreads();
}

constexpr int BM = 256, BK = 64, HALF = 128, HTB = HALF * BK * 2, STAGE_BYTES = 8 * HTB, NXCD = 8, WGM = 8;
__host__ __device__ __forceinline__ int lds_byte(int r, int c) { const int st = (r >> 4) * 2 + (c >> 5), rr = r & 15, cc = c & 31, ob = rr * 64 + cc * 2; return st * 1024 + (ob ^ (((ob >> 9) & 1) << 5)); }
__host__ __device__ __forceinline__ void stage_rc(int b, int& R, int& C) { const int st = b / 1024, sb = b % 1024, swz = sb ^ (((sb >> 9) & 1) << 5); R = (st >> 1) * 16 + swz / 64; C = (st & 1) * 32 + (swz % 64) / 2; }

struct GUnit { const char* a; const char* b; int pn; int row0; int nrows; int aux; };
__device__ __forceinline__ void map_unit(int L, int nM, int nN, int& pm, int& pn) {
    const int nwg = nM * nN; int wgid = L;
    { const int q = nwg / NXCD, r = nwg % NXCD, xcd = wgid % NXCD, off = wgid / NXCD; wgid = (xcd < r ? xcd * (q + 1) : r * (q + 1) + (xcd - r) * q) + off; }
    const int nig = WGM * nN, gid = wgid / nig, fm = gid * WGM, gsz = (nM - fm) < WGM ? (nM - fm) : WGM;
    pm = fm + ((wgid % nig) % gsz); pn = (wgid % nig) / gsz;
}
struct DenseSched {
    const bf16_t* A; const bf16_t* Bt; int lda, K, nM, nN, G, c;
    __device__ __forceinline__ bool next(int i, GUnit& u) const {
        const long L = (long)i * G + c; if (L >= (long)nM * nN) return false;
        int pm, pn; map_unit((int)L, nM, nN, pm, pn);
        u.a = (const char*)(A + (size_t)pm * BM * lda); u.b = (const char*)(Bt + (size_t)pn * BM * K); u.pn = pn; u.row0 = pm * BM; u.nrows = BM; u.aux = 0; return true;
    }
};
struct BandSched {
    const bf16_t* A; const bf16_t* Bt; int lda, ldb, nM, nN, G, c;
    __device__ __forceinline__ bool next(int i, GUnit& u) const {
        const long L = (long)i * G + c; if (L >= (long)nM * nN) return false;
        int pm, pn; map_unit((int)L, nM, nN, pm, pn);
        int k0 = ((128 * pn / 80) * 80 / 64) * 64; k0 = k0 > ldb - 384 ? ldb - 384 : k0;
        u.a = (const char*)(A + (size_t)pm * BM * lda + k0); u.b = (const char*)(Bt + (size_t)pn * BM * ldb + k0); u.pn = pn; u.row0 = pm * BM; u.nrows = BM; u.aux = 0; return true;
    }
};
struct MoeSched {
    const unsigned char* A; const unsigned char* W; const int4* tiles; const int* inv; int NT, nN, N, K, G, c;
    __device__ __forceinline__ bool next(int i, GUnit& u) const {
        const long L = (long)i * G + c; if (L >= (long)NT * nN) return false;
        int pm, pn; map_unit((int)L, NT, nN, pm, pn);
        const int4 t = tiles[1 + pm];
        const int e = __builtin_amdgcn_readfirstlane(t.x), r0 = __builtin_amdgcn_readfirstlane(t.y), nr = __builtin_amdgcn_readfirstlane(t.z);
        u.a = (const char*)(A + (size_t)r0 * K); u.b = (const char*)(W + ((size_t)e * N + (size_t)pn * BM) * K); u.pn = pn; u.row0 = r0; u.nrows = nr; u.aux = e; return true;
    }
};

template <bool F8, bool GATHER = false, class Epi, class Sched>
__device__ __forceinline__ void gemm_phase(LAS unsigned char* lds, const int K  , const int lda, const int ldb  , const Sched& S, const Epi& E) {
    const int tid = tid_opaque(), wid = __builtin_amdgcn_readfirstlane(tid >> 6), lane = tid & 63, wr = wid >> 2, wc = wid & 3, fr = lane & 15, fq = lane >> 4;
    const int nt = F8 ? K / 128 : K / BK;
    unsigned voffA[2], voffB[2];
#pragma unroll
    for (int i = 0; i < 2; ++i) { int R, C; stage_rc(tid * 16 + i * 8192, R, C); voffA[i] = F8 ? (unsigned)(R * lda + 2 * C) : (unsigned)(R * lda + C) * 2u; voffB[i] = F8 ? (unsigned)(R * ldb + 2 * C) : (unsigned)(R * ldb + C) * 2u; }
    int gR[2]; unsigned gC[2]; unsigned vc[2][2], vn[2][2];
#pragma unroll
    for (int i = 0; i < 2; ++i) { int R, C; stage_rc(tid * 16 + i * 8192, R, C); gR[i] = R; gC[i] = 2u * (unsigned)C; }
#define PG8_GLOAD(dst, unit) do { if constexpr (GATHER) { _Pragma("unroll") for (int _h = 0; _h < 2; ++_h) _Pragma("unroll") for (int _i = 0; _i < 2; ++_i) \
        dst[_h][_i] = (unsigned)S.inv[(unit).row0 + _h * HALF + gR[_i]] * (unsigned)lda + gC[_i]; } } while (0)
#define PG8_STAGE_A(bufoff, h, kofs, unext) do { if constexpr (GATHER) { _Pragma("unroll") for (int _i = 0; _i < 2; ++_i) \
        __builtin_amdgcn_global_load_lds((const unsigned*)((const char*)S.A + (kofs) + ((unext) ? vn[h][_i] : vc[h][_i])), (LAS unsigned*)(lds + (bufoff) + ldsw + _i * 8192), 16, 0, 0); } \
        else PG8_STAGE(bufoff, ((unext) ? nA : cA) + (h) * hstepA + (kofs), voffA); } while (0)
    const size_t kstep = (size_t)(BK * 2);
    const size_t hstepA = (size_t)HALF * lda * (F8 ? 1 : 2), hstepB = (size_t)HALF * ldb * (F8 ? 1 : 2);
    const unsigned ldsw = (unsigned)wid * 1024u;
    const int aoff = lds_byte(wr * 64 + fr, fq * 8), boff = lds_byte(wc * 32 + fr, fq * 8);
    const LAS unsigned char* ldsA = lds + aoff; const LAS unsigned char* ldsB = lds + 65536 + boff;
#define PG8_SA(b, h) (((b) * 2 + (h)) * HTB)
#define PG8_SB(b, h) ((4 + (b) * 2 + (h)) * HTB)
#define PG8_STAGE(bufoff, gbase, voff) do { _Pragma("unroll") for (int _i = 0; _i < 2; ++_i) \
        __builtin_amdgcn_global_load_lds((const unsigned*)((const char*)(gbase) + (voff)[_i]), (LAS unsigned*)(lds + (bufoff) + ldsw + _i * 8192), 16, 0, 0); } while (0)
#define PG8_LD16(off) (*(const LAS u32x4*)(lds + (off)))
#define PG8_LDA16(off) (*(const LAS u32x4*)(ldsA + (off)))
#define PG8_LDB16(off) (*(const LAS u32x4*)(ldsB + (off)))
#define PG8_LDA(dst, b, h) do { _Pragma("unroll") for (int m = 0; m < 4; ++m) { \
        if constexpr (F8) dst##8[m] = __builtin_shufflevector(PG8_LDA16(PG8_SA(b, h) + m * 2048), PG8_LDA16(PG8_SA(b, h) + m * 2048 + 1024), 0, 1, 2, 3, 4, 5, 6, 7); \
        else { _Pragma("unroll") for (int k = 0; k < 2; ++k) dst[m][k] = *(const LAS bf16x8*)(lds + PG8_SA(b, h) + aoff + m * 2048 + k * 1024); } } } while (0)
#define PG8_LDB(dst, b, h) do { _Pragma("unroll") for (int n = 0; n < 2; ++n) { \
        if constexpr (F8) dst##8[n] = __builtin_shufflevector(PG8_LDB16(PG8_SB(b, h) - 65536 + n * 2048), PG8_LDB16(PG8_SB(b, h) - 65536 + n * 2048 + 1024), 0, 1, 2, 3, 4, 5, 6, 7); \
        else { _Pragma("unroll") for (int k = 0; k < 2; ++k) dst[n][k] = *(const LAS bf16x8*)(lds + PG8_SB(b, h) + boff + n * 2048 + k * 1024); } } } while (0)
#define PG8_MMA(ai, bj, At, Bt) do { __builtin_amdgcn_s_setprio(1); _Pragma("unroll") for (int m = 0; m < 4; ++m) _Pragma("unroll") for (int n = 0; n < 2; ++n) { \
        if constexpr (F8) asm("v_mfma_f32_16x16x128_f8f6f4 %0, %1, %2, %0" : "+v"(acc[ai][bj][m][n]) : "v"(Bt##8[n]), "v"(At##8[m])); \
        else { _Pragma("unroll") for (int k = 0; k < 2; ++k) acc[ai][bj][m][n] = __builtin_amdgcn_mfma_f32_16x16x32_bf16(Bt[n][k], At[m][k], acc[ai][bj][m][n], 0, 0, 0); } } \
        __builtin_amdgcn_s_setprio(0); } while (0)
#define PG8_WAIT_V(n) asm volatile("s_waitcnt vmcnt(" #n ")" ::: "memory")
#define PG8_WAIT_L(n) asm volatile("s_waitcnt lgkmcnt(" #n ")" ::: "memory")
#define PG8_BAR __builtin_amdgcn_s_barrier()
#define PG8_SCHED __builtin_amdgcn_sched_barrier(0)
    GUnit cur, nxt; int ui = 0;
    if (!S.next(0, cur)) return;
    f32x4 acc[2][2][4][2];
#pragma unroll
    for (int a = 0; a < 2; ++a)
#pragma unroll
        for (int b = 0; b < 2; ++b)
#pragma unroll
            for (int m = 0; m < 4; ++m)
#pragma unroll
                for (int n = 0; n < 2; ++n) acc[a][b][m][n] = (f32x4){0.f, 0.f, 0.f, 0.f};
    bf16x8 At[4][2], B0[2][2], B1[2][2];
    typedef unsigned u32x8 __attribute__((ext_vector_type(8)));
    u32x8 At8[4], B08[2], B18[2];
    const char* cA = cur.a; const char* cB = cur.b; const char* nA = cA;
    PG8_GLOAD(vc, cur);
    PG8_STAGE(PG8_SB(0, 0), cB, voffB); PG8_STAGE_A(PG8_SA(0, 0), 0, (size_t)0, false); PG8_STAGE(PG8_SB(0, 1), cB + hstepB, voffB); PG8_STAGE_A(PG8_SA(0, 1), 1, (size_t)0, false);
    if (wr == 1) PG8_BAR;
    PG8_WAIT_V(4); PG8_BAR;
    PG8_STAGE(PG8_SB(1, 0), cB + kstep, voffB); PG8_STAGE_A(PG8_SA(1, 0), 0, kstep, false); PG8_STAGE(PG8_SB(1, 1), cB + hstepB + kstep, voffB);
    PG8_WAIT_V(6); PG8_BAR;
    for (;;) {
        const bool has_next = S.next(ui + 1, nxt);
        nA = has_next ? nxt.a : cA; const char* nB = has_next ? nxt.b : cB;
        if (has_next) PG8_GLOAD(vn, nxt); else { _Pragma("unroll") for (int _h = 0; _h < 2; ++_h) _Pragma("unroll") for (int _i = 0; _i < 2; ++_i) vn[_h][_i] = vc[_h][_i]; }
#pragma unroll 1
        for (int t = 0; t < nt; t += 2) {
            const bool last = (t == nt - 2);
            const size_t ka1 = (size_t)(t + 1) * kstep, ka2 = last ? (size_t)0 : (size_t)(t + 2) * kstep, ka3 = ka2 + kstep;
            const char* b2 = last ? nB : cB + (size_t)(t + 2) * kstep;
            const char* b3 = b2 + kstep;
            PG8_LDB(B0, 0, 0); PG8_SCHED; PG8_LDA(At, 0, 0); PG8_STAGE_A(PG8_SA(1, 1), 1, ka1, false);
            PG8_WAIT_L(8); PG8_BAR; PG8_WAIT_L(0); PG8_MMA(0, 0, At, B0); PG8_BAR; PG8_SCHED;
            PG8_LDB(B1, 0, 1); PG8_STAGE(PG8_SB(0, 0), b2, voffB);
            PG8_BAR; PG8_WAIT_L(0); PG8_MMA(0, 1, At, B1); PG8_BAR;
            PG8_LDA(At, 0, 1); PG8_STAGE_A(PG8_SA(0, 0), 0, ka2, last);
            PG8_BAR; PG8_WAIT_L(0); PG8_MMA(1, 0, At, B0); PG8_BAR; PG8_SCHED;
            PG8_STAGE(PG8_SB(0, 1), b2 + hstepB, voffB);
            PG8_WAIT_V(6); PG8_BAR; PG8_MMA(1, 1, At, B1); PG8_BAR;
            PG8_LDB(B0, 1, 0); PG8_SCHED; PG8_LDA(At, 1, 0); PG8_STAGE_A(PG8_SA(0, 1), 1, ka2, last);
            PG8_WAIT_L(8); PG8_BAR; PG8_WAIT_L(0); PG8_MMA(0, 0, At, B0); PG8_BAR; PG8_SCHED;
            PG8_LDB(B1, 1, 1); PG8_STAGE(PG8_SB(1, 0), b3, voffB);
            PG8_BAR; PG8_WAIT_L(0); PG8_MMA(0, 1, At, B1); PG8_BAR;
            PG8_LDA(At, 1, 1); PG8_STAGE_A(PG8_SA(1, 0), 0, ka3, last);
            PG8_BAR; PG8_WAIT_L(0); PG8_MMA(1, 0, At, B0); PG8_BAR; PG8_SCHED;
            PG8_STAGE(PG8_SB(1, 1), b3 + hstepB, voffB);
            PG8_WAIT_V(6); PG8_BAR; PG8_MMA(1, 1, At, B1); PG8_BAR;
        }
        if constexpr (F8) asm volatile("s_nop 15\n\ts_nop 15" ::: "memory");
        E(acc, cur, wr, wc, fr, fq);
        if (!has_next) break;
#pragma unroll
        for (int a = 0; a < 2; ++a)
#pragma unroll
            for (int b = 0; b < 2; ++b)
#pragma unroll
                for (int m = 0; m < 4; ++m)
#pragma unroll
                    for (int n = 0; n < 2; ++n) acc[a][b][m][n] = (f32x4){0.f, 0.f, 0.f, 0.f};
        cur = nxt; cA = nA; cB = nB; ++ui;
#pragma unroll
        for (int _h = 0; _h < 2; ++_h)
#pragma unroll
            for (int _i = 0; _i < 2; ++_i) vc[_h][_i] = vn[_h][_i];
    }
    PG8_WAIT_V(0);
    if (wr == 0) PG8_BAR;
    PG8_BAR;
#undef PG8_SA
#undef PG8_SB
#undef PG8_STAGE
#undef PG8_STAGE_A
#undef PG8_GLOAD
#undef PG8_LDA
#undef PG8_LDB
#undef PG8_MMA
#undef PG8_LD16
#undef PG8_LDA16
#undef PG8_LDB16
#undef PG8_WAIT_V
#undef PG8_WAIT_L
#undef PG8_BAR
#undef PG8_SCHED
}
typedef f32x4 acc_t[2][2][4][2];
__device__ __forceinline__ u32x4 pack8(f32x4 a, f32x4 b) { return (u32x4){cvt_pk_bf16(a[0], a[1]), cvt_pk_bf16(a[2], a[3]), cvt_pk_bf16(b[0], b[1]), cvt_pk_bf16(b[2], b[3])}; }
__device__ __forceinline__ void unpack8(u32x4 v, float* f) { f[0] = bf_lo(v[0]); f[1] = bf_hi(v[0]); f[2] = bf_lo(v[1]); f[3] = bf_hi(v[1]); f[4] = bf_lo(v[2]); f[5] = bf_hi(v[2]); f[6] = bf_lo(v[3]); f[7] = bf_hi(v[3]); }

template <bool MASK> struct EpiPlain {
    bf16_t* O; int ldo; float scale;
    __device__ __forceinline__ void operator()(const acc_t& acc, const GUnit& u, int wr, int wc, int fr, int fq) const {
        const int colb = u.pn * 256 + wc * 32 + fq * 8;
#pragma unroll
        for (int ai = 0; ai < 2; ++ai)
#pragma unroll
            for (int m = 0; m < 4; ++m) {
                const int r = ai * 128 + wr * 64 + m * 16 + fr;
                if (MASK && r >= u.nrows) continue;
                bf16_t* rowp = O + (size_t)(u.row0 + r) * ldo + colb;
#pragma unroll
                for (int bj = 0; bj < 2; ++bj) st16(rowp + bj * 128, pack8(acc[ai][bj][m][0] * scale, acc[ai][bj][m][1] * scale));
            }
    }
};

struct EpiResid {
    float* XF; const float* XR;
    __device__ __forceinline__ void operator()(const acc_t& acc, const GUnit& u, int wr, int wc, int fr, int fq) const {
        const int colb = u.pn * 256 + wc * 32 + fq * 8;
#pragma unroll
        for (int ai = 0; ai < 2; ++ai)
#pragma unroll
            for (int m = 0; m < 4; ++m) {
                const int r = ai * 128 + wr * 64 + m * 16 + fr;
                float* rowp = XF + (size_t)(u.row0 + r) * 1024 + colb; const float* rrow = XR + (size_t)(u.row0 + r) * 1024 + colb;
                asm volatile("" ::: "memory");
#pragma unroll
                for (int bj = 0; bj < 2; ++bj) {
                    const f32x4 x0 = *(const f32x4*)(rrow + bj * 128), x1 = *(const f32x4*)(rrow + bj * 128 + 4);
                    *(f32x4*)(rowp + bj * 128) = x0 * DN_ALPHA + acc[ai][bj][m][0]; *(f32x4*)(rowp + bj * 128 + 4) = x1 * DN_ALPHA + acc[ai][bj][m][1];
                }
            }
    }
};

__device__ __forceinline__ float clamp8(float x) { return __builtin_amdgcn_fmed3f(x, -448.f, 448.f); }
__device__ __forceinline__ u32x2 pack8_fp8(const float* f) {
    unsigned a = 0u, b = 0u;
    a = __builtin_amdgcn_cvt_pk_fp8_f32(clamp8(f[0]), clamp8(f[1]), a, false); a = __builtin_amdgcn_cvt_pk_fp8_f32(clamp8(f[2]), clamp8(f[3]), a, true);
    b = __builtin_amdgcn_cvt_pk_fp8_f32(clamp8(f[4]), clamp8(f[5]), b, false); b = __builtin_amdgcn_cvt_pk_fp8_f32(clamp8(f[6]), clamp8(f[7]), b, true);
    return (u32x2){a, b};
}
struct EpiMoeGU {
    unsigned char* O;
    __device__ __forceinline__ void operator()(const acc_t& acc, const GUnit& u, int wr, int wc, int fr, int fq) const {
        const int colb = u.pn * 128 + wc * 32 + fq * 8;
#pragma unroll
        for (int ai = 0; ai < 2; ++ai)
#pragma unroll
            for (int m = 0; m < 4; ++m) {
                const int r = ai * 128 + wr * 64 + m * 16 + fr;
                if (r >= u.nrows) continue;
                float h[8];
                constexpr float DS = 1.f / (S8_X * S8_WGU);
#pragma unroll
                for (int bj = 0; bj < 2; ++bj)
#pragma unroll
                    for (int jj = 0; jj < 4; ++jj) h[bj * 4 + jj] = silu_(acc[ai][bj][m][0][jj] * DS) * (acc[ai][bj][m][1][jj] * (DS * S8_H));
                *(u32x2*)(O + (size_t)(u.row0 + r) * 1024 + colb) = pack8_fp8(h);
            }
    }
};

struct EpiScIn {
    bf16_t* P; bf16_t* BG;
    __device__ __forceinline__ void operator()(const acc_t& acc, const GUnit& u, int wr, int wc, int fr, int fq) const {
        if (u.pn < 8) {
            const int colb = u.pn * 128 + wc * 32 + fq * 8;
#pragma unroll
            for (int ai = 0; ai < 2; ++ai)
#pragma unroll
                for (int m = 0; m < 4; ++m) {
                    const int r = ai * 128 + wr * 64 + m * 16 + fr;
                    st16(P + (size_t)(u.row0 + r) * 1024 + colb, pack8(acc[ai][0][m][0] * acc[ai][0][m][1], acc[ai][1][m][0] * acc[ai][1][m][1]));
                }
        } else {
            const int colb = (u.pn - 8) * 256 + wc * 32 + fq * 8;
#pragma unroll
            for (int ai = 0; ai < 2; ++ai)
#pragma unroll
                for (int m = 0; m < 4; ++m) {
                    const int r = ai * 128 + wr * 64 + m * 16 + fr;
                    bf16_t* rowp = BG + (size_t)(u.row0 + r) * 1024 + colb;
#pragma unroll
                    for (int bj = 0; bj < 2; ++bj) st16(rowp + bj * 128, pack8(acc[ai][bj][m][0], acc[ai][bj][m][1]));
                }
        }
    }
};

struct EpiLruIn {
    bf16_t* GG; bf16_t* REC;
    __device__ __forceinline__ void operator()(const acc_t& acc, const GUnit& u, int wr, int wc, int fr, int fq) const {
        const bool isg = u.pn < 5;
        bf16_t* O = GG + (isg ? 0l : (REC - GG));
        const int colb = (isg ? u.pn : u.pn - 5) * 256 + wc * 32 + fq * 8;
#pragma unroll
        for (int ai = 0; ai < 2; ++ai)
#pragma unroll
            for (int m = 0; m < 4; ++m) {
                const int r = ai * 128 + wr * 64 + m * 16 + fr;
                bf16_t* rowp = O + (size_t)(u.row0 + r) * LRU_W + colb;
#pragma unroll
                for (int bj = 0; bj < 2; ++bj) {
                    f32x4 v0 = acc[ai][bj][m][0], v1 = acc[ai][bj][m][1];
                    if (isg) {
#pragma unroll
                        for (int jj = 0; jj < 4; ++jj) { v0[jj] = gelu_tanh(v0[jj]); v1[jj] = gelu_tanh(v1[jj]); }
                    }
                    st16(rowp + bj * 128, pack8(v0, v1));
                }
            }
    }
};

struct EpiLruGate {
    const bf16_t* U; bf16_t* LOGA; bf16_t* BIN; const float* ba; const float* bx; const float* lam;
    __device__ __forceinline__ void operator()(const acc_t& acc, const GUnit& u, int wr, int wc, int fr, int fq) const {
        const int ch0 = u.pn * 128 + wc * 32 + fq * 8;
        float ba8[8], bx8[8], ls8[8];
#pragma unroll
        for (int i = 0; i < 8; ++i) { ba8[i] = ba[ch0 + i]; bx8[i] = bx[ch0 + i]; const float l = lam[ch0 + i]; ls8[i] = -8.f * log1pf(__expf(-l)); }
#pragma unroll
        for (int ai = 0; ai < 2; ++ai)
#pragma unroll
            for (int m = 0; m < 4; ++m) {
                const int r = ai * 128 + wr * 64 + m * 16 + fr;
                const size_t off = (size_t)(u.row0 + r) * LRU_W + ch0;
                float u8[8]; unpack8(ld16(U + off), u8);
                f32x4 la[2], bi[2];
#pragma unroll
                for (int bj = 0; bj < 2; ++bj)
#pragma unroll
                    for (int jj = 0; jj < 4; ++jj) {
                        const int i = bj * 4 + jj;
                        const float rg = sigmoidf_(acc[ai][bj][m][0][jj] + ba8[i]);
                        const float ig = sigmoidf_(acc[ai][bj][m][1][jj] + bx8[i]);
                        const float l = rg * ls8[i];
                        const float om = fmaxf(1.f - fast_exp(2.f * l), 0.f);
                        la[bj][jj] = l; bi[bj][jj] = __builtin_sqrtf(om) * ig * u8[i];
                    }
                st16(LOGA + off, pack8(la[0], la[1]));
                st16(BIN + off, pack8(bi[0], bi[1]));
            }
    }
};

struct EpiNsaIn {
    bf16_t* Q; bf16_t* KC; bf16_t* VC; bf16_t* KS; bf16_t* VST; bf16_t* KW; bf16_t* VWT; float* GATES; const int* pos; const float* bgate;
    __device__ __forceinline__ void operator()(const acc_t& acc, const GUnit& u, int wr, int wc, int fr, int fq) const {
        const int pn = u.pn;
        if (pn <= 3 || pn == 6 || pn == 8) {
            bf16_t* O = Q + (pn <= 3 ? 0l : (pn == 6 ? (KS - Q) : (KW - Q)));
            const int ldo = pn <= 3 ? 1024 : 256;
            const int colbase = pn <= 3 ? pn * 256 : 0;
            const float scale = pn <= 3 ? 0.125f * LOG2E : 1.f;
            float invf[4];
#pragma unroll
            for (int jj = 0; jj < 4; ++jj) invf[jj] = exp2f(-(float)(16 * (wc & 1) + 4 * fq + jj) * (13.287712379549449f / 32.f));
#pragma unroll
            for (int ai = 0; ai < 2; ++ai)
#pragma unroll
                for (int m = 0; m < 4; ++m) {
                    const int row = u.row0 + ai * 128 + wr * 64 + m * 16 + fr;
                    const float p = (float)pos[row];
                    float sn[4], cs[4];
#pragma unroll
                    for (int jj = 0; jj < 4; ++jj) sincos_rad(p * invf[jj], sn[jj], cs[jj]);
#pragma unroll
                    for (int bj = 0; bj < 2; ++bj) {
                        const f32x4 x1 = acc[ai][bj][m][0], x2 = acc[ai][bj][m][1];
                        float o1[4], o2[4];
#pragma unroll
                        for (int jj = 0; jj < 4; ++jj) { o1[jj] = (x1[jj] * cs[jj] - x2[jj] * sn[jj]) * scale; o2[jj] = (x1[jj] * sn[jj] + x2[jj] * cs[jj]) * scale; }
                        bf16_t* p1 = O + (size_t)row * ldo + colbase + 64 * (2 * bj + (wc >> 1)) + 16 * (wc & 1) + 4 * fq;
                        *(u32x2*)p1 = (u32x2){cvt_pk_bf16(o1[0], o1[1]), cvt_pk_bf16(o1[2], o1[3])};
                        *(u32x2*)(p1 + 32) = (u32x2){cvt_pk_bf16(o2[0], o2[1]), cvt_pk_bf16(o2[2], o2[3])};
                    }
                }
        } else if (pn == 4 || pn == 5) {
            bf16_t* O = KC + (pn == 4 ? 0l : (VC - KC));
            const int colb = wc * 32 + fq * 8;
#pragma unroll
            for (int ai = 0; ai < 2; ++ai)
#pragma unroll
                for (int m = 0; m < 4; ++m) {
                    const int row = u.row0 + ai * 128 + wr * 64 + m * 16 + fr;
#pragma unroll
                    for (int bj = 0; bj < 2; ++bj) st16(O + (size_t)row * 256 + colb + bj * 128, pack8(acc[ai][bj][m][0], acc[ai][bj][m][1]));
                }
        } else if (pn == 7 || pn == 9) {
            bf16_t* O = VST + (pn == 7 ? 0l : (VWT - VST));
#pragma unroll
            for (int ai = 0; ai < 2; ++ai)
#pragma unroll
                for (int m = 0; m < 4; ++m) {
                    const int row = u.row0 + ai * 128 + wr * 64 + m * 16 + fr;
                    const int b = row >> 11, s = row & 2047;
#pragma unroll
                    for (int bj = 0; bj < 2; ++bj) {
                        const int g = 2 * bj + (wc >> 1);
                        bf16_t* base = O + ((size_t)(b * 4 + g) * 64 + 32 * (wc & 1) + 8 * fq) * SEQ + s;
#pragma unroll
                        for (int n = 0; n < 2; ++n)
#pragma unroll
                            for (int jj = 0; jj < 4; ++jj) base[(size_t)(4 * n + jj) * SEQ] = f2bf(acc[ai][bj][m][n][jj]);
                    }
                }
        } else {
            if (wc < 2 && (wc == 0 || fq < 2)) {
                const int c0 = 32 * wc + 8 * fq;
                f32x4 bg[2];
#pragma unroll
                for (int n = 0; n < 2; ++n) bg[n] = *(const f32x4*)(bgate + c0 + 4 * n);
#pragma unroll
                for (int ai = 0; ai < 2; ++ai)
#pragma unroll
                    for (int m = 0; m < 4; ++m) {
                        const int row = u.row0 + ai * 128 + wr * 64 + m * 16 + fr;
#pragma unroll
                        for (int n = 0; n < 2; ++n) {
                            f32x4 v;
#pragma unroll
                            for (int jj = 0; jj < 4; ++jj) v[jj] = sigmoidf_(acc[ai][0][m][n][jj] + bg[n][jj]);
                            *(f32x4*)(GATES + (size_t)row * 48 + c0 + 4 * n) = v;
                        }
                    }
            }
        }
    }
};
__device__ __forceinline__ int map_plain8(int cc) { const int bj = cc >> 7, wc = (cc >> 5) & 3, n = (cc >> 4) & 1, fq = (cc >> 2) & 3; return 128 * bj + 32 * wc + 8 * fq + 4 * n; }
__device__ __forceinline__ int map_rope(int cc) { const int bj = cc >> 7, wc = (cc >> 5) & 3, n = (cc >> 4) & 1, fq = (cc >> 2) & 3; return 64 * (2 * bj + (wc >> 1)) + 32 * n + 16 * (wc & 1) + 4 * fq; }
__device__ __forceinline__ void map_pair(int cc, int& n, int& ch) { const int bj = cc >> 7, wc = (cc >> 5) & 3, fq = (cc >> 2) & 3; n = (cc >> 4) & 1; ch = 32 * wc + 8 * fq + 4 * bj; }
constexpr f32x4 F4ZERO = {0.f, 0.f, 0.f, 0.f};

struct FetchNsaIn { const float* W;
    __device__ __forceinline__ f32x4 operator()(int, int c4, int k) const { const int pn = c4 >> 8, cc = c4 & 255; const bool rope = (pn <= 3 || pn == 6 || pn == 8);
        const int col = pn * 256 + (rope ? map_rope(cc) : map_plain8(cc)); if (col >= 2608) return F4ZERO; return *(const f32x4*)(W + (size_t)k * 2608 + col); } };
struct FetchPlain { const float* W; int ld; size_t bstride;
    __device__ __forceinline__ f32x4 operator()(int bt, int c4, int k) const { const int col = (c4 & ~255) + map_plain8(c4 & 255); return *(const f32x4*)(W + (size_t)bt * bstride + (size_t)k * ld + col); } };
struct FetchPair { const float* W0; long d01; int ld; size_t bstride;
    __device__ __forceinline__ f32x4 operator()(int bt, int c4, int k) const { int n, ch; map_pair(c4 & 255, n, ch); ch += (c4 >> 8) * 128; return *(const f32x4*)(W0 + (n ? d01 : 0l) + (long)((size_t)bt * bstride + (size_t)k * ld + ch)); } };
struct FetchScIn { const float* W;
    __device__ __forceinline__ f32x4 operator()(int, int c4, int k) const { const int pn = c4 >> 8, cc = c4 & 255;
        if (pn < 8) { int n, ch; map_pair(cc, n, ch); ch += pn * 128; return *(const f32x4*)(W + (size_t)k * 3072 + (n ? 2048 : 0) + ch); }
        return *(const f32x4*)(W + (size_t)k * 3072 + 1024 + (pn - 8) * 256 + map_plain8(cc)); } };
struct FetchLruGate { const float* wa; long dax;
    __device__ __forceinline__ f32x4 operator()(int, int c4, int k) const { int n, ch; map_pair(c4 & 255, n, ch); ch += (c4 >> 8) * 128; const int h = ch / 80; if (k / 80 != h) return F4ZERO;
        return *(const f32x4*)(wa + (n ? dax : 0l) + (long)(h * 6400 + (k - 80 * h) * 80 + (ch - 80 * h))); } };
struct FetchIdent { const float* W; int ld; size_t bstride;
    __device__ __forceinline__ f32x4 operator()(int bt, int c4, int k) const { return *(const f32x4*)(W + (size_t)bt * bstride + (size_t)k * ld + c4); } };

template <bool OUT8 = false, class F>
__device__ __forceinline__ void convert_wt(LAS unsigned char* lds, void* dstv, int nbatch, int Nd, int K, const F& fetch, const float scale = 1.f) {
    constexpr int GRP = 4;
    LAS float* tile = (LAS float*)lds;
    const int tid = tid_opaque();
    const int ntk = K / 64, ntc = Nd / 64, per = ntc * ntk, total = per * nbatch;
    const bool split = (Nd & 255) == 0;
    const int c4i = tid & 15, kk = tid >> 4, rr4 = 4 * c4i, row = tid >> 3, k8 = (tid & 7) * 8;
    for (int t0 = blockIdx.x * GRP; t0 < total; t0 += gridDim.x * GRP) {
        f32x4 v[GRP][2];
#pragma unroll
        for (int gi = 0; gi < GRP; ++gi) {
            const int t = t0 + gi;
            if (t < total) {
                const int bt = t / per, tt = t - bt * per, tc = tt / ntk, tk = tt - tc * ntk, k0 = tk * 64;
                const int cbase = split ? (tc >> 2) * 256 + (tc & 3) * 32 : tc * 64;
                const int crow4 = cbase + (split ? ((rr4 & 31) + (rr4 >> 5) * 128) : rr4);
#pragma unroll
                for (int p = 0; p < 2; ++p) v[gi][p] = fetch(bt, crow4, k0 + kk + 32 * p);
            }
        }
        __syncthreads();
#pragma unroll
        for (int gi = 0; gi < GRP; ++gi)
            if (t0 + gi < total) {
#pragma unroll
                for (int p = 0; p < 2; ++p)
#pragma unroll
                    for (int j = 0; j < 4; ++j) tile[gi * 4160 + (4 * c4i + j) * 65 + kk + 32 * p] = v[gi][p][j];
            }
        __syncthreads();
#pragma unroll
        for (int gi = 0; gi < GRP; ++gi) {
            const int t = t0 + gi;
            if (t < total) {
                const int bt = t / per, tt = t - bt * per, tc = tt / ntk, tk = tt - tc * ntk, k0 = tk * 64;
                const int cbase = split ? (tc >> 2) * 256 + (tc & 3) * 32 : tc * 64;
                const int crow = cbase + (split ? ((row & 31) + (row >> 5) * 128) : row);
                float f[8];
#pragma unroll
                for (int i = 0; i < 8; ++i) f[i] = tile[gi * 4160 + row * 65 + k8 + i];
                if constexpr (OUT8) {
#pragma unroll
                    for (int i = 0; i < 8; ++i) f[i] *= scale;
                    *(u32x2*)((unsigned char*)dstv + ((size_t)bt * Nd + crow) * K + k0 + k8) = pack8_fp8(f);
                } else st16((bf16_t*)dstv + ((size_t)bt * Nd + crow) * K + k0 + k8, (u32x4){cvt_pk_bf16(f[0], f[1]), cvt_pk_bf16(f[2], f[3]), cvt_pk_bf16(f[4], f[5]), cvt_pk_bf16(f[6], f[7])});
            }
        }
    }
    __syncthreads();
}

__device__ __forceinline__ void convert_x(const float* x, bf16_t* XA) {
    const size_t n8 = (size_t)T_TOK * DM / 8;
    const int tidx = tid_opaque();
    for (size_t i = (size_t)blockIdx.x * NTHR + tidx; i < n8; i += (size_t)gridDim.x * NTHR) {
        const f32x4 a = *(const f32x4*)(x + i * 8), b = *(const f32x4*)(x + i * 8 + 4);
        st16(XA + i * 8, pack8(a, b));
    }
}
__device__ __forceinline__ void cmp_bias_phase(LAS unsigned char* lds, const float* pek, const float* w1k, const float* pev, const float* w1v, float* bias1) {
    LAS float* red = (LAS float*)lds;
    const int tidx = tid_opaque();
    for (int blk = blockIdx.x; blk < 32; blk += gridDim.x) {
        const int v = blk >> 3, j = v >> 1, kv = v & 1, hid = (blk & 7) * 8 + (tidx & 7), part = tidx >> 3;
        const float* pe = pek + (kv ? (pev - pek) : 0l) + j * 2048; const float* w1 = w1k + (kv ? (w1v - w1k) : 0l) + (size_t)j * 2048 * 64;
        float s = 0.f;
#pragma unroll 8
        for (int i = part * 32; i < part * 32 + 32; ++i) s += pe[i] * w1[i * 64 + hid];
        __syncthreads();
        red[part * 8 + (tidx & 7)] = s;
        __syncthreads();
        if (tidx < 8) { float t = 0.f; for (int q = 0; q < 64; ++q) t += red[q * 8 + tidx]; bias1[v * 64 + (blk & 7) * 8 + tidx] = t; }
    }
    __syncthreads();
}

__device__ __forceinline__ void ln1_router_phase(LAS unsigned char* lds, const float* XF, const bf16_t* MBm, float* XW, unsigned char* X8, const float* gam, const float* bet,
                                                 const float* rw, const float* rb, int* route_e, float* route_w, int* cnt) {
    LAS f32x4* rwl = (LAS f32x4*)lds;
    LAS int* lcnt = (LAS int*)(lds + 65536);
    const int tid = tid_opaque(), lane = tid & 63, w = tid >> 6;
    __syncthreads();
    for (int i = tid; i < 4096; i += NTHR) { const int col = i >> 2, q = i & 3; const int seg = col >> 9, ln = (col >> 3) & 63, j = col & 7;
        rwl[((q * 2 + seg) * 8 + j) * 64 + ln] = *(const f32x4*)(rw + col * 16 + 4 * q); }
    for (int chunk = blockIdx.x; chunk < 256; chunk += gridDim.x) {
        __syncthreads();
        if (tid < 16) lcnt[tid] = 0;
        __syncthreads();
        const size_t row0 = (size_t)chunk * 256 + w * 32;
        f32x4 nx[2][4]; u32x4 nm[2][2];
#pragma unroll
        for (int rr = 0; rr < 2; ++rr)
#pragma unroll
            for (int sg = 0; sg < 2; ++sg) { nx[rr][sg * 2] = *(const f32x4*)(XF + (row0 + rr) * DM + sg * 512 + lane * 8); nx[rr][sg * 2 + 1] = *(const f32x4*)(XF + (row0 + rr) * DM + sg * 512 + lane * 8 + 4);
                nm[rr][sg] = ld16(MBm + (row0 + rr) * DM + sg * 512 + lane * 8); }
        for (int i = 0; i < 32; i += 2) {
            f32x2 y2[16];
            {
                float xv[2][16];
#pragma unroll
                for (int rr = 0; rr < 2; ++rr) {
#pragma unroll
                    for (int sg = 0; sg < 2; ++sg) { float mv[8]; unpack8(nm[rr][sg], mv);
#pragma unroll
                        for (int j = 0; j < 4; ++j) { xv[rr][sg * 8 + j] = DN_ALPHA * nx[rr][sg * 2][j] + mv[j]; xv[rr][sg * 8 + 4 + j] = DN_ALPHA * nx[rr][sg * 2 + 1][j] + mv[4 + j]; } }
                }
                if (i + 2 < 32) {
#pragma unroll
                    for (int rr = 0; rr < 2; ++rr)
#pragma unroll
                        for (int sg = 0; sg < 2; ++sg) { nx[rr][sg * 2] = *(const f32x4*)(XF + (row0 + i + 2 + rr) * DM + sg * 512 + lane * 8); nx[rr][sg * 2 + 1] = *(const f32x4*)(XF + (row0 + i + 2 + rr) * DM + sg * 512 + lane * 8 + 4);
                            nm[rr][sg] = ld16(MBm + (row0 + i + 2 + rr) * DM + sg * 512 + lane * 8); }
                }
                float mean[2], rstd[2];
#pragma unroll
                for (int rr = 0; rr < 2; ++rr) { float s = 0.f;
#pragma unroll
                    for (int j = 0; j < 16; ++j) s += xv[rr][j];
                    mean[rr] = wave_sum_dpp(s) * (1.f / 1024.f); }
#pragma unroll
                for (int rr = 0; rr < 2; ++rr) { float q = 0.f;
#pragma unroll
                    for (int j = 0; j < 16; ++j) { const float d = xv[rr][j] - mean[rr]; q += d * d; }
                    rstd[rr] = rsqrtf(wave_sum_dpp(q) * (1.f / 1024.f) + LN_EPS); }
#pragma unroll
                for (int sg = 0; sg < 2; ++sg) {
                    const f32x4 ga = *(const f32x4*)(gam + sg * 512 + lane * 8), gb = *(const f32x4*)(gam + sg * 512 + lane * 8 + 4);
                    const f32x4 ba = *(const f32x4*)(bet + sg * 512 + lane * 8), bb = *(const f32x4*)(bet + sg * 512 + lane * 8 + 4);
#pragma unroll
                    for (int rr = 0; rr < 2; ++rr) {
                        f32x4 o0, o1;
#pragma unroll
                        for (int j = 0; j < 4; ++j) { o0[j] = (xv[rr][sg * 8 + j] - mean[rr]) * rstd[rr] * ga[j] + ba[j]; o1[j] = (xv[rr][sg * 8 + 4 + j] - mean[rr]) * rstd[rr] * gb[j] + bb[j];
                            y2[sg * 8 + j][rr] = o0[j]; y2[sg * 8 + 4 + j][rr] = o1[j]; }
                        *(f32x4*)(XW + (row0 + i + rr) * DM + sg * 512 + lane * 8) = o0; *(f32x4*)(XW + (row0 + i + rr) * DM + sg * 512 + lane * 8 + 4) = o1;
                        { const f32x4 a8 = o0 * S8_X, b8 = o1 * S8_X; const float f8[8] = {a8[0], a8[1], a8[2], a8[3], b8[0], b8[1], b8[2], b8[3]};
                          *(u32x2*)(X8 + (row0 + i + rr) * DM + sg * 512 + lane * 8) = pack8_fp8(f8); }
                    }
                }
            }
            f32x2 lg2[16];
#pragma unroll
            for (int e = 0; e < 16; ++e) lg2[e] = (f32x2){0.f, 0.f};
#pragma unroll
            for (int sg = 0; sg < 2; ++sg)
#pragma unroll
                for (int j = 0; j < 8; ++j) {
                    if ((j & 1) == 0) __builtin_amdgcn_sched_barrier(0);
#pragma unroll
                    for (int q = 0; q < 4; ++q) {
                        const f32x4 wv = rwl[((q * 2 + sg) * 8 + j) * 64 + lane];
#pragma unroll
                        for (int e = 0; e < 4; ++e) lg2[q * 4 + e] += y2[sg * 8 + j] * (f32x2){wv[e], wv[e]};
                    }
                }
#pragma unroll
            for (int rr = 0; rr < 2; ++rr) {
                float sc[16], bi[16];
#pragma unroll
                for (int e = 0; e < 16; ++e) { const float l = wave_sum_dpp(lg2[e][rr]); sc[e] = 1.f / (1.f + __expf(-l)); bi[e] = sc[e] + rb[e]; }
                float gs[4];
#pragma unroll
                for (int g = 0; g < 4; ++g) { const float a = bi[4 * g], b = bi[4 * g + 1], c = bi[4 * g + 2], d = bi[4 * g + 3];
                    gs[g] = fmaxf(fmaxf(fmaxf(a + b, a + c), fmaxf(a + d, b + c)), fmaxf(b + d, c + d)); }
                int bg = 0; float bgs = gs[0];
#pragma unroll
                for (int g = 1; g < 4; ++g) if (gs[g] > bgs) { bgs = gs[g]; bg = g; }
                float vb[4], vs[4];
#pragma unroll
                for (int k = 0; k < 4; ++k) { vb[k] = bg == 0 ? bi[k] : (bg == 1 ? bi[4 + k] : (bg == 2 ? bi[8 + k] : bi[12 + k])); vs[k] = bg == 0 ? sc[k] : (bg == 1 ? sc[4 + k] : (bg == 2 ? sc[8 + k] : sc[12 + k])); }
                int i1 = 0; float b1 = vb[0], s1 = vs[0];
#pragma unroll
                for (int k = 1; k < 4; ++k) if (vb[k] > b1) { b1 = vb[k]; s1 = vs[k]; i1 = k; }
                int i2 = -1; float b2 = -3e38f, s2 = 0.f;
#pragma unroll
                for (int k = 0; k < 4; ++k) if (k != i1 && vb[k] > b2) { b2 = vb[k]; s2 = vs[k]; i2 = k; }
                const float inv = 1.f / (s1 + s2);
                if (lane == 0) {
                    const size_t row = row0 + i + rr;
                    const int e0 = bg * 4 + i1, e1 = bg * 4 + i2;
                    route_e[row] = e0 | (e1 << 8); route_w[row * 2] = s1 * inv; route_w[row * 2 + 1] = s2 * inv;
                    atomicAdd((int*)&lcnt[e0], 1); atomicAdd((int*)&lcnt[e1], 1);
                }
            }
        }
        __syncthreads();
        if (tid < 16) cnt[chunk * 16 + tid] = lcnt[tid];
    }
    __syncthreads();
}

__device__ __forceinline__ void moe_gather_phase(LAS unsigned char* lds, const int* route_e, const int* cnt, int* pos_out, int* inv, int4* tiles) {
    LAS int* s_tot = (LAS int*)lds; LAS int* s_pre = s_tot + 16; LAS int* s_off = s_pre + 16; LAS int* s_wcnt = s_off + 16; LAS int* s_lpos = s_wcnt + 128;
    const int tid = tid_opaque(), lane = tid & 63, w = tid >> 6;
    for (int chunk = blockIdx.x; chunk < 256; chunk += gridDim.x) {
        __syncthreads();
        { const int e = tid >> 5, j = tid & 31; int tot = 0, pre = 0;
            for (int c = j; c < 256; c += 32) { const int v = cnt[c * 16 + e]; tot += v; pre += (c < chunk) ? v : 0; }
#pragma unroll
            for (int o = 16; o >= 1; o >>= 1) { tot += __shfl_xor(tot, o); pre += __shfl_xor(pre, o); }
            if (j == 0) { s_tot[e] = tot; s_pre[e] = pre; } }
        __syncthreads();
        if (tid == 0) { int off = 0; for (int e = 0; e < 16; ++e) { s_off[e] = off; off += s_tot[e]; } }
        const int token = chunk * 256 + (tid >> 1), slot = tid & 1;
        const int re = route_e[token]; const int e = slot ? ((re >> 8) & 255) : (re & 255);
        int rk = 0;
#pragma unroll
        for (int e2 = 0; e2 < 16; ++e2) { const unsigned long long mk = __ballot(e == e2); if (e == e2) rk = __popcll(mk & ((1ull << lane) - 1ull)); if (lane == 0) s_wcnt[w * 16 + e2] = __popcll(mk); }
        __syncthreads();
        int base = s_off[e] + s_pre[e];
        for (int w2 = 0; w2 < w; ++w2) base += s_wcnt[w2 * 16 + e];
        const int p = base + rk;
        pos_out[token * 2 + slot] = p; inv[p] = token;
        if (chunk == 0 && tid == 0) {
            int nt = 0;
            for (int e2 = 0; e2 < 16; ++e2) { const int n = s_tot[e2]; for (int r = 0; r < n; r += 256) { tiles[1 + nt] = make_int4(e2, s_off[e2] + r, (n - r) < 256 ? (n - r) : 256, 0); ++nt; } }
            tiles[0] = make_int4(nt, 0, 0, 0);
        }
        if (chunk == 0 && tid < 256) inv[2 * T_TOK + tid] = 0;
    }
    __syncthreads();
}

template <bool LAST>
__device__ __forceinline__ void ln2_combine_phase(const float* XF, float* XW, const bf16_t* YM, const int* pos, const float* route_w, const float* gam, const float* bet, bf16_t* XO) {
    const int tid = tid_opaque(), lane = tid & 63, w = tid >> 6;
    float gm[16], bt[16];
#pragma unroll
    for (int s = 0; s < 2; ++s)
#pragma unroll
        for (int j = 0; j < 8; ++j) { gm[s * 8 + j] = gam[s * 512 + lane * 8 + j]; bt[s * 8 + j] = bet[s * 512 + lane * 8 + j]; }
    const size_t rstep = (size_t)gridDim.x * 8;
    int np0 = 0, np1 = 0; float nw0 = 0.f, nw1 = 0.f;
    { const size_t r0 = (size_t)blockIdx.x * 8 + w; if (r0 < (size_t)T_TOK) { np0 = pos[r0 * 2]; np1 = pos[r0 * 2 + 1]; nw0 = route_w[r0 * 2]; nw1 = route_w[r0 * 2 + 1]; } }
    for (size_t row = (size_t)blockIdx.x * 8 + w; row < (size_t)T_TOK; row += rstep) {
        const int p0 = np0, p1 = np1; const float w0 = nw0, w1 = nw1;
        { const size_t rn = row + rstep; if (rn < (size_t)T_TOK) { np0 = pos[rn * 2]; np1 = pos[rn * 2 + 1]; nw0 = route_w[rn * 2]; nw1 = route_w[rn * 2 + 1]; } }
        float xv[16], a[16], b[16];
#pragma unroll
        for (int sg = 0; sg < 2; ++sg) { const f32x4 c = *(const f32x4*)(XF + row * DM + sg * 512 + lane * 8), d = *(const f32x4*)(XF + row * DM + sg * 512 + lane * 8 + 4);
#pragma unroll
            for (int j = 0; j < 4; ++j) { xv[sg * 8 + j] = c[j]; xv[sg * 8 + 4 + j] = d[j]; } }
        unpack8(ld16(YM + (size_t)p0 * DM + lane * 8), a); unpack8(ld16(YM + (size_t)p0 * DM + 512 + lane * 8), a + 8);
        unpack8(ld16(YM + (size_t)p1 * DM + lane * 8), b); unpack8(ld16(YM + (size_t)p1 * DM + 512 + lane * 8), b + 8);
        float s = 0.f;
#pragma unroll
        for (int j = 0; j < 16; ++j) { xv[j] = DN_ALPHA * xv[j] + (w0 * a[j] + w1 * b[j]); s += xv[j]; }
        const float mean = wave_sum_dpp(s) * (1.f / 1024.f);
        float q = 0.f;
#pragma unroll
        for (int j = 0; j < 16; ++j) { const float d = xv[j] - mean; q += d * d; }
        const float rstd = rsqrtf(wave_sum_dpp(q) * (1.f / 1024.f) + LN_EPS);
        float y[16];
#pragma unroll
        for (int j = 0; j < 16; ++j) y[j] = (xv[j] - mean) * rstd * gm[j] + bt[j];
        float* outf = XW;
        *(f32x4*)(outf + row * DM + lane * 8) = (f32x4){y[0], y[1], y[2], y[3]}; *(f32x4*)(outf + row * DM + lane * 8 + 4) = (f32x4){y[4], y[5], y[6], y[7]};
        *(f32x4*)(outf + row * DM + 512 + lane * 8) = (f32x4){y[8], y[9], y[10], y[11]}; *(f32x4*)(outf + row * DM + 512 + lane * 8 + 4) = (f32x4){y[12], y[13], y[14], y[15]};
        if (!LAST) {
            st16(XO + row * DM + lane * 8, (u32x4){cvt_pk_bf16(y[0], y[1]), cvt_pk_bf16(y[2], y[3]), cvt_pk_bf16(y[4], y[5]), cvt_pk_bf16(y[6], y[7])});
            st16(XO + row * DM + 512 + lane * 8, (u32x4){cvt_pk_bf16(y[8], y[9]), cvt_pk_bf16(y[10], y[11]), cvt_pk_bf16(y[12], y[13]), cvt_pk_bf16(y[14], y[15])});
        }
    }
}

__device__ __forceinline__ void sc_conv_phase(const bf16_t* P, const bf16_t* BG, bf16_t* Y, const float* cw, const float* cb) {
    const int items = (T_TOK / 16) * 128; const int tidx = tid_opaque();
    for (int it = blockIdx.x * NTHR + tidx; it < items; it += gridDim.x * NTHR) {
        const int cg = it & 127, run = it >> 7, c0 = cg * 8; const size_t t0 = (size_t)run * 16; const int s = (int)(t0 & 2047);
        float w0[8], w1[8], w2[8], b8[8];
#pragma unroll
        for (int j = 0; j < 8; ++j) { w0[j] = cw[c0 + j]; w1[j] = cw[1024 + c0 + j]; w2[j] = cw[2048 + c0 + j]; b8[j] = cb[c0 + j]; }
        float pm2[8], pm1[8];
        if (s == 0) {
#pragma unroll
            for (int j = 0; j < 8; ++j) { pm2[j] = 0.f; pm1[j] = 0.f; }
        } else { unpack8(ld16(P + (t0 - 2) * DM + c0), pm2); unpack8(ld16(P + (t0 - 1) * DM + c0), pm1); }
#pragma unroll 4
        for (int i = 0; i < 16; ++i) {
            float cur[8], bg[8], y[8];
            unpack8(ld16(P + (t0 + i) * DM + c0), cur); unpack8(ld16(BG + (t0 + i) * DM + c0), bg);
#pragma unroll
            for (int j = 0; j < 8; ++j) { y[j] = bg[j] * (b8[j] + w0[j] * pm2[j] + w1[j] * pm1[j] + w2[j] * cur[j]); pm2[j] = pm1[j]; pm1[j] = cur[j]; }
            st16(Y + (t0 + i) * DM + c0, (u32x4){cvt_pk_bf16(y[0], y[1]), cvt_pk_bf16(y[2], y[3]), cvt_pk_bf16(y[4], y[5]), cvt_pk_bf16(y[6], y[7])});
        }
    }
}
__device__ __forceinline__ void lru_conv_phase(const bf16_t* REC, bf16_t* U, const float* cw, const float* cb) {
    const int items = (T_TOK / 16) * 160; const int tidx = tid_opaque();
    for (int it = blockIdx.x * NTHR + tidx; it < items; it += gridDim.x * NTHR) {
        const int cg = it % 160, run = it / 160, c0 = cg * 8; const size_t t0 = (size_t)run * 16; const int s = (int)(t0 & 2047);
        float w0[8], w1[8], w2[8], w3[8], b8[8];
#pragma unroll
        for (int j = 0; j < 8; ++j) { w0[j] = cw[c0 + j]; w1[j] = cw[LRU_W + c0 + j]; w2[j] = cw[2 * LRU_W + c0 + j]; w3[j] = cw[3 * LRU_W + c0 + j]; b8[j] = cb[c0 + j]; }
        float p3[8], p2[8], p1[8];
        if (s == 0) {
#pragma unroll
            for (int j = 0; j < 8; ++j) { p3[j] = 0.f; p2[j] = 0.f; p1[j] = 0.f; }
        } else { unpack8(ld16(REC + (t0 - 3) * LRU_W + c0), p3); unpack8(ld16(REC + (t0 - 2) * LRU_W + c0), p2); unpack8(ld16(REC + (t0 - 1) * LRU_W + c0), p1); }
#pragma unroll 4
        for (int i = 0; i < 16; ++i) {
            float cur[8], y[8];
            unpack8(ld16(REC + (t0 + i) * LRU_W + c0), cur);
#pragma unroll
            for (int j = 0; j < 8; ++j) { y[j] = b8[j] + w0[j] * p3[j] + w1[j] * p2[j] + w2[j] * p1[j] + w3[j] * cur[j]; p3[j] = p2[j]; p2[j] = p1[j]; p1[j] = cur[j]; }
            st16(U + (t0 + i) * LRU_W + c0, (u32x4){cvt_pk_bf16(y[0], y[1]), cvt_pk_bf16(y[2], y[3]), cvt_pk_bf16(y[4], y[5]), cvt_pk_bf16(y[6], y[7])});
        }
    }
}

__device__ __forceinline__ void lru_scan1_phase(const bf16_t* LOGA, const bf16_t* BIN, f32x4* carry) {
    const int tidx = tid_opaque(); const int lane = tidx & 63, w = tidx >> 6;
    for (int it = blockIdx.x * 8 + w; it < 10240; it += gridDim.x * 8) {
        const int cgp = it % 10, ck = (it / 10) & 31, b = it / 320, ch = cgp * 128 + lane * 2;
        const size_t base = ((size_t)b * SEQ + ck * 64) * LRU_W + ch;
        float h0 = 0.f, h1 = 0.f, s0 = 0.f, s1 = 0.f;
#pragma unroll 8
        for (int t = 0; t < 64; ++t) {
            const unsigned la = *(const unsigned*)(LOGA + base + (size_t)t * LRU_W), bi = *(const unsigned*)(BIN + base + (size_t)t * LRU_W);
            const float l0 = bf_lo(la), l1 = bf_hi(la);
            h0 = fast_exp(l0) * h0 + bf_lo(bi); h1 = fast_exp(l1) * h1 + bf_hi(bi); s0 += l0; s1 += l1;
        }
        carry[(((size_t)b * 32 + ck) * LRU_W + ch) >> 1] = (f32x4){s0, h0, s1, h1};
    }
}
__device__ __forceinline__ void lru_scan2_phase(const bf16_t* LOGA, const bf16_t* BIN, const bf16_t* GG, const f32x4* carry, bf16_t* Y) {
    const int tidx = tid_opaque(); const int lane = tidx & 63, w = tidx >> 6;
    for (int it = blockIdx.x * 8 + w; it < 10240; it += gridDim.x * 8) {
        const int cgp = it % 10, ck = (it / 10) & 31, b = it / 320, ch = cgp * 128 + lane * 2;
        float h0 = 0.f, h1 = 0.f;
        for (int c2 = 0; c2 < ck; ++c2) { const f32x4 cv = carry[(((size_t)b * 32 + c2) * LRU_W + ch) >> 1]; h0 = fast_exp(cv[0]) * h0 + cv[1]; h1 = fast_exp(cv[2]) * h1 + cv[3]; }
        const size_t base = ((size_t)b * SEQ + ck * 64) * LRU_W + ch;
#pragma unroll 8
        for (int t = 0; t < 64; ++t) {
            const unsigned la = *(const unsigned*)(LOGA + base + (size_t)t * LRU_W), bi = *(const unsigned*)(BIN + base + (size_t)t * LRU_W), gg = *(const unsigned*)(GG + base + (size_t)t * LRU_W);
            h0 = fast_exp(bf_lo(la)) * h0 + bf_lo(bi); h1 = fast_exp(bf_hi(la)) * h1 + bf_hi(bi);
            *(unsigned*)(Y + base + (size_t)t * LRU_W) = cvt_pk_bf16(bf_lo(gg) * h0, bf_hi(gg) * h1);
        }
    }
}
__device__ __forceinline__ bf16x8 pack8s(const float* f) {
    const unsigned a = cvt_pk_bf16(f[0], f[1]), b = cvt_pk_bf16(f[2], f[3]), c = cvt_pk_bf16(f[4], f[5]), d = cvt_pk_bf16(f[6], f[7]);
    u32x4 v = {a, b, c, d}; return __builtin_bit_cast(bf16x8, v);
}
__device__ __forceinline__ void nsa_compress_phase(const bf16_t* KC, const bf16_t* VC, const bf16_t* W1T, const float* w2k, const float* w2v, const float* bias1,
                                                   const int* pos, bf16_t* KCMP, bf16_t* VCMPT) {
    const int tidx = tid_opaque(); const int lane = tidx & 63, w = tidx >> 6, rowi = lane & 15, gq = lane >> 4;
    for (int task = blockIdx.x * 8 + w; task < 2048; task += gridDim.x * 8) {
        const int kv = task >> 10, tt = task & 1023, rho = tt * 16 + rowi, b = rho >> 9, n = (rho >> 2) & 127, g = rho & 3;
        const bf16_t* src = KC + (kv ? (VC - KC) : 0l) + (size_t)b * SEQ * 256 + g * 64 + 8 * gq;
        const bf16_t* w1t = W1T + (size_t)kv * 64 * 2048 + (size_t)rowi * 2048 + 8 * gq;
        f32x4 hacc[4];
#pragma unroll
        for (int ht = 0; ht < 4; ++ht) hacc[ht] = (f32x4){0.f, 0.f, 0.f, 0.f};
#pragma unroll 4
        for (int kk = 0; kk < 64; ++kk) {
            int tok = 16 * n + (kk >> 1); tok = tok > 2047 ? 2047 : tok;
            const bf16x8 af = *(const bf16x8*)(src + (size_t)tok * 256 + 32 * (kk & 1));
#pragma unroll
            for (int ht = 0; ht < 4; ++ht) { const bf16x8 wf = *(const bf16x8*)(w1t + (size_t)(16 * ht) * 2048 + kk * 32); hacc[ht] = __builtin_amdgcn_mfma_f32_16x16x32_bf16(wf, af, hacc[ht], 0, 0, 0); }
        }
        bf16x8 pf[2];
#pragma unroll
        for (int p = 0; p < 2; ++p) { float hv[8];
#pragma unroll
            for (int jj = 0; jj < 4; ++jj) { hv[jj] = gelu_tanh(hacc[2 * p][jj] + bias1[kv * 64 + 32 * p + 4 * gq + jj]); hv[4 + jj] = gelu_tanh(hacc[2 * p + 1][jj] + bias1[kv * 64 + 32 * p + 16 + 4 * gq + jj]); }
            pf[p] = pack8s(hv); }
        const float* w2 = w2k + (kv ? (w2v - w2k) : 0l);
        f32x4 oacc[4];
#pragma unroll
        for (int dt = 0; dt < 4; ++dt) { oacc[dt] = (f32x4){0.f, 0.f, 0.f, 0.f};
#pragma unroll
            for (int p = 0; p < 2; ++p) { float wv[8]; const int dout = 16 * dt + rowi;
#pragma unroll
                for (int i = 0; i < 4; ++i) { wv[i] = w2[(32 * p + 4 * gq + i) * 64 + dout]; wv[4 + i] = w2[(32 * p + 16 + 4 * gq + i) * 64 + dout]; }
                oacc[dt] = __builtin_amdgcn_mfma_f32_16x16x32_bf16(pack8s(wv), pf[p], oacc[dt], 0, 0, 0); } }
        const bool padrow = (n == 127);
        if (kv == 0) {
            int pidx = 16 * n + 31; pidx = pidx > 2047 ? 2047 : pidx;
            const float pp = (float)pos[b * SEQ + pidx];
            bf16_t* dst = KCMP + ((size_t)(b * 128 + n) * 4 + g) * 64;
#pragma unroll
            for (int dt = 0; dt < 2; ++dt) { float o1[4], o2[4];
#pragma unroll
                for (int jj = 0; jj < 4; ++jj) { const float inv = exp2f(-(float)(16 * dt + 4 * gq + jj) * (13.287712379549449f / 32.f)); float sn, cs; sincos_rad(pp * inv, sn, cs);
                    const float x1 = oacc[dt][jj], x2 = oacc[dt + 2][jj]; o1[jj] = padrow ? 0.f : x1 * cs - x2 * sn; o2[jj] = padrow ? 0.f : x1 * sn + x2 * cs; }
                *(u32x2*)(dst + 16 * dt + 4 * gq) = (u32x2){cvt_pk_bf16(o1[0], o1[1]), cvt_pk_bf16(o1[2], o1[3])};
                *(u32x2*)(dst + 32 + 16 * dt + 4 * gq) = (u32x2){cvt_pk_bf16(o2[0], o2[1]), cvt_pk_bf16(o2[2], o2[3])}; }
        } else {
            bf16_t* dst = VCMPT + ((size_t)(b * 4 + g) * 64) * 128 + n;
#pragma unroll
            for (int dt = 0; dt < 4; ++dt)
#pragma unroll
                for (int jj = 0; jj < 4; ++jj) dst[(size_t)(16 * dt + 4 * gq + jj) * 128] = padrow ? (bf16_t)0 : f2bf(oacc[dt][jj]);
        }
    }
}

struct AttnArgs { const bf16_t* Q; const bf16_t* KS; const bf16_t* VST; const bf16_t* KW; const bf16_t* VWT; const bf16_t* KCMP; const bf16_t* VCMPT; const float* GATES; bf16_t* O; };
constexpr int AL_KC = 0, AL_VC = 18432, AL_KB = 35840, AL_VB = 54272, AL_PS = 72704, AL_IMP = 89088, AL_SEL = 93184, AL_OT = 93312;
constexpr float ATT_THR = 8.f;

__device__ __forceinline__ float max16(const f32x4 (&a)[4]) {
    float m0 = fmaxf(fmaxf(a[0][0], a[0][1]), a[0][2]), m1 = fmaxf(fmaxf(a[0][3], a[1][0]), a[1][1]), m2 = fmaxf(fmaxf(a[1][2], a[1][3]), a[2][0]);
    float m3 = fmaxf(fmaxf(a[2][1], a[2][2]), a[2][3]), m4 = fmaxf(fmaxf(a[3][0], a[3][1]), a[3][2]);
    return fmaxf(fmaxf(fmaxf(m0, m1), fmaxf(m2, m3)), fmaxf(m4, a[3][3]));
}

template <int MODE>
__device__ __forceinline__ void attn_branch(LAS unsigned char* lds, const bf16_t* Kg, const bf16_t* Vg, const int kb_lo, const int kb_hi, const bool first_staged,
                                            const bf16x8 (&qf)[2][2], const int (&sq)[2], const unsigned (&selm)[2], const float* const (&gatep)[2], LAS f32x4* otl  ,
                                            const int n, const int gq, const int tid) {
    const int skey = tid >> 3, spc = tid & 7;
    const bf16_t* kgp = Kg + (size_t)skey * 256 + spc * 8;
    const bf16_t* vgp = Vg + (size_t)skey * SEQ + spc * 8;
    const int soff = skey * 144 + spc * 16;
    u32x4 kr, vr;
    if (!first_staged) {
        kr = ld16(kgp + (size_t)kb_lo * 64 * 256); vr = ld16(vgp + kb_lo * 64);
        *(LAS u32x4*)(lds + AL_KB + soff) = kr; *(LAS u32x4*)(lds + AL_VB + soff) = vr;
        __syncthreads();
    }
    float m_run[2] = {0.f, 0.f}, l_run[2] = {0.f, 0.f};
    const float gate[2] = {gatep[0][MODE + 1], gatep[1][MODE + 1]};
    f32x4 oacc[2][4];
#pragma unroll
    for (int ti = 0; ti < 2; ++ti)
#pragma unroll
        for (int dt = 0; dt < 4; ++dt) oacc[ti][dt] = (f32x4){0.f, 0.f, 0.f, 0.f};
    for (int kb = kb_lo; kb <= kb_hi; ++kb) {
        const int buf = (kb - kb_lo) & 1;
        if (kb < kb_hi) { kr = ld16(kgp + (size_t)(kb + 1) * 64 * 256); vr = ld16(vgp + (kb + 1) * 64); }
        const LAS unsigned char* kbuf = lds + AL_KB + buf * 9216; const LAS unsigned char* vbuf = lds + AL_VB + buf * 9216;
        f32x4 sacc[2][4];
        bool selb[2];
#pragma unroll
        for (int ti = 0; ti < 2; ++ti) selb[ti] = MODE == 0 ? (((selm[ti] >> kb) & 1u) != 0u) : true;
#pragma unroll
        for (int kt = 0; kt < 4; ++kt) {
            const bf16x8 k0 = *(const LAS bf16x8*)(kbuf + (16 * kt + n) * 144 + gq * 16), k1 = *(const LAS bf16x8*)(kbuf + (16 * kt + n) * 144 + 64 + gq * 16);
#pragma unroll
            for (int ti = 0; ti < 2; ++ti) {
                sacc[ti][kt] = __builtin_amdgcn_mfma_f32_16x16x32_bf16(k0, qf[ti][0], (f32x4){0.f, 0.f, 0.f, 0.f}, 0, 0, 0);
                sacc[ti][kt] = __builtin_amdgcn_mfma_f32_16x16x32_bf16(k1, qf[ti][1], sacc[ti][kt], 0, 0, 0);
            }
        }
        const bool need_mask = (kb == kb_hi) || (MODE == 1 && kb == kb_lo);
        if (need_mask) {
#pragma unroll
            for (int ti = 0; ti < 2; ++ti) {
                const int rel = sq[ti] - kb * 64 - 4 * gq;
#pragma unroll
                for (int kt = 0; kt < 4; ++kt)
#pragma unroll
                    for (int jj = 0; jj < 4; ++jj) { const int tt = 16 * kt + jj; const bool v = MODE == 0 ? (tt <= rel) : (tt <= rel && tt > rel - 512); sacc[ti][kt][jj] = v ? sacc[ti][kt][jj] : NEGBIG; }
            }
        }
        float mx[2];
#pragma unroll
        for (int ti = 0; ti < 2; ++ti) { mx[ti] = max16(sacc[ti]) - m_run[ti]; mx[ti] = selb[ti] ? mx[ti] : NEGBIG; }
        const bool slow = (mx[0] > ATT_THR) || (mx[1] > ATT_THR) || (l_run[0] == 0.f && mx[0] > -1e29f && mx[0] < -ATT_THR) || (l_run[1] == 0.f && mx[1] > -1e29f && mx[1] < -ATT_THR);
        if (__any(slow)) {
#pragma unroll
            for (int ti = 0; ti < 2; ++ti) {
                float mr = fmaxf(mx[ti], __shfl_xor(mx[ti], 16)); mr = fmaxf(mr, __shfl_xor(mr, 32));
                float lr = l_run[ti] + __shfl_xor(l_run[ti], 16); lr += __shfl_xor(lr, 32);
                const bool has = mr > -1e29f;
                const float delta = !has ? 0.f : (lr == 0.f ? mr : fmaxf(mr, 0.f));
                const float alpha = lr == 0.f ? 1.f : fast_exp2(-delta);
                l_run[ti] *= alpha; m_run[ti] += delta;
#pragma unroll
                for (int dt = 0; dt < 4; ++dt) oacc[ti][dt] *= alpha;
            }
        }
        if (__any(m_run[0] != 0.f || m_run[1] != 0.f)) {
#pragma unroll
            for (int ti = 0; ti < 2; ++ti)
#pragma unroll
                for (int kt = 0; kt < 4; ++kt) sacc[ti][kt] -= m_run[ti];
        }
        bf16x8 pf[2][2];
#pragma unroll
        for (int ti = 0; ti < 2; ++ti) {
            float ps = 0.f;
#pragma unroll
            for (int kt = 0; kt < 4; ++kt)
#pragma unroll
                for (int jj = 0; jj < 4; ++jj) { const float e = fast_exp2(sacc[ti][kt][jj]); sacc[ti][kt][jj] = e; ps += e; }
            l_run[ti] += selb[ti] ? ps : 0.f;
#pragma unroll
            for (int p = 0; p < 2; ++p) { u32x4 v = {cvt_pk_bf16(sacc[ti][2 * p][0], sacc[ti][2 * p][1]), cvt_pk_bf16(sacc[ti][2 * p][2], sacc[ti][2 * p][3]),
                                                     cvt_pk_bf16(sacc[ti][2 * p + 1][0], sacc[ti][2 * p + 1][1]), cvt_pk_bf16(sacc[ti][2 * p + 1][2], sacc[ti][2 * p + 1][3])};
                if (MODE == 0) { v[0] = selb[ti] ? v[0] : 0u; v[1] = selb[ti] ? v[1] : 0u; v[2] = selb[ti] ? v[2] : 0u; v[3] = selb[ti] ? v[3] : 0u; }
                pf[ti][p] = __builtin_bit_cast(bf16x8, v); }
        }
#pragma unroll
        for (int dt = 0; dt < 4; ++dt)
#pragma unroll
            for (int p = 0; p < 2; ++p) {
                const LAS unsigned char* vp = vbuf + (16 * dt + n) * 144 + (32 * p + 4 * gq) * 2;
                const u32x2 a = *(const LAS u32x2*)vp, b2 = *(const LAS u32x2*)(vp + 32);
                u32x4 v = {a[0], a[1], b2[0], b2[1]};
                const bf16x8 vf = __builtin_bit_cast(bf16x8, v);
#pragma unroll
                for (int ti = 0; ti < 2; ++ti) oacc[ti][dt] = __builtin_amdgcn_mfma_f32_16x16x32_bf16(vf, pf[ti][p], oacc[ti][dt], 0, 0, 0);
            }
        if (kb < kb_hi) { *(LAS u32x4*)(lds + AL_KB + (buf ^ 1) * 9216 + soff) = kr; *(LAS u32x4*)(lds + AL_VB + (buf ^ 1) * 9216 + soff) = vr; }
        __syncthreads();
    }
#pragma unroll
    for (int ti = 0; ti < 2; ++ti) {
        float lt = l_run[ti] + __shfl_xor(l_run[ti], 16); lt += __shfl_xor(lt, 32);
        const float inv = lt > 0.f ? gate[ti] / lt : 0.f;
#pragma unroll
        for (int dt = 0; dt < 4; ++dt) otl[(ti * 4 + dt) * 64] += oacc[ti][dt] * inv;
    }
}

__device__ __forceinline__ unsigned attn_cmp_tile(LAS unsigned char* lds, const bf16x8 qf0, const bf16x8 qf1, const int s, const int sbase  , const float g0,
                                                  LAS f32x4* otl  , const int lane, const int w, const int n, const int gq, const int tl, const int r) {
    f32x4 sacc[8];
#pragma unroll
    for (int kt = 0; kt < 8; ++kt) {
        const bf16x8 k0 = *(const LAS bf16x8*)(lds + AL_KC + (16 * kt + n) * 144 + gq * 16), k1 = *(const LAS bf16x8*)(lds + AL_KC + (16 * kt + n) * 144 + 64 + gq * 16);
        sacc[kt] = __builtin_amdgcn_mfma_f32_16x16x32_bf16(k0, qf0, (f32x4){0.f, 0.f, 0.f, 0.f}, 0, 0, 0);
        sacc[kt] = __builtin_amdgcn_mfma_f32_16x16x32_bf16(k1, qf1, sacc[kt], 0, 0, 0);
    }
    float mx = NEGBIG;
    const int lim = ((s - 31) >> 4) - 4 * gq;
#pragma unroll
    for (int kt = 0; kt < 8; ++kt)
#pragma unroll
        for (int jj = 0; jj < 4; ++jj) { const bool v = (16 * kt + jj <= lim); sacc[kt][jj] = v ? sacc[kt][jj] : NEGBIG; mx = fmaxf(mx, sacc[kt][jj]); }
    mx = fmaxf(mx, __shfl_xor(mx, 16)); mx = fmaxf(mx, __shfl_xor(mx, 32));
    float ps = 0.f;
#pragma unroll
    for (int kt = 0; kt < 8; ++kt)
#pragma unroll
        for (int jj = 0; jj < 4; ++jj) { const float e = sacc[kt][jj] > -1e29f ? fast_exp2(sacc[kt][jj] - mx) : 0.f; sacc[kt][jj] = e; ps += e; }
    ps += __shfl_xor(ps, 16); ps += __shfl_xor(ps, 32);
    const float inv = ps > 0.f ? 1.f / ps : 0.f;
#pragma unroll
    for (int kt = 0; kt < 8; ++kt) {
        f32x4 pp;
#pragma unroll
        for (int jj = 0; jj < 4; ++jj) { sacc[kt][jj] *= inv; float t = sacc[kt][jj]; t += dpp_mov<0xB1>(t); t += dpp_mov<0x4E>(t); pp[jj] = t; }
        if (r == 0) *(LAS f32x4*)(lds + AL_PS + ((w * 4 + tl) * 128 + 16 * kt + 4 * gq) * 4) = pp;
    }
    f32x4 otot[4];
#pragma unroll
    for (int dt = 0; dt < 4; ++dt) otot[dt] = (f32x4){0.f, 0.f, 0.f, 0.f};
#pragma unroll
    for (int p = 0; p < 4; ++p) {
        u32x4 pv = {cvt_pk_bf16(sacc[2 * p][0], sacc[2 * p][1]), cvt_pk_bf16(sacc[2 * p][2], sacc[2 * p][3]), cvt_pk_bf16(sacc[2 * p + 1][0], sacc[2 * p + 1][1]), cvt_pk_bf16(sacc[2 * p + 1][2], sacc[2 * p + 1][3])};
        const bf16x8 pf = __builtin_bit_cast(bf16x8, pv);
#pragma unroll
        for (int dt = 0; dt < 4; ++dt) {
            const LAS unsigned char* vp = lds + AL_VC + (16 * dt + n) * 272 + (32 * p + 4 * gq) * 2;
            const u32x2 a = *(const LAS u32x2*)vp, b2 = *(const LAS u32x2*)(vp + 32);
            u32x4 v = {a[0], a[1], b2[0], b2[1]};
            otot[dt] = __builtin_amdgcn_mfma_f32_16x16x32_bf16(__builtin_bit_cast(bf16x8, v), pf, otot[dt], 0, 0, 0);
        }
    }
#pragma unroll
    for (int dt = 0; dt < 4; ++dt) otl[dt * 64] = otot[dt] * g0;
    asm volatile("s_waitcnt lgkmcnt(0)" ::: "memory");
    __builtin_amdgcn_wave_barrier();
    const int tl2 = lane >> 4, q = lane & 15, s2 = sbase + tl2, blkq = s2 >> 6;
    const LAS float* psr = (const LAS float*)(lds + AL_PS + ((w * 4 + tl2) * 128) * 4);
    const f32x4 xa = *(const LAS f32x4*)(psr + 8 * q), xb = *(const LAS f32x4*)(psr + 8 * q + 4);
    const float prev = q > 0 ? psr[8 * q - 1] : 0.f;
    float a0 = prev + xa[0] + xa[1] + xa[2] + xa[3], a1 = xa[3] + xb[0] + xb[1] + xb[2] + xb[3];
    const int m0 = 2 * q, m1 = 2 * q + 1;
    { const int rel0 = blkq - m0, rel1 = blkq - m1;
        if (rel0 < 0) a0 = -1.f;
        if (rel1 < 0) a1 = -1.f;
        if (m0 == 0 || rel0 == 0 || rel0 == 1) a0 = 1e6f;
        if (rel1 == 0 || rel1 == 1) a1 = 1e6f; }
    LAS float* impw = (LAS float*)(lds + AL_IMP + ((w * 4 + tl2) * 32) * 4);
    *(LAS f32x2*)(impw + 2 * q) = (f32x2){a0, a1};
    asm volatile("s_waitcnt lgkmcnt(0)" ::: "memory");
    __builtin_amdgcn_wave_barrier();
    int rk0 = 0, rk1 = 0;
#pragma unroll
    for (int i4 = 0; i4 < 8; ++i4) { const f32x4 v = *(const LAS f32x4*)(impw + 4 * i4);
#pragma unroll
        for (int j = 0; j < 4; ++j) { const int mm = 4 * i4 + j; rk0 += (v[j] > a0 || (v[j] == a0 && mm < m0)) ? 1 : 0; rk1 += (v[j] > a1 || (v[j] == a1 && mm < m1)) ? 1 : 0; } }
    unsigned bits = (rk0 < 16 ? (1u << m0) : 0u) | (rk1 < 16 ? (1u << m1) : 0u);
    bits |= dpp_movu<0xB1>(bits); bits |= dpp_movu<0x4E>(bits); bits |= dpp_movu<0x141>(bits); bits |= dpp_movu<0x140>(bits);
    LAS unsigned* selw = (LAS unsigned*)(lds + AL_SEL + (w * 4) * 4);
    if (q == 0) selw[tl2] = bits;
    asm volatile("s_waitcnt lgkmcnt(0)" ::: "memory");
    __builtin_amdgcn_wave_barrier();
    const unsigned selm = selw[tl];
    asm volatile("s_waitcnt lgkmcnt(0)" ::: "memory");
    __builtin_amdgcn_wave_barrier();
    return selm;
}

__device__ __forceinline__ void nsa_attn_phase(LAS unsigned char* lds, const AttnArgs& A) {
    const int tid0 = tid_opaque();
    for (int u = blockIdx.x; u < 4096; u += gridDim.x) {
        int tid = tid0; asm volatile("" : "+v"(tid));
        const int lane = tid & 63, w = tid >> 6, n = lane & 15, gq = lane >> 4, tl = n >> 2, r = n & 3;
        const int kq = u >> 8, c = 2 * kq + ((((u >> 7) & 1) ^ kq) & 1), bgi = u & 127, b = bgi >> 2, g = bgi & 3, s0 = c * 64;
        int sq[2]; bf16x8 qf[2][2]; const float* gp[2];
#pragma unroll
        for (int ti = 0; ti < 2; ++ti) {
            sq[ti] = s0 + 8 * w + 4 * ti + tl;
            const size_t qrow = (size_t)b * SEQ + sq[ti];
            const bf16_t* qp = A.Q + qrow * 1024 + g * 256 + r * 64 + 8 * gq;
            qf[ti][0] = *(const bf16x8*)qp; qf[ti][1] = *(const bf16x8*)(qp + 32);
            gp[ti] = A.GATES + qrow * 48 + (g * 4 + r) * 3;
        }
        const bf16_t* KSg = A.KS + (size_t)b * SEQ * 256 + g * 64; const bf16_t* VSg = A.VST + (size_t)(b * 4 + g) * 64 * SEQ;
        const bf16_t* KWg = A.KW + (size_t)b * SEQ * 256 + g * 64; const bf16_t* VWg = A.VWT + (size_t)(b * 4 + g) * 64 * SEQ;
        __syncthreads();
#pragma unroll
        for (int i = 0; i < 2; ++i) { const int pid = tid + 512 * i;
            { const int key = pid >> 3, pc = pid & 7; *(LAS u32x4*)(lds + AL_KC + key * 144 + pc * 16) = ld16(A.KCMP + ((size_t)(b * 128 + key) * 4 + g) * 64 + pc * 8); }
            { const int d = pid >> 4, pc = pid & 15; *(LAS u32x4*)(lds + AL_VC + d * 272 + pc * 16) = ld16(A.VCMPT + ((size_t)(b * 4 + g) * 64 + d) * 128 + pc * 8); } }
        { const int skey = tid >> 3, spc = tid & 7;
            *(LAS u32x4*)(lds + AL_KB + skey * 144 + spc * 16) = ld16(KSg + (size_t)skey * 256 + spc * 8);
            *(LAS u32x4*)(lds + AL_VB + skey * 144 + spc * 16) = ld16(VSg + (size_t)skey * SEQ + spc * 8); }
        __syncthreads();
        LAS f32x4* otl = (LAS f32x4*)(lds + AL_OT) + w * 512 + lane;
        unsigned selm[2];
#pragma unroll
        for (int ti = 0; ti < 2; ++ti) { selm[ti] = attn_cmp_tile(lds, qf[ti][0], qf[ti][1], sq[ti], s0 + 8 * w + 4 * ti, gp[ti][0], otl + ti * 256, lane, w, n, gq, tl, r); }
        attn_branch<0>(lds, KSg, VSg, 0, c, true, qf, sq, selm, gp, otl, n, gq, tid);
        attn_branch<1>(lds, KWg, VWg, c >= 8 ? c - 8 : 0, c, false, qf, sq, selm, gp, otl, n, gq, tid);
#pragma unroll
        for (int ti = 0; ti < 2; ++ti) {
            bf16_t* op = A.O + ((size_t)b * SEQ + sq[ti]) * 1024 + g * 256 + r * 64 + 4 * gq;
#pragma unroll
            for (int dt = 0; dt < 4; ++dt) { const f32x4 o = otl[(ti * 4 + dt) * 64]; *(u32x2*)(op + 16 * dt) = (u32x2){cvt_pk_bf16(o[0], o[1]), cvt_pk_bf16(o[2], o[3])}; }
        }
    }
    __syncthreads();
}
#ifndef DBG_ZERO_KIND
#define DBG_ZERO_KIND -1
#endif
struct Params { const float* in[31]; float* out; unsigned char* ws; int ph_lo, ph_hi; };
constexpr int N_PHASES = 38;

#ifndef DUP_MASK
#define DUP_MASK 0ull
#endif
#define PH_BEGIN(k) if ((k) >= p.ph_lo && (k) < p.ph_hi) { for (int rep_ = 0; rep_ < (((DUP_MASK >> (k)) & 1ull) ? 2 : 1); ++rep_) {
#define PH_END(k) } if ((k) + 1 < p.ph_hi) xcd_barrier(bar); }

template <int LAYER>
__device__ __forceinline__ void layer_body(const Params& p, LAS unsigned char* lds, const XcdBarrier& bar) {
    constexpr int kind = LAYER % 3, j = LAYER / 3;
    constexpr int PB = LAYER == 0 ? 1 : (LAYER == 1 ? 10 : (LAYER == 2 ? 18 : 29));
    constexpr int NMIX = kind == 0 ? 4 : (kind == 1 ? 3 : 6);
    unsigned char* ws = p.ws;
    const int G = gridDim.x, cblk = blockIdx.x;
    const int* positions = (const int*)p.in[1];
    bf16_t* XA = (bf16_t*)(ws + WS_XA); float* XF = p.out; bf16_t* MB = (bf16_t*)(ws + B_MB);
    int* route_e = (int*)(ws + WS_ROUTE_E); float* route_w = (float*)(ws + WS_ROUTE_W); int* posb = (int*)(ws + WS_POS); int* cnt = (int*)(ws + WS_CNT);
    int4* tiles = (int4*)(ws + WS_TILE); float* bias1 = (float*)(ws + WS_BIAS1);
    if constexpr (kind == 0) {
        bf16_t* Q = (bf16_t*)(ws + B_Q); bf16_t* KC = (bf16_t*)(ws + B_KC); bf16_t* VC = (bf16_t*)(ws + B_VC); bf16_t* KS = (bf16_t*)(ws + B_KS); bf16_t* VST = (bf16_t*)(ws + B_VST);
        bf16_t* KW = (bf16_t*)(ws + B_KW); bf16_t* VWT = (bf16_t*)(ws + B_VWT); bf16_t* OB = (bf16_t*)(ws + B_O);
        float* GATES = (float*)(ws + WS_GATES); bf16_t* KCMP = (bf16_t*)(ws + WS_KCMP); bf16_t* VCMPT = (bf16_t*)(ws + WS_VCMPT);
        PH_BEGIN(PB + 0)
            DenseSched S{XA, (const bf16_t*)(ws + W_NSA_IN) + (size_t)j * NSA_NP * 1024, 1024, 1024, T_TOK / 256, NSA_NP / 256, G, cblk};
            EpiNsaIn E{Q, KC, VC, KS, VST, KW, VWT, GATES, positions, p.in[3] + j * 48};
            gemm_phase<false>(lds, 1024, 1024, 1024, S, E);
        PH_END(PB + 0)
        PH_BEGIN(PB + 1)
            nsa_compress_phase(KC, VC, (const bf16_t*)(ws + W_CMP1) + (size_t)j * 2 * 64 * 2048, p.in[6] + j * 4096, p.in[9] + j * 4096, bias1 + j * 128, positions, KCMP, VCMPT);
        PH_END(PB + 1)
        PH_BEGIN(PB + 2)
            AttnArgs A{Q, KS, VST, KW, VWT, KCMP, VCMPT, GATES, OB};
            nsa_attn_phase(lds, A);
        PH_END(PB + 2)
        PH_BEGIN(PB + 3)
            DenseSched S{OB, (const bf16_t*)(ws + W_NSA_OUT) + (size_t)j * 1024 * 1024, 1024, 1024, T_TOK / 256, 4, G, cblk};
            EpiPlain<false> E{MB, 1024, 1.f};
            gemm_phase<false>(lds, 1024, 1024, 1024, S, E);
        PH_END(PB + 3)
    } else if constexpr (kind == 1) {
        bf16_t* P = (bf16_t*)(ws + B_P); bf16_t* BGb = (bf16_t*)(ws + B_BG); bf16_t* Y = (bf16_t*)(ws + B_Y);
        PH_BEGIN(PB + 0)
            DenseSched S{XA, (const bf16_t*)(ws + W_SC_IN), 1024, 1024, T_TOK / 256, 12, G, cblk};
            EpiScIn E{P, BGb};
            gemm_phase<false>(lds, 1024, 1024, 1024, S, E);
        PH_END(PB + 0)
        PH_BEGIN(PB + 1)
            sc_conv_phase(P, BGb, Y, p.in[12], p.in[13]);
        PH_END(PB + 1)
        PH_BEGIN(PB + 2)
            DenseSched S{Y, (const bf16_t*)(ws + W_SC_OUT), 1024, 1024, T_TOK / 256, 4, G, cblk};
            EpiPlain<false> E{MB, 1024, 1.f};
            gemm_phase<false>(lds, 1024, 1024, 1024, S, E);
        PH_END(PB + 2)
    } else {
        bf16_t* GG = (bf16_t*)(ws + B_GG); bf16_t* R1 = (bf16_t*)(ws + B_R1); bf16_t* R2 = (bf16_t*)(ws + B_R2); bf16_t* R3 = (bf16_t*)(ws + B_R3);
        f32x4* carry = (f32x4*)(ws + WS_CARRY);
        PH_BEGIN(PB + 0)
            DenseSched S{XA, (const bf16_t*)(ws + W_LRU_IN), 1024, 1024, T_TOK / 256, 10, G, cblk};
            EpiLruIn E{GG, R1};
            gemm_phase<false>(lds, 1024, 1024, 1024, S, E);
        PH_END(PB + 0)
        PH_BEGIN(PB + 1)
            lru_conv_phase(R1, R2, p.in[16], p.in[17]);
        PH_END(PB + 1)
        PH_BEGIN(PB + 2)
            BandSched S{R2, (const bf16_t*)(ws + W_LRU_G), LRU_W, LRU_W, T_TOK / 256, 10, G, cblk};
            EpiLruGate E{R2, R1, R3, p.in[19], p.in[21], p.in[22]};
            gemm_phase<false>(lds, 384, LRU_W, LRU_W, S, E);
        PH_END(PB + 2)
        PH_BEGIN(PB + 3)
            lru_scan1_phase(R1, R3, carry);
        PH_END(PB + 3)
        PH_BEGIN(PB + 4)
            lru_scan2_phase(R1, R3, GG, carry, R2);
        PH_END(PB + 4)
        PH_BEGIN(PB + 5)
            DenseSched S{R2, (const bf16_t*)(ws + W_LRU_OUT), LRU_W, LRU_W, T_TOK / 256, 4, G, cblk};
            EpiPlain<false> E{MB, 1024, 1.f};
            gemm_phase<false>(lds, LRU_W, LRU_W, LRU_W, S, E);
        PH_END(PB + 5)
    }
    constexpr int FB = PB + NMIX;
    unsigned char* X8 = ws + B_XG; int* invb = (int*)(ws + WS_INV); unsigned char* HID = ws + B_HID; bf16_t* YM = (bf16_t*)(ws + B_YM); unsigned char* WGU = ws + B_WMOE + WMOE_GU; unsigned char* WDN = ws + B_WMOE + WMOE_DN;
    const float* lng = p.in[29] + (size_t)LAYER * 2048; const float* lnb = p.in[30] + (size_t)LAYER * 2048;
    PH_BEGIN(FB + 0)
#if defined(SHADOW_LN) && (SHADOW_LN & 1)
        ln1_router_phase(lds, LAYER == 0 ? p.in[0] : (const float*)XF, MB, (float*)(ws + WS_BIG + 192 * MiB), ws + WS_BIG + 448 * MiB, lng, lnb, p.in[24], p.in[25], (int*)(ws + WS_BIG + 300 * MiB), (float*)(ws + WS_BIG + 302 * MiB), (int*)(ws + WS_BIG + 304 * MiB));
#endif
        ln1_router_phase(lds, LAYER == 0 ? p.in[0] : (const float*)XF, MB, XF, X8, lng, lnb, p.in[24], p.in[25], route_e, route_w, cnt);
    PH_END(FB + 0)
    PH_BEGIN(FB + 1)
        moe_gather_phase(lds, route_e, cnt, posb, invb, tiles);
        convert_wt<true>(lds, WGU, 16, 2048, 1024, FetchPair{p.in[26] + (size_t)LAYER * 16 * 1048576, (long)(p.in[27] - p.in[26]), 1024, (size_t)1048576}, S8_WGU);
        convert_wt<true>(lds, WDN, 16, 1024, 1024, FetchPlain{p.in[28] + (size_t)LAYER * 16 * 1048576, 1024, (size_t)1048576}, S8_WD);
    PH_END(FB + 1)
    PH_BEGIN(FB + 2)
        const int NT = __builtin_amdgcn_readfirstlane(tiles[0].x);
        MoeSched S{X8, WGU, tiles, invb, NT, 8, 2048, 1024, G, cblk};
        EpiMoeGU E{HID};
        gemm_phase<true, true>(lds, 1024, 1024, 1024, S, E);
    PH_END(FB + 2)
    PH_BEGIN(FB + 3)
        const int NT = __builtin_amdgcn_readfirstlane(tiles[0].x);
        MoeSched S{HID, WDN, tiles, invb, NT, 4, 1024, 1024, G, cblk};
        EpiPlain<true> E{YM, 1024, 1.f / (S8_H * S8_WD)};
        gemm_phase<true>(lds, 1024, 1024, 1024, S, E);
    PH_END(FB + 3)
    PH_BEGIN(FB + 4)
#if defined(SHADOW_LN) && (SHADOW_LN & 2)
        ln2_combine_phase<LAYER == DEPTH - 1>(XF, (float*)(ws + B_XG), YM, posb, route_w, lng + 1024, lnb + 1024, (bf16_t*)(ws + WS_BIG + 512 * MiB));
#endif
        ln2_combine_phase<LAYER == DEPTH - 1>(XF, XF, YM, posb, route_w, lng + 1024, lnb + 1024, XA);
    PH_END(FB + 4)
}

__global__ void __launch_bounds__(NTHR, 2) hybrid_fwd(Params p) {
    extern __shared__ __attribute__((aligned(16))) unsigned char lds_raw[];
    LAS unsigned char* lds = (LAS unsigned char*)lds_raw;
    volatile LAS unsigned* bst = (volatile LAS unsigned*)(lds + LDS_BYTES - 16);
    const bool use_bar = (p.ph_hi - p.ph_lo) > 1;
    if (threadIdx.x == 0) { bst[0] = 0u; bst[1] = 0u; bst[2] = 0u; bst[3] = 0u; }
    __syncthreads();
    XcdBarrier bar; bar.bar = (unsigned*)(p.ws + WS_CTL); bar.x = 0; bar.st = bst;
    if (use_bar) bar = xcd_barrier_post((unsigned*)(p.ws + WS_CTL), bst);
    PH_BEGIN(0)
        unsigned char* ws = p.ws;
        convert_x(p.in[0], (bf16_t*)(ws + WS_XA));
        for (int j = 0; j < 2; ++j) {
            convert_wt(lds, (bf16_t*)(ws + W_NSA_IN) + (size_t)j * NSA_NP * 1024, 1, NSA_NP, 1024, FetchNsaIn{p.in[2] + (size_t)j * 1024 * 2608});
            convert_wt(lds, (bf16_t*)(ws + W_NSA_OUT) + (size_t)j * 1024 * 1024, 1, 1024, 1024, FetchPlain{p.in[10] + (size_t)j * 1024 * 1024, 1024, 0});
            convert_wt(lds, (bf16_t*)(ws + W_CMP1) + (size_t)(j * 2 + 0) * 64 * 2048, 1, 64, 2048, FetchIdent{p.in[5] + (size_t)j * 2048 * 64, 64, 0});
            convert_wt(lds, (bf16_t*)(ws + W_CMP1) + (size_t)(j * 2 + 1) * 64 * 2048, 1, 64, 2048, FetchIdent{p.in[8] + (size_t)j * 2048 * 64, 64, 0});
        }
        convert_wt(lds, (bf16_t*)(ws + W_SC_IN), 1, 3072, 1024, FetchScIn{p.in[11]});
        convert_wt(lds, (bf16_t*)(ws + W_SC_OUT), 1, 1024, 1024, FetchPlain{p.in[14], 1024, 0});
        convert_wt(lds, (bf16_t*)(ws + W_LRU_IN), 1, 2560, 1024, FetchPlain{p.in[15], 2560, 0});
        convert_wt(lds, (bf16_t*)(ws + W_LRU_G), 1, 2560, 1280, FetchLruGate{p.in[18], (long)(p.in[20] - p.in[18])});
        convert_wt(lds, (bf16_t*)(ws + W_LRU_OUT), 1, 1024, 1280, FetchPlain{p.in[23], 1024, 0});
        cmp_bias_phase(lds, p.in[4], p.in[5], p.in[7], p.in[8], (float*)(ws + WS_BIAS1));
    PH_END(0)
    layer_body<0>(p, lds, bar);
    layer_body<1>(p, lds, bar);
    layer_body<2>(p, lds, bar);
    layer_body<3>(p, lds, bar);
}
#undef PH_BEGIN
#undef PH_END

#ifndef MK_SPLIT
#define MK_SPLIT 0
#endif
extern "C" void kernel_launch(void* const* d_in, const int* in_sizes, int n_in, void* d_out, int out_size, void* d_ws, size_t ws_size, hipStream_t stream) {
    static int grid = 0;
    if (grid == 0) {
        int dev = 0, cus = 0, per_cu = 0;
        if (n_in != 31 || ws_size < WS_END) { fprintf(stderr, "kernel_launch: unexpected n_in %d or ws_size %zu (need %zu)\n", n_in, ws_size, (size_t)WS_END); grid = -1; return; }
        if (hipGetDevice(&dev) != hipSuccess || hipDeviceGetAttribute(&cus, hipDeviceAttributeMultiprocessorCount, dev) != hipSuccess) { grid = -1; return; }
        if (hipFuncSetAttribute((const void*)hybrid_fwd, hipFuncAttributeMaxDynamicSharedMemorySize, LDS_BYTES) != hipSuccess) { fprintf(stderr, "kernel_launch: hipFuncSetAttribute failed\n"); grid = -1; return; }
        if (hipOccupancyMaxActiveBlocksPerMultiprocessor(&per_cu, (const void*)hybrid_fwd, NTHR, LDS_BYTES) != hipSuccess || per_cu < 1) fprintf(stderr, "kernel_launch: occupancy query says %d\n", per_cu);
        (void)hipGetLastError();
        grid = cus;
    }
    if (grid < 0) return;
    (void)hipMemsetAsync((char*)d_ws + WS_CTL, 0, 64 * 1024, stream);
    Params p{};
    for (int i = 0; i < 31; ++i) p.in[i] = (const float*)d_in[i];
    p.out = (float*)d_out; p.ws = (unsigned char*)d_ws;
#if MK_SPLIT
    for (int ph = 0; ph < N_PHASES; ++ph) { p.ph_lo = ph; p.ph_hi = ph + 1; hipLaunchKernelGGL(hybrid_fwd, dim3(grid), dim3(NTHR), LDS_BYTES, stream, p); }
#else
    p.ph_lo = 0; p.ph_hi = N_PHASES;
    hipLaunchKernelGGL(hybrid_fwd, dim3(grid), dim3(NTHR), LDS_BYTES, stream, p);
#endif
    const hipError_t le = hipPeekAtLastError();
    if (le != hipSuccess) fprintf(stderr, "kernel_launch: launch failed: %s\n", hipGetErrorName(le));
}
```

```cpp
#include <hip/hip_runtime.h>
#include <stdint.h>
#include <stdio.h>

#define LAS __attribute__((address_space(3)))
typedef unsigned short bf16_t;
typedef short bf16x8 __attribute__((ext_vector_type(8)));
typedef float f32x4 __attribute__((ext_vector_type(4)));
typedef float f32x2 __attribute__((ext_vector_type(2)));
typedef unsigned u32x4 __attribute__((ext_vector_type(4)));
typedef unsigned u32x2 __attribute__((ext_vector_type(2)));
typedef int i32x8 __attribute__((ext_vector_type(8)));

constexpr int T_TOK = 65536, DM = 1024, SEQ = 2048, NBATCH = 32, DEPTH = 4;
constexpr int NTHR = 512;
constexpr int NSA_NP = 2816;
constexpr int LRU_W = 1280;
constexpr int NEXP = 16;
constexpr float DN_ALPHA = 1.6817928305074292f;
constexpr float LN_EPS = 1e-5f;
constexpr float NEGBIG = -1e30f;
constexpr float LOG2E = 1.4426950408889634f;

constexpr size_t KiB = 1024, MiB = 1024 * 1024;
constexpr size_t WS_CTL = 0;
constexpr size_t WS_ROUTE_E = 64 * KiB;
constexpr size_t WS_ROUTE_W = WS_ROUTE_E + 256 * KiB;
constexpr size_t WS_POS = WS_ROUTE_W + 512 * KiB;
constexpr size_t WS_CNT = WS_POS + 512 * KiB;
constexpr size_t WS_TILE = WS_CNT + 16 * KiB;
constexpr size_t WS_BIAS1 = WS_TILE + 16 * KiB;
constexpr size_t WS_INV = 1408 * KiB;
constexpr size_t WS_KCMP = 2 * MiB;
constexpr size_t WS_VCMPT = 4 * MiB;
constexpr size_t WS_CARRY = 6 * MiB;
constexpr size_t WS_GATES = 16 * MiB;
constexpr size_t WS_W = 28 * MiB;
constexpr size_t W_NSA_IN = WS_W;
constexpr size_t W_NSA_OUT = W_NSA_IN + 2 * (size_t)NSA_NP * 1024 * 2;
constexpr size_t W_SC_IN = W_NSA_OUT + 2 * (size_t)1024 * 1024 * 2;
constexpr size_t W_SC_OUT = W_SC_IN + (size_t)3072 * 1024 * 2;
constexpr size_t W_LRU_IN = W_SC_OUT + (size_t)1024 * 1024 * 2;
constexpr size_t W_LRU_G = W_LRU_IN + (size_t)2560 * 1024 * 2;
constexpr size_t W_LRU_OUT = W_LRU_G + (size_t)2560 * 1280 * 2;
constexpr size_t W_CMP1 = W_LRU_OUT + (size_t)1024 * 1280 * 2;
constexpr size_t W_END = W_CMP1 + 4 * (size_t)64 * 2048 * 2;
constexpr size_t WS_XA = 66 * MiB;
constexpr size_t WS_WMOE = WS_XA + 128 * MiB;
constexpr size_t WS_BIG = WS_WMOE + 96 * MiB;
constexpr size_t WS_END = WS_BIG + 642 * MiB;
static_assert(W_END <= WS_XA, "weights overflow");
constexpr size_t B_Q = WS_BIG, B_KC = B_Q + 128 * MiB, B_VC = B_KC + 32 * MiB, B_KS = B_VC + 32 * MiB, B_VST = B_KS + 32 * MiB, B_KW = B_VST + 32 * MiB,
                 B_VWT = B_KW + 32 * MiB, B_O = B_VWT + 32 * MiB;
constexpr size_t B_P = WS_BIG, B_BG = B_P + 128 * MiB, B_Y = B_BG + 128 * MiB;
constexpr size_t B_GG = WS_BIG, B_R1 = B_GG + 160 * MiB, B_R2 = B_R1 + 160 * MiB, B_R3 = B_R2 + 160 * MiB;
constexpr size_t B_MB = WS_BIG;
constexpr size_t B_XG = WS_BIG + 128 * MiB, B_HID = B_XG + 64 * MiB, B_YM = B_HID + 128 * MiB, B_WMOE = WS_WMOE;
constexpr size_t WMOE_GU = 0, WMOE_DN = (size_t)16 * 2048 * 1024;
constexpr float S8_X = 16.f, S8_WGU = 256.f, S8_H = 16.f, S8_WD = 512.f, S8_Y = 128.f;

constexpr int LDS_BYTES = 163840;

__device__ __forceinline__ unsigned cvt_pk_bf16(float lo, float hi) { unsigned r; asm volatile("v_cvt_pk_bf16_f32 %0, %1, %2" : "=v"(r) : "v"(lo), "v"(hi)); return r; }
__device__ __forceinline__ float bf_lo(unsigned u) { return __uint_as_float(u << 16); }
__device__ __forceinline__ float bf_hi(unsigned u) { return __uint_as_float(u & 0xffff0000u); }
__device__ __forceinline__ float bf2f(bf16_t h) { return __uint_as_float(((unsigned)h) << 16); }
__device__ __forceinline__ bf16_t f2bf(float f) { return (bf16_t)(cvt_pk_bf16(f, 0.f) & 0xffffu); }
__device__ __forceinline__ float fast_exp2(float x) { return __builtin_amdgcn_exp2f(x); }
__device__ __forceinline__ float fast_exp(float x) { return __builtin_amdgcn_exp2f(x * LOG2E); }
__device__ __forceinline__ float fast_rcp(float x) { return __builtin_amdgcn_rcpf(x); }
__device__ __forceinline__ float sigmoidf_(float x) { return fast_rcp(1.f + fast_exp(-x)); }
__device__ __forceinline__ float gelu_tanh(float x) { const float u = 0.7978845608028654f * (x + 0.044715f * x * x * x); return x * fast_rcp(1.f + fast_exp(-2.f * u)); }
__device__ __forceinline__ float silu_(float x) { return x * fast_rcp(1.f + fast_exp(-x)); }
__device__ __forceinline__ void sincos_rad(float ang, float& s, float& c) {
    float r = ang * 0.15915494309189535f; r = __builtin_amdgcn_fractf(r); s = __builtin_amdgcn_sinf(r); c = __builtin_amdgcn_cosf(r); }
__device__ __forceinline__ float wave_sum(float v) {
#pragma unroll
    for (int o = 32; o >= 1; o >>= 1) v += __shfl_xor(v, o);
    return v; }
template <int CTRL> __device__ __forceinline__ float dpp_mov(float v) { return __builtin_bit_cast(float, __builtin_amdgcn_update_dpp(0, __builtin_bit_cast(int, v), CTRL, 0xf, 0xf, false)); }
template <int CTRL> __device__ __forceinline__ unsigned dpp_movu(unsigned v) { return (unsigned)__builtin_amdgcn_update_dpp(0, (int)v, CTRL, 0xf, 0xf, false); }
__device__ __forceinline__ float row16_sum(float v) { v += dpp_mov<0xB1>(v); v += dpp_mov<0x4E>(v); v += dpp_mov<0x141>(v); v += dpp_mov<0x140>(v); return v; }
__device__ __forceinline__ float wave_sum_dpp(float v) { v = row16_sum(v); v += __shfl_xor(v, 16); v += __shfl_xor(v, 32); return v; }
__device__ __forceinline__ int tid_opaque() { int t = threadIdx.x; asm volatile("" : "+v"(t)); return t; }
__device__ __forceinline__ u32x4 ld16(const void* p) { return *(const u32x4*)p; }
__device__ __forceinline__ void st16(void* p, u32x4 v) { *(u32x4*)p = v; }

#define XB_TMO      128
#define XB_XCNT(j)  (256  + 64 * (j))
#define XB_XSUB(j)  (1280 + 64 * (j))
#define XB_XGEN(j)  (2304 + 64 * (j))
#define XB_TOP      3328
#define XB_TOPGEN   3392
#define XCD_BAR_WORDS 3456
#define XB_SPIN_CAP (1u << 22)
__device__ __forceinline__ unsigned xb_ld(unsigned* p)              { return __hip_atomic_load(p, __ATOMIC_RELAXED, __HIP_MEMORY_SCOPE_AGENT); }
__device__ __forceinline__ unsigned xb_add(unsigned* p, unsigned v) { return __hip_atomic_fetch_add(p, v, __ATOMIC_RELAXED, __HIP_MEMORY_SCOPE_AGENT); }
__device__ __forceinline__ unsigned xb_xcc_id() { return (unsigned)__builtin_amdgcn_s_getreg((3 << 11) | 20) & 0xFu; }
#define XB_SPIN(cond, bar) do { unsigned _sp = 0; while (cond) { __builtin_amdgcn_s_sleep(1); \
    if ((++_sp & 255u) == 0u) { if (xb_ld(&(bar)[XB_TMO])) break; if (_sp > XB_SPIN_CAP) { atomicAdd(&(bar)[XB_TMO], 1u); break; } } } } while (0)
struct XcdBarrier { unsigned* bar; unsigned x; volatile LAS unsigned* st; };
__device__ __forceinline__ XcdBarrier xcd_barrier_post(unsigned* bar, volatile LAS unsigned* st) {
    XcdBarrier b; b.bar = bar; b.x = xb_xcc_id(); b.st = st;
    if (threadIdx.x == 0) (void)xb_add(&bar[XB_XCNT(b.x)], 1u);
    return b;
}
__device__ __forceinline__ void xcd_barrier_complete(unsigned* bar, unsigned x, unsigned& nloc, unsigned& nx) {
    const unsigned G = gridDim.x * gridDim.y * gridDim.z;
    unsigned sum, cnt, mine, sp = 0u;
    for (;;) {
        sum = 0u; cnt = 0u; mine = 0u;
#pragma unroll
        for (unsigned j = 0; j < 16; ++j) { const unsigned c = xb_ld(&bar[XB_XCNT(j)]); sum += c; cnt += (c > 0u) ? 1u : 0u; mine = (j == x) ? c : mine; }
        if (sum == G) break;
        __builtin_amdgcn_s_sleep(1);
        if ((++sp & 255u) == 0u) { if (xb_ld(&bar[XB_TMO])) break; if (sp > XB_SPIN_CAP) { atomicAdd(&bar[XB_TMO], 1u); break; } }
    }
    nloc = mine > 0u ? mine : 1u; nx = cnt > 0u ? cnt : 1u;
}
__device__ __forceinline__ void xcd_barrier(const XcdBarrier& b) {
    asm volatile("s_waitcnt vmcnt(0)" ::: "memory");
    __syncthreads();
    if (threadIdx.x == 0) {
        unsigned* bar = b.bar;
        __builtin_amdgcn_s_waitcnt(0);
        unsigned nloc = b.st[0], nx = b.st[1];
        if (nloc == 0u) { xcd_barrier_complete(bar, b.x, nloc, nx); b.st[0] = nloc; b.st[1] = nx; }
        const unsigned old = xb_add(&bar[XB_XSUB(b.x)], 1u);
        const unsigned gen = old / nloc;
        if (old + 1u == (gen + 1u) * nloc) {
            __builtin_amdgcn_fence(__ATOMIC_RELEASE, "agent");
            asm volatile("s_waitcnt vmcnt(0)" ::: "memory");
            const unsigned og = xb_add(&bar[XB_TOP], 1u);
            const unsigned tg = og / nx;
            if (og + 1u == (tg + 1u) * nx) xb_add(&bar[XB_TOPGEN], 1u);
            else XB_SPIN(xb_ld(&bar[XB_TOPGEN]) == tg, bar);
            __builtin_amdgcn_fence(__ATOMIC_ACQUIRE, "agent");
            xb_add(&bar[XB_XGEN(b.x)], 1u);
            asm volatile("s_waitcnt vmcnt(0)" ::: "memory");
        } else {
            XB_SPIN(xb_ld(&bar[XB_XGEN(b.x)]) == gen, bar);
            __builtin_amdgcn_fence(__ATOMIC_ACQUIRE, "agent");
            asm volatile("s_waitcnt vmcnt(0)" ::: "memory");
        }
    }
    __syncthreads();
}

constexpr int BM = 256, BK = 64, HALF = 128, HTB = HALF * BK * 2, STAGE_BYTES = 8 * HTB, NXCD = 8, WGM = 8;
__host__ __device__ __forceinline__ int lds_byte(int r, int c) { const int st = (r >> 4) * 2 + (c >> 5), rr = r & 15, cc = c & 31, ob = rr * 64 + cc * 2; return st * 1024 + (ob ^ (((ob >> 9) & 1) << 5)); }
__host__ __device__ __forceinline__ void stage_rc(int b, int& R, int& C) { const int st = b / 1024, sb = b % 1024, swz = sb ^ (((sb >> 9) & 1) << 5); R = (st >> 1) * 16 + swz / 64; C = (st & 1) * 32 + (swz % 64) / 2; }

struct GUnit { const char* a; const char* b; int pn; int row0; int nrows; int aux; };
__device__ __forceinline__ void map_unit(int L, int nM, int nN, int& pm, int& pn) {
    const int nwg = nM * nN; int wgid = L;
    { const int q = nwg / NXCD, r = nwg % NXCD, xcd = wgid % NXCD, off = wgid / NXCD; wgid = (xcd < r ? xcd * (q + 1) : r * (q + 1) + (xcd - r) * q) + off; }
    const int nig = WGM * nN, gid = wgid / nig, fm = gid * WGM, gsz = (nM - fm) < WGM ? (nM - fm) : WGM;
    pm = fm + ((wgid % nig) % gsz); pn = (wgid % nig) / gsz;
}
struct DenseSched {
    const bf16_t* A; const bf16_t* Bt; int lda, K, nM, nN, G, c;
    __device__ __forceinline__ bool next(int i, GUnit& u) const {
        const long L = (long)i * G + c; if (L >= (long)nM * nN) return false;
        int pm, pn; map_unit((int)L, nM, nN, pm, pn);
        u.a = (const char*)(A + (size_t)pm * BM * lda); u.b = (const char*)(Bt + (size_t)pn * BM * K); u.pn = pn; u.row0 = pm * BM; u.nrows = BM; u.aux = 0; return true;
    }
};
struct BandSched {
    const bf16_t* A; const bf16_t* Bt; int lda, ldb, nM, nN, G, c;
    __device__ __forceinline__ bool next(int i, GUnit& u) const {
        const long L = (long)i * G + c; if (L >= (long)nM * nN) return false;
        int pm, pn; map_unit((int)L, nM, nN, pm, pn);
        int k0 = ((128 * pn / 80) * 80 / 64) * 64; k0 = k0 > ldb - 384 ? ldb - 384 : k0;
        u.a = (const char*)(A + (size_t)pm * BM * lda + k0); u.b = (const char*)(Bt + (size_t)pn * BM * ldb + k0); u.pn = pn; u.row0 = pm * BM; u.nrows = BM; u.aux = 0; return true;
    }
};
struct MoeSched {
    const unsigned char* A; const unsigned char* W; const int4* tiles; const int* inv; int NT, nN, N, K, G, c;
    __device__ __forceinline__ bool next(int i, GUnit& u) const {
        const long L = (long)i * G + c; if (L >= (long)NT * nN) return false;
        int pm, pn; map_unit((int)L, NT, nN, pm, pn);
        const int4 t = tiles[1 + pm];
        const int e = __builtin_amdgcn_readfirstlane(t.x), r0 = __builtin_amdgcn_readfirstlane(t.y), nr = __builtin_amdgcn_readfirstlane(t.z);
        u.a = (const char*)(A + (size_t)r0 * K); u.b = (const char*)(W + ((size_t)e * N + (size_t)pn * BM) * K); u.pn = pn; u.row0 = r0; u.nrows = nr; u.aux = e; return true;
    }
};

template <bool F8, bool GATHER = false, class Epi, class Sched>
__device__ __forceinline__ void gemm_phase(LAS unsigned char* lds, const int K  , const int lda, const int ldb  , const Sched& S, const Epi& E) {
    const int tid = tid_opaque(), wid = __builtin_amdgcn_readfirstlane(tid >> 6), lane = tid & 63, wr = wid >> 2, wc = wid & 3, fr = lane & 15, fq = lane >> 4;
    const int nt = F8 ? K / 128 : K / BK;
    unsigned voffA[2], voffB[2];
#pragma unroll
    for (int i = 0; i < 2; ++i) { int R, C; stage_rc(tid * 16 + i * 8192, R, C); voffA[i] = F8 ? (unsigned)(R * lda + 2 * C) : (unsigned)(R * lda + C) * 2u; voffB[i] = F8 ? (unsigned)(R * ldb + 2 * C) : (unsigned)(R * ldb + C) * 2u; }
    int gR[2]; unsigned gC[2]; unsigned vc[2][2], vn[2][2];
#pragma unroll
    for (int i = 0; i < 2; ++i) { int R, C; stage_rc(tid * 16 + i * 8192, R, C); gR[i] = R; gC[i] = 2u * (unsigned)C; }
#define PG8_GLOAD(dst, unit) do { if constexpr (GATHER) { _Pragma("unroll") for (int _h = 0; _h < 2; ++_h) _Pragma("unroll") for (int _i = 0; _i < 2; ++_i) \
        dst[_h][_i] = (unsigned)S.inv[(unit).row0 + _h * HALF + gR[_i]] * (unsigned)lda + gC[_i]; } } while (0)
#define PG8_STAGE_A(bufoff, h, kofs, unext) do { if constexpr (GATHER) { _Pragma("unroll") for (int _i = 0; _i < 2; ++_i) \
        __builtin_amdgcn_global_load_lds((const unsigned*)((const char*)S.A + (kofs) + ((unext) ? vn[h][_i] : vc[h][_i])), (LAS unsigned*)(lds + (bufoff) + ldsw + _i * 8192), 16, 0, 0); } \
        else PG8_STAGE(bufoff, ((unext) ? nA : cA) + (h) * hstepA + (kofs), voffA); } while (0)
    const size_t kstep = (size_t)(BK * 2);
    const size_t hstepA = (size_t)HALF * lda * (F8 ? 1 : 2), hstepB = (size_t)HALF * ldb * (F8 ? 1 : 2);
    const unsigned ldsw = (unsigned)wid * 1024u;
    const int aoff = lds_byte(wr * 64 + fr, fq * 8), boff = lds_byte(wc * 32 + fr, fq * 8);
    const LAS unsigned char* ldsA = lds + aoff; const LAS unsigned char* ldsB = lds + 65536 + boff;
#define PG8_SA(b, h) (((b) * 2 + (h)) * HTB)
#define PG8_SB(b, h) ((4 + (b) * 2 + (h)) * HTB)
#define PG8_STAGE(bufoff, gbase, voff) do { _Pragma("unroll") for (int _i = 0; _i < 2; ++_i) \
        __builtin_amdgcn_global_load_lds((const unsigned*)((const char*)(gbase) + (voff)[_i]), (LAS unsigned*)(lds + (bufoff) + ldsw + _i * 8192), 16, 0, 0); } while (0)
#define PG8_LD16(off) (*(const LAS u32x4*)(lds + (off)))
#define PG8_LDA16(off) (*(const LAS u32x4*)(ldsA + (off)))
#define PG8_LDB16(off) (*(const LAS u32x4*)(ldsB + (off)))
#define PG8_LDA(dst, b, h) do { _Pragma("unroll") for (int m = 0; m < 4; ++m) { \
        if constexpr (F8) dst##8[m] = __builtin_shufflevector(PG8_LDA16(PG8_SA(b, h) + m * 2048), PG8_LDA16(PG8_SA(b, h) + m * 2048 + 1024), 0, 1, 2, 3, 4, 5, 6, 7); \
        else { _Pragma("unroll") for (int k = 0; k < 2; ++k) dst[m][k] = *(const LAS bf16x8*)(lds + PG8_SA(b, h) + aoff + m * 2048 + k * 1024); } } } while (0)
#define PG8_LDB(dst, b, h) do { _Pragma("unroll") for (int n = 0; n < 2; ++n) { \
        if constexpr (F8) dst##8[n] = __builtin_shufflevector(PG8_LDB16(PG8_SB(b, h) - 65536 + n * 2048), PG8_LDB16(PG8_SB(b, h) - 65536 + n * 2048 + 1024), 0, 1, 2, 3, 4, 5, 6, 7); \
        else { _Pragma("unroll") for (int k = 0; k < 2; ++k) dst[n][k] = *(const LAS bf16x8*)(lds + PG8_SB(b, h) + boff + n * 2048 + k * 1024); } } } while (0)
#define PG8_MMA(ai, bj, At, Bt) do { __builtin_amdgcn_s_setprio(1); _Pragma("unroll") for (int m = 0; m < 4; ++m) _Pragma("unroll") for (int n = 0; n < 2; ++n) { \
        if constexpr (F8) asm("v_mfma_f32_16x16x128_f8f6f4 %0, %1, %2, %0" : "+v"(acc[ai][bj][m][n]) : "v"(Bt##8[n]), "v"(At##8[m])); \
        else { _Pragma("unroll") for (int k = 0; k < 2; ++k) acc[ai][bj][m][n] = __builtin_amdgcn_mfma_f32_16x16x32_bf16(Bt[n][k], At[m][k], acc[ai][bj][m][n], 0, 0, 0); } } \
        __builtin_amdgcn_s_setprio(0); } while (0)
#define PG8_WAIT_V(n) asm volatile("s_waitcnt vmcnt(" #n ")" ::: "memory")
#define PG8_WAIT_L(n) asm volatile("s_waitcnt lgkmcnt(" #n ")" ::: "memory")
#define PG8_BAR __builtin_amdgcn_s_barrier()
#define PG8_SCHED __builtin_amdgcn_sched_barrier(0)
    GUnit cur, nxt; int ui = 0;
    if (!S.next(0, cur)) return;
    f32x4 acc[2][2][4][2];
#pragma unroll
    for (int a = 0; a < 2; ++a)
#pragma unroll
        for (int b = 0; b < 2; ++b)
#pragma unroll
            for (int m = 0; m < 4; ++m)
#pragma unroll
                for (int n = 0; n < 2; ++n) acc[a][b][m][n] = (f32x4){0.f, 0.f, 0.f, 0.f};
    bf16x8 At[4][2], B0[2][2], B1[2][2];
    typedef unsigned u32x8 __attribute__((ext_vector_type(8)));
    u32x8 At8[4], B08[2], B18[2];
    const char* cA = cur.a; const char* cB = cur.b; const char* nA = cA;
    PG8_GLOAD(vc, cur);
    PG8_STAGE(PG8_SB(0, 0), cB, voffB); PG8_STAGE_A(PG8_SA(0, 0), 0, (size_t)0, false); PG8_STAGE(PG8_SB(0, 1), cB + hstepB, voffB); PG8_STAGE_A(PG8_SA(0, 1), 1, (size_t)0, false);
    if (wr == 1) PG8_BAR;
    PG8_WAIT_V(4); PG8_BAR;
    PG8_STAGE(PG8_SB(1, 0), cB + kstep, voffB); PG8_STAGE_A(PG8_SA(1, 0), 0, kstep, false); PG8_STAGE(PG8_SB(1, 1), cB + hstepB + kstep, voffB);
    PG8_WAIT_V(6); PG8_BAR;
    for (;;) {
        const bool has_next = S.next(ui + 1, nxt);
        nA = has_next ? nxt.a : cA; const char* nB = has_next ? nxt.b : cB;
        if (has_next) PG8_GLOAD(vn, nxt); else { _Pragma("unroll") for (int _h = 0; _h < 2; ++_h) _Pragma("unroll") for (int _i = 0; _i < 2; ++_i) vn[_h][_i] = vc[_h][_i]; }
#pragma unroll 1
        for (int t = 0; t < nt; t += 2) {
            const bool last = (t == nt - 2);
            const size_t ka1 = (size_t)(t + 1) * kstep, ka2 = last ? (size_t)0 : (size_t)(t + 2) * kstep, ka3 = ka2 + kstep;
            const char* b2 = last ? nB : cB + (size_t)(t + 2) * kstep;
            const char* b3 = b2 + kstep;
            PG8_LDB(B0, 0, 0); PG8_SCHED; PG8_LDA(At, 0, 0); PG8_STAGE_A(PG8_SA(1, 1), 1, ka1, false);
            PG8_WAIT_L(8); PG8_BAR; PG8_WAIT_L(0); PG8_MMA(0, 0, At, B0); PG8_BAR; PG8_SCHED;
            PG8_LDB(B1, 0, 1); PG8_STAGE(PG8_SB(0, 0), b2, voffB);
            PG8_BAR; PG8_WAIT_L(0); PG8_MMA(0, 1, At, B1); PG8_BAR;
            PG8_LDA(At, 0, 1); PG8_STAGE_A(PG8_SA(0, 0), 0, ka2, last);
            PG8_BAR; PG8_WAIT_L(0); PG8_MMA(1, 0, At, B0); PG8_BAR; PG8_SCHED;
            PG8_STAGE(PG8_SB(0, 1), b2 + hstepB, voffB);
            PG8_WAIT_V(6); PG8_BAR; PG8_MMA(1, 1, At, B1); PG8_BAR;
            PG8_LDB(B0, 1, 0); PG8_SCHED; PG8_LDA(At, 1, 0); PG8_STAGE_A(PG8_SA(0, 1), 1, ka2, last);
            PG8_WAIT_L(8); PG8_BAR; PG8_WAIT_L(0); PG8_MMA(0, 0, At, B0); PG8_BAR; PG8_SCHED;
            PG8_LDB(B1, 1, 1); PG8_STAGE(PG8_SB(1, 0), b3, voffB);
            PG8_BAR; PG8_WAIT_L(0); PG8_MMA(0, 1, At, B1); PG8_BAR;
            PG8_LDA(At, 1, 1); PG8_STAGE_A(PG8_SA(1, 0), 0, ka3, last);
            PG8_BAR; PG8_WAIT_L(0); PG8_MMA(1, 0, At, B0); PG8_BAR; PG8_SCHED;
            PG8_STAGE(PG8_SB(1, 1), b3 + hstepB, voffB);
            PG8_WAIT_V(6); PG8_BAR; PG8_MMA(1, 1, At, B1); PG8_BAR;
        }
        if constexpr (F8) asm volatile("s_nop 15\n\ts_nop 15" ::: "memory");
        E(acc, cur, wr, wc, fr, fq);
        if (!has_next) break;
#pragma unroll
        for (int a = 0; a < 2; ++a)
#pragma unroll
            for (int b = 0; b < 2; ++b)
#pragma unroll
                for (int m = 0; m < 4; ++m)
#pragma unroll
                    for (int n = 0; n < 2; ++n) acc[a][b][m][n] = (f32x4){0.f, 0.f, 0.f, 0.f};
        cur = nxt; cA = nA; cB = nB; ++ui;
#pragma unroll
        for (int _h = 0; _h < 2; ++_h)
#pragma unroll
            for (int _i = 0; _i < 2; ++_i) vc[_h][_i] = vn[_h][_i];
    }
    PG8_WAIT_V(0);
    if (wr == 0) PG8_BAR;
    PG8_BAR;
#undef PG8_SA
#undef PG8_SB
#undef PG8_STAGE
#undef PG8_STAGE_A
#undef PG8_GLOAD
#undef PG8_LDA
#undef PG8_LDB
#undef PG8_MMA
#undef PG8_LD16
#undef PG8_LDA16
#undef PG8_LDB16
#undef PG8_WAIT_V
#undef PG8_WAIT_L
#undef PG8_BAR
#undef PG8_SCHED
}
typedef f32x4 acc_t[2][2][4][2];
__device__ __forceinline__ u32x4 pack8(f32x4 a, f32x4 b) { return (u32x4){cvt_pk_bf16(a[0], a[1]), cvt_pk_bf16(a[2], a[3]), cvt_pk_bf16(b[0], b[1]), cvt_pk_bf16(b[2], b[3])}; }
__device__ __forceinline__ void unpack8(u32x4 v, float* f) { f[0] = bf_lo(v[0]); f[1] = bf_hi(v[0]); f[2] = bf_lo(v[1]); f[3] = bf_hi(v[1]); f[4] = bf_lo(v[2]); f[5] = bf_hi(v[2]); f[6] = bf_lo(v[3]); f[7] = bf_hi(v[3]); }

template <bool MASK> struct EpiPlain {
    bf16_t* O; int ldo; float scale;
    __device__ __forceinline__ void operator()(const acc_t& acc, const GUnit& u, int wr, int wc, int fr, int fq) const {
        const int colb = u.pn * 256 + wc * 32 + fq * 8;
#pragma unroll
        for (int ai = 0; ai < 2; ++ai)
#pragma unroll
            for (int m = 0; m < 4; ++m) {
                const int r = ai * 128 + wr * 64 + m * 16 + fr;
                if (MASK && r >= u.nrows) continue;
                bf16_t* rowp = O + (size_t)(u.row0 + r) * ldo + colb;
#pragma unroll
                for (int bj = 0; bj < 2; ++bj) st16(rowp + bj * 128, pack8(acc[ai][bj][m][0] * scale, acc[ai][bj][m][1] * scale));
            }
    }
};

struct EpiResid {
    float* XF; const float* XR;
    __device__ __forceinline__ void operator()(const acc_t& acc, const GUnit& u, int wr, int wc, int fr, int fq) const {
        const int colb = u.pn * 256 + wc * 32 + fq * 8;
#pragma unroll
        for (int ai = 0; ai < 2; ++ai)
#pragma unroll
            for (int m = 0; m < 4; ++m) {
                const int r = ai * 128 + wr * 64 + m * 16 + fr;
                float* rowp = XF + (size_t)(u.row0 + r) * 1024 + colb; const float* rrow = XR + (size_t)(u.row0 + r) * 1024 + colb;
                asm volatile("" ::: "memory");
#pragma unroll
                for (int bj = 0; bj < 2; ++bj) {
                    const f32x4 x0 = *(const f32x4*)(rrow + bj * 128), x1 = *(const f32x4*)(rrow + bj * 128 + 4);
                    *(f32x4*)(rowp + bj * 128) = x0 * DN_ALPHA + acc[ai][bj][m][0]; *(f32x4*)(rowp + bj * 128 + 4) = x1 * DN_ALPHA + acc[ai][bj][m][1];
                }
            }
    }
};

__device__ __forceinline__ float clamp8(float x) { return __builtin_amdgcn_fmed3f(x, -448.f, 448.f); }
__device__ __forceinline__ u32x2 pack8_fp8(const float* f) {
    unsigned a = 0u, b = 0u;
    a = __builtin_amdgcn_cvt_pk_fp8_f32(clamp8(f[0]), clamp8(f[1]), a, false); a = __builtin_amdgcn_cvt_pk_fp8_f32(clamp8(f[2]), clamp8(f[3]), a, true);
    b = __builtin_amdgcn_cvt_pk_fp8_f32(clamp8(f[4]), clamp8(f[5]), b, false); b = __builtin_amdgcn_cvt_pk_fp8_f32(clamp8(f[6]), clamp8(f[7]), b, true);
    return (u32x2){a, b};
}
__device__ __forceinline__ void unpack8_fp8(u32x2 v, float* f) {
    const f32x2 a = __builtin_amdgcn_cvt_pk_f32_fp8(v[0], false), b = __builtin_amdgcn_cvt_pk_f32_fp8(v[0], true), c = __builtin_amdgcn_cvt_pk_f32_fp8(v[1], false), d = __builtin_amdgcn_cvt_pk_f32_fp8(v[1], true);
    f[0] = a[0]; f[1] = a[1]; f[2] = b[0]; f[3] = b[1]; f[4] = c[0]; f[5] = c[1]; f[6] = d[0]; f[7] = d[1]; }
struct EpiMoeDown8 {
    unsigned char* O; float scale;
    __device__ __forceinline__ void operator()(const acc_t& acc, const GUnit& u, int wr, int wc, int fr, int fq) const {
        const int colb = u.pn * 256 + wc * 32 + fq * 8;
#pragma unroll
        for (int ai = 0; ai < 2; ++ai)
#pragma unroll
            for (int m = 0; m < 4; ++m) {
                const int r = ai * 128 + wr * 64 + m * 16 + fr;
                if (r >= u.nrows) continue;
                unsigned char* rowp = O + (size_t)(u.row0 + r) * 1024 + colb;
#pragma unroll
                for (int bj = 0; bj < 2; ++bj) { const f32x4 v0 = acc[ai][bj][m][0] * scale, v1 = acc[ai][bj][m][1] * scale;
                    const float f[8] = {v0[0], v0[1], v0[2], v0[3], v1[0], v1[1], v1[2], v1[3]}; *(u32x2*)(rowp + bj * 128) = pack8_fp8(f); }
            }
    }
};
struct EpiMoeGU {
    unsigned char* O;
    __device__ __forceinline__ void operator()(const acc_t& acc, const GUnit& u, int wr, int wc, int fr, int fq) const {
        const int colb = u.pn * 128 + wc * 32 + fq * 8;
#pragma unroll
        for (int ai = 0; ai < 2; ++ai)
#pragma unroll
            for (int m = 0; m < 4; ++m) {
                const int r = ai * 128 + wr * 64 + m * 16 + fr;
                if (r >= u.nrows) continue;
                float h[8];
                constexpr float DS = 1.f / (S8_X * S8_WGU);
#pragma unroll
                for (int bj = 0; bj < 2; ++bj)
#pragma unroll
                    for (int jj = 0; jj < 4; ++jj) h[bj * 4 + jj] = silu_(acc[ai][bj][m][0][jj] * DS) * (acc[ai][bj][m][1][jj] * (DS * S8_H));
                *(u32x2*)(O + (size_t)(u.row0 + r) * 1024 + colb) = pack8_fp8(h);
            }
    }
};

struct EpiScIn {
    bf16_t* P; bf16_t* BG;
    __device__ __forceinline__ void operator()(const acc_t& acc, const GUnit& u, int wr, int wc, int fr, int fq) const {
        if (u.pn < 8) {
            const int colb = u.pn * 128 + wc * 32 + fq * 8;
#pragma unroll
            for (int ai = 0; ai < 2; ++ai)
#pragma unroll
                for (int m = 0; m < 4; ++m) {
                    const int r = ai * 128 + wr * 64 + m * 16 + fr;
                    st16(P + (size_t)(u.row0 + r) * 1024 + colb, pack8(acc[ai][0][m][0] * acc[ai][0][m][1], acc[ai][1][m][0] * acc[ai][1][m][1]));
                }
        } else {
            const int colb = (u.pn - 8) * 256 + wc * 32 + fq * 8;
#pragma unroll
            for (int ai = 0; ai < 2; ++ai)
#pragma unroll
                for (int m = 0; m < 4; ++m) {
                    const int r = ai * 128 + wr * 64 + m * 16 + fr;
                    bf16_t* rowp = BG + (size_t)(u.row0 + r) * 1024 + colb;
#pragma unroll
                    for (int bj = 0; bj < 2; ++bj) st16(rowp + bj * 128, pack8(acc[ai][bj][m][0], acc[ai][bj][m][1]));
                }
        }
    }
};

struct EpiLruIn {
    bf16_t* GG; bf16_t* REC;
    __device__ __forceinline__ void operator()(const acc_t& acc, const GUnit& u, int wr, int wc, int fr, int fq) const {
        const bool isg = u.pn < 5;
        bf16_t* O = GG + (isg ? 0l : (REC - GG));
        const int colb = (isg ? u.pn : u.pn - 5) * 256 + wc * 32 + fq * 8;
#pragma unroll
        for (int ai = 0; ai < 2; ++ai)
#pragma unroll
            for (int m = 0; m < 4; ++m) {
                const int r = ai * 128 + wr * 64 + m * 16 + fr;
                bf16_t* rowp = O + (size_t)(u.row0 + r) * LRU_W + colb;
#pragma unroll
                for (int bj = 0; bj < 2; ++bj) {
                    f32x4 v0 = acc[ai][bj][m][0], v1 = acc[ai][bj][m][1];
                    if (isg) {
#pragma unroll
                        for (int jj = 0; jj < 4; ++jj) { v0[jj] = gelu_tanh(v0[jj]); v1[jj] = gelu_tanh(v1[jj]); }
                    }
                    st16(rowp + bj * 128, pack8(v0, v1));
                }
            }
    }
};

struct EpiLruGate {
    const bf16_t* U; bf16_t* LOGA; bf16_t* BIN; const float* ba; const float* bx; const float* lam;
    __device__ __forceinline__ void operator()(const acc_t& acc, const GUnit& u, int wr, int wc, int fr, int fq) const {
        const int ch0 = u.pn * 128 + wc * 32 + fq * 8;
        float ba8[8], bx8[8], ls8[8];
#pragma unroll
        for (int i = 0; i < 8; ++i) { ba8[i] = ba[ch0 + i]; bx8[i] = bx[ch0 + i]; const float l = lam[ch0 + i]; ls8[i] = -8.f * log1pf(__expf(-l)); }
#pragma unroll
        for (int ai = 0; ai < 2; ++ai)
#pragma unroll
            for (int m = 0; m < 4; ++m) {
                const int r = ai * 128 + wr * 64 + m * 16 + fr;
                const size_t off = (size_t)(u.row0 + r) * LRU_W + ch0;
                float u8[8]; unpack8(ld16(U + off), u8);
                f32x4 la[2], bi[2];
#pragma unroll
                for (int bj = 0; bj < 2; ++bj)
#pragma unroll
                    for (int jj = 0; jj < 4; ++jj) {
                        const int i = bj * 4 + jj;
                        const float rg = sigmoidf_(acc[ai][bj][m][0][jj] + ba8[i]);
                        const float ig = sigmoidf_(acc[ai][bj][m][1][jj] + bx8[i]);
                        const float l = rg * ls8[i];
                        const float om = fmaxf(1.f - fast_exp(2.f * l), 0.f);
                        la[bj][jj] = l; bi[bj][jj] = __builtin_sqrtf(om) * ig * u8[i];
                    }
                st16(LOGA + off, pack8(la[0], la[1]));
                st16(BIN + off, pack8(bi[0], bi[1]));
            }
    }
};

struct EpiNsaIn {
    bf16_t* Q; bf16_t* KC; bf16_t* VC; bf16_t* KS; bf16_t* VST; bf16_t* KW; bf16_t* VWT; float* GATES; const int* pos; const float* bgate;
    __device__ __forceinline__ void operator()(const acc_t& acc, const GUnit& u, int wr, int wc, int fr, int fq) const {
        const int pn = u.pn;
        if (pn <= 3 || pn == 6 || pn == 8) {
            bf16_t* O = Q + (pn <= 3 ? 0l : (pn == 6 ? (KS - Q) : (KW - Q)));
            const int ldo = pn <= 3 ? 1024 : 256;
            const int colbase = pn <= 3 ? pn * 256 : 0;
            const float scale = pn <= 3 ? 0.125f * LOG2E : 1.f;
            float invf[4];
#pragma unroll
            for (int jj = 0; jj < 4; ++jj) invf[jj] = exp2f(-(float)(16 * (wc & 1) + 4 * fq + jj) * (13.287712379549449f / 32.f));
#pragma unroll
            for (int ai = 0; ai < 2; ++ai)
#pragma unroll
                for (int m = 0; m < 4; ++m) {
                    const int row = u.row0 + ai * 128 + wr * 64 + m * 16 + fr;
                    const float p = (float)pos[row];
                    float sn[4], cs[4];
#pragma unroll
                    for (int jj = 0; jj < 4; ++jj) sincos_rad(p * invf[jj], sn[jj], cs[jj]);
#pragma unroll
                    for (int bj = 0; bj < 2; ++bj) {
                        const f32x4 x1 = acc[ai][bj][m][0], x2 = acc[ai][bj][m][1];
                        float o1[4], o2[4];
#pragma unroll
                        for (int jj = 0; jj < 4; ++jj) { o1[jj] = (x1[jj] * cs[jj] - x2[jj] * sn[jj]) * scale; o2[jj] = (x1[jj] * sn[jj] + x2[jj] * cs[jj]) * scale; }
                        bf16_t* p1 = O + (size_t)row * ldo + colbase + 64 * (2 * bj + (wc >> 1)) + 16 * (wc & 1) + 4 * fq;
                        *(u32x2*)p1 = (u32x2){cvt_pk_bf16(o1[0], o1[1]), cvt_pk_bf16(o1[2], o1[3])};
                        *(u32x2*)(p1 + 32) = (u32x2){cvt_pk_bf16(o2[0], o2[1]), cvt_pk_bf16(o2[2], o2[3])};
                    }
                }
        } else if (pn == 4 || pn == 5) {
            bf16_t* O = KC + (pn == 4 ? 0l : (VC - KC));
            const int colb = wc * 32 + fq * 8;
#pragma unroll
            for (int ai = 0; ai < 2; ++ai)
#pragma unroll
                for (int m = 0; m < 4; ++m) {
                    const int row = u.row0 + ai * 128 + wr * 64 + m * 16 + fr;
#pragma unroll
                    for (int bj = 0; bj < 2; ++bj) st16(O + (size_t)row * 256 + colb + bj * 128, pack8(acc[ai][bj][m][0], acc[ai][bj][m][1]));
                }
        } else if (pn == 7 || pn == 9) {
            bf16_t* O = VST + (pn == 7 ? 0l : (VWT - VST));
#pragma unroll
            for (int ai = 0; ai < 2; ++ai)
#pragma unroll
                for (int m = 0; m < 4; ++m) {
                    const int row = u.row0 + ai * 128 + wr * 64 + m * 16 + fr;
                    const int b = row >> 11, s = row & 2047;
#pragma unroll
                    for (int bj = 0; bj < 2; ++bj) {
                        const int g = 2 * bj + (wc >> 1);
                        bf16_t* base = O + ((size_t)(b * 4 + g) * 64 + 32 * (wc & 1) + 8 * fq) * SEQ + s;
#pragma unroll
                        for (int n = 0; n < 2; ++n)
#pragma unroll
                            for (int jj = 0; jj < 4; ++jj) base[(size_t)(4 * n + jj) * SEQ] = f2bf(acc[ai][bj][m][n][jj]);
                    }
                }
        } else {
            if (wc < 2 && (wc == 0 || fq < 2)) {
                const int c0 = 32 * wc + 8 * fq;
                f32x4 bg[2];
#pragma unroll
                for (int n = 0; n < 2; ++n) bg[n] = *(const f32x4*)(bgate + c0 + 4 * n);
#pragma unroll
                for (int ai = 0; ai < 2; ++ai)
#pragma unroll
                    for (int m = 0; m < 4; ++m) {
                        const int row = u.row0 + ai * 128 + wr * 64 + m * 16 + fr;
#pragma unroll
                        for (int n = 0; n < 2; ++n) {
                            f32x4 v;
#pragma unroll
                            for (int jj = 0; jj < 4; ++jj) v[jj] = sigmoidf_(acc[ai][0][m][n][jj] + bg[n][jj]);
                            *(f32x4*)(GATES + (size_t)row * 48 + c0 + 4 * n) = v;
                        }
                    }
            }
        }
    }
};
__device__ __forceinline__ int map_plain8(int cc) { const int bj = cc >> 7, wc = (cc >> 5) & 3, n = (cc >> 4) & 1, fq = (cc >> 2) & 3; return 128 * bj + 32 * wc + 8 * fq + 4 * n; }
__device__ __forceinline__ int map_rope(int cc) { const int bj = cc >> 7, wc = (cc >> 5) & 3, n = (cc >> 4) & 1, fq = (cc >> 2) & 3; return 64 * (2 * bj + (wc >> 1)) + 32 * n + 16 * (wc & 1) + 4 * fq; }
__device__ __forceinline__ void map_pair(int cc, int& n, int& ch) { const int bj = cc >> 7, wc = (cc >> 5) & 3, fq = (cc >> 2) & 3; n = (cc >> 4) & 1; ch = 32 * wc + 8 * fq + 4 * bj; }
constexpr f32x4 F4ZERO = {0.f, 0.f, 0.f, 0.f};

struct FetchNsaIn { const float* W;
    __device__ __forceinline__ f32x4 operator()(int, int c4, int k) const { const int pn = c4 >> 8, cc = c4 & 255; const bool rope = (pn <= 3 || pn == 6 || pn == 8);
        const int col = pn * 256 + (rope ? map_rope(cc) : map_plain8(cc)); if (col >= 2608) return F4ZERO; return *(const f32x4*)(W + (size_t)k * 2608 + col); } };
struct FetchPlain { const float* W; int ld; size_t bstride;
    __device__ __forceinline__ f32x4 operator()(int bt, int c4, int k) const { const int col = (c4 & ~255) + map_plain8(c4 & 255); return *(const f32x4*)(W + (size_t)bt * bstride + (size_t)k * ld + col); } };
struct FetchPair { const float* W0; long d01; int ld; size_t bstride;
    __device__ __forceinline__ f32x4 operator()(int bt, int c4, int k) const { int n, ch; map_pair(c4 & 255, n, ch); ch += (c4 >> 8) * 128; return *(const f32x4*)(W0 + (n ? d01 : 0l) + (long)((size_t)bt * bstride + (size_t)k * ld + ch)); } };
struct FetchScIn { const float* W;
    __device__ __forceinline__ f32x4 operator()(int, int c4, int k) const { const int pn = c4 >> 8, cc = c4 & 255;
        if (pn < 8) { int n, ch; map_pair(cc, n, ch); ch += pn * 128; return *(const f32x4*)(W + (size_t)k * 3072 + (n ? 2048 : 0) + ch); }
        return *(const f32x4*)(W + (size_t)k * 3072 + 1024 + (pn - 8) * 256 + map_plain8(cc)); } };
struct FetchLruGate { const float* wa; long dax;
    __device__ __forceinline__ f32x4 operator()(int, int c4, int k) const { int n, ch; map_pair(c4 & 255, n, ch); ch += (c4 >> 8) * 128; const int h = ch / 80; if (k / 80 != h) return F4ZERO;
        return *(const f32x4*)(wa + (n ? dax : 0l) + (long)(h * 6400 + (k - 80 * h) * 80 + (ch - 80 * h))); } };
struct FetchIdent { const float* W; int ld; size_t bstride;
    __device__ __forceinline__ f32x4 operator()(int bt, int c4, int k) const { return *(const f32x4*)(W + (size_t)bt * bstride + (size_t)k * ld + c4); } };

template <bool OUT8 = false, class F>
__device__ __forceinline__ void convert_wt(LAS unsigned char* lds, void* dstv, int nbatch, int Nd, int K, const F& fetch, const float scale = 1.f) {
    constexpr int GRP = 4;
    LAS float* tile = (LAS float*)lds;
    const int tid = tid_opaque();
    const int ntk = K / 64, ntc = Nd / 64, per = ntc * ntk, total = per * nbatch;
    const bool split = (Nd & 255) == 0;
    const int c4i = tid & 15, kk = tid >> 4, rr4 = 4 * c4i, row = tid >> 3, k8 = (tid & 7) * 8;
    for (int t0 = blockIdx.x * GRP; t0 < total; t0 += gridDim.x * GRP) {
        f32x4 v[GRP][2];
#pragma unroll
        for (int gi = 0; gi < GRP; ++gi) {
            const int t = t0 + gi;
            if (t < total) {
                const int bt = t / per, tt = t - bt * per, tc = tt / ntk, tk = tt - tc * ntk, k0 = tk * 64;
                const int cbase = split ? (tc >> 2) * 256 + (tc & 3) * 32 : tc * 64;
                const int crow4 = cbase + (split ? ((rr4 & 31) + (rr4 >> 5) * 128) : rr4);
#pragma unroll
                for (int p = 0; p < 2; ++p) v[gi][p] = fetch(bt, crow4, k0 + kk + 32 * p);
            }
        }
        __syncthreads();
#pragma unroll
        for (int gi = 0; gi < GRP; ++gi)
            if (t0 + gi < total) {
#pragma unroll
                for (int p = 0; p < 2; ++p)
#pragma unroll
                    for (int j = 0; j < 4; ++j) tile[gi * 4160 + (4 * c4i + j) * 65 + kk + 32 * p] = v[gi][p][j];
            }
        __syncthreads();
#pragma unroll
        for (int gi = 0; gi < GRP; ++gi) {
            const int t = t0 + gi;
            if (t < total) {
                const int bt = t / per, tt = t - bt * per, tc = tt / ntk, tk = tt - tc * ntk, k0 = tk * 64;
                const int cbase = split ? (tc >> 2) * 256 + (tc & 3) * 32 : tc * 64;
                const int crow = cbase + (split ? ((row & 31) + (row >> 5) * 128) : row);
                float f[8];
#pragma unroll
                for (int i = 0; i < 8; ++i) f[i] = tile[gi * 4160 + row * 65 + k8 + i];
                if constexpr (OUT8) {
#pragma unroll
                    for (int i = 0; i < 8; ++i) f[i] *= scale;
                    *(u32x2*)((unsigned char*)dstv + ((size_t)bt * Nd + crow) * K + k0 + k8) = pack8_fp8(f);
                } else st16((bf16_t*)dstv + ((size_t)bt * Nd + crow) * K + k0 + k8, (u32x4){cvt_pk_bf16(f[0], f[1]), cvt_pk_bf16(f[2], f[3]), cvt_pk_bf16(f[4], f[5]), cvt_pk_bf16(f[6], f[7])});
            }
        }
    }
    __syncthreads();
}

__device__ __forceinline__ void convert_x(const float* x, bf16_t* XA) {
    const size_t n8 = (size_t)T_TOK * DM / 8;
    const int tidx = tid_opaque();
    for (size_t i = (size_t)blockIdx.x * NTHR + tidx; i < n8; i += (size_t)gridDim.x * NTHR) {
        const f32x4 a = *(const f32x4*)(x + i * 8), b = *(const f32x4*)(x + i * 8 + 4);
        st16(XA + i * 8, pack8(a, b));
    }
}
__device__ __forceinline__ void cmp_bias_phase(LAS unsigned char* lds, const float* pek, const float* w1k, const float* pev, const float* w1v, float* bias1) {
    LAS float* red = (LAS float*)lds;
    const int tidx = tid_opaque();
    for (int blk = blockIdx.x; blk < 32; blk += gridDim.x) {
        const int v = blk >> 3, j = v >> 1, kv = v & 1, hid = (blk & 7) * 8 + (tidx & 7), part = tidx >> 3;
        const float* pe = pek + (kv ? (pev - pek) : 0l) + j * 2048; const float* w1 = w1k + (kv ? (w1v - w1k) : 0l) + (size_t)j * 2048 * 64;
        float s = 0.f;
#pragma unroll 8
        for (int i = part * 32; i < part * 32 + 32; ++i) s += pe[i] * w1[i * 64 + hid];
        __syncthreads();
        red[part * 8 + (tidx & 7)] = s;
        __syncthreads();
        if (tidx < 8) { float t = 0.f; for (int q = 0; q < 64; ++q) t += red[q * 8 + tidx]; bias1[v * 64 + (blk & 7) * 8 + tidx] = t; }
    }
    __syncthreads();
}

__device__ __forceinline__ void ln1_router_phase(LAS unsigned char* lds, const float* XF, const bf16_t* MBm, float* XW, unsigned char* X8, const float* gam, const float* bet,
                                                 const float* rw, const float* rb, int* route_e, float* route_w, int* cnt) {
    LAS f32x4* rwl = (LAS f32x4*)lds;
    LAS int* lcnt = (LAS int*)(lds + 65536);
    const int tid = tid_opaque(), lane = tid & 63, w = tid >> 6;
    __syncthreads();
    for (int i = tid; i < 4096; i += NTHR) { const int col = i >> 2, q = i & 3; const int seg = col >> 9, ln = (col >> 3) & 63, j = col & 7;
        rwl[((q * 2 + seg) * 8 + j) * 64 + ln] = *(const f32x4*)(rw + col * 16 + 4 * q); }
    for (int chunk = blockIdx.x; chunk < 256; chunk += gridDim.x) {
        __syncthreads();
        if (tid < 16) lcnt[tid] = 0;
        __syncthreads();
        const size_t row0 = (size_t)chunk * 256 + w * 32;
        f32x4 nx[2][4]; u32x4 nm[2][2];
#pragma unroll
        for (int rr = 0; rr < 2; ++rr)
#pragma unroll
            for (int sg = 0; sg < 2; ++sg) { nx[rr][sg * 2] = *(const f32x4*)(XF + (row0 + rr) * DM + sg * 512 + lane * 8); nx[rr][sg * 2 + 1] = *(const f32x4*)(XF + (row0 + rr) * DM + sg * 512 + lane * 8 + 4);
                nm[rr][sg] = ld16(MBm + (row0 + rr) * DM + sg * 512 + lane * 8); }
        for (int i = 0; i < 32; i += 2) {
            f32x2 y2[16];
            {
                float xv[2][16];
#pragma unroll
                for (int rr = 0; rr < 2; ++rr) {
#pragma unroll
                    for (int sg = 0; sg < 2; ++sg) { float mv[8]; unpack8(nm[rr][sg], mv);
#pragma unroll
                        for (int j = 0; j < 4; ++j) { xv[rr][sg * 8 + j] = DN_ALPHA * nx[rr][sg * 2][j] + mv[j]; xv[rr][sg * 8 + 4 + j] = DN_ALPHA * nx[rr][sg * 2 + 1][j] + mv[4 + j]; } }
                }
                if (i + 2 < 32) {
#pragma unroll
                    for (int rr = 0; rr < 2; ++rr)
#pragma unroll
                        for (int sg = 0; sg < 2; ++sg) { nx[rr][sg * 2] = *(const f32x4*)(XF + (row0 + i + 2 + rr) * DM + sg * 512 + lane * 8); nx[rr][sg * 2 + 1] = *(const f32x4*)(XF + (row0 + i + 2 + rr) * DM + sg * 512 + lane * 8 + 4);
                            nm[rr][sg] = ld16(MBm + (row0 + i + 2 + rr) * DM + sg * 512 + lane * 8); }
                }
                float mean[2], rstd[2];
#pragma unroll
                for (int rr = 0; rr < 2; ++rr) { float s = 0.f;
#pragma unroll
                    for (int j = 0; j < 16; ++j) s += xv[rr][j];
                    mean[rr] = wave_sum_dpp(s) * (1.f / 1024.f); }
#pragma unroll
                for (int rr = 0; rr < 2; ++rr) { float q = 0.f;
#pragma unroll
                    for (int j = 0; j < 16; ++j) { const float d = xv[rr][j] - mean[rr]; q += d * d; }
                    rstd[rr] = rsqrtf(wave_sum_dpp(q) * (1.f / 1024.f) + LN_EPS); }
#pragma unroll
                for (int sg = 0; sg < 2; ++sg) {
                    const f32x4 ga = *(const f32x4*)(gam + sg * 512 + lane * 8), gb = *(const f32x4*)(gam + sg * 512 + lane * 8 + 4);
                    const f32x4 ba = *(const f32x4*)(bet + sg * 512 + lane * 8), bb = *(const f32x4*)(bet + sg * 512 + lane * 8 + 4);
#pragma unroll
                    for (int rr = 0; rr < 2; ++rr) {
                        f32x4 o0, o1;
#pragma unroll
                        for (int j = 0; j < 4; ++j) { o0[j] = (xv[rr][sg * 8 + j] - mean[rr]) * rstd[rr] * ga[j] + ba[j]; o1[j] = (xv[rr][sg * 8 + 4 + j] - mean[rr]) * rstd[rr] * gb[j] + bb[j];
                            y2[sg * 8 + j][rr] = o0[j]; y2[sg * 8 + 4 + j][rr] = o1[j]; }
                        *(f32x4*)(XW + (row0 + i + rr) * DM + sg * 512 + lane * 8) = o0; *(f32x4*)(XW + (row0 + i + rr) * DM + sg * 512 + lane * 8 + 4) = o1;
                        { const f32x4 a8 = o0 * S8_X, b8 = o1 * S8_X; const float f8[8] = {a8[0], a8[1], a8[2], a8[3], b8[0], b8[1], b8[2], b8[3]};
                          *(u32x2*)(X8 + (row0 + i + rr) * DM + sg * 512 + lane * 8) = pack8_fp8(f8); }
                    }
                }
            }
            f32x2 lg2[16];
#pragma unroll
            for (int e = 0; e < 16; ++e) lg2[e] = (f32x2){0.f, 0.f};
#pragma unroll
            for (int sg = 0; sg < 2; ++sg)
#pragma unroll
                for (int j = 0; j < 8; ++j) {
                    if ((j & 1) == 0) __builtin_amdgcn_sched_barrier(0);
#pragma unroll
                    for (int q = 0; q < 4; ++q) {
                        const f32x4 wv = rwl[((q * 2 + sg) * 8 + j) * 64 + lane];
#pragma unroll
                        for (int e = 0; e < 4; ++e) lg2[q * 4 + e] += y2[sg * 8 + j] * (f32x2){wv[e], wv[e]};
                    }
                }
#pragma unroll
            for (int rr = 0; rr < 2; ++rr) {
                float sc[16], bi[16];
#pragma unroll
                for (int e = 0; e < 16; ++e) { const float l = wave_sum_dpp(lg2[e][rr]); sc[e] = 1.f / (1.f + __expf(-l)); bi[e] = sc[e] + rb[e]; }
                float gs[4];
#pragma unroll
                for (int g = 0; g < 4; ++g) { const float a = bi[4 * g], b = bi[4 * g + 1], c = bi[4 * g + 2], d = bi[4 * g + 3];
                    gs[g] = fmaxf(fmaxf(fmaxf(a + b, a + c), fmaxf(a + d, b + c)), fmaxf(b + d, c + d)); }
                int bg = 0; float bgs = gs[0];
#pragma unroll
                for (int g = 1; g < 4; ++g) if (gs[g] > bgs) { bgs = gs[g]; bg = g; }
                float vb[4], vs[4];
#pragma unroll
                for (int k = 0; k < 4; ++k) { vb[k] = bg == 0 ? bi[k] : (bg == 1 ? bi[4 + k] : (bg == 2 ? bi[8 + k] : bi[12 + k])); vs[k] = bg == 0 ? sc[k] : (bg == 1 ? sc[4 + k] : (bg == 2 ? sc[8 + k] : sc[12 + k])); }
                int i1 = 0; float b1 = vb[0], s1 = vs[0];
#pragma unroll
                for (int k = 1; k < 4; ++k) if (vb[k] > b1) { b1 = vb[k]; s1 = vs[k]; i1 = k; }
                int i2 = -1; float b2 = -3e38f, s2 = 0.f;
#pragma unroll
                for (int k = 0; k < 4; ++k) if (k != i1 && vb[k] > b2) { b2 = vb[k]; s2 = vs[k]; i2 = k; }
                const float inv = 1.f / (s1 + s2);
                if (lane == 0) {
                    const size_t row = row0 + i + rr;
                    const int e0 = bg * 4 + i1, e1 = bg * 4 + i2;
                    route_e[row] = e0 | (e1 << 8); route_w[row * 2] = s1 * inv; route_w[row * 2 + 1] = s2 * inv;
                    atomicAdd((int*)&lcnt[e0], 1); atomicAdd((int*)&lcnt[e1], 1);
                }
            }
        }
        __syncthreads();
        if (tid < 16) cnt[chunk * 16 + tid] = lcnt[tid];
    }
    __syncthreads();
}

__device__ __forceinline__ void moe_gather_phase(LAS unsigned char* lds, const int* route_e, const int* cnt, int* pos_out, int* inv, int4* tiles) {
    LAS int* s_tot = (LAS int*)lds; LAS int* s_pre = s_tot + 16; LAS int* s_off = s_pre + 16; LAS int* s_wcnt = s_off + 16; LAS int* s_lpos = s_wcnt + 128;
    const int tid = tid_opaque(), lane = tid & 63, w = tid >> 6;
    for (int chunk = blockIdx.x; chunk < 256; chunk += gridDim.x) {
        __syncthreads();
        { const int e = tid >> 5, j = tid & 31; int tot = 0, pre = 0;
            for (int c = j; c < 256; c += 32) { const int v = cnt[c * 16 + e]; tot += v; pre += (c < chunk) ? v : 0; }
#pragma unroll
            for (int o = 16; o >= 1; o >>= 1) { tot += __shfl_xor(tot, o); pre += __shfl_xor(pre, o); }
            if (j == 0) { s_tot[e] = tot; s_pre[e] = pre; } }
        __syncthreads();
        if (tid == 0) { int off = 0; for (int e = 0; e < 16; ++e) { s_off[e] = off; off += s_tot[e]; } }
        const int token = chunk * 256 + (tid >> 1), slot = tid & 1;
        const int re = route_e[token]; const int e = slot ? ((re >> 8) & 255) : (re & 255);
        int rk = 0;
#pragma unroll
        for (int e2 = 0; e2 < 16; ++e2) { const unsigned long long mk = __ballot(e == e2); if (e == e2) rk = __popcll(mk & ((1ull << lane) - 1ull)); if (lane == 0) s_wcnt[w * 16 + e2] = __popcll(mk); }
        __syncthreads();
        int base = s_off[e] + s_pre[e];
        for (int w2 = 0; w2 < w; ++w2) base += s_wcnt[w2 * 16 + e];
        const int p = base + rk;
        pos_out[token * 2 + slot] = p; inv[p] = token;
        if (chunk == 0 && tid == 0) {
            int nt = 0;
            for (int e2 = 0; e2 < 16; ++e2) { const int n = s_tot[e2]; for (int r = 0; r < n; r += 256) { tiles[1 + nt] = make_int4(e2, s_off[e2] + r, (n - r) < 256 ? (n - r) : 256, 0); ++nt; } }
            tiles[0] = make_int4(nt, 0, 0, 0);
        }
        if (chunk == 0 && tid < 256) inv[2 * T_TOK + tid] = 0;
    }
    __syncthreads();
}

template <bool LAST>
__device__ __forceinline__ void ln2_combine_phase(const float* XF, float* XW, const unsigned char* YM, const int* pos, const float* route_w, const float* gam, const float* bet, bf16_t* XO) {
    const int tid = tid_opaque(), lane = tid & 63, w = tid >> 6;
    float gm[16], bt[16];
#pragma unroll
    for (int s = 0; s < 2; ++s)
#pragma unroll
        for (int j = 0; j < 8; ++j) { gm[s * 8 + j] = gam[s * 512 + lane * 8 + j]; bt[s * 8 + j] = bet[s * 512 + lane * 8 + j]; }
    const size_t rstep = (size_t)gridDim.x * 8;
    int np0 = 0, np1 = 0; float nw0 = 0.f, nw1 = 0.f;
    { const size_t r0 = (size_t)blockIdx.x * 8 + w; if (r0 < (size_t)T_TOK) { np0 = pos[r0 * 2]; np1 = pos[r0 * 2 + 1]; nw0 = route_w[r0 * 2]; nw1 = route_w[r0 * 2 + 1]; } }
    for (size_t row = (size_t)blockIdx.x * 8 + w; row < (size_t)T_TOK; row += rstep) {
        const int p0 = np0, p1 = np1; const float w0 = nw0, w1 = nw1;
        { const size_t rn = row + rstep; if (rn < (size_t)T_TOK) { np0 = pos[rn * 2]; np1 = pos[rn * 2 + 1]; nw0 = route_w[rn * 2]; nw1 = route_w[rn * 2 + 1]; } }
        float xv[16], a[16], b[16];
#pragma unroll
        for (int sg = 0; sg < 2; ++sg) { const f32x4 c = *(const f32x4*)(XF + row * DM + sg * 512 + lane * 8), d = *(const f32x4*)(XF + row * DM + sg * 512 + lane * 8 + 4);
#pragma unroll
            for (int j = 0; j < 4; ++j) { xv[sg * 8 + j] = c[j]; xv[sg * 8 + 4 + j] = d[j]; } }
        unpack8_fp8(*(const u32x2*)(YM + (size_t)p0 * DM + lane * 8), a); unpack8_fp8(*(const u32x2*)(YM + (size_t)p0 * DM + 512 + lane * 8), a + 8);
        unpack8_fp8(*(const u32x2*)(YM + (size_t)p1 * DM + lane * 8), b); unpack8_fp8(*(const u32x2*)(YM + (size_t)p1 * DM + 512 + lane * 8), b + 8);
        float s = 0.f;
#pragma unroll
        for (int j = 0; j < 16; ++j) { xv[j] = DN_ALPHA * xv[j] + (w0 * a[j] + w1 * b[j]) * (1.f / S8_Y); s += xv[j]; }
        const float mean = wave_sum_dpp(s) * (1.f / 1024.f);
        float q = 0.f;
#pragma unroll
        for (int j = 0; j < 16; ++j) { const float d = xv[j] - mean; q += d * d; }
        const float rstd = rsqrtf(wave_sum_dpp(q) * (1.f / 1024.f) + LN_EPS);
        float y[16];
#pragma unroll
        for (int j = 0; j < 16; ++j) y[j] = (xv[j] - mean) * rstd * gm[j] + bt[j];
        float* outf = XW;
        *(f32x4*)(outf + row * DM + lane * 8) = (f32x4){y[0], y[1], y[2], y[3]}; *(f32x4*)(outf + row * DM + lane * 8 + 4) = (f32x4){y[4], y[5], y[6], y[7]};
        *(f32x4*)(outf + row * DM + 512 + lane * 8) = (f32x4){y[8], y[9], y[10], y[11]}; *(f32x4*)(outf + row * DM + 512 + lane * 8 + 4) = (f32x4){y[12], y[13], y[14], y[15]};
        if (!LAST) {
            st16(XO + row * DM + lane * 8, (u32x4){cvt_pk_bf16(y[0], y[1]), cvt_pk_bf16(y[2], y[3]), cvt_pk_bf16(y[4], y[5]), cvt_pk_bf16(y[6], y[7])});
            st16(XO + row * DM + 512 + lane * 8, (u32x4){cvt_pk_bf16(y[8], y[9]), cvt_pk_bf16(y[10], y[11]), cvt_pk_bf16(y[12], y[13]), cvt_pk_bf16(y[14], y[15])});
        }
    }
}

__device__ __forceinline__ void sc_conv_phase(const bf16_t* P, const bf16_t* BG, bf16_t* Y, const float* cw, const float* cb) {
    const int items = (T_TOK / 16) * 128; const int tidx = tid_opaque();
    for (int it = blockIdx.x * NTHR + tidx; it < items; it += gridDim.x * NTHR) {
        const int cg = it & 127, run = it >> 7, c0 = cg * 8; const size_t t0 = (size_t)run * 16; const int s = (int)(t0 & 2047);
        float w0[8], w1[8], w2[8], b8[8];
#pragma unroll
        for (int j = 0; j < 8; ++j) { w0[j] = cw[c0 + j]; w1[j] = cw[1024 + c0 + j]; w2[j] = cw[2048 + c0 + j]; b8[j] = cb[c0 + j]; }
        float pm2[8], pm1[8];
        if (s == 0) {
#pragma unroll
            for (int j = 0; j < 8; ++j) { pm2[j] = 0.f; pm1[j] = 0.f; }
        } else { unpack8(ld16(P + (t0 - 2) * DM + c0), pm2); unpack8(ld16(P + (t0 - 1) * DM + c0), pm1); }
#pragma unroll 4
        for (int i = 0; i < 16; ++i) {
            float cur[8], bg[8], y[8];
            unpack8(ld16(P + (t0 + i) * DM + c0), cur); unpack8(ld16(BG + (t0 + i) * DM + c0), bg);
#pragma unroll
            for (int j = 0; j < 8; ++j) { y[j] = bg[j] * (b8[j] + w0[j] * pm2[j] + w1[j] * pm1[j] + w2[j] * cur[j]); pm2[j] = pm1[j]; pm1[j] = cur[j]; }
            st16(Y + (t0 + i) * DM + c0, (u32x4){cvt_pk_bf16(y[0], y[1]), cvt_pk_bf16(y[2], y[3]), cvt_pk_bf16(y[4], y[5]), cvt_pk_bf16(y[6], y[7])});
        }
    }
}
__device__ __forceinline__ void lru_conv_phase(const bf16_t* REC, bf16_t* U, const float* cw, const float* cb) {
    const int items = (T_TOK / 16) * 160; const int tidx = tid_opaque();
    for (int it = blockIdx.x * NTHR + tidx; it < items; it += gridDim.x * NTHR) {
        const int cg = it % 160, run = it / 160, c0 = cg * 8; const size_t t0 = (size_t)run * 16; const int s = (int)(t0 & 2047);
        float w0[8], w1[8], w2[8], w3[8], b8[8];
#pragma unroll
        for (int j = 0; j < 8; ++j) { w0[j] = cw[c0 + j]; w1[j] = cw[LRU_W + c0 + j]; w2[j] = cw[2 * LRU_W + c0 + j]; w3[j] = cw[3 * LRU_W + c0 + j]; b8[j] = cb[c0 + j]; }
        float p3[8], p2[8], p1[8];
        if (s == 0) {
#pragma unroll
            for (int j = 0; j < 8; ++j) { p3[j] = 0.f; p2[j] = 0.f; p1[j] = 0.f; }
        } else { unpack8(ld16(REC + (t0 - 3) * LRU_W + c0), p3); unpack8(ld16(REC + (t0 - 2) * LRU_W + c0), p2); unpack8(ld16(REC + (t0 - 1) * LRU_W + c0), p1); }
#pragma unroll 4
        for (int i = 0; i < 16; ++i) {
            float cur[8], y[8];
            unpack8(ld16(REC + (t0 + i) * LRU_W + c0), cur);
#pragma unroll
            for (int j = 0; j < 8; ++j) { y[j] = b8[j] + w0[j] * p3[j] + w1[j] * p2[j] + w2[j] * p1[j] + w3[j] * cur[j]; p3[j] = p2[j]; p2[j] = p1[j]; p1[j] = cur[j]; }
            st16(U + (t0 + i) * LRU_W + c0, (u32x4){cvt_pk_bf16(y[0], y[1]), cvt_pk_bf16(y[2], y[3]), cvt_pk_bf16(y[4], y[5]), cvt_pk_bf16(y[6], y[7])});
        }
    }
}

__device__ __forceinline__ void lru_scan1_phase(const bf16_t* LOGA, const bf16_t* BIN, f32x4* carry) {
    const int tidx = tid_opaque(); const int lane = tidx & 63, w = tidx >> 6;
    for (int it = blockIdx.x * 8 + w; it < 10240; it += gridDim.x * 8) {
        const int cgp = it % 10, ck = (it / 10) & 31, b = it / 320, ch = cgp * 128 + lane * 2;
        const size_t base = ((size_t)b * SEQ + ck * 64) * LRU_W + ch;
        float h0 = 0.f, h1 = 0.f, s0 = 0.f, s1 = 0.f;
#pragma unroll 8
        for (int t = 0; t < 64; ++t) {
            const unsigned la = *(const unsigned*)(LOGA + base + (size_t)t * LRU_W), bi = *(const unsigned*)(BIN + base + (size_t)t * LRU_W);
            const float l0 = bf_lo(la), l1 = bf_hi(la);
            h0 = fast_exp(l0) * h0 + bf_lo(bi); h1 = fast_exp(l1) * h1 + bf_hi(bi); s0 += l0; s1 += l1;
        }
        carry[(((size_t)b * 32 + ck) * LRU_W + ch) >> 1] = (f32x4){s0, h0, s1, h1};
    }
}
__device__ __forceinline__ void lru_scan2_phase(const bf16_t* LOGA, const bf16_t* BIN, const bf16_t* GG, const f32x4* carry, bf16_t* Y) {
    const int tidx = tid_opaque(); const int lane = tidx & 63, w = tidx >> 6;
    for (int it = blockIdx.x * 8 + w; it < 10240; it += gridDim.x * 8) {
        const int cgp = it % 10, ck = (it / 10) & 31, b = it / 320, ch = cgp * 128 + lane * 2;
        float h0 = 0.f, h1 = 0.f;
        for (int c2 = 0; c2 < ck; ++c2) { const f32x4 cv = carry[(((size_t)b * 32 + c2) * LRU_W + ch) >> 1]; h0 = fast_exp(cv[0]) * h0 + cv[1]; h1 = fast_exp(cv[2]) * h1 + cv[3]; }
        const size_t base = ((size_t)b * SEQ + ck * 64) * LRU_W + ch;
#pragma unroll 8
        for (int t = 0; t < 64; ++t) {
            const unsigned la = *(const unsigned*)(LOGA + base + (size_t)t * LRU_W), bi = *(const unsigned*)(BIN + base + (size_t)t * LRU_W), gg = *(const unsigned*)(GG + base + (size_t)t * LRU_W);
            h0 = fast_exp(bf_lo(la)) * h0 + bf_lo(bi); h1 = fast_exp(bf_hi(la)) * h1 + bf_hi(bi);
            *(unsigned*)(Y + base + (size_t)t * LRU_W) = cvt_pk_bf16(bf_lo(gg) * h0, bf_hi(gg) * h1);
        }
    }
}
__device__ __forceinline__ bf16x8 pack8s(const float* f) {
    const unsigned a = cvt_pk_bf16(f[0], f[1]), b = cvt_pk_bf16(f[2], f[3]), c = cvt_pk_bf16(f[4], f[5]), d = cvt_pk_bf16(f[6], f[7]);
    u32x4 v = {a, b, c, d}; return __builtin_bit_cast(bf16x8, v);
}
__device__ __forceinline__ void nsa_compress_phase(const bf16_t* KC, const bf16_t* VC, const bf16_t* W1T, const float* w2k, const float* w2v, const float* bias1,
                                                   const int* pos, bf16_t* KCMP, bf16_t* VCMPT) {
    const int tidx = tid_opaque(); const int lane = tidx & 63, w = tidx >> 6, rowi = lane & 15, gq = lane >> 4;
    for (int task = blockIdx.x * 8 + w; task < 2048; task += gridDim.x * 8) {
        const int kv = task >> 10, tt = task & 1023, rho = tt * 16 + rowi, b = rho >> 9, n = (rho >> 2) & 127, g = rho & 3;
        const bf16_t* src = KC + (kv ? (VC - KC) : 0l) + (size_t)b * SEQ * 256 + g * 64 + 8 * gq;
        const bf16_t* w1t = W1T + (size_t)kv * 64 * 2048 + (size_t)rowi * 2048 + 8 * gq;
        f32x4 hacc[4];
#pragma unroll
        for (int ht = 0; ht < 4; ++ht) hacc[ht] = (f32x4){0.f, 0.f, 0.f, 0.f};
#pragma unroll 4
        for (int kk = 0; kk < 64; ++kk) {
            int tok = 16 * n + (kk >> 1); tok = tok > 2047 ? 2047 : tok;
            const bf16x8 af = *(const bf16x8*)(src + (size_t)tok * 256 + 32 * (kk & 1));
#pragma unroll
            for (int ht = 0; ht < 4; ++ht) { const bf16x8 wf = *(const bf16x8*)(w1t + (size_t)(16 * ht) * 2048 + kk * 32); hacc[ht] = __builtin_amdgcn_mfma_f32_16x16x32_bf16(wf, af, hacc[ht], 0, 0, 0); }
        }
        bf16x8 pf[2];
#pragma unroll
        for (int p = 0; p < 2; ++p) { float hv[8];
#pragma unroll
            for (int jj = 0; jj < 4; ++jj) { hv[jj] = gelu_tanh(hacc[2 * p][jj] + bias1[kv * 64 + 32 * p + 4 * gq + jj]); hv[4 + jj] = gelu_tanh(hacc[2 * p + 1][jj] + bias1[kv * 64 + 32 * p + 16 + 4 * gq + jj]); }
            pf[p] = pack8s(hv); }
        const float* w2 = w2k + (kv ? (w2v - w2k) : 0l);
        f32x4 oacc[4];
#pragma unroll
        for (int dt = 0; dt < 4; ++dt) { oacc[dt] = (f32x4){0.f, 0.f, 0.f, 0.f};
#pragma unroll
            for (int p = 0; p < 2; ++p) { float wv[8]; const int dout = 16 * dt + rowi;
#pragma unroll
                for (int i = 0; i < 4; ++i) { wv[i] = w2[(32 * p + 4 * gq + i) * 64 + dout]; wv[4 + i] = w2[(32 * p + 16 + 4 * gq + i) * 64 + dout]; }
                oacc[dt] = __builtin_amdgcn_mfma_f32_16x16x32_bf16(pack8s(wv), pf[p], oacc[dt], 0, 0, 0); } }
        const bool padrow = (n == 127);
        if (kv == 0) {
            int pidx = 16 * n + 31; pidx = pidx > 2047 ? 2047 : pidx;
            const float pp = (float)pos[b * SEQ + pidx];
            bf16_t* dst = KCMP + ((size_t)(b * 128 + n) * 4 + g) * 64;
#pragma unroll
            for (int dt = 0; dt < 2; ++dt) { float o1[4], o2[4];
#pragma unroll
                for (int jj = 0; jj < 4; ++jj) { const float inv = exp2f(-(float)(16 * dt + 4 * gq + jj) * (13.287712379549449f / 32.f)); float sn, cs; sincos_rad(pp * inv, sn, cs);
                    const float x1 = oacc[dt][jj], x2 = oacc[dt + 2][jj]; o1[jj] = padrow ? 0.f : x1 * cs - x2 * sn; o2[jj] = padrow ? 0.f : x1 * sn + x2 * cs; }
                *(u32x2*)(dst + 16 * dt + 4 * gq) = (u32x2){cvt_pk_bf16(o1[0], o1[1]), cvt_pk_bf16(o1[2], o1[3])};
                *(u32x2*)(dst + 32 + 16 * dt + 4 * gq) = (u32x2){cvt_pk_bf16(o2[0], o2[1]), cvt_pk_bf16(o2[2], o2[3])}; }
        } else {
            bf16_t* dst = VCMPT + ((size_t)(b * 4 + g) * 64) * 128 + n;
#pragma unroll
            for (int dt = 0; dt < 4; ++dt)
#pragma unroll
                for (int jj = 0; jj < 4; ++jj) dst[(size_t)(16 * dt + 4 * gq + jj) * 128] = padrow ? (bf16_t)0 : f2bf(oacc[dt][jj]);
        }
    }
}

struct AttnArgs { const bf16_t* Q; const bf16_t* KS; const bf16_t* VST; const bf16_t* KW; const bf16_t* VWT; const bf16_t* KCMP; const bf16_t* VCMPT; const float* GATES; bf16_t* O; };
constexpr int AL_KC = 0, AL_VC = 18432, AL_KB = 35840, AL_VB = 54272, AL_PS = 72704, AL_IMP = 89088, AL_SEL = 93184, AL_OT = 93312;
constexpr float ATT_THR = 8.f;

__device__ __forceinline__ float max16(const f32x4 (&a)[4]) {
    float m0 = fmaxf(fmaxf(a[0][0], a[0][1]), a[0][2]), m1 = fmaxf(fmaxf(a[0][3], a[1][0]), a[1][1]), m2 = fmaxf(fmaxf(a[1][2], a[1][3]), a[2][0]);
    float m3 = fmaxf(fmaxf(a[2][1], a[2][2]), a[2][3]), m4 = fmaxf(fmaxf(a[3][0], a[3][1]), a[3][2]);
    return fmaxf(fmaxf(fmaxf(m0, m1), fmaxf(m2, m3)), fmaxf(m4, a[3][3]));
}

template <int MODE>
__device__ __forceinline__ void attn_branch(LAS unsigned char* lds, const bf16_t* Kg, const bf16_t* Vg, const int kb_lo, const int kb_hi, const bool first_staged,
                                            const bf16x8 (&qf)[2][2], const int (&sq)[2], const unsigned (&selm)[2], const float* const (&gatep)[2], LAS f32x4* otl  ,
                                            const int n, const int gq, const int tid) {
    const int skey = tid >> 3, spc = tid & 7;
    const bf16_t* kgp = Kg + (size_t)skey * 256 + spc * 8;
    const bf16_t* vgp = Vg + (size_t)skey * SEQ + spc * 8;
    const int soff = skey * 144 + spc * 16;
    u32x4 kr, vr;
    if (!first_staged) {
        kr = ld16(kgp + (size_t)kb_lo * 64 * 256); vr = ld16(vgp + kb_lo * 64);
        *(LAS u32x4*)(lds + AL_KB + soff) = kr; *(LAS u32x4*)(lds + AL_VB + soff) = vr;
        __syncthreads();
    }
    float m_run[2] = {0.f, 0.f}, l_run[2] = {0.f, 0.f};
    const float gate[2] = {gatep[0][MODE + 1], gatep[1][MODE + 1]};
    f32x4 oacc[2][4];
#pragma unroll
    for (int ti = 0; ti < 2; ++ti)
#pragma unroll
        for (int dt = 0; dt < 4; ++dt) oacc[ti][dt] = (f32x4){0.f, 0.f, 0.f, 0.f};
    for (int kb = kb_lo; kb <= kb_hi; ++kb) {
        const int buf = (kb - kb_lo) & 1;
        if (kb < kb_hi) { kr = ld16(kgp + (size_t)(kb + 1) * 64 * 256); vr = ld16(vgp + (kb + 1) * 64); }
        const LAS unsigned char* kbuf = lds + AL_KB + buf * 9216; const LAS unsigned char* vbuf = lds + AL_VB + buf * 9216;
        f32x4 sacc[2][4];
        bool selb[2];
#pragma unroll
        for (int ti = 0; ti < 2; ++ti) selb[ti] = MODE == 0 ? (((selm[ti] >> kb) & 1u) != 0u) : true;
#pragma unroll
        for (int kt = 0; kt < 4; ++kt) {
            const bf16x8 k0 = *(const LAS bf16x8*)(kbuf + (16 * kt + n) * 144 + gq * 16), k1 = *(const LAS bf16x8*)(kbuf + (16 * kt + n) * 144 + 64 + gq * 16);
#pragma unroll
            for (int ti = 0; ti < 2; ++ti) {
                sacc[ti][kt] = __builtin_amdgcn_mfma_f32_16x16x32_bf16(k0, qf[ti][0], (f32x4){0.f, 0.f, 0.f, 0.f}, 0, 0, 0);
                sacc[ti][kt] = __builtin_amdgcn_mfma_f32_16x16x32_bf16(k1, qf[ti][1], sacc[ti][kt], 0, 0, 0);
            }
        }
        const bool need_mask = (kb == kb_hi) || (MODE == 1 && kb == kb_lo);
        if (need_mask) {
#pragma unroll
            for (int ti = 0; ti < 2; ++ti) {
                const int rel = sq[ti] - kb * 64 - 4 * gq;
#pragma unroll
                for (int kt = 0; kt < 4; ++kt)
#pragma unroll
                    for (int jj = 0; jj < 4; ++jj) { const int tt = 16 * kt + jj; const bool v = MODE == 0 ? (tt <= rel) : (tt <= rel && tt > rel - 512); sacc[ti][kt][jj] = v ? sacc[ti][kt][jj] : NEGBIG; }
            }
        }
        float mx[2];
#pragma unroll
        for (int ti = 0; ti < 2; ++ti) { mx[ti] = max16(sacc[ti]) - m_run[ti]; mx[ti] = selb[ti] ? mx[ti] : NEGBIG; }
        const bool slow = (mx[0] > ATT_THR) || (mx[1] > ATT_THR) || (l_run[0] == 0.f && mx[0] > -1e29f && mx[0] < -ATT_THR) || (l_run[1] == 0.f && mx[1] > -1e29f && mx[1] < -ATT_THR);
        if (__any(slow)) {
#pragma unroll
            for (int ti = 0; ti < 2; ++ti) {
                float mr = fmaxf(mx[ti], __shfl_xor(mx[ti], 16)); mr = fmaxf(mr, __shfl_xor(mr, 32));
                float lr = l_run[ti] + __shfl_xor(l_run[ti], 16); lr += __shfl_xor(lr, 32);
                const bool has = mr > -1e29f;
                const float delta = !has ? 0.f : (lr == 0.f ? mr : fmaxf(mr, 0.f));
                const float alpha = lr == 0.f ? 1.f : fast_exp2(-delta);
                l_run[ti] *= alpha; m_run[ti] += delta;
#pragma unroll
                for (int dt = 0; dt < 4; ++dt) oacc[ti][dt] *= alpha;
            }
        }
        if (__any(m_run[0] != 0.f || m_run[1] != 0.f)) {
#pragma unroll
            for (int ti = 0; ti < 2; ++ti)
#pragma unroll
                for (int kt = 0; kt < 4; ++kt) sacc[ti][kt] -= m_run[ti];
        }
        bf16x8 pf[2][2];
#pragma unroll
        for (int ti = 0; ti < 2; ++ti) {
            float ps = 0.f;
#pragma unroll
            for (int kt = 0; kt < 4; ++kt)
#pragma unroll
                for (int jj = 0; jj < 4; ++jj) { const float e = fast_exp2(sacc[ti][kt][jj]); sacc[ti][kt][jj] = e; ps += e; }
            l_run[ti] += selb[ti] ? ps : 0.f;
#pragma unroll
            for (int p = 0; p < 2; ++p) { u32x4 v = {cvt_pk_bf16(sacc[ti][2 * p][0], sacc[ti][2 * p][1]), cvt_pk_bf16(sacc[ti][2 * p][2], sacc[ti][2 * p][3]),
                                                     cvt_pk_bf16(sacc[ti][2 * p + 1][0], sacc[ti][2 * p + 1][1]), cvt_pk_bf16(sacc[ti][2 * p + 1][2], sacc[ti][2 * p + 1][3])};
                if (MODE == 0) { v[0] = selb[ti] ? v[0] : 0u; v[1] = selb[ti] ? v[1] : 0u; v[2] = selb[ti] ? v[2] : 0u; v[3] = selb[ti] ? v[3] : 0u; }
                pf[ti][p] = __builtin_bit_cast(bf16x8, v); }
        }
#pragma unroll
        for (int dt = 0; dt < 4; ++dt)
#pragma unroll
            for (int p = 0; p < 2; ++p) {
                const LAS unsigned char* vp = vbuf + (16 * dt + n) * 144 + (32 * p + 4 * gq) * 2;
                const u32x2 a = *(const LAS u32x2*)vp, b2 = *(const LAS u32x2*)(vp + 32);
                u32x4 v = {a[0], a[1], b2[0], b2[1]};
                const bf16x8 vf = __builtin_bit_cast(bf16x8, v);
#pragma unroll
                for (int ti = 0; ti < 2; ++ti) oacc[ti][dt] = __builtin_amdgcn_mfma_f32_16x16x32_bf16(vf, pf[ti][p], oacc[ti][dt], 0, 0, 0);
            }
        if (kb < kb_hi) { *(LAS u32x4*)(lds + AL_KB + (buf ^ 1) * 9216 + soff) = kr; *(LAS u32x4*)(lds + AL_VB + (buf ^ 1) * 9216 + soff) = vr; }
        __syncthreads();
    }
#pragma unroll
    for (int ti = 0; ti < 2; ++ti) {
        float lt = l_run[ti] + __shfl_xor(l_run[ti], 16); lt += __shfl_xor(lt, 32);
        const float inv = lt > 0.f ? gate[ti] / lt : 0.f;
#pragma unroll
        for (int dt = 0; dt < 4; ++dt) otl[(ti * 4 + dt) * 64] += oacc[ti][dt] * inv;
    }
}

__device__ __forceinline__ unsigned attn_cmp_tile(LAS unsigned char* lds, const bf16x8 qf0, const bf16x8 qf1, const int s, const int sbase  , const float g0,
                                                  LAS f32x4* otl  , const int lane, const int w, const int n, const int gq, const int tl, const int r) {
    f32x4 sacc[8];
#pragma unroll
    for (int kt = 0; kt < 8; ++kt) {
        const bf16x8 k0 = *(const LAS bf16x8*)(lds + AL_KC + (16 * kt + n) * 144 + gq * 16), k1 = *(const LAS bf16x8*)(lds + AL_KC + (16 * kt + n) * 144 + 64 + gq * 16);
        sacc[kt] = __builtin_amdgcn_mfma_f32_16x16x32_bf16(k0, qf0, (f32x4){0.f, 0.f, 0.f, 0.f}, 0, 0, 0);
        sacc[kt] = __builtin_amdgcn_mfma_f32_16x16x32_bf16(k1, qf1, sacc[kt], 0, 0, 0);
    }
    float mx = NEGBIG;
    const int lim = ((s - 31) >> 4) - 4 * gq;
#pragma unroll
    for (int kt = 0; kt < 8; ++kt)
#pragma unroll
        for (int jj = 0; jj < 4; ++jj) { const bool v = (16 * kt + jj <= lim); sacc[kt][jj] = v ? sacc[kt][jj] : NEGBIG; mx = fmaxf(mx, sacc[kt][jj]); }
    mx = fmaxf(mx, __shfl_xor(mx, 16)); mx = fmaxf(mx, __shfl_xor(mx, 32));
    float ps = 0.f;
#pragma unroll
    for (int kt = 0; kt < 8; ++kt)
#pragma unroll
        for (int jj = 0; jj < 4; ++jj) { const float e = sacc[kt][jj] > -1e29f ? fast_exp2(sacc[kt][jj] - mx) : 0.f; sacc[kt][jj] = e; ps += e; }
    ps += __shfl_xor(ps, 16); ps += __shfl_xor(ps, 32);
    const float inv = ps > 0.f ? 1.f / ps : 0.f;
#pragma unroll
    for (int kt = 0; kt < 8; ++kt) {
        f32x4 pp;
#pragma unroll
        for (int jj = 0; jj < 4; ++jj) { sacc[kt][jj] *= inv; float t = sacc[kt][jj]; t += dpp_mov<0xB1>(t); t += dpp_mov<0x4E>(t); pp[jj] = t; }
        if (r == 0) *(LAS f32x4*)(lds + AL_PS + ((w * 4 + tl) * 128 + 16 * kt + 4 * gq) * 4) = pp;
    }
    f32x4 otot[4];
#pragma unroll
    for (int dt = 0; dt < 4; ++dt) otot[dt] = (f32x4){0.f, 0.f, 0.f, 0.f};
#pragma unroll
    for (int p = 0; p < 4; ++p) {
        u32x4 pv = {cvt_pk_bf16(sacc[2 * p][0], sacc[2 * p][1]), cvt_pk_bf16(sacc[2 * p][2], sacc[2 * p][3]), cvt_pk_bf16(sacc[2 * p + 1][0], sacc[2 * p + 1][1]), cvt_pk_bf16(sacc[2 * p + 1][2], sacc[2 * p + 1][3])};
        const bf16x8 pf = __builtin_bit_cast(bf16x8, pv);
#pragma unroll
        for (int dt = 0; dt < 4; ++dt) {
            const LAS unsigned char* vp = lds + AL_VC + (16 * dt + n) * 272 + (32 * p + 4 * gq) * 2;
            const u32x2 a = *(const LAS u32x2*)vp, b2 = *(const LAS u32x2*)(vp + 32);
            u32x4 v = {a[0], a[1], b2[0], b2[1]};
            otot[dt] = __builtin_amdgcn_mfma_f32_16x16x32_bf16(__builtin_bit_cast(bf16x8, v), pf, otot[dt], 0, 0, 0);
        }
    }
#pragma unroll
    for (int dt = 0; dt < 4; ++dt) otl[dt * 64] = otot[dt] * g0;
    asm volatile("s_waitcnt lgkmcnt(0)" ::: "memory");
    __builtin_amdgcn_wave_barrier();
    const int tl2 = lane >> 4, q = lane & 15, s2 = sbase + tl2, blkq = s2 >> 6;
    const LAS float* psr = (const LAS float*)(lds + AL_PS + ((w * 4 + tl2) * 128) * 4);
    const f32x4 xa = *(const LAS f32x4*)(psr + 8 * q), xb = *(const LAS f32x4*)(psr + 8 * q + 4);
    const float prev = q > 0 ? psr[8 * q - 1] : 0.f;
    float a0 = prev + xa[0] + xa[1] + xa[2] + xa[3], a1 = xa[3] + xb[0] + xb[1] + xb[2] + xb[3];
    const int m0 = 2 * q, m1 = 2 * q + 1;
    { const int rel0 = blkq - m0, rel1 = blkq - m1;
        if (rel0 < 0) a0 = -1.f;
        if (rel1 < 0) a1 = -1.f;
        if (m0 == 0 || rel0 == 0 || rel0 == 1) a0 = 1e6f;
        if (rel1 == 0 || rel1 == 1) a1 = 1e6f; }
    LAS float* impw = (LAS float*)(lds + AL_IMP + ((w * 4 + tl2) * 32) * 4);
    *(LAS f32x2*)(impw + 2 * q) = (f32x2){a0, a1};
    asm volatile("s_waitcnt lgkmcnt(0)" ::: "memory");
    __builtin_amdgcn_wave_barrier();
    int rk0 = 0, rk1 = 0;
#pragma unroll
    for (int i4 = 0; i4 < 8; ++i4) { const f32x4 v = *(const LAS f32x4*)(impw + 4 * i4);
#pragma unroll
        for (int j = 0; j < 4; ++j) { const int mm = 4 * i4 + j; rk0 += (v[j] > a0 || (v[j] == a0 && mm < m0)) ? 1 : 0; rk1 += (v[j] > a1 || (v[j] == a1 && mm < m1)) ? 1 : 0; } }
    unsigned bits = (rk0 < 16 ? (1u << m0) : 0u) | (rk1 < 16 ? (1u << m1) : 0u);
    bits |= dpp_movu<0xB1>(bits); bits |= dpp_movu<0x4E>(bits); bits |= dpp_movu<0x141>(bits); bits |= dpp_movu<0x140>(bits);
    LAS unsigned* selw = (LAS unsigned*)(lds + AL_SEL + (w * 4) * 4);
    if (q == 0) selw[tl2] = bits;
    asm volatile("s_waitcnt lgkmcnt(0)" ::: "memory");
    __builtin_amdgcn_wave_barrier();
    const unsigned selm = selw[tl];
    asm volatile("s_waitcnt lgkmcnt(0)" ::: "memory");
    __builtin_amdgcn_wave_barrier();
    return selm;
}

__device__ __forceinline__ void nsa_attn_phase(LAS unsigned char* lds, const AttnArgs& A) {
    const int tid0 = tid_opaque();
    for (int u = blockIdx.x; u < 4096; u += gridDim.x) {
        int tid = tid0; asm volatile("" : "+v"(tid));
        const int lane = tid & 63, w = tid >> 6, n = lane & 15, gq = lane >> 4, tl = n >> 2, r = n & 3;
        const int kq = u >> 8, c = 2 * kq + ((((u >> 7) & 1) ^ kq) & 1), bgi = u & 127, b = bgi >> 2, g = bgi & 3, s0 = c * 64;
        int sq[2]; bf16x8 qf[2][2]; const float* gp[2];
#pragma unroll
        for (int ti = 0; ti < 2; ++ti) {
            sq[ti] = s0 + 8 * w + 4 * ti + tl;
            const size_t qrow = (size_t)b * SEQ + sq[ti];
            const bf16_t* qp = A.Q + qrow * 1024 + g * 256 + r * 64 + 8 * gq;
            qf[ti][0] = *(const bf16x8*)qp; qf[ti][1] = *(const bf16x8*)(qp + 32);
            gp[ti] = A.GATES + qrow * 48 + (g * 4 + r) * 3;
        }
        const bf16_t* KSg = A.KS + (size_t)b * SEQ * 256 + g * 64; const bf16_t* VSg = A.VST + (size_t)(b * 4 + g) * 64 * SEQ;
        const bf16_t* KWg = A.KW + (size_t)b * SEQ * 256 + g * 64; const bf16_t* VWg = A.VWT + (size_t)(b * 4 + g) * 64 * SEQ;
        __syncthreads();
#pragma unroll
        for (int i = 0; i < 2; ++i) { const int pid = tid + 512 * i;
            { const int key = pid >> 3, pc = pid & 7; *(LAS u32x4*)(lds + AL_KC + key * 144 + pc * 16) = ld16(A.KCMP + ((size_t)(b * 128 + key) * 4 + g) * 64 + pc * 8); }
            { const int d = pid >> 4, pc = pid & 15; *(LAS u32x4*)(lds + AL_VC + d * 272 + pc * 16) = ld16(A.VCMPT + ((size_t)(b * 4 + g) * 64 + d) * 128 + pc * 8); } }
        { const int skey = tid >> 3, spc = tid & 7;
            *(LAS u32x4*)(lds + AL_KB + skey * 144 + spc * 16) = ld16(KSg + (size_t)skey * 256 + spc * 8);
            *(LAS u32x4*)(lds + AL_VB + skey * 144 + spc * 16) = ld16(VSg + (size_t)skey * SEQ + spc * 8); }
        __syncthreads();
        LAS f32x4* otl = (LAS f32x4*)(lds + AL_OT) + w * 512 + lane;
        unsigned selm[2];
#pragma unroll
        for (int ti = 0; ti < 2; ++ti) { selm[ti] = attn_cmp_tile(lds, qf[ti][0], qf[ti][1], sq[ti], s0 + 8 * w + 4 * ti, gp[ti][0], otl + ti * 256, lane, w, n, gq, tl, r); }
        attn_branch<0>(lds, KSg, VSg, 0, c, true, qf, sq, selm, gp, otl, n, gq, tid);
        attn_branch<1>(lds, KWg, VWg, c >= 8 ? c - 8 : 0, c, false, qf, sq, selm, gp, otl, n, gq, tid);
#pragma unroll
        for (int ti = 0; ti < 2; ++ti) {
            bf16_t* op = A.O + ((size_t)b * SEQ + sq[ti]) * 1024 + g * 256 + r * 64 + 4 * gq;
#pragma unroll
            for (int dt = 0; dt < 4; ++dt) { const f32x4 o = otl[(ti * 4 + dt) * 64]; *(u32x2*)(op + 16 * dt) = (u32x2){cvt_pk_bf16(o[0], o[1]), cvt_pk_bf16(o[2], o[3])}; }
        }
    }
    __syncthreads();
}
#ifndef DBG_ZERO_KIND
#define DBG_ZERO_KIND -1
#endif
struct Params { const float* in[31]; float* out; unsigned char* ws; int ph_lo, ph_hi; };
constexpr int N_PHASES = 38;

#ifndef DUP_MASK
#define DUP_MASK 0ull
#endif
#define PH_BEGIN(k) if ((k) >= p.ph_lo && (k) < p.ph_hi) { for (int rep_ = 0; rep_ < (((DUP_MASK >> (k)) & 1ull) ? 2 : 1); ++rep_) {
#define PH_END(k) } if ((k) + 1 < p.ph_hi) xcd_barrier(bar); }

template <int LAYER>
__device__ __forceinline__ void layer_body(const Params& p, LAS unsigned char* lds, const XcdBarrier& bar) {
    constexpr int kind = LAYER % 3, j = LAYER / 3;
    constexpr int PB = LAYER == 0 ? 1 : (LAYER == 1 ? 10 : (LAYER == 2 ? 18 : 29));
    constexpr int NMIX = kind == 0 ? 4 : (kind == 1 ? 3 : 6);
    unsigned char* ws = p.ws;
    const int G = gridDim.x, cblk = blockIdx.x;
    const int* positions = (const int*)p.in[1];
    bf16_t* XA = (bf16_t*)(ws + WS_XA); float* XF = p.out; bf16_t* MB = (bf16_t*)(ws + B_MB);
    int* route_e = (int*)(ws + WS_ROUTE_E); float* route_w = (float*)(ws + WS_ROUTE_W); int* posb = (int*)(ws + WS_POS); int* cnt = (int*)(ws + WS_CNT);
    int4* tiles = (int4*)(ws + WS_TILE); float* bias1 = (float*)(ws + WS_BIAS1);
    if constexpr (kind == 0) {
        bf16_t* Q = (bf16_t*)(ws + B_Q); bf16_t* KC = (bf16_t*)(ws + B_KC); bf16_t* VC = (bf16_t*)(ws + B_VC); bf16_t* KS = (bf16_t*)(ws + B_KS); bf16_t* VST = (bf16_t*)(ws + B_VST);
        bf16_t* KW = (bf16_t*)(ws + B_KW); bf16_t* VWT = (bf16_t*)(ws + B_VWT); bf16_t* OB = (bf16_t*)(ws + B_O);
        float* GATES = (float*)(ws + WS_GATES); bf16_t* KCMP = (bf16_t*)(ws + WS_KCMP); bf16_t* VCMPT = (bf16_t*)(ws + WS_VCMPT);
        PH_BEGIN(PB + 0)
            DenseSched S{XA, (const bf16_t*)(ws + W_NSA_IN) + (size_t)j * NSA_NP * 1024, 1024, 1024, T_TOK / 256, NSA_NP / 256, G, cblk};
            EpiNsaIn E{Q, KC, VC, KS, VST, KW, VWT, GATES, positions, p.in[3] + j * 48};
            gemm_phase<false>(lds, 1024, 1024, 1024, S, E);
        PH_END(PB + 0)
        PH_BEGIN(PB + 1)
            nsa_compress_phase(KC, VC, (const bf16_t*)(ws + W_CMP1) + (size_t)j * 2 * 64 * 2048, p.in[6] + j * 4096, p.in[9] + j * 4096, bias1 + j * 128, positions, KCMP, VCMPT);
        PH_END(PB + 1)
        PH_BEGIN(PB + 2)
            AttnArgs A{Q, KS, VST, KW, VWT, KCMP, VCMPT, GATES, OB};
            nsa_attn_phase(lds, A);
        PH_END(PB + 2)
        PH_BEGIN(PB + 3)
            DenseSched S{OB, (const bf16_t*)(ws + W_NSA_OUT) + (size_t)j * 1024 * 1024, 1024, 1024, T_TOK / 256, 4, G, cblk};
            EpiPlain<false> E{MB, 1024, 1.f};
            gemm_phase<false>(lds, 1024, 1024, 1024, S, E);
        PH_END(PB + 3)
    } else if constexpr (kind == 1) {
        bf16_t* P = (bf16_t*)(ws + B_P); bf16_t* BGb = (bf16_t*)(ws + B_BG); bf16_t* Y = (bf16_t*)(ws + B_Y);
        PH_BEGIN(PB + 0)
            DenseSched S{XA, (const bf16_t*)(ws + W_SC_IN), 1024, 1024, T_TOK / 256, 12, G, cblk};
            EpiScIn E{P, BGb};
            gemm_phase<false>(lds, 1024, 1024, 1024, S, E);
        PH_END(PB + 0)
        PH_BEGIN(PB + 1)
            sc_conv_phase(P, BGb, Y, p.in[12], p.in[13]);
        PH_END(PB + 1)
        PH_BEGIN(PB + 2)
            DenseSched S{Y, (const bf16_t*)(ws + W_SC_OUT), 1024, 1024, T_TOK / 256, 4, G, cblk};
            EpiPlain<false> E{MB, 1024, 1.f};
            gemm_phase<false>(lds, 1024, 1024, 1024, S, E);
        PH_END(PB + 2)
    } else {
        bf16_t* GG = (bf16_t*)(ws + B_GG); bf16_t* R1 = (bf16_t*)(ws + B_R1); bf16_t* R2 = (bf16_t*)(ws + B_R2); bf16_t* R3 = (bf16_t*)(ws + B_R3);
        f32x4* carry = (f32x4*)(ws + WS_CARRY);
        PH_BEGIN(PB + 0)
            DenseSched S{XA, (const bf16_t*)(ws + W_LRU_IN), 1024, 1024, T_TOK / 256, 10, G, cblk};
            EpiLruIn E{GG, R1};
            gemm_phase<false>(lds, 1024, 1024, 1024, S, E);
        PH_END(PB + 0)
        PH_BEGIN(PB + 1)
            lru_conv_phase(R1, R2, p.in[16], p.in[17]);
        PH_END(PB + 1)
        PH_BEGIN(PB + 2)
            BandSched S{R2, (const bf16_t*)(ws + W_LRU_G), LRU_W, LRU_W, T_TOK / 256, 10, G, cblk};
            EpiLruGate E{R2, R1, R3, p.in[19], p.in[21], p.in[22]};
            gemm_phase<false>(lds, 384, LRU_W, LRU_W, S, E);
        PH_END(PB + 2)
        PH_BEGIN(PB + 3)
            lru_scan1_phase(R1, R3, carry);
        PH_END(PB + 3)
        PH_BEGIN(PB + 4)
            lru_scan2_phase(R1, R3, GG, carry, R2);
        PH_END(PB + 4)
        PH_BEGIN(PB + 5)
            DenseSched S{R2, (const bf16_t*)(ws + W_LRU_OUT), LRU_W, LRU_W, T_TOK / 256, 4, G, cblk};
            EpiPlain<false> E{MB, 1024, 1.f};
            gemm_phase<false>(lds, LRU_W, LRU_W, LRU_W, S, E);
        PH_END(PB + 5)
    }
    constexpr int FB = PB + NMIX;
    unsigned char* X8 = ws + B_XG; int* invb = (int*)(ws + WS_INV); unsigned char* HID = ws + B_HID; unsigned char* YM = ws + B_YM; unsigned char* WGU = ws + B_WMOE + WMOE_GU; unsigned char* WDN = ws + B_WMOE + WMOE_DN;
    const float* lng = p.in[29] + (size_t)LAYER * 2048; const float* lnb = p.in[30] + (size_t)LAYER * 2048;
    PH_BEGIN(FB + 0)
#if defined(SHADOW_LN) && (SHADOW_LN & 1)
        ln1_router_phase(lds, LAYER == 0 ? p.in[0] : (const float*)XF, MB, (float*)(ws + WS_BIG + 192 * MiB), ws + WS_BIG + 448 * MiB, lng, lnb, p.in[24], p.in[25], (int*)(ws + WS_BIG + 300 * MiB), (float*)(ws + WS_BIG + 302 * MiB), (int*)(ws + WS_BIG + 304 * MiB));
#endif
        ln1_router_phase(lds, LAYER == 0 ? p.in[0] : (const float*)XF, MB, XF, X8, lng, lnb, p.in[24], p.in[25], route_e, route_w, cnt);
    PH_END(FB + 0)
    PH_BEGIN(FB + 1)
        moe_gather_phase(lds, route_e, cnt, posb, invb, tiles);
        convert_wt<true>(lds, WGU, 16, 2048, 1024, FetchPair{p.in[26] + (size_t)LAYER * 16 * 1048576, (long)(p.in[27] - p.in[26]), 1024, (size_t)1048576}, S8_WGU);
        convert_wt<true>(lds, WDN, 16, 1024, 1024, FetchPlain{p.in[28] + (size_t)LAYER * 16 * 1048576, 1024, (size_t)1048576}, S8_WD);
    PH_END(FB + 1)
    PH_BEGIN(FB + 2)
        const int NT = __builtin_amdgcn_readfirstlane(tiles[0].x);
        MoeSched S{X8, WGU, tiles, invb, NT, 8, 2048, 1024, G, cblk};
        EpiMoeGU E{HID};
        gemm_phase<true, true>(lds, 1024, 1024, 1024, S, E);
    PH_END(FB + 2)
    PH_BEGIN(FB + 3)
        const int NT = __builtin_amdgcn_readfirstlane(tiles[0].x);
        MoeSched S{HID, WDN, tiles, invb, NT, 4, 1024, 1024, G, cblk};
        EpiMoeDown8 E{YM, S8_Y / (S8_H * S8_WD)};
        gemm_phase<true>(lds, 1024, 1024, 1024, S, E);
    PH_END(FB + 3)
    PH_BEGIN(FB + 4)
#if defined(SHADOW_LN) && (SHADOW_LN & 2)
        ln2_combine_phase<LAYER == DEPTH - 1>(XF, (float*)(ws + B_XG), YM, posb, route_w, lng + 1024, lnb + 1024, (bf16_t*)(ws + WS_BIG + 512 * MiB));
#endif
        ln2_combine_phase<LAYER == DEPTH - 1>(XF, XF, YM, posb, route_w, lng + 1024, lnb + 1024, XA);
    PH_END(FB + 4)
}

__global__ void __launch_bounds__(NTHR, 2) hybrid_fwd(Params p) {
    extern __shared__ __attribute__((aligned(16))) unsigned char lds_raw[];
    LAS unsigned char* lds = (LAS unsigned char*)lds_raw;
    volatile LAS unsigned* bst = (volatile LAS unsigned*)(lds + LDS_BYTES - 16);
    const bool use_bar = (p.ph_hi - p.ph_lo) > 1;
    if (threadIdx.x == 0) { bst[0] = 0u; bst[1] = 0u; bst[2] = 0u; bst[3] = 0u; }
    __syncthreads();
    XcdBarrier bar; bar.bar = (unsigned*)(p.ws + WS_CTL); bar.x = 0; bar.st = bst;
    if (use_bar) bar = xcd_barrier_post((unsigned*)(p.ws + WS_CTL), bst);
    PH_BEGIN(0)
        unsigned char* ws = p.ws;
        convert_x(p.in[0], (bf16_t*)(ws + WS_XA));
        for (int j = 0; j < 2; ++j) {
            convert_wt(lds, (bf16_t*)(ws + W_NSA_IN) + (size_t)j * NSA_NP * 1024, 1, NSA_NP, 1024, FetchNsaIn{p.in[2] + (size_t)j * 1024 * 2608});
            convert_wt(lds, (bf16_t*)(ws + W_NSA_OUT) + (size_t)j * 1024 * 1024, 1, 1024, 1024, FetchPlain{p.in[10] + (size_t)j * 1024 * 1024, 1024, 0});
            convert_wt(lds, (bf16_t*)(ws + W_CMP1) + (size_t)(j * 2 + 0) * 64 * 2048, 1, 64, 2048, FetchIdent{p.in[5] + (size_t)j * 2048 * 64, 64, 0});
            convert_wt(lds, (bf16_t*)(ws + W_CMP1) + (size_t)(j * 2 + 1) * 64 * 2048, 1, 64, 2048, FetchIdent{p.in[8] + (size_t)j * 2048 * 64, 64, 0});
        }
        convert_wt(lds, (bf16_t*)(ws + W_SC_IN), 1, 3072, 1024, FetchScIn{p.in[11]});
        convert_wt(lds, (bf16_t*)(ws + W_SC_OUT), 1, 1024, 1024, FetchPlain{p.in[14], 1024, 0});
        convert_wt(lds, (bf16_t*)(ws + W_LRU_IN), 1, 2560, 1024, FetchPlain{p.in[15], 2560, 0});
        convert_wt(lds, (bf16_t*)(ws + W_LRU_G), 1, 2560, 1280, FetchLruGate{p.in[18], (long)(p.in[20] - p.in[18])});
        convert_wt(lds, (bf16_t*)(ws + W_LRU_OUT), 1, 1024, 1280, FetchPlain{p.in[23], 1024, 0});
        cmp_bias_phase(lds, p.in[4], p.in[5], p.in[7], p.in[8], (float*)(ws + WS_BIAS1));
    PH_END(0)
    layer_body<0>(p, lds, bar);
    layer_body<1>(p, lds, bar);
    layer_body<2>(p, lds, bar);
    layer_body<3>(p, lds, bar);
}
#undef PH_BEGIN
#undef PH_END

#ifndef MK_SPLIT
#define MK_SPLIT 0
#endif
extern "C" void kernel_launch(void* const* d_in, const int* in_sizes, int n_in, void* d_out, int out_size, void* d_ws, size_t ws_size, hipStream_t stream) {
    static int grid = 0;
    if (grid == 0) {
        int dev = 0, cus = 0, per_cu = 0;
        if (n_in != 31 || ws_size < WS_END) { fprintf(stderr, "kernel_launch: unexpected n_in %d or ws_size %zu (need %zu)\n", n_in, ws_size, (size_t)WS_END); grid = -1; return; }
        if (hipGetDevice(&dev) != hipSuccess || hipDeviceGetAttribute(&cus, hipDeviceAttributeMultiprocessorCount, dev) != hipSuccess) { grid = -1; return; }
        if (hipFuncSetAttribute((const void*)hybrid_fwd, hipFuncAttributeMaxDynamicSharedMemorySize, LDS_BYTES) != hipSuccess) { fprintf(stderr, "kernel_launch: hipFuncSetAttribute failed\n"); grid = -1; return; }
        if (hipOccupancyMaxActiveBlocksPerMultiprocessor(&per_cu, (const void*)hybrid_fwd, NTHR, LDS_BYTES) != hipSuccess || per_cu < 1) fprintf(stderr, "kernel_launch: occupancy query says %d\n", per_cu);
        (void)hipGetLastError();
        grid = cus;
    }
    if (grid < 0) return;
    (void)hipMemsetAsync((char*)d_ws + WS_CTL, 0, 64 * 1024, stream);
    Params p{};
    for (int i = 0; i < 31; ++i) p.in[i] = (const float*)d_in[i];
    p.out = (float*)d_out; p.ws = (unsigned char*)d_ws;
#if MK_SPLIT
    for (int ph = 0; ph < N_PHASES; ++ph) { p.ph_lo = ph; p.ph_hi = ph + 1; hipLaunchKernelGGL(hybrid_fwd, dim3(grid), dim3(NTHR), LDS_BYTES, stream, p); }
#else
    p.ph_lo = 0; p.ph_hi = N_PHASES;
    hipLaunchKernelGGL(hybrid_fwd, dim3(grid), dim3(NTHR), LDS_BYTES, stream, p);
#endif
    const hipError_t le = hipPeekAtLastError();
    if (le != hipSuccess) fprintf(stderr, "kernel_launch: launch failed: %s\n", hipGetErrorName(le));
}
```

```cpp
#include <hip/hip_runtime.h>
#include <stdint.h>
#include <stdio.h>

#define LAS __attribute__((address_space(3)))
typedef unsigned short bf16_t;
typedef short bf16x8 __attribute__((ext_vector_type(8)));
typedef float f32x4 __attribute__((ext_vector_type(4)));
typedef float f32x2 __attribute__((ext_vector_type(2)));
typedef unsigned u32x4 __attribute__((ext_vector_type(4)));
typedef unsigned u32x2 __attribute__((ext_vector_type(2)));
typedef int i32x8 __attribute__((ext_vector_type(8)));

constexpr int T_TOK = 65536, DM = 1024, SEQ = 2048, NBATCH = 32, DEPTH = 4;
constexpr int NTHR = 512;
constexpr int NSA_NP = 2816;
constexpr int LRU_W = 1280;
constexpr int NEXP = 16;
constexpr float DN_ALPHA = 1.6817928305074292f;
constexpr float LN_EPS = 1e-5f;
constexpr float NEGBIG = -1e30f;
constexpr float LOG2E = 1.4426950408889634f;

constexpr size_t KiB = 1024, MiB = 1024 * 1024;
constexpr size_t WS_CTL = 0;
constexpr size_t WS_ROUTE_E = 64 * KiB;
constexpr size_t WS_ROUTE_W = WS_ROUTE_E + 256 * KiB;
constexpr size_t WS_POS = WS_ROUTE_W + 512 * KiB;
constexpr size_t WS_CNT = WS_POS + 512 * KiB;
constexpr size_t WS_TILE = WS_CNT + 16 * KiB;
constexpr size_t WS_BIAS1 = WS_TILE + 16 * KiB;
constexpr size_t WS_INV = 1408 * KiB;
constexpr size_t WS_KCMP = 2 * MiB;
constexpr size_t WS_VCMPT = 4 * MiB;
constexpr size_t WS_CARRY = 6 * MiB;
constexpr size_t WS_GATES = 16 * MiB;
constexpr size_t WS_W = 28 * MiB;
constexpr size_t W_NSA_IN = WS_W;
constexpr size_t W_NSA_OUT = W_NSA_IN + 2 * (size_t)NSA_NP * 1024 * 2;
constexpr size_t W_SC_IN = W_NSA_OUT + 2 * (size_t)1024 * 1024 * 2;
constexpr size_t W_SC_OUT = W_SC_IN + (size_t)3072 * 1024 * 2;
constexpr size_t W_LRU_IN = W_SC_OUT + (size_t)1024 * 1024 * 2;
constexpr size_t W_LRU_G = W_LRU_IN + (size_t)2560 * 1024 * 2;
constexpr size_t W_LRU_OUT = W_LRU_G + (size_t)2560 * 1280 * 2;
constexpr size_t W_CMP1 = W_LRU_OUT + (size_t)1024 * 1280 * 2;
constexpr size_t W_END = W_CMP1 + 4 * (size_t)64 * 2048 * 2;
constexpr size_t WS_XA = 66 * MiB;
constexpr size_t WS_WMOE = WS_XA + 128 * MiB;
constexpr size_t WS_BIG = WS_WMOE + 96 * MiB;
constexpr size_t WS_END = WS_BIG + 642 * MiB;
static_assert(W_END <= WS_XA, "weights overflow");
constexpr size_t B_Q = WS_BIG, B_KC = B_Q + 128 * MiB, B_VC = B_KC + 32 * MiB, B_KS = B_VC + 32 * MiB, B_VST = B_KS + 32 * MiB, B_KW = B_VST + 32 * MiB,
                 B_VWT = B_KW + 32 * MiB, B_O = B_VWT + 32 * MiB;
constexpr size_t B_P = WS_BIG, B_BG = B_P + 128 * MiB, B_Y = B_BG + 128 * MiB;
constexpr size_t B_GG = WS_BIG, B_R1 = B_GG + 160 * MiB, B_R2 = B_R1 + 160 * MiB, B_R3 = B_R2 + 160 * MiB;
constexpr size_t B_MB = WS_BIG;
constexpr size_t B_XG = WS_BIG + 128 * MiB, B_HID = B_XG + 64 * MiB, B_YM = B_HID + 128 * MiB, B_WMOE = WS_WMOE;
constexpr size_t WMOE_GU = 0, WMOE_DN = (size_t)16 * 2048 * 1024;
constexpr float S8_X = 16.f, S8_WGU = 256.f, S8_H = 16.f, S8_WD = 512.f, S8_Y = 128.f, S8_WI = 256.f, S8_O = 32.f, S8_WO = 512.f;

constexpr int LDS_BYTES = 163840;

__device__ __forceinline__ unsigned cvt_pk_bf16(float lo, float hi) { unsigned r; asm volatile("v_cvt_pk_bf16_f32 %0, %1, %2" : "=v"(r) : "v"(lo), "v"(hi)); return r; }
__device__ __forceinline__ float bf_lo(unsigned u) { return __uint_as_float(u << 16); }
__device__ __forceinline__ float bf_hi(unsigned u) { return __uint_as_float(u & 0xffff0000u); }
__device__ __forceinline__ float bf2f(bf16_t h) { return __uint_as_float(((unsigned)h) << 16); }
__device__ __forceinline__ bf16_t f2bf(float f) { return (bf16_t)(cvt_pk_bf16(f, 0.f) & 0xffffu); }
__device__ __forceinline__ float fast_exp2(float x) { return __builtin_amdgcn_exp2f(x); }
__device__ __forceinline__ float fast_exp(float x) { return __builtin_amdgcn_exp2f(x * LOG2E); }
__device__ __forceinline__ float fast_rcp(float x) { return __builtin_amdgcn_rcpf(x); }
__device__ __forceinline__ float sigmoidf_(float x) { return fast_rcp(1.f + fast_exp(-x)); }
__device__ __forceinline__ float gelu_tanh(float x) { const float u = 0.7978845608028654f * (x + 0.044715f * x * x * x); return x * fast_rcp(1.f + fast_exp(-2.f * u)); }
__device__ __forceinline__ float silu_(float x) { return x * fast_rcp(1.f + fast_exp(-x)); }
__device__ __forceinline__ void sincos_rad(float ang, float& s, float& c) {
    float r = ang * 0.15915494309189535f; r = __builtin_amdgcn_fractf(r); s = __builtin_amdgcn_sinf(r); c = __builtin_amdgcn_cosf(r); }
__device__ __forceinline__ float wave_sum(float v) {
#pragma unroll
    for (int o = 32; o >= 1; o >>= 1) v += __shfl_xor(v, o);
    return v; }
template <int CTRL> __device__ __forceinline__ float dpp_mov(float v) { return __builtin_bit_cast(float, __builtin_amdgcn_update_dpp(0, __builtin_bit_cast(int, v), CTRL, 0xf, 0xf, false)); }
template <int CTRL> __device__ __forceinline__ unsigned dpp_movu(unsigned v) { return (unsigned)__builtin_amdgcn_update_dpp(0, (int)v, CTRL, 0xf, 0xf, false); }
__device__ __forceinline__ float row16_sum(float v) { v += dpp_mov<0xB1>(v); v += dpp_mov<0x4E>(v); v += dpp_mov<0x141>(v); v += dpp_mov<0x140>(v); return v; }
__device__ __forceinline__ float wave_sum_dpp(float v) { v = row16_sum(v); v += __shfl_xor(v, 16); v += __shfl_xor(v, 32); return v; }
__device__ __forceinline__ int tid_opaque() { int t = threadIdx.x; asm volatile("" : "+v"(t)); return t; }
__device__ __forceinline__ u32x4 ld16(const void* p) { return *(const u32x4*)p; }
__device__ __forceinline__ void st16(void* p, u32x4 v) { *(u32x4*)p = v; }

#define XB_TMO      128
#define XB_XCNT(j)  (256  + 64 * (j))
#define XB_XSUB(j)  (1280 + 64 * (j))
#define XB_XGEN(j)  (2304 + 64 * (j))
#define XB_TOP      3328
#define XB_TOPGEN   3392
#define XCD_BAR_WORDS 3456
#define XB_SPIN_CAP (1u << 22)
__device__ __forceinline__ unsigned xb_ld(unsigned* p)              { return __hip_atomic_load(p, __ATOMIC_RELAXED, __HIP_MEMORY_SCOPE_AGENT); }
__device__ __forceinline__ unsigned xb_add(unsigned* p, unsigned v) { return __hip_atomic_fetch_add(p, v, __ATOMIC_RELAXED, __HIP_MEMORY_SCOPE_AGENT); }
__device__ __forceinline__ unsigned xb_xcc_id() { return (unsigned)__builtin_amdgcn_s_getreg((3 << 11) | 20) & 0xFu; }
#define XB_SPIN(cond, bar) do { unsigned _sp = 0; while (cond) { __builtin_amdgcn_s_sleep(1); \
    if ((++_sp & 255u) == 0u) { if (xb_ld(&(bar)[XB_TMO])) break; if (_sp > XB_SPIN_CAP) { atomicAdd(&(bar)[XB_TMO], 1u); break; } } } } while (0)
struct XcdBarrier { unsigned* bar; unsigned x; volatile LAS unsigned* st; };
__device__ __forceinline__ XcdBarrier xcd_barrier_post(unsigned* bar, volatile LAS unsigned* st) {
    XcdBarrier b; b.bar = bar; b.x = xb_xcc_id(); b.st = st;
    if (threadIdx.x == 0) (void)xb_add(&bar[XB_XCNT(b.x)], 1u);
    return b;
}
__device__ __forceinline__ void xcd_barrier_complete(unsigned* bar, unsigned x, unsigned& nloc, unsigned& nx) {
    const unsigned G = gridDim.x * gridDim.y * gridDim.z;
    unsigned sum, cnt, mine, sp = 0u;
    for (;;) {
        sum = 0u; cnt = 0u; mine = 0u;
#pragma unroll
        for (unsigned j = 0; j < 16; ++j) { const unsigned c = xb_ld(&bar[XB_XCNT(j)]); sum += c; cnt += (c > 0u) ? 1u : 0u; mine = (j == x) ? c : mine; }
        if (sum == G) break;
        __builtin_amdgcn_s_sleep(1);
        if ((++sp & 255u) == 0u) { if (xb_ld(&bar[XB_TMO])) break; if (sp > XB_SPIN_CAP) { atomicAdd(&bar[XB_TMO], 1u); break; } }
    }
    nloc = mine > 0u ? mine : 1u; nx = cnt > 0u ? cnt : 1u;
}
__device__ __forceinline__ void xcd_barrier(const XcdBarrier& b) {
    asm volatile("s_waitcnt vmcnt(0)" ::: "memory");
    __syncthreads();
    if (threadIdx.x == 0) {
        unsigned* bar = b.bar;
        __builtin_amdgcn_s_waitcnt(0);
        unsigned nloc = b.st[0], nx = b.st[1];
        if (nloc == 0u) { xcd_barrier_complete(bar, b.x, nloc, nx); b.st[0] = nloc; b.st[1] = nx; }
        const unsigned old = xb_add(&bar[XB_XSUB(b.x)], 1u);
        const unsigned gen = old / nloc;
        if (old + 1u == (gen + 1u) * nloc) {
            __builtin_amdgcn_fence(__ATOMIC_RELEASE, "agent");
            asm volatile("s_waitcnt vmcnt(0)" ::: "memory");
            const unsigned og = xb_add(&bar[XB_TOP], 1u);
            const unsigned tg = og / nx;
            if (og + 1u == (tg + 1u) * nx) xb_add(&bar[XB_TOPGEN], 1u);
            else XB_SPIN(xb_ld(&bar[XB_TOPGEN]) == tg, bar);
            __builtin_amdgcn_fence(__ATOMIC_ACQUIRE, "agent");
            xb_add(&bar[XB_XGEN(b.x)], 1u);
            asm volatile("s_waitcnt vmcnt(0)" ::: "memory");
        } else {
            XB_SPIN(xb_ld(&bar[XB_XGEN(b.x)]) == gen, bar);
            __builtin_amdgcn_fence(__ATOMIC_ACQUIRE, "agent");
            asm volatile("s_waitcnt vmcnt(0)" ::: "memory");
        }
    }
    __syncthreads();
}

constexpr int BM = 256, BK = 64, HALF = 128, HTB = HALF * BK * 2, STAGE_BYTES = 8 * HTB, NXCD = 8, WGM = 8;
__host__ __device__ __forceinline__ int lds_byte(int r, int c) { const int st = (r >> 4) * 2 + (c >> 5), rr = r & 15, cc = c & 31, ob = rr * 64 + cc * 2; return st * 1024 + (ob ^ (((ob >> 9) & 1) << 5)); }
__host__ __device__ __forceinline__ void stage_rc(int b, int& R, int& C) { const int st = b / 1024, sb = b % 1024, swz = sb ^ (((sb >> 9) & 1) << 5); R = (st >> 1) * 16 + swz / 64; C = (st & 1) * 32 + (swz % 64) / 2; }

struct GUnit { const char* a; const char* b; int pn; int row0; int nrows; int aux; };
__device__ __forceinline__ void map_unit(int L, int nM, int nN, int& pm, int& pn) {
    const int nwg = nM * nN; int wgid = L;
    { const int q = nwg / NXCD, r = nwg % NXCD, xcd = wgid % NXCD, off = wgid / NXCD; wgid = (xcd < r ? xcd * (q + 1) : r * (q + 1) + (xcd - r) * q) + off; }
    const int nig = WGM * nN, gid = wgid / nig, fm = gid * WGM, gsz = (nM - fm) < WGM ? (nM - fm) : WGM;
    pm = fm + ((wgid % nig) % gsz); pn = (wgid % nig) / gsz;
}
struct DenseSched {
    const bf16_t* A; const bf16_t* Bt; int lda, K, nM, nN, G, c;
    __device__ __forceinline__ bool next(int i, GUnit& u) const {
        const long L = (long)i * G + c; if (L >= (long)nM * nN) return false;
        int pm, pn; map_unit((int)L, nM, nN, pm, pn);
        u.a = (const char*)(A + (size_t)pm * BM * lda); u.b = (const char*)(Bt + (size_t)pn * BM * K); u.pn = pn; u.row0 = pm * BM; u.nrows = BM; u.aux = 0; return true;
    }
};
struct DenseSched8 {
    const unsigned char* A; const unsigned char* Bt; int lda, K, nM, nN, G, c;
    __device__ __forceinline__ bool next(int i, GUnit& u) const {
        const long L = (long)i * G + c; if (L >= (long)nM * nN) return false;
        int pm, pn; map_unit((int)L, nM, nN, pm, pn);
        u.a = (const char*)(A + (size_t)pm * BM * lda); u.b = (const char*)(Bt + (size_t)pn * BM * K); u.pn = pn; u.row0 = pm * BM; u.nrows = BM; u.aux = 0; return true;
    }
};
struct BandSched {
    const bf16_t* A; const bf16_t* Bt; int lda, ldb, nM, nN, G, c;
    __device__ __forceinline__ bool next(int i, GUnit& u) const {
        const long L = (long)i * G + c; if (L >= (long)nM * nN) return false;
        int pm, pn; map_unit((int)L, nM, nN, pm, pn);
        int k0 = ((128 * pn / 80) * 80 / 64) * 64; k0 = k0 > ldb - 384 ? ldb - 384 : k0;
        u.a = (const char*)(A + (size_t)pm * BM * lda + k0); u.b = (const char*)(Bt + (size_t)pn * BM * ldb + k0); u.pn = pn; u.row0 = pm * BM; u.nrows = BM; u.aux = 0; return true;
    }
};
struct MoeSched {
    const unsigned char* A; const unsigned char* W; const int4* tiles; const int* inv; int NT, nN, N, K, G, c;
    __device__ __forceinline__ bool next(int i, GUnit& u) const {
        const long L = (long)i * G + c; if (L >= (long)NT * nN) return false;
        int pm, pn; map_unit((int)L, NT, nN, pm, pn);
        const int4 t = tiles[1 + pm];
        const int e = __builtin_amdgcn_readfirstlane(t.x), r0 = __builtin_amdgcn_readfirstlane(t.y), nr = __builtin_amdgcn_readfirstlane(t.z);
        u.a = (const char*)(A + (size_t)r0 * K); u.b = (const char*)(W + ((size_t)e * N + (size_t)pn * BM) * K); u.pn = pn; u.row0 = r0; u.nrows = nr; u.aux = e; return true;
    }
};

template <bool F8, bool GATHER = false, class Epi, class Sched>
__device__ __forceinline__ void gemm_phase(LAS unsigned char* lds, const int K  , const int lda, const int ldb  , const Sched& S, const Epi& E, const float accs = 1.f  ) {
    const int tid = tid_opaque(), wid = __builtin_amdgcn_readfirstlane(tid >> 6), lane = tid & 63, wr = wid >> 2, wc = wid & 3, fr = lane & 15, fq = lane >> 4;
    const int nt = F8 ? K / 128 : K / BK;
    unsigned voffA[2], voffB[2];
#pragma unroll
    for (int i = 0; i < 2; ++i) { int R, C; stage_rc(tid * 16 + i * 8192, R, C); voffA[i] = F8 ? (unsigned)(R * lda + 2 * C) : (unsigned)(R * lda + C) * 2u; voffB[i] = F8 ? (unsigned)(R * ldb + 2 * C) : (unsigned)(R * ldb + C) * 2u; }
    int gR[2]; unsigned gC[2]; unsigned vc[2][2], vn[2][2];
#pragma unroll
    for (int i = 0; i < 2; ++i) { int R, C; stage_rc(tid * 16 + i * 8192, R, C); gR[i] = R; gC[i] = 2u * (unsigned)C; }
#define PG8_GLOAD(dst, unit) do { if constexpr (GATHER) { _Pragma("unroll") for (int _h = 0; _h < 2; ++_h) _Pragma("unroll") for (int _i = 0; _i < 2; ++_i) \
        dst[_h][_i] = (unsigned)S.inv[(unit).row0 + _h * HALF + gR[_i]] * (unsigned)lda + gC[_i]; } } while (0)
#define PG8_STAGE_A(bufoff, h, kofs, unext) do { if constexpr (GATHER) { _Pragma("unroll") for (int _i = 0; _i < 2; ++_i) \
        __builtin_amdgcn_global_load_lds((const unsigned*)((const char*)S.A + (kofs) + ((unext) ? vn[h][_i] : vc[h][_i])), (LAS unsigned*)(lds + (bufoff) + ldsw + _i * 8192), 16, 0, 0); } \
        else PG8_STAGE(bufoff, ((unext) ? nA : cA) + (h) * hstepA + (kofs), voffA); } while (0)
    const size_t kstep = (size_t)(BK * 2);
    const size_t hstepA = (size_t)HALF * lda * (F8 ? 1 : 2), hstepB = (size_t)HALF * ldb * (F8 ? 1 : 2);
    const unsigned ldsw = (unsigned)wid * 1024u;
    const int aoff = lds_byte(wr * 64 + fr, fq * 8), boff = lds_byte(wc * 32 + fr, fq * 8);
    const LAS unsigned char* ldsA = lds + aoff; const LAS unsigned char* ldsB = lds + 65536 + boff;
#define PG8_SA(b, h) (((b) * 2 + (h)) * HTB)
#define PG8_SB(b, h) ((4 + (b) * 2 + (h)) * HTB)
#define PG8_STAGE(bufoff, gbase, voff) do { _Pragma("unroll") for (int _i = 0; _i < 2; ++_i) \
        __builtin_amdgcn_global_load_lds((const unsigned*)((const char*)(gbase) + (voff)[_i]), (LAS unsigned*)(lds + (bufoff) + ldsw + _i * 8192), 16, 0, 0); } while (0)
#define PG8_LD16(off) (*(const LAS u32x4*)(lds + (off)))
#define PG8_LDA16(off) (*(const LAS u32x4*)(ldsA + (off)))
#define PG8_LDB16(off) (*(const LAS u32x4*)(ldsB + (off)))
#define PG8_LDA(dst, b, h) do { _Pragma("unroll") for (int m = 0; m < 4; ++m) { \
        if constexpr (F8) dst##8[m] = __builtin_shufflevector(PG8_LDA16(PG8_SA(b, h) + m * 2048), PG8_LDA16(PG8_SA(b, h) + m * 2048 + 1024), 0, 1, 2, 3, 4, 5, 6, 7); \
        else { _Pragma("unroll") for (int k = 0; k < 2; ++k) dst[m][k] = *(const LAS bf16x8*)(lds + PG8_SA(b, h) + aoff + m * 2048 + k * 1024); } } } while (0)
#define PG8_LDB(dst, b, h) do { _Pragma("unroll") for (int n = 0; n < 2; ++n) { \
        if constexpr (F8) dst##8[n] = __builtin_shufflevector(PG8_LDB16(PG8_SB(b, h) - 65536 + n * 2048), PG8_LDB16(PG8_SB(b, h) - 65536 + n * 2048 + 1024), 0, 1, 2, 3, 4, 5, 6, 7); \
        else { _Pragma("unroll") for (int k = 0; k < 2; ++k) dst[n][k] = *(const LAS bf16x8*)(lds + PG8_SB(b, h) + boff + n * 2048 + k * 1024); } } } while (0)
#define PG8_MMA(ai, bj, At, Bt) do { __builtin_amdgcn_s_setprio(1); _Pragma("unroll") for (int m = 0; m < 4; ++m) _Pragma("unroll") for (int n = 0; n < 2; ++n) { \
        if constexpr (F8) asm("v_mfma_f32_16x16x128_f8f6f4 %0, %1, %2, %0" : "+v"(acc[ai][bj][m][n]) : "v"(Bt##8[n]), "v"(At##8[m])); \
        else { _Pragma("unroll") for (int k = 0; k < 2; ++k) acc[ai][bj][m][n] = __builtin_amdgcn_mfma_f32_16x16x32_bf16(Bt[n][k], At[m][k], acc[ai][bj][m][n], 0, 0, 0); } } \
        __builtin_amdgcn_s_setprio(0); } while (0)
#define PG8_WAIT_V(n) asm volatile("s_waitcnt vmcnt(" #n ")" ::: "memory")
#define PG8_WAIT_L(n) asm volatile("s_waitcnt lgkmcnt(" #n ")" ::: "memory")
#define PG8_BAR __builtin_amdgcn_s_barrier()
#define PG8_SCHED __builtin_amdgcn_sched_barrier(0)
    GUnit cur, nxt; int ui = 0;
    if (!S.next(0, cur)) return;
    f32x4 acc[2][2][4][2];
#pragma unroll
    for (int a = 0; a < 2; ++a)
#pragma unroll
        for (int b = 0; b < 2; ++b)
#pragma unroll
            for (int m = 0; m < 4; ++m)
#pragma unroll
                for (int n = 0; n < 2; ++n) acc[a][b][m][n] = (f32x4){0.f, 0.f, 0.f, 0.f};
    bf16x8 At[4][2], B0[2][2], B1[2][2];
    typedef unsigned u32x8 __attribute__((ext_vector_type(8)));
    u32x8 At8[4], B08[2], B18[2];
    const char* cA = cur.a; const char* cB = cur.b; const char* nA = cA;
    PG8_GLOAD(vc, cur);
    PG8_STAGE(PG8_SB(0, 0), cB, voffB); PG8_STAGE_A(PG8_SA(0, 0), 0, (size_t)0, false); PG8_STAGE(PG8_SB(0, 1), cB + hstepB, voffB); PG8_STAGE_A(PG8_SA(0, 1), 1, (size_t)0, false);
    if (wr == 1) PG8_BAR;
    PG8_WAIT_V(4); PG8_BAR;
    PG8_STAGE(PG8_SB(1, 0), cB + kstep, voffB); PG8_STAGE_A(PG8_SA(1, 0), 0, kstep, false); PG8_STAGE(PG8_SB(1, 1), cB + hstepB + kstep, voffB);
    PG8_WAIT_V(6); PG8_BAR;
    for (;;) {
        const bool has_next = S.next(ui + 1, nxt);
        nA = has_next ? nxt.a : cA; const char* nB = has_next ? nxt.b : cB;
        if (has_next) PG8_GLOAD(vn, nxt); else { _Pragma("unroll") for (int _h = 0; _h < 2; ++_h) _Pragma("unroll") for (int _i = 0; _i < 2; ++_i) vn[_h][_i] = vc[_h][_i]; }
#pragma unroll 1
        for (int t = 0; t < nt; t += 2) {
            const bool last = (t == nt - 2);
            const size_t ka1 = (size_t)(t + 1) * kstep, ka2 = last ? (size_t)0 : (size_t)(t + 2) * kstep, ka3 = ka2 + kstep;
            const char* b2 = last ? nB : cB + (size_t)(t + 2) * kstep;
            const char* b3 = b2 + kstep;
            PG8_LDB(B0, 0, 0); PG8_SCHED; PG8_LDA(At, 0, 0); PG8_STAGE_A(PG8_SA(1, 1), 1, ka1, false);
            PG8_WAIT_L(8); PG8_BAR; PG8_WAIT_L(0); PG8_MMA(0, 0, At, B0); PG8_BAR; PG8_SCHED;
            PG8_LDB(B1, 0, 1); PG8_STAGE(PG8_SB(0, 0), b2, voffB);
            PG8_BAR; PG8_WAIT_L(0); PG8_MMA(0, 1, At, B1); PG8_BAR;
            PG8_LDA(At, 0, 1); PG8_STAGE_A(PG8_SA(0, 0), 0, ka2, last);
            PG8_BAR; PG8_WAIT_L(0); PG8_MMA(1, 0, At, B0); PG8_BAR; PG8_SCHED;
            PG8_STAGE(PG8_SB(0, 1), b2 + hstepB, voffB);
            PG8_WAIT_V(6); PG8_BAR; PG8_MMA(1, 1, At, B1); PG8_BAR;
            PG8_LDB(B0, 1, 0); PG8_SCHED; PG8_LDA(At, 1, 0); PG8_STAGE_A(PG8_SA(0, 1), 1, ka2, last);
            PG8_WAIT_L(8); PG8_BAR; PG8_WAIT_L(0); PG8_MMA(0, 0, At, B0); PG8_BAR; PG8_SCHED;
            PG8_LDB(B1, 1, 1); PG8_STAGE(PG8_SB(1, 0), b3, voffB);
            PG8_BAR; PG8_WAIT_L(0); PG8_MMA(0, 1, At, B1); PG8_BAR;
            PG8_LDA(At, 1, 1); PG8_STAGE_A(PG8_SA(1, 0), 0, ka3, last);
            PG8_BAR; PG8_WAIT_L(0); PG8_MMA(1, 0, At, B0); PG8_BAR; PG8_SCHED;
            PG8_STAGE(PG8_SB(1, 1), b3 + hstepB, voffB);
            PG8_WAIT_V(6); PG8_BAR; PG8_MMA(1, 1, At, B1); PG8_BAR;
        }
        if constexpr (F8) asm volatile("s_nop 15\n\ts_nop 15" ::: "memory");
        if (accs != 1.f) {
#pragma unroll
            for (int a = 0; a < 2; ++a)
#pragma unroll
                for (int b = 0; b < 2; ++b)
#pragma unroll
                    for (int m = 0; m < 4; ++m)
#pragma unroll
                        for (int n = 0; n < 2; ++n) acc[a][b][m][n] *= accs;
        }
        E(acc, cur, wr, wc, fr, fq);
        if (!has_next) break;
#pragma unroll
        for (int a = 0; a < 2; ++a)
#pragma unroll
            for (int b = 0; b < 2; ++b)
#pragma unroll
                for (int m = 0; m < 4; ++m)
#pragma unroll
                    for (int n = 0; n < 2; ++n) acc[a][b][m][n] = (f32x4){0.f, 0.f, 0.f, 0.f};
        cur = nxt; cA = nA; cB = nB; ++ui;
#pragma unroll
        for (int _h = 0; _h < 2; ++_h)
#pragma unroll
            for (int _i = 0; _i < 2; ++_i) vc[_h][_i] = vn[_h][_i];
    }
    PG8_WAIT_V(0);
    if (wr == 0) PG8_BAR;
    PG8_BAR;
#undef PG8_SA
#undef PG8_SB
#undef PG8_STAGE
#undef PG8_STAGE_A
#undef PG8_GLOAD
#undef PG8_LDA
#undef PG8_LDB
#undef PG8_MMA
#undef PG8_LD16
#undef PG8_LDA16
#undef PG8_LDB16
#undef PG8_WAIT_V
#undef PG8_WAIT_L
#undef PG8_BAR
#undef PG8_SCHED
}
typedef f32x4 acc_t[2][2][4][2];
__device__ __forceinline__ u32x4 pack8(f32x4 a, f32x4 b) { return (u32x4){cvt_pk_bf16(a[0], a[1]), cvt_pk_bf16(a[2], a[3]), cvt_pk_bf16(b[0], b[1]), cvt_pk_bf16(b[2], b[3])}; }
__device__ __forceinline__ void unpack8(u32x4 v, float* f) { f[0] = bf_lo(v[0]); f[1] = bf_hi(v[0]); f[2] = bf_lo(v[1]); f[3] = bf_hi(v[1]); f[4] = bf_lo(v[2]); f[5] = bf_hi(v[2]); f[6] = bf_lo(v[3]); f[7] = bf_hi(v[3]); }

template <bool MASK> struct EpiPlain {
    bf16_t* O; int ldo; float scale;
    __device__ __forceinline__ void operator()(const acc_t& acc, const GUnit& u, int wr, int wc, int fr, int fq) const {
        const int colb = u.pn * 256 + wc * 32 + fq * 8;
#pragma unroll
        for (int ai = 0; ai < 2; ++ai)
#pragma unroll
            for (int m = 0; m < 4; ++m) {
                const int r = ai * 128 + wr * 64 + m * 16 + fr;
                if (MASK && r >= u.nrows) continue;
                bf16_t* rowp = O + (size_t)(u.row0 + r) * ldo + colb;
#pragma unroll
                for (int bj = 0; bj < 2; ++bj) st16(rowp + bj * 128, pack8(acc[ai][bj][m][0] * scale, acc[ai][bj][m][1] * scale));
            }
    }
};

struct EpiResid {
    float* XF; const float* XR;
    __device__ __forceinline__ void operator()(const acc_t& acc, const GUnit& u, int wr, int wc, int fr, int fq) const {
        const int colb = u.pn * 256 + wc * 32 + fq * 8;
#pragma unroll
        for (int ai = 0; ai < 2; ++ai)
#pragma unroll
            for (int m = 0; m < 4; ++m) {
                const int r = ai * 128 + wr * 64 + m * 16 + fr;
                float* rowp = XF + (size_t)(u.row0 + r) * 1024 + colb; const float* rrow = XR + (size_t)(u.row0 + r) * 1024 + colb;
                asm volatile("" ::: "memory");
#pragma unroll
                for (int bj = 0; bj < 2; ++bj) {
                    const f32x4 x0 = *(const f32x4*)(rrow + bj * 128), x1 = *(const f32x4*)(rrow + bj * 128 + 4);
                    *(f32x4*)(rowp + bj * 128) = x0 * DN_ALPHA + acc[ai][bj][m][0]; *(f32x4*)(rowp + bj * 128 + 4) = x1 * DN_ALPHA + acc[ai][bj][m][1];
                }
            }
    }
};

__device__ __forceinline__ float clamp8(float x) { return __builtin_amdgcn_fmed3f(x, -448.f, 448.f); }
__device__ __forceinline__ u32x2 pack8_fp8(const float* f) {
    unsigned a = 0u, b = 0u;
    a = __builtin_amdgcn_cvt_pk_fp8_f32(clamp8(f[0]), clamp8(f[1]), a, false); a = __builtin_amdgcn_cvt_pk_fp8_f32(clamp8(f[2]), clamp8(f[3]), a, true);
    b = __builtin_amdgcn_cvt_pk_fp8_f32(clamp8(f[4]), clamp8(f[5]), b, false); b = __builtin_amdgcn_cvt_pk_fp8_f32(clamp8(f[6]), clamp8(f[7]), b, true);
    return (u32x2){a, b};
}
__device__ __forceinline__ void unpack8_fp8(u32x2 v, float* f) {
    const f32x2 a = __builtin_amdgcn_cvt_pk_f32_fp8(v[0], false), b = __builtin_amdgcn_cvt_pk_f32_fp8(v[0], true), c = __builtin_amdgcn_cvt_pk_f32_fp8(v[1], false), d = __builtin_amdgcn_cvt_pk_f32_fp8(v[1], true);
    f[0] = a[0]; f[1] = a[1]; f[2] = b[0]; f[3] = b[1]; f[4] = c[0]; f[5] = c[1]; f[6] = d[0]; f[7] = d[1]; }
struct EpiMoeDown8 {
    unsigned char* O; float scale;
    __device__ __forceinline__ void operator()(const acc_t& acc, const GUnit& u, int wr, int wc, int fr, int fq) const {
        const int colb = u.pn * 256 + wc * 32 + fq * 8;
#pragma unroll
        for (int ai = 0; ai < 2; ++ai)
#pragma unroll
            for (int m = 0; m < 4; ++m) {
                const int r = ai * 128 + wr * 64 + m * 16 + fr;
                if (r >= u.nrows) continue;
                unsigned char* rowp = O + (size_t)(u.row0 + r) * 1024 + colb;
#pragma unroll
                for (int bj = 0; bj < 2; ++bj) { const f32x4 v0 = acc[ai][bj][m][0] * scale, v1 = acc[ai][bj][m][1] * scale;
                    const float f[8] = {v0[0], v0[1], v0[2], v0[3], v1[0], v1[1], v1[2], v1[3]}; *(u32x2*)(rowp + bj * 128) = pack8_fp8(f); }
            }
    }
};
struct EpiMoeGU {
    unsigned char* O;
    __device__ __forceinline__ void operator()(const acc_t& acc, const GUnit& u, int wr, int wc, int fr, int fq) const {
        const int colb = u.pn * 128 + wc * 32 + fq * 8;
#pragma unroll
        for (int ai = 0; ai < 2; ++ai)
#pragma unroll
            for (int m = 0; m < 4; ++m) {
                const int r = ai * 128 + wr * 64 + m * 16 + fr;
                if (r >= u.nrows) continue;
                float h[8];
                constexpr float DS = 1.f / (S8_X * S8_WGU);
#pragma unroll
                for (int bj = 0; bj < 2; ++bj)
#pragma unroll
                    for (int jj = 0; jj < 4; ++jj) h[bj * 4 + jj] = silu_(acc[ai][bj][m][0][jj] * DS) * (acc[ai][bj][m][1][jj] * (DS * S8_H));
                *(u32x2*)(O + (size_t)(u.row0 + r) * 1024 + colb) = pack8_fp8(h);
            }
    }
};

struct EpiScIn {
    bf16_t* P; bf16_t* BG;
    __device__ __forceinline__ void operator()(const acc_t& acc, const GUnit& u, int wr, int wc, int fr, int fq) const {
        if (u.pn < 8) {
            const int colb = u.pn * 128 + wc * 32 + fq * 8;
#pragma unroll
            for (int ai = 0; ai < 2; ++ai)
#pragma unroll
                for (int m = 0; m < 4; ++m) {
                    const int r = ai * 128 + wr * 64 + m * 16 + fr;
                    st16(P + (size_t)(u.row0 + r) * 1024 + colb, pack8(acc[ai][0][m][0] * acc[ai][0][m][1], acc[ai][1][m][0] * acc[ai][1][m][1]));
                }
        } else {
            const int colb = (u.pn - 8) * 256 + wc * 32 + fq * 8;
#pragma unroll
            for (int ai = 0; ai < 2; ++ai)
#pragma unroll
                for (int m = 0; m < 4; ++m) {
                    const int r = ai * 128 + wr * 64 + m * 16 + fr;
                    bf16_t* rowp = BG + (size_t)(u.row0 + r) * 1024 + colb;
#pragma unroll
                    for (int bj = 0; bj < 2; ++bj) st16(rowp + bj * 128, pack8(acc[ai][bj][m][0], acc[ai][bj][m][1]));
                }
        }
    }
};

struct EpiLruIn {
    bf16_t* GG; bf16_t* REC;
    __device__ __forceinline__ void operator()(const acc_t& acc, const GUnit& u, int wr, int wc, int fr, int fq) const {
        const bool isg = u.pn < 5;
        bf16_t* O = GG + (isg ? 0l : (REC - GG));
        const int colb = (isg ? u.pn : u.pn - 5) * 256 + wc * 32 + fq * 8;
#pragma unroll
        for (int ai = 0; ai < 2; ++ai)
#pragma unroll
            for (int m = 0; m < 4; ++m) {
                const int r = ai * 128 + wr * 64 + m * 16 + fr;
                bf16_t* rowp = O + (size_t)(u.row0 + r) * LRU_W + colb;
#pragma unroll
                for (int bj = 0; bj < 2; ++bj) {
                    f32x4 v0 = acc[ai][bj][m][0], v1 = acc[ai][bj][m][1];
                    if (isg) {
#pragma unroll
                        for (int jj = 0; jj < 4; ++jj) { v0[jj] = gelu_tanh(v0[jj]); v1[jj] = gelu_tanh(v1[jj]); }
                    }
                    st16(rowp + bj * 128, pack8(v0, v1));
                }
            }
    }
};

struct EpiLruGate {
    const bf16_t* U; bf16_t* LOGA; bf16_t* BIN; const float* ba; const float* bx; const float* lam;
    __device__ __forceinline__ void operator()(const acc_t& acc, const GUnit& u, int wr, int wc, int fr, int fq) const {
        const int ch0 = u.pn * 128 + wc * 32 + fq * 8;
        float ba8[8], bx8[8], ls8[8];
#pragma unroll
        for (int i = 0; i < 8; ++i) { ba8[i] = ba[ch0 + i]; bx8[i] = bx[ch0 + i]; const float l = lam[ch0 + i]; ls8[i] = -8.f * log1pf(__expf(-l)); }
#pragma unroll
        for (int ai = 0; ai < 2; ++ai)
#pragma unroll
            for (int m = 0; m < 4; ++m) {
                const int r = ai * 128 + wr * 64 + m * 16 + fr;
                const size_t off = (size_t)(u.row0 + r) * LRU_W + ch0;
                float u8[8]; unpack8(ld16(U + off), u8);
                f32x4 la[2], bi[2];
#pragma unroll
                for (int bj = 0; bj < 2; ++bj)
#pragma unroll
                    for (int jj = 0; jj < 4; ++jj) {
                        const int i = bj * 4 + jj;
                        const float rg = sigmoidf_(acc[ai][bj][m][0][jj] + ba8[i]);
                        const float ig = sigmoidf_(acc[ai][bj][m][1][jj] + bx8[i]);
                        const float l = rg * ls8[i];
                        const float om = fmaxf(1.f - fast_exp(2.f * l), 0.f);
                        la[bj][jj] = l; bi[bj][jj] = __builtin_sqrtf(om) * ig * u8[i];
                    }
                st16(LOGA + off, pack8(la[0], la[1]));
                st16(BIN + off, pack8(bi[0], bi[1]));
            }
    }
};

struct EpiNsaIn {
    bf16_t* Q; bf16_t* KC; bf16_t* VC; bf16_t* KS; bf16_t* VST; bf16_t* KW; bf16_t* VWT; float* GATES; const int* pos; const float* bgate;
    __device__ __forceinline__ void operator()(const acc_t& acc, const GUnit& u, int wr, int wc, int fr, int fq) const {
        const int pn = u.pn;
        if (pn <= 3 || pn == 6 || pn == 8) {
            bf16_t* O = Q + (pn <= 3 ? 0l : (pn == 6 ? (KS - Q) : (KW - Q)));
            const int ldo = pn <= 3 ? 1024 : 256;
            const int colbase = pn <= 3 ? pn * 256 : 0;
            const float scale = pn <= 3 ? 0.125f * LOG2E : 1.f;
            float invf[4];
#pragma unroll
            for (int jj = 0; jj < 4; ++jj) invf[jj] = exp2f(-(float)(16 * (wc & 1) + 4 * fq + jj) * (13.287712379549449f / 32.f));
#pragma unroll
            for (int ai = 0; ai < 2; ++ai)
#pragma unroll
                for (int m = 0; m < 4; ++m) {
                    const int row = u.row0 + ai * 128 + wr * 64 + m * 16 + fr;
                    const float p = (float)pos[row];
                    float sn[4], cs[4];
#pragma unroll
                    for (int jj = 0; jj < 4; ++jj) sincos_rad(p * invf[jj], sn[jj], cs[jj]);
#pragma unroll
                    for (int bj = 0; bj < 2; ++bj) {
                        const f32x4 x1 = acc[ai][bj][m][0], x2 = acc[ai][bj][m][1];
                        float o1[4], o2[4];
#pragma unroll
                        for (int jj = 0; jj < 4; ++jj) { o1[jj] = (x1[jj] * cs[jj] - x2[jj] * sn[jj]) * scale; o2[jj] = (x1[jj] * sn[jj] + x2[jj] * cs[jj]) * scale; }
                        bf16_t* p1 = O + (size_t)row * ldo + colbase + 64 * (2 * bj + (wc >> 1)) + 16 * (wc & 1) + 4 * fq;
                        *(u32x2*)p1 = (u32x2){cvt_pk_bf16(o1[0], o1[1]), cvt_pk_bf16(o1[2], o1[3])};
                        *(u32x2*)(p1 + 32) = (u32x2){cvt_pk_bf16(o2[0], o2[1]), cvt_pk_bf16(o2[2], o2[3])};
                    }
                }
        } else if (pn == 4 || pn == 5) {
            bf16_t* O = KC + (pn == 4 ? 0l : (VC - KC));
            const int colb = wc * 32 + fq * 8;
#pragma unroll
            for (int ai = 0; ai < 2; ++ai)
#pragma unroll
                for (int m = 0; m < 4; ++m) {
                    const int row = u.row0 + ai * 128 + wr * 64 + m * 16 + fr;
#pragma unroll
                    for (int bj = 0; bj < 2; ++bj) st16(O + (size_t)row * 256 + colb + bj * 128, pack8(acc[ai][bj][m][0], acc[ai][bj][m][1]));
                }
        } else if (pn == 7 || pn == 9) {
            bf16_t* O = VST + (pn == 7 ? 0l : (VWT - VST));
#pragma unroll
            for (int ai = 0; ai < 2; ++ai)
#pragma unroll
                for (int m = 0; m < 4; ++m) {
                    const int row = u.row0 + ai * 128 + wr * 64 + m * 16 + fr;
                    const int b = row >> 11, s = row & 2047;
#pragma unroll
                    for (int bj = 0; bj < 2; ++bj) {
                        const int g = 2 * bj + (wc >> 1);
                        bf16_t* base = O + ((size_t)(b * 4 + g) * 64 + 32 * (wc & 1) + 8 * fq) * SEQ + s;
#pragma unroll
                        for (int n = 0; n < 2; ++n)
#pragma unroll
                            for (int jj = 0; jj < 4; ++jj) base[(size_t)(4 * n + jj) * SEQ] = f2bf(acc[ai][bj][m][n][jj]);
                    }
                }
        } else {
            if (wc < 2 && (wc == 0 || fq < 2)) {
                const int c0 = 32 * wc + 8 * fq;
                f32x4 bg[2];
#pragma unroll
                for (int n = 0; n < 2; ++n) bg[n] = *(const f32x4*)(bgate + c0 + 4 * n);
#pragma unroll
                for (int ai = 0; ai < 2; ++ai)
#pragma unroll
                    for (int m = 0; m < 4; ++m) {
                        const int row = u.row0 + ai * 128 + wr * 64 + m * 16 + fr;
#pragma unroll
                        for (int n = 0; n < 2; ++n) {
                            f32x4 v;
#pragma unroll
                            for (int jj = 0; jj < 4; ++jj) v[jj] = sigmoidf_(acc[ai][0][m][n][jj] + bg[n][jj]);
                            *(f32x4*)(GATES + (size_t)row * 48 + c0 + 4 * n) = v;
                        }
                    }
            }
        }
    }
};
__device__ __forceinline__ int map_plain8(int cc) { const int bj = cc >> 7, wc = (cc >> 5) & 3, n = (cc >> 4) & 1, fq = (cc >> 2) & 3; return 128 * bj + 32 * wc + 8 * fq + 4 * n; }
__device__ __forceinline__ int map_rope(int cc) { const int bj = cc >> 7, wc = (cc >> 5) & 3, n = (cc >> 4) & 1, fq = (cc >> 2) & 3; return 64 * (2 * bj + (wc >> 1)) + 32 * n + 16 * (wc & 1) + 4 * fq; }
__device__ __forceinline__ void map_pair(int cc, int& n, int& ch) { const int bj = cc >> 7, wc = (cc >> 5) & 3, fq = (cc >> 2) & 3; n = (cc >> 4) & 1; ch = 32 * wc + 8 * fq + 4 * bj; }
constexpr f32x4 F4ZERO = {0.f, 0.f, 0.f, 0.f};

struct FetchNsaIn { const float* W;
    __device__ __forceinline__ f32x4 operator()(int, int c4, int k) const { const int pn = c4 >> 8, cc = c4 & 255; const bool rope = (pn <= 3 || pn == 6 || pn == 8);
        const int col = pn * 256 + (rope ? map_rope(cc) : map_plain8(cc)); if (col >= 2608) return F4ZERO; return *(const f32x4*)(W + (size_t)k * 2608 + col); } };
struct FetchPlain { const float* W; int ld; size_t bstride;
    __device__ __forceinline__ f32x4 operator()(int bt, int c4, int k) const { const int col = (c4 & ~255) + map_plain8(c4 & 255); return *(const f32x4*)(W + (size_t)bt * bstride + (size_t)k * ld + col); } };
struct FetchPair { const float* W0; long d01; int ld; size_t bstride;
    __device__ __forceinline__ f32x4 operator()(int bt, int c4, int k) const { int n, ch; map_pair(c4 & 255, n, ch); ch += (c4 >> 8) * 128; return *(const f32x4*)(W0 + (n ? d01 : 0l) + (long)((size_t)bt * bstride + (size_t)k * ld + ch)); } };
struct FetchScIn { const float* W;
    __device__ __forceinline__ f32x4 operator()(int, int c4, int k) const { const int pn = c4 >> 8, cc = c4 & 255;
        if (pn < 8) { int n, ch; map_pair(cc, n, ch); ch += pn * 128; return *(const f32x4*)(W + (size_t)k * 3072 + (n ? 2048 : 0) + ch); }
        return *(const f32x4*)(W + (size_t)k * 3072 + 1024 + (pn - 8) * 256 + map_plain8(cc)); } };
struct FetchLruGate { const float* wa; long dax;
    __device__ __forceinline__ f32x4 operator()(int, int c4, int k) const { int n, ch; map_pair(c4 & 255, n, ch); ch += (c4 >> 8) * 128; const int h = ch / 80; if (k / 80 != h) return F4ZERO;
        return *(const f32x4*)(wa + (n ? dax : 0l) + (long)(h * 6400 + (k - 80 * h) * 80 + (ch - 80 * h))); } };
struct FetchIdent { const float* W; int ld; size_t bstride;
    __device__ __forceinline__ f32x4 operator()(int bt, int c4, int k) const { return *(const f32x4*)(W + (size_t)bt * bstride + (size_t)k * ld + c4); } };

template <bool OUT8 = false, class F>
__device__ __forceinline__ void convert_wt(LAS unsigned char* lds, void* dstv, int nbatch, int Nd, int K, const F& fetch, const float scale = 1.f) {
    constexpr int GRP = 4;
    LAS float* tile = (LAS float*)lds;
    const int tid = tid_opaque();
    const int ntk = K / 64, ntc = Nd / 64, per = ntc * ntk, total = per * nbatch;
    const bool split = (Nd & 255) == 0;
    const int c4i = tid & 15, kk = tid >> 4, rr4 = 4 * c4i, row = tid >> 3, k8 = (tid & 7) * 8;
    for (int t0 = blockIdx.x * GRP; t0 < total; t0 += gridDim.x * GRP) {
        f32x4 v[GRP][2];
#pragma unroll
        for (int gi = 0; gi < GRP; ++gi) {
            const int t = t0 + gi;
            if (t < total) {
                const int bt = t / per, tt = t - bt * per, tc = tt / ntk, tk = tt - tc * ntk, k0 = tk * 64;
                const int cbase = split ? (tc >> 2) * 256 + (tc & 3) * 32 : tc * 64;
                const int crow4 = cbase + (split ? ((rr4 & 31) + (rr4 >> 5) * 128) : rr4);
#pragma unroll
                for (int p = 0; p < 2; ++p) v[gi][p] = fetch(bt, crow4, k0 + kk + 32 * p);
            }
        }
        __syncthreads();
#pragma unroll
        for (int gi = 0; gi < GRP; ++gi)
            if (t0 + gi < total) {
#pragma unroll
                for (int p = 0; p < 2; ++p)
#pragma unroll
                    for (int j = 0; j < 4; ++j) tile[gi * 4160 + (4 * c4i + j) * 65 + kk + 32 * p] = v[gi][p][j];
            }
        __syncthreads();
#pragma unroll
        for (int gi = 0; gi < GRP; ++gi) {
            const int t = t0 + gi;
            if (t < total) {
                const int bt = t / per, tt = t - bt * per, tc = tt / ntk, tk = tt - tc * ntk, k0 = tk * 64;
                const int cbase = split ? (tc >> 2) * 256 + (tc & 3) * 32 : tc * 64;
                const int crow = cbase + (split ? ((row & 31) + (row >> 5) * 128) : row);
                float f[8];
#pragma unroll
                for (int i = 0; i < 8; ++i) f[i] = tile[gi * 4160 + row * 65 + k8 + i];
                if constexpr (OUT8) {
#pragma unroll
                    for (int i = 0; i < 8; ++i) f[i] *= scale;
                    *(u32x2*)((unsigned char*)dstv + ((size_t)bt * Nd + crow) * K + k0 + k8) = pack8_fp8(f);
                } else st16((bf16_t*)dstv + ((size_t)bt * Nd + crow) * K + k0 + k8, (u32x4){cvt_pk_bf16(f[0], f[1]), cvt_pk_bf16(f[2], f[3]), cvt_pk_bf16(f[4], f[5]), cvt_pk_bf16(f[6], f[7])});
            }
        }
    }
    __syncthreads();
}

template <bool X8OUT>
__device__ __forceinline__ void convert_x(const float* x, unsigned char* XA) {
    const size_t n8 = (size_t)T_TOK * DM / 8;
    const int tidx = tid_opaque();
    for (size_t i = (size_t)blockIdx.x * NTHR + tidx; i < n8; i += (size_t)gridDim.x * NTHR) {
        if constexpr (X8OUT) {
            const f32x4 a = *(const f32x4*)(x + i * 8) * S8_X, b = *(const f32x4*)(x + i * 8 + 4) * S8_X;
            const float f[8] = {a[0], a[1], a[2], a[3], b[0], b[1], b[2], b[3]};
            *(u32x2*)(XA + i * 8) = pack8_fp8(f);
        } else { const f32x4 a = *(const f32x4*)(x + i * 8), b = *(const f32x4*)(x + i * 8 + 4); st16((bf16_t*)XA + i * 8, pack8(a, b)); }
    }
}
__device__ __forceinline__ void cmp_bias_phase(LAS unsigned char* lds, const float* pek, const float* w1k, const float* pev, const float* w1v, float* bias1) {
    LAS float* red = (LAS float*)lds;
    const int tidx = tid_opaque();
    for (int blk = blockIdx.x; blk < 32; blk += gridDim.x) {
        const int v = blk >> 3, j = v >> 1, kv = v & 1, hid = (blk & 7) * 8 + (tidx & 7), part = tidx >> 3;
        const float* pe = pek + (kv ? (pev - pek) : 0l) + j * 2048; const float* w1 = w1k + (kv ? (w1v - w1k) : 0l) + (size_t)j * 2048 * 64;
        float s = 0.f;
#pragma unroll 8
        for (int i = part * 32; i < part * 32 + 32; ++i) s += pe[i] * w1[i * 64 + hid];
        __syncthreads();
        red[part * 8 + (tidx & 7)] = s;
        __syncthreads();
        if (tidx < 8) { float t = 0.f; for (int q = 0; q < 64; ++q) t += red[q * 8 + tidx]; bias1[v * 64 + (blk & 7) * 8 + tidx] = t; }
    }
    __syncthreads();
}

__device__ __forceinline__ void ln1_router_phase(LAS unsigned char* lds, const float* XF, const bf16_t* MBm, float* XW, unsigned char* X8, const float* gam, const float* bet,
                                                 const float* rw, const float* rb, int* route_e, float* route_w, int* cnt) {
    LAS f32x4* rwl = (LAS f32x4*)lds;
    LAS int* lcnt = (LAS int*)(lds + 65536);
    const int tid = tid_opaque(), lane = tid & 63, w = tid >> 6;
    __syncthreads();
    for (int i = tid; i < 4096; i += NTHR) { const int col = i >> 2, q = i & 3; const int seg = col >> 9, ln = (col >> 3) & 63, j = col & 7;
        rwl[((q * 2 + seg) * 8 + j) * 64 + ln] = *(const f32x4*)(rw + col * 16 + 4 * q); }
    for (int chunk = blockIdx.x; chunk < 256; chunk += gridDim.x) {
        __syncthreads();
        if (tid < 16) lcnt[tid] = 0;
        __syncthreads();
        const size_t row0 = (size_t)chunk * 256 + w * 32;
        f32x4 nx[2][4]; u32x4 nm[2][2];
#pragma unroll
        for (int rr = 0; rr < 2; ++rr)
#pragma unroll
            for (int sg = 0; sg < 2; ++sg) { nx[rr][sg * 2] = *(const f32x4*)(XF + (row0 + rr) * DM + sg * 512 + lane * 8); nx[rr][sg * 2 + 1] = *(const f32x4*)(XF + (row0 + rr) * DM + sg * 512 + lane * 8 + 4);
                nm[rr][sg] = ld16(MBm + (row0 + rr) * DM + sg * 512 + lane * 8); }
        for (int i = 0; i < 32; i += 2) {
            f32x2 y2[16];
            {
                float xv[2][16];
#pragma unroll
                for (int rr = 0; rr < 2; ++rr) {
#pragma unroll
                    for (int sg = 0; sg < 2; ++sg) { float mv[8]; unpack8(nm[rr][sg], mv);
#pragma unroll
                        for (int j = 0; j < 4; ++j) { xv[rr][sg * 8 + j] = DN_ALPHA * nx[rr][sg * 2][j] + mv[j]; xv[rr][sg * 8 + 4 + j] = DN_ALPHA * nx[rr][sg * 2 + 1][j] + mv[4 + j]; } }
                }
                if (i + 2 < 32) {
#pragma unroll
                    for (int rr = 0; rr < 2; ++rr)
#pragma unroll
                        for (int sg = 0; sg < 2; ++sg) { nx[rr][sg * 2] = *(const f32x4*)(XF + (row0 + i + 2 + rr) * DM + sg * 512 + lane * 8); nx[rr][sg * 2 + 1] = *(const f32x4*)(XF + (row0 + i + 2 + rr) * DM + sg * 512 + lane * 8 + 4);
                            nm[rr][sg] = ld16(MBm + (row0 + i + 2 + rr) * DM + sg * 512 + lane * 8); }
                }
                float mean[2], rstd[2];
#pragma unroll
                for (int rr = 0; rr < 2; ++rr) { float s = 0.f;
#pragma unroll
                    for (int j = 0; j < 16; ++j) s += xv[rr][j];
                    mean[rr] = wave_sum_dpp(s) * (1.f / 1024.f); }
#pragma unroll
                for (int rr = 0; rr < 2; ++rr) { float q = 0.f;
#pragma unroll
                    for (int j = 0; j < 16; ++j) { const float d = xv[rr][j] - mean[rr]; q += d * d; }
                    rstd[rr] = rsqrtf(wave_sum_dpp(q) * (1.f / 1024.f) + LN_EPS); }
#pragma unroll
                for (int sg = 0; sg < 2; ++sg) {
                    const f32x4 ga = *(const f32x4*)(gam + sg * 512 + lane * 8), gb = *(const f32x4*)(gam + sg * 512 + lane * 8 + 4);
                    const f32x4 ba = *(const f32x4*)(bet + sg * 512 + lane * 8), bb = *(const f32x4*)(bet + sg * 512 + lane * 8 + 4);
#pragma unroll
                    for (int rr = 0; rr < 2; ++rr) {
                        f32x4 o0, o1;
#pragma unroll
                        for (int j = 0; j < 4; ++j) { o0[j] = (xv[rr][sg * 8 + j] - mean[rr]) * rstd[rr] * ga[j] + ba[j]; o1[j] = (xv[rr][sg * 8 + 4 + j] - mean[rr]) * rstd[rr] * gb[j] + bb[j];
                            y2[sg * 8 + j][rr] = o0[j]; y2[sg * 8 + 4 + j][rr] = o1[j]; }
                        *(f32x4*)(XW + (row0 + i + rr) * DM + sg * 512 + lane * 8) = o0; *(f32x4*)(XW + (row0 + i + rr) * DM + sg * 512 + lane * 8 + 4) = o1;
                        { const f32x4 a8 = o0 * S8_X, b8 = o1 * S8_X; const float f8[8] = {a8[0], a8[1], a8[2], a8[3], b8[0], b8[1], b8[2], b8[3]};
                          *(u32x2*)(X8 + (row0 + i + rr) * DM + sg * 512 + lane * 8) = pack8_fp8(f8); }
                    }
                }
            }
            f32x2 lg2[16];
#pragma unroll
            for (int e = 0; e < 16; ++e) lg2[e] = (f32x2){0.f, 0.f};
#pragma unroll
            for (int sg = 0; sg < 2; ++sg)
#pragma unroll
                for (int j = 0; j < 8; ++j) {
                    if ((j & 1) == 0) __builtin_amdgcn_sched_barrier(0);
#pragma unroll
                    for (int q = 0; q < 4; ++q) {
                        const f32x4 wv = rwl[((q * 2 + sg) * 8 + j) * 64 + lane];
#pragma unroll
                        for (int e = 0; e < 4; ++e) lg2[q * 4 + e] += y2[sg * 8 + j] * (f32x2){wv[e], wv[e]};
                    }
                }
#pragma unroll
            for (int rr = 0; rr < 2; ++rr) {
                float sc[16], bi[16];
#pragma unroll
                for (int e = 0; e < 16; ++e) { const float l = wave_sum_dpp(lg2[e][rr]); sc[e] = 1.f / (1.f + __expf(-l)); bi[e] = sc[e] + rb[e]; }
                float gs[4];
#pragma unroll
                for (int g = 0; g < 4; ++g) { const float a = bi[4 * g], b = bi[4 * g + 1], c = bi[4 * g + 2], d = bi[4 * g + 3];
                    gs[g] = fmaxf(fmaxf(fmaxf(a + b, a + c), fmaxf(a + d, b + c)), fmaxf(b + d, c + d)); }
                int bg = 0; float bgs = gs[0];
#pragma unroll
                for (int g = 1; g < 4; ++g) if (gs[g] > bgs) { bgs = gs[g]; bg = g; }
                float vb[4], vs[4];
#pragma unroll
                for (int k = 0; k < 4; ++k) { vb[k] = bg == 0 ? bi[k] : (bg == 1 ? bi[4 + k] : (bg == 2 ? bi[8 + k] : bi[12 + k])); vs[k] = bg == 0 ? sc[k] : (bg == 1 ? sc[4 + k] : (bg == 2 ? sc[8 + k] : sc[12 + k])); }
                int i1 = 0; float b1 = vb[0], s1 = vs[0];
#pragma unroll
                for (int k = 1; k < 4; ++k) if (vb[k] > b1) { b1 = vb[k]; s1 = vs[k]; i1 = k; }
                int i2 = -1; float b2 = -3e38f, s2 = 0.f;
#pragma unroll
                for (int k = 0; k < 4; ++k) if (k != i1 && vb[k] > b2) { b2 = vb[k]; s2 = vs[k]; i2 = k; }
                const float inv = 1.f / (s1 + s2);
                if (lane == 0) {
                    const size_t row = row0 + i + rr;
                    const int e0 = bg * 4 + i1, e1 = bg * 4 + i2;
                    route_e[row] = e0 | (e1 << 8); route_w[row * 2] = s1 * inv; route_w[row * 2 + 1] = s2 * inv;
                    atomicAdd((int*)&lcnt[e0], 1); atomicAdd((int*)&lcnt[e1], 1);
                }
            }
        }
        __syncthreads();
        if (tid < 16) cnt[chunk * 16 + tid] = lcnt[tid];
    }
    __syncthreads();
}

__device__ __forceinline__ void moe_gather_phase(LAS unsigned char* lds, const int* route_e, const int* cnt, int* pos_out, int* inv, int4* tiles) {
    LAS int* s_tot = (LAS int*)lds; LAS int* s_pre = s_tot + 16; LAS int* s_off = s_pre + 16; LAS int* s_wcnt = s_off + 16; LAS int* s_lpos = s_wcnt + 128;
    const int tid = tid_opaque(), lane = tid & 63, w = tid >> 6;
    for (int chunk = blockIdx.x; chunk < 256; chunk += gridDim.x) {
        __syncthreads();
        { const int e = tid >> 5, j = tid & 31; int tot = 0, pre = 0;
            for (int c = j; c < 256; c += 32) { const int v = cnt[c * 16 + e]; tot += v; pre += (c < chunk) ? v : 0; }
#pragma unroll
            for (int o = 16; o >= 1; o >>= 1) { tot += __shfl_xor(tot, o); pre += __shfl_xor(pre, o); }
            if (j == 0) { s_tot[e] = tot; s_pre[e] = pre; } }
        __syncthreads();
        if (tid == 0) { int off = 0; for (int e = 0; e < 16; ++e) { s_off[e] = off; off += s_tot[e]; } }
        const int token = chunk * 256 + (tid >> 1), slot = tid & 1;
        const int re = route_e[token]; const int e = slot ? ((re >> 8) & 255) : (re & 255);
        int rk = 0;
#pragma unroll
        for (int e2 = 0; e2 < 16; ++e2) { const unsigned long long mk = __ballot(e == e2); if (e == e2) rk = __popcll(mk & ((1ull << lane) - 1ull)); if (lane == 0) s_wcnt[w * 16 + e2] = __popcll(mk); }
        __syncthreads();
        int base = s_off[e] + s_pre[e];
        for (int w2 = 0; w2 < w; ++w2) base += s_wcnt[w2 * 16 + e];
        const int p = base + rk;
        pos_out[token * 2 + slot] = p; inv[p] = token;
        if (chunk == 0 && tid == 0) {
            int nt = 0;
            for (int e2 = 0; e2 < 16; ++e2) { const int n = s_tot[e2]; for (int r = 0; r < n; r += 256) { tiles[1 + nt] = make_int4(e2, s_off[e2] + r, (n - r) < 256 ? (n - r) : 256, 0); ++nt; } }
            tiles[0] = make_int4(nt, 0, 0, 0);
        }
        if (chunk == 0 && tid < 256) inv[2 * T_TOK + tid] = 0;
    }
    __syncthreads();
}

template <bool LAST, bool X8OUT>
__device__ __forceinline__ void ln2_combine_phase(const float* XF, float* XW, const unsigned char* YM, const int* pos, const float* route_w, const float* gam, const float* bet, unsigned char* XO) {
    const int tid = tid_opaque(), lane = tid & 63, w = tid >> 6;
    float gm[16], bt[16];
#pragma unroll
    for (int s = 0; s < 2; ++s)
#pragma unroll
        for (int j = 0; j < 8; ++j) { gm[s * 8 + j] = gam[s * 512 + lane * 8 + j]; bt[s * 8 + j] = bet[s * 512 + lane * 8 + j]; }
    const size_t rstep = (size_t)gridDim.x * 8;
    int np0 = 0, np1 = 0; float nw0 = 0.f, nw1 = 0.f;
    { const size_t r0 = (size_t)blockIdx.x * 8 + w; if (r0 < (size_t)T_TOK) { np0 = pos[r0 * 2]; np1 = pos[r0 * 2 + 1]; nw0 = route_w[r0 * 2]; nw1 = route_w[r0 * 2 + 1]; } }
    for (size_t row = (size_t)blockIdx.x * 8 + w; row < (size_t)T_TOK; row += rstep) {
        const int p0 = np0, p1 = np1; const float w0 = nw0, w1 = nw1;
        { const size_t rn = row + rstep; if (rn < (size_t)T_TOK) { np0 = pos[rn * 2]; np1 = pos[rn * 2 + 1]; nw0 = route_w[rn * 2]; nw1 = route_w[rn * 2 + 1]; } }
        float xv[16], a[16], b[16];
#pragma unroll
        for (int sg = 0; sg < 2; ++sg) { const f32x4 c = *(const f32x4*)(XF + row * DM + sg * 512 + lane * 8), d = *(const f32x4*)(XF + row * DM + sg * 512 + lane * 8 + 4);
#pragma unroll
            for (int j = 0; j < 4; ++j) { xv[sg * 8 + j] = c[j]; xv[sg * 8 + 4 + j] = d[j]; } }
        unpack8_fp8(*(const u32x2*)(YM + (size_t)p0 * DM + lane * 8), a); unpack8_fp8(*(const u32x2*)(YM + (size_t)p0 * DM + 512 + lane * 8), a + 8);
        unpack8_fp8(*(const u32x2*)(YM + (size_t)p1 * DM + lane * 8), b); unpack8_fp8(*(const u32x2*)(YM + (size_t)p1 * DM + 512 + lane * 8), b + 8);
        float s = 0.f;
#pragma unroll
        for (int j = 0; j < 16; ++j) { xv[j] = DN_ALPHA * xv[j] + (w0 * a[j] + w1 * b[j]) * (1.f / S8_Y); s += xv[j]; }
        const float mean = wave_sum_dpp(s) * (1.f / 1024.f);
        float q = 0.f;
#pragma unroll
        for (int j = 0; j < 16; ++j) { const float d = xv[j] - mean; q += d * d; }
        const float rstd = rsqrtf(wave_sum_dpp(q) * (1.f / 1024.f) + LN_EPS);
        float y[16];
#pragma unroll
        for (int j = 0; j < 16; ++j) y[j] = (xv[j] - mean) * rstd * gm[j] + bt[j];
        float* outf = XW;
        *(f32x4*)(outf + row * DM + lane * 8) = (f32x4){y[0], y[1], y[2], y[3]}; *(f32x4*)(outf + row * DM + lane * 8 + 4) = (f32x4){y[4], y[5], y[6], y[7]};
        *(f32x4*)(outf + row * DM + 512 + lane * 8) = (f32x4){y[8], y[9], y[10], y[11]}; *(f32x4*)(outf + row * DM + 512 + lane * 8 + 4) = (f32x4){y[12], y[13], y[14], y[15]};
        if (!LAST) {
            if constexpr (X8OUT) {
                float ys[16];
#pragma unroll
                for (int j = 0; j < 16; ++j) ys[j] = y[j] * S8_X;
                *(u32x2*)(XO + row * DM + lane * 8) = pack8_fp8(ys); *(u32x2*)(XO + row * DM + 512 + lane * 8) = pack8_fp8(ys + 8);
            } else {
                bf16_t* XOb = (bf16_t*)XO;
                st16(XOb + row * DM + lane * 8, (u32x4){cvt_pk_bf16(y[0], y[1]), cvt_pk_bf16(y[2], y[3]), cvt_pk_bf16(y[4], y[5]), cvt_pk_bf16(y[6], y[7])});
                st16(XOb + row * DM + 512 + lane * 8, (u32x4){cvt_pk_bf16(y[8], y[9]), cvt_pk_bf16(y[10], y[11]), cvt_pk_bf16(y[12], y[13]), cvt_pk_bf16(y[14], y[15])});
            }
        }
    }
}

__device__ __forceinline__ void sc_conv_phase(const bf16_t* P, const bf16_t* BG, bf16_t* Y, const float* cw, const float* cb) {
    const int items = (T_TOK / 16) * 128; const int tidx = tid_opaque();
    for (int it = blockIdx.x * NTHR + tidx; it < items; it += gridDim.x * NTHR) {
        const int cg = it & 127, run = it >> 7, c0 = cg * 8; const size_t t0 = (size_t)run * 16; const int s = (int)(t0 & 2047);
        float w0[8], w1[8], w2[8], b8[8];
#pragma unroll
        for (int j = 0; j < 8; ++j) { w0[j] = cw[c0 + j]; w1[j] = cw[1024 + c0 + j]; w2[j] = cw[2048 + c0 + j]; b8[j] = cb[c0 + j]; }
        float pm2[8], pm1[8];
        if (s == 0) {
#pragma unroll
            for (int j = 0; j < 8; ++j) { pm2[j] = 0.f; pm1[j] = 0.f; }
        } else { unpack8(ld16(P + (t0 - 2) * DM + c0), pm2); unpack8(ld16(P + (t0 - 1) * DM + c0), pm1); }
#pragma unroll 4
        for (int i = 0; i < 16; ++i) {
            float cur[8], bg[8], y[8];
            unpack8(ld16(P + (t0 + i) * DM + c0), cur); unpack8(ld16(BG + (t0 + i) * DM + c0), bg);
#pragma unroll
            for (int j = 0; j < 8; ++j) { y[j] = bg[j] * (b8[j] + w0[j] * pm2[j] + w1[j] * pm1[j] + w2[j] * cur[j]); pm2[j] = pm1[j]; pm1[j] = cur[j]; }
            st16(Y + (t0 + i) * DM + c0, (u32x4){cvt_pk_bf16(y[0], y[1]), cvt_pk_bf16(y[2], y[3]), cvt_pk_bf16(y[4], y[5]), cvt_pk_bf16(y[6], y[7])});
        }
    }
}
__device__ __forceinline__ void lru_conv_phase(const bf16_t* REC, bf16_t* U, const float* cw, const float* cb) {
    const int items = (T_TOK / 16) * 160; const int tidx = tid_opaque();
    for (int it = blockIdx.x * NTHR + tidx; it < items; it += gridDim.x * NTHR) {
        const int cg = it % 160, run = it / 160, c0 = cg * 8; const size_t t0 = (size_t)run * 16; const int s = (int)(t0 & 2047);
        float w0[8], w1[8], w2[8], w3[8], b8[8];
#pragma unroll
        for (int j = 0; j < 8; ++j) { w0[j] = cw[c0 + j]; w1[j] = cw[LRU_W + c0 + j]; w2[j] = cw[2 * LRU_W + c0 + j]; w3[j] = cw[3 * LRU_W + c0 + j]; b8[j] = cb[c0 + j]; }
        float p3[8], p2[8], p1[8];
        if (s == 0) {
#pragma unroll
            for (int j = 0; j < 8; ++j) { p3[j] = 0.f; p2[j] = 0.f; p1[j] = 0.f; }
        } else { unpack8(ld16(REC + (t0 - 3) * LRU_W + c0), p3); unpack8(ld16(REC + (t0 - 2) * LRU_W + c0), p2); unpack8(ld16(REC + (t0 - 1) * LRU_W + c0), p1); }
#pragma unroll 4
        for (int i = 0; i < 16; ++i) {
            float cur[8], y[8];
            unpack8(ld16(REC + (t0 + i) * LRU_W + c0), cur);
#pragma unroll
            for (int j = 0; j < 8; ++j) { y[j] = b8[j] + w0[j] * p3[j] + w1[j] * p2[j] + w2[j] * p1[j] + w3[j] * cur[j]; p3[j] = p2[j]; p2[j] = p1[j]; p1[j] = cur[j]; }
            st16(U + (t0 + i) * LRU_W + c0, (u32x4){cvt_pk_bf16(y[0], y[1]), cvt_pk_bf16(y[2], y[3]), cvt_pk_bf16(y[4], y[5]), cvt_pk_bf16(y[6], y[7])});
        }
    }
}

__device__ __forceinline__ void lru_scan1_phase(const bf16_t* LOGA, const bf16_t* BIN, f32x4* carry) {
    const int tidx = tid_opaque(); const int lane = tidx & 63, w = tidx >> 6;
    for (int it = blockIdx.x * 8 + w; it < 10240; it += gridDim.x * 8) {
        const int cgp = it % 10, ck = (it / 10) & 31, b = it / 320, ch = cgp * 128 + lane * 2;
        const size_t base = ((size_t)b * SEQ + ck * 64) * LRU_W + ch;
        float h0 = 0.f, h1 = 0.f, s0 = 0.f, s1 = 0.f;
#pragma unroll 8
        for (int t = 0; t < 64; ++t) {
            const unsigned la = *(const unsigned*)(LOGA + base + (size_t)t * LRU_W), bi = *(const unsigned*)(BIN + base + (size_t)t * LRU_W);
            const float l0 = bf_lo(la), l1 = bf_hi(la);
            h0 = fast_exp(l0) * h0 + bf_lo(bi); h1 = fast_exp(l1) * h1 + bf_hi(bi); s0 += l0; s1 += l1;
        }
        carry[(((size_t)b * 32 + ck) * LRU_W + ch) >> 1] = (f32x4){s0, h0, s1, h1};
    }
}
__device__ __forceinline__ void lru_scan2_phase(const bf16_t* LOGA, const bf16_t* BIN, const bf16_t* GG, const f32x4* carry, bf16_t* Y) {
    const int tidx = tid_opaque(); const int lane = tidx & 63, w = tidx >> 6;
    for (int it = blockIdx.x * 8 + w; it < 10240; it += gridDim.x * 8) {
        const int cgp = it % 10, ck = (it / 10) & 31, b = it / 320, ch = cgp * 128 + lane * 2;
        float h0 = 0.f, h1 = 0.f;
        for (int c2 = 0; c2 < ck; ++c2) { const f32x4 cv = carry[(((size_t)b * 32 + c2) * LRU_W + ch) >> 1]; h0 = fast_exp(cv[0]) * h0 + cv[1]; h1 = fast_exp(cv[2]) * h1 + cv[3]; }
        const size_t base = ((size_t)b * SEQ + ck * 64) * LRU_W + ch;
#pragma unroll 8
        for (int t = 0; t < 64; ++t) {
            const unsigned la = *(const unsigned*)(LOGA + base + (size_t)t * LRU_W), bi = *(const unsigned*)(BIN + base + (size_t)t * LRU_W), gg = *(const unsigned*)(GG + base + (size_t)t * LRU_W);
            h0 = fast_exp(bf_lo(la)) * h0 + bf_lo(bi); h1 = fast_exp(bf_hi(la)) * h1 + bf_hi(bi);
            *(unsigned*)(Y + base + (size_t)t * LRU_W) = cvt_pk_bf16(bf_lo(gg) * h0, bf_hi(gg) * h1);
        }
    }
}
__device__ __forceinline__ bf16x8 pack8s(const float* f) {
    const unsigned a = cvt_pk_bf16(f[0], f[1]), b = cvt_pk_bf16(f[2], f[3]), c = cvt_pk_bf16(f[4], f[5]), d = cvt_pk_bf16(f[6], f[7]);
    u32x4 v = {a, b, c, d}; return __builtin_bit_cast(bf16x8, v);
}
__device__ __forceinline__ void nsa_compress_phase(const bf16_t* KC, const bf16_t* VC, const bf16_t* W1T, const float* w2k, const float* w2v, const float* bias1,
                                                   const int* pos, bf16_t* KCMP, bf16_t* VCMPT) {
    const int tidx = tid_opaque(); const int lane = tidx & 63, w = tidx >> 6, rowi = lane & 15, gq = lane >> 4;
    for (int task = blockIdx.x * 8 + w; task < 2048; task += gridDim.x * 8) {
        const int kv = task >> 10, tt = task & 1023, rho = tt * 16 + rowi, b = rho >> 9, n = (rho >> 2) & 127, g = rho & 3;
        const bf16_t* src = KC + (kv ? (VC - KC) : 0l) + (size_t)b * SEQ * 256 + g * 64 + 8 * gq;
        const bf16_t* w1t = W1T + (size_t)kv * 64 * 2048 + (size_t)rowi * 2048 + 8 * gq;
        f32x4 hacc[4];
#pragma unroll
        for (int ht = 0; ht < 4; ++ht) hacc[ht] = (f32x4){0.f, 0.f, 0.f, 0.f};
#pragma unroll 4
        for (int kk = 0; kk < 64; ++kk) {
            int tok = 16 * n + (kk >> 1); tok = tok > 2047 ? 2047 : tok;
            const bf16x8 af = *(const bf16x8*)(src + (size_t)tok * 256 + 32 * (kk & 1));
#pragma unroll
            for (int ht = 0; ht < 4; ++ht) { const bf16x8 wf = *(const bf16x8*)(w1t + (size_t)(16 * ht) * 2048 + kk * 32); hacc[ht] = __builtin_amdgcn_mfma_f32_16x16x32_bf16(wf, af, hacc[ht], 0, 0, 0); }
        }
        bf16x8 pf[2];
#pragma unroll
        for (int p = 0; p < 2; ++p) { float hv[8];
#pragma unroll
            for (int jj = 0; jj < 4; ++jj) { hv[jj] = gelu_tanh(hacc[2 * p][jj] + bias1[kv * 64 + 32 * p + 4 * gq + jj]); hv[4 + jj] = gelu_tanh(hacc[2 * p + 1][jj] + bias1[kv * 64 + 32 * p + 16 + 4 * gq + jj]); }
            pf[p] = pack8s(hv); }
        const float* w2 = w2k + (kv ? (w2v - w2k) : 0l);
        f32x4 oacc[4];
#pragma unroll
        for (int dt = 0; dt < 4; ++dt) { oacc[dt] = (f32x4){0.f, 0.f, 0.f, 0.f};
#pragma unroll
            for (int p = 0; p < 2; ++p) { float wv[8]; const int dout = 16 * dt + rowi;
#pragma unroll
                for (int i = 0; i < 4; ++i) { wv[i] = w2[(32 * p + 4 * gq + i) * 64 + dout]; wv[4 + i] = w2[(32 * p + 16 + 4 * gq + i) * 64 + dout]; }
                oacc[dt] = __builtin_amdgcn_mfma_f32_16x16x32_bf16(pack8s(wv), pf[p], oacc[dt], 0, 0, 0); } }
        const bool padrow = (n == 127);
        if (kv == 0) {
            int pidx = 16 * n + 31; pidx = pidx > 2047 ? 2047 : pidx;
            const float pp = (float)pos[b * SEQ + pidx];
            bf16_t* dst = KCMP + ((size_t)(b * 128 + n) * 4 + g) * 64;
#pragma unroll
            for (int dt = 0; dt < 2; ++dt) { float o1[4], o2[4];
#pragma unroll
                for (int jj = 0; jj < 4; ++jj) { const float inv = exp2f(-(float)(16 * dt + 4 * gq + jj) * (13.287712379549449f / 32.f)); float sn, cs; sincos_rad(pp * inv, sn, cs);
                    const float x1 = oacc[dt][jj], x2 = oacc[dt + 2][jj]; o1[jj] = padrow ? 0.f : x1 * cs - x2 * sn; o2[jj] = padrow ? 0.f : x1 * sn + x2 * cs; }
                *(u32x2*)(dst + 16 * dt + 4 * gq) = (u32x2){cvt_pk_bf16(o1[0], o1[1]), cvt_pk_bf16(o1[2], o1[3])};
                *(u32x2*)(dst + 32 + 16 * dt + 4 * gq) = (u32x2){cvt_pk_bf16(o2[0], o2[1]), cvt_pk_bf16(o2[2], o2[3])}; }
        } else {
            bf16_t* dst = VCMPT + ((size_t)(b * 4 + g) * 64) * 128 + n;
#pragma unroll
            for (int dt = 0; dt < 4; ++dt)
#pragma unroll
                for (int jj = 0; jj < 4; ++jj) dst[(size_t)(16 * dt + 4 * gq + jj) * 128] = padrow ? (bf16_t)0 : f2bf(oacc[dt][jj]);
        }
    }
}

struct AttnArgs { const bf16_t* Q; const bf16_t* KS; const bf16_t* VST; const bf16_t* KW; const bf16_t* VWT; const bf16_t* KCMP; const bf16_t* VCMPT; const float* GATES; unsigned char* O; };
constexpr int AL_KC = 0, AL_VC = 18432, AL_KB = 35840, AL_VB = 54272, AL_PS = 72704, AL_IMP = 89088, AL_SEL = 93184, AL_OT = 93312;
constexpr float ATT_THR = 8.f;

__device__ __forceinline__ float max16(const f32x4 (&a)[4]) {
    float m0 = fmaxf(fmaxf(a[0][0], a[0][1]), a[0][2]), m1 = fmaxf(fmaxf(a[0][3], a[1][0]), a[1][1]), m2 = fmaxf(fmaxf(a[1][2], a[1][3]), a[2][0]);
    float m3 = fmaxf(fmaxf(a[2][1], a[2][2]), a[2][3]), m4 = fmaxf(fmaxf(a[3][0], a[3][1]), a[3][2]);
    return fmaxf(fmaxf(fmaxf(m0, m1), fmaxf(m2, m3)), fmaxf(m4, a[3][3]));
}

template <int MODE>
__device__ __forceinline__ void attn_branch(LAS unsigned char* lds, const bf16_t* Kg, const bf16_t* Vg, const int kb_lo, const int kb_hi, const bool first_staged,
                                            const bf16x8 (&qf)[2][2], const int (&sq)[2], const unsigned (&selm)[2], const float* const (&gatep)[2], LAS f32x4* otl  ,
                                            const int n, const int gq, const int tid) {
    const int skey = tid >> 3, spc = tid & 7;
    const bf16_t* kgp = Kg + (size_t)skey * 256 + spc * 8;
    const bf16_t* vgp = Vg + (size_t)skey * SEQ + spc * 8;
    const int soff = skey * 144 + spc * 16;
    u32x4 kr, vr;
    if (!first_staged) {
        kr = ld16(kgp + (size_t)kb_lo * 64 * 256); vr = ld16(vgp + kb_lo * 64);
        *(LAS u32x4*)(lds + AL_KB + soff) = kr; *(LAS u32x4*)(lds + AL_VB + soff) = vr;
        __syncthreads();
    }
    float m_run[2] = {0.f, 0.f}, l_run[2] = {0.f, 0.f};
    const float gate[2] = {gatep[0][MODE + 1], gatep[1][MODE + 1]};
    f32x4 oacc[2][4];
#pragma unroll
    for (int ti = 0; ti < 2; ++ti)
#pragma unroll
        for (int dt = 0; dt < 4; ++dt) oacc[ti][dt] = (f32x4){0.f, 0.f, 0.f, 0.f};
    for (int kb = kb_lo; kb <= kb_hi; ++kb) {
        const int buf = (kb - kb_lo) & 1;
        if (kb < kb_hi) { kr = ld16(kgp + (size_t)(kb + 1) * 64 * 256); vr = ld16(vgp + (kb + 1) * 64); }
        const LAS unsigned char* kbuf = lds + AL_KB + buf * 9216; const LAS unsigned char* vbuf = lds + AL_VB + buf * 9216;
        f32x4 sacc[2][4];
        bool selb[2];
#pragma unroll
        for (int ti = 0; ti < 2; ++ti) selb[ti] = MODE == 0 ? (((selm[ti] >> kb) & 1u) != 0u) : true;
#pragma unroll
        for (int kt = 0; kt < 4; ++kt) {
            const bf16x8 k0 = *(const LAS bf16x8*)(kbuf + (16 * kt + n) * 144 + gq * 16), k1 = *(const LAS bf16x8*)(kbuf + (16 * kt + n) * 144 + 64 + gq * 16);
#pragma unroll
            for (int ti = 0; ti < 2; ++ti) {
                sacc[ti][kt] = __builtin_amdgcn_mfma_f32_16x16x32_bf16(k0, qf[ti][0], (f32x4){0.f, 0.f, 0.f, 0.f}, 0, 0, 0);
                sacc[ti][kt] = __builtin_amdgcn_mfma_f32_16x16x32_bf16(k1, qf[ti][1], sacc[ti][kt], 0, 0, 0);
            }
        }
        const bool need_mask = (kb == kb_hi) || (MODE == 1 && kb == kb_lo);
        if (need_mask) {
#pragma unroll
            for (int ti = 0; ti < 2; ++ti) {
                const int rel = sq[ti] - kb * 64 - 4 * gq;
#pragma unroll
                for (int kt = 0; kt < 4; ++kt)
#pragma unroll
                    for (int jj = 0; jj < 4; ++jj) { const int tt = 16 * kt + jj; const bool v = MODE == 0 ? (tt <= rel) : (tt <= rel && tt > rel - 512); sacc[ti][kt][jj] = v ? sacc[ti][kt][jj] : NEGBIG; }
            }
        }
        float mx[2];
#pragma unroll
        for (int ti = 0; ti < 2; ++ti) { mx[ti] = max16(sacc[ti]) - m_run[ti]; mx[ti] = selb[ti] ? mx[ti] : NEGBIG; }
        const bool slow = (mx[0] > ATT_THR) || (mx[1] > ATT_THR) || (l_run[0] == 0.f && mx[0] > -1e29f && mx[0] < -ATT_THR) || (l_run[1] == 0.f && mx[1] > -1e29f && mx[1] < -ATT_THR);
        if (__any(slow)) {
#pragma unroll
            for (int ti = 0; ti < 2; ++ti) {
                float mr = fmaxf(mx[ti], __shfl_xor(mx[ti], 16)); mr = fmaxf(mr, __shfl_xor(mr, 32));
                float lr = l_run[ti] + __shfl_xor(l_run[ti], 16); lr += __shfl_xor(lr, 32);
                const bool has = mr > -1e29f;
                const float delta = !has ? 0.f : (lr == 0.f ? mr : fmaxf(mr, 0.f));
                const float alpha = lr == 0.f ? 1.f : fast_exp2(-delta);
                l_run[ti] *= alpha; m_run[ti] += delta;
#pragma unroll
                for (int dt = 0; dt < 4; ++dt) oacc[ti][dt] *= alpha;
            }
        }
        if (__any(m_run[0] != 0.f || m_run[1] != 0.f)) {
#pragma unroll
            for (int ti = 0; ti < 2; ++ti)
#pragma unroll
                for (int kt = 0; kt < 4; ++kt) sacc[ti][kt] -= m_run[ti];
        }
        bf16x8 pf[2][2];
#pragma unroll
        for (int ti = 0; ti < 2; ++ti) {
            float ps = 0.f;
#pragma unroll
            for (int kt = 0; kt < 4; ++kt)
#pragma unroll
                for (int jj = 0; jj < 4; ++jj) { const float e = fast_exp2(sacc[ti][kt][jj]); sacc[ti][kt][jj] = e; ps += e; }
            l_run[ti] += selb[ti] ? ps : 0.f;
#pragma unroll
            for (int p = 0; p < 2; ++p) { u32x4 v = {cvt_pk_bf16(sacc[ti][2 * p][0], sacc[ti][2 * p][1]), cvt_pk_bf16(sacc[ti][2 * p][2], sacc[ti][2 * p][3]),
                                                     cvt_pk_bf16(sacc[ti][2 * p + 1][0], sacc[ti][2 * p + 1][1]), cvt_pk_bf16(sacc[ti][2 * p + 1][2], sacc[ti][2 * p + 1][3])};
                if (MODE == 0) { v[0] = selb[ti] ? v[0] : 0u; v[1] = selb[ti] ? v[1] : 0u; v[2] = selb[ti] ? v[2] : 0u; v[3] = selb[ti] ? v[3] : 0u; }
                pf[ti][p] = __builtin_bit_cast(bf16x8, v); }
        }
#pragma unroll
        for (int dt = 0; dt < 4; ++dt)
#pragma unroll
            for (int p = 0; p < 2; ++p) {
                const LAS unsigned char* vp = vbuf + (16 * dt + n) * 144 + (32 * p + 4 * gq) * 2;
                const u32x2 a = *(const LAS u32x2*)vp, b2 = *(const LAS u32x2*)(vp + 32);
                u32x4 v = {a[0], a[1], b2[0], b2[1]};
                const bf16x8 vf = __builtin_bit_cast(bf16x8, v);
#pragma unroll
                for (int ti = 0; ti < 2; ++ti) oacc[ti][dt] = __builtin_amdgcn_mfma_f32_16x16x32_bf16(vf, pf[ti][p], oacc[ti][dt], 0, 0, 0);
            }
        if (kb < kb_hi) { *(LAS u32x4*)(lds + AL_KB + (buf ^ 1) * 9216 + soff) = kr; *(LAS u32x4*)(lds + AL_VB + (buf ^ 1) * 9216 + soff) = vr; }
        __syncthreads();
    }
#pragma unroll
    for (int ti = 0; ti < 2; ++ti) {
        float lt = l_run[ti] + __shfl_xor(l_run[ti], 16); lt += __shfl_xor(lt, 32);
        const float inv = lt > 0.f ? gate[ti] / lt : 0.f;
#pragma unroll
        for (int dt = 0; dt < 4; ++dt) otl[(ti * 4 + dt) * 64] += oacc[ti][dt] * inv;
    }
}

__device__ __forceinline__ unsigned attn_cmp_tile(LAS unsigned char* lds, const bf16x8 qf0, const bf16x8 qf1, const int s, const int sbase  , const float g0,
                                                  LAS f32x4* otl  , const int lane, const int w, const int n, const int gq, const int tl, const int r) {
    f32x4 sacc[8];
#pragma unroll
    for (int kt = 0; kt < 8; ++kt) {
        const bf16x8 k0 = *(const LAS bf16x8*)(lds + AL_KC + (16 * kt + n) * 144 + gq * 16), k1 = *(const LAS bf16x8*)(lds + AL_KC + (16 * kt + n) * 144 + 64 + gq * 16);
        sacc[kt] = __builtin_amdgcn_mfma_f32_16x16x32_bf16(k0, qf0, (f32x4){0.f, 0.f, 0.f, 0.f}, 0, 0, 0);
        sacc[kt] = __builtin_amdgcn_mfma_f32_16x16x32_bf16(k1, qf1, sacc[kt], 0, 0, 0);
    }
    float mx = NEGBIG;
    const int lim = ((s - 31) >> 4) - 4 * gq;
#pragma unroll
    for (int kt = 0; kt < 8; ++kt)
#pragma unroll
        for (int jj = 0; jj < 4; ++jj) { const bool v = (16 * kt + jj <= lim); sacc[kt][jj] = v ? sacc[kt][jj] : NEGBIG; mx = fmaxf(mx, sacc[kt][jj]); }
    mx = fmaxf(mx, __shfl_xor(mx, 16)); mx = fmaxf(mx, __shfl_xor(mx, 32));
    float ps = 0.f;
#pragma unroll
    for (int kt = 0; kt < 8; ++kt)
#pragma unroll
        for (int jj = 0; jj < 4; ++jj) { const float e = sacc[kt][jj] > -1e29f ? fast_exp2(sacc[kt][jj] - mx) : 0.f; sacc[kt][jj] = e; ps += e; }
    ps += __shfl_xor(ps, 16); ps += __shfl_xor(ps, 32);
    const float inv = ps > 0.f ? 1.f / ps : 0.f;
#pragma unroll
    for (int kt = 0; kt < 8; ++kt) {
        f32x4 pp;
#pragma unroll
        for (int jj = 0; jj < 4; ++jj) { sacc[kt][jj] *= inv; float t = sacc[kt][jj]; t += dpp_mov<0xB1>(t); t += dpp_mov<0x4E>(t); pp[jj] = t; }
        if (r == 0) *(LAS f32x4*)(lds + AL_PS + ((w * 4 + tl) * 128 + 16 * kt + 4 * gq) * 4) = pp;
    }
    f32x4 otot[4];
#pragma unroll
    for (int dt = 0; dt < 4; ++dt) otot[dt] = (f32x4){0.f, 0.f, 0.f, 0.f};
#pragma unroll
    for (int p = 0; p < 4; ++p) {
        u32x4 pv = {cvt_pk_bf16(sacc[2 * p][0], sacc[2 * p][1]), cvt_pk_bf16(sacc[2 * p][2], sacc[2 * p][3]), cvt_pk_bf16(sacc[2 * p + 1][0], sacc[2 * p + 1][1]), cvt_pk_bf16(sacc[2 * p + 1][2], sacc[2 * p + 1][3])};
        const bf16x8 pf = __builtin_bit_cast(bf16x8, pv);
#pragma unroll
        for (int dt = 0; dt < 4; ++dt) {
            const LAS unsigned char* vp = lds + AL_VC + (16 * dt + n) * 272 + (32 * p + 4 * gq) * 2;
            const u32x2 a = *(const LAS u32x2*)vp, b2 = *(const LAS u32x2*)(vp + 32);
            u32x4 v = {a[0], a[1], b2[0], b2[1]};
            otot[dt] = __builtin_amdgcn_mfma_f32_16x16x32_bf16(__builtin_bit_cast(bf16x8, v), pf, otot[dt], 0, 0, 0);
        }
    }
#pragma unroll
    for (int dt = 0; dt < 4; ++dt) otl[dt * 64] = otot[dt] * g0;
    asm volatile("s_waitcnt lgkmcnt(0)" ::: "memory");
    __builtin_amdgcn_wave_barrier();
    const int tl2 = lane >> 4, q = lane & 15, s2 = sbase + tl2, blkq = s2 >> 6;
    const LAS float* psr = (const LAS float*)(lds + AL_PS + ((w * 4 + tl2) * 128) * 4);
    const f32x4 xa = *(const LAS f32x4*)(psr + 8 * q), xb = *(const LAS f32x4*)(psr + 8 * q + 4);
    const float prev = q > 0 ? psr[8 * q - 1] : 0.f;
    float a0 = prev + xa[0] + xa[1] + xa[2] + xa[3], a1 = xa[3] + xb[0] + xb[1] + xb[2] + xb[3];
    const int m0 = 2 * q, m1 = 2 * q + 1;
    { const int rel0 = blkq - m0, rel1 = blkq - m1;
        if (rel0 < 0) a0 = -1.f;
        if (rel1 < 0) a1 = -1.f;
        if (m0 == 0 || rel0 == 0 || rel0 == 1) a0 = 1e6f;
        if (rel1 == 0 || rel1 == 1) a1 = 1e6f; }
    LAS float* impw = (LAS float*)(lds + AL_IMP + ((w * 4 + tl2) * 32) * 4);
    *(LAS f32x2*)(impw + 2 * q) = (f32x2){a0, a1};
    asm volatile("s_waitcnt lgkmcnt(0)" ::: "memory");
    __builtin_amdgcn_wave_barrier();
    int rk0 = 0, rk1 = 0;
#pragma unroll
    for (int i4 = 0; i4 < 8; ++i4) { const f32x4 v = *(const LAS f32x4*)(impw + 4 * i4);
#pragma unroll
        for (int j = 0; j < 4; ++j) { const int mm = 4 * i4 + j; rk0 += (v[j] > a0 || (v[j] == a0 && mm < m0)) ? 1 : 0; rk1 += (v[j] > a1 || (v[j] == a1 && mm < m1)) ? 1 : 0; } }
    unsigned bits = (rk0 < 16 ? (1u << m0) : 0u) | (rk1 < 16 ? (1u << m1) : 0u);
    bits |= dpp_movu<0xB1>(bits); bits |= dpp_movu<0x4E>(bits); bits |= dpp_movu<0x141>(bits); bits |= dpp_movu<0x140>(bits);
    LAS unsigned* selw = (LAS unsigned*)(lds + AL_SEL + (w * 4) * 4);
    if (q == 0) selw[tl2] = bits;
    asm volatile("s_waitcnt lgkmcnt(0)" ::: "memory");
    __builtin_amdgcn_wave_barrier();
    const unsigned selm = selw[tl];
    asm volatile("s_waitcnt lgkmcnt(0)" ::: "memory");
    __builtin_amdgcn_wave_barrier();
    return selm;
}

__device__ __forceinline__ void nsa_attn_phase(LAS unsigned char* lds, const AttnArgs& A) {
    const int tid0 = tid_opaque();
    for (int u = blockIdx.x; u < 4096; u += gridDim.x) {
        int tid = tid0; asm volatile("" : "+v"(tid));
        const int lane = tid & 63, w = tid >> 6, n = lane & 15, gq = lane >> 4, tl = n >> 2, r = n & 3;
        const int kq = u >> 8, c = 2 * kq + ((((u >> 7) & 1) ^ kq) & 1), bgi = u & 127, b = bgi >> 2, g = bgi & 3, s0 = c * 64;
        int sq[2]; bf16x8 qf[2][2]; const float* gp[2];
#pragma unroll
        for (int ti = 0; ti < 2; ++ti) {
            sq[ti] = s0 + 8 * w + 4 * ti + tl;
            const size_t qrow = (size_t)b * SEQ + sq[ti];
            const bf16_t* qp = A.Q + qrow * 1024 + g * 256 + r * 64 + 8 * gq;
            qf[ti][0] = *(const bf16x8*)qp; qf[ti][1] = *(const bf16x8*)(qp + 32);
            gp[ti] = A.GATES + qrow * 48 + (g * 4 + r) * 3;
        }
        const bf16_t* KSg = A.KS + (size_t)b * SEQ * 256 + g * 64; const bf16_t* VSg = A.VST + (size_t)(b * 4 + g) * 64 * SEQ;
        const bf16_t* KWg = A.KW + (size_t)b * SEQ * 256 + g * 64; const bf16_t* VWg = A.VWT + (size_t)(b * 4 + g) * 64 * SEQ;
        __syncthreads();
#pragma unroll
        for (int i = 0; i < 2; ++i) { const int pid = tid + 512 * i;
            { const int key = pid >> 3, pc = pid & 7; *(LAS u32x4*)(lds + AL_KC + key * 144 + pc * 16) = ld16(A.KCMP + ((size_t)(b * 128 + key) * 4 + g) * 64 + pc * 8); }
            { const int d = pid >> 4, pc = pid & 15; *(LAS u32x4*)(lds + AL_VC + d * 272 + pc * 16) = ld16(A.VCMPT + ((size_t)(b * 4 + g) * 64 + d) * 128 + pc * 8); } }
        { const int skey = tid >> 3, spc = tid & 7;
            *(LAS u32x4*)(lds + AL_KB + skey * 144 + spc * 16) = ld16(KSg + (size_t)skey * 256 + spc * 8);
            *(LAS u32x4*)(lds + AL_VB + skey * 144 + spc * 16) = ld16(VSg + (size_t)skey * SEQ + spc * 8); }
        __syncthreads();
        LAS f32x4* otl = (LAS f32x4*)(lds + AL_OT) + w * 512 + lane;
        unsigned selm[2];
#pragma unroll
        for (int ti = 0; ti < 2; ++ti) { selm[ti] = attn_cmp_tile(lds, qf[ti][0], qf[ti][1], sq[ti], s0 + 8 * w + 4 * ti, gp[ti][0], otl + ti * 256, lane, w, n, gq, tl, r); }
        attn_branch<0>(lds, KSg, VSg, 0, c, true, qf, sq, selm, gp, otl, n, gq, tid);
        attn_branch<1>(lds, KWg, VWg, c >= 8 ? c - 8 : 0, c, false, qf, sq, selm, gp, otl, n, gq, tid);
#pragma unroll
        for (int ti = 0; ti < 2; ++ti) {
            unsigned char* op = A.O + ((size_t)b * SEQ + sq[ti]) * 1024 + g * 256 + r * 64 + 4 * gq;
#pragma unroll
            for (int dt = 0; dt < 4; ++dt) { const f32x4 o = otl[(ti * 4 + dt) * 64] * S8_O; unsigned pk = 0u;
                pk = __builtin_amdgcn_cvt_pk_fp8_f32(clamp8(o[0]), clamp8(o[1]), pk, false); pk = __builtin_amdgcn_cvt_pk_fp8_f32(clamp8(o[2]), clamp8(o[3]), pk, true);
                *(unsigned*)(op + 16 * dt) = pk; }
        }
    }
    __syncthreads();
}
#ifndef DBG_ZERO_KIND
#define DBG_ZERO_KIND -1
#endif
#ifndef F8IN_MASK
#define F8IN_MASK 1
#endif
struct Params { const float* in[31]; float* out; unsigned char* ws; int ph_lo, ph_hi; };
constexpr int N_PHASES = 38;

#ifndef DUP_MASK
#define DUP_MASK 0ull
#endif
#define PH_BEGIN(k) if ((k) >= p.ph_lo && (k) < p.ph_hi) { for (int rep_ = 0; rep_ < (((DUP_MASK >> (k)) & 1ull) ? 2 : 1); ++rep_) {
#define PH_END(k) } if ((k) + 1 < p.ph_hi) xcd_barrier(bar); }

template <int LAYER>
__device__ __forceinline__ void layer_body(const Params& p, LAS unsigned char* lds, const XcdBarrier& bar) {
    constexpr int kind = LAYER % 3, j = LAYER / 3;
    constexpr int PB = LAYER == 0 ? 1 : (LAYER == 1 ? 10 : (LAYER == 2 ? 18 : 29));
    constexpr int NMIX = kind == 0 ? 4 : (kind == 1 ? 3 : 6);
    unsigned char* ws = p.ws;
    const int G = gridDim.x, cblk = blockIdx.x;
    const int* positions = (const int*)p.in[1];
    unsigned char* XA = ws + WS_XA; float* XF = p.out; bf16_t* MB = (bf16_t*)(ws + B_MB);
    int* route_e = (int*)(ws + WS_ROUTE_E); float* route_w = (float*)(ws + WS_ROUTE_W); int* posb = (int*)(ws + WS_POS); int* cnt = (int*)(ws + WS_CNT);
    int4* tiles = (int4*)(ws + WS_TILE); float* bias1 = (float*)(ws + WS_BIAS1);
    if constexpr (kind == 0) {
        bf16_t* Q = (bf16_t*)(ws + B_Q); bf16_t* KC = (bf16_t*)(ws + B_KC); bf16_t* VC = (bf16_t*)(ws + B_VC); bf16_t* KS = (bf16_t*)(ws + B_KS); bf16_t* VST = (bf16_t*)(ws + B_VST);
        bf16_t* KW = (bf16_t*)(ws + B_KW); bf16_t* VWT = (bf16_t*)(ws + B_VWT); unsigned char* OB = ws + B_O;
        float* GATES = (float*)(ws + WS_GATES); bf16_t* KCMP = (bf16_t*)(ws + WS_KCMP); bf16_t* VCMPT = (bf16_t*)(ws + WS_VCMPT);
        PH_BEGIN(PB + 0)
            EpiNsaIn E{Q, KC, VC, KS, VST, KW, VWT, GATES, positions, p.in[3] + j * 48};
            if constexpr (F8IN_MASK & 1) { DenseSched8 S{XA, ws + W_NSA_IN + (size_t)j * NSA_NP * 1024, 1024, 1024, T_TOK / 256, NSA_NP / 256, G, cblk};
                gemm_phase<true>(lds, 1024, 1024, 1024, S, E, 1.f / (S8_X * S8_WI)); }
            else { DenseSched S{(const bf16_t*)XA, (const bf16_t*)(ws + W_NSA_IN) + (size_t)j * NSA_NP * 1024, 1024, 1024, T_TOK / 256, NSA_NP / 256, G, cblk};
                gemm_phase<false>(lds, 1024, 1024, 1024, S, E); }
        PH_END(PB + 0)
        PH_BEGIN(PB + 1)
            nsa_compress_phase(KC, VC, (const bf16_t*)(ws + W_CMP1) + (size_t)j * 2 * 64 * 2048, p.in[6] + j * 4096, p.in[9] + j * 4096, bias1 + j * 128, positions, KCMP, VCMPT);
        PH_END(PB + 1)
        PH_BEGIN(PB + 2)
            AttnArgs A{Q, KS, VST, KW, VWT, KCMP, VCMPT, GATES, OB};
            nsa_attn_phase(lds, A);
        PH_END(PB + 2)
        PH_BEGIN(PB + 3)
            DenseSched8 S{OB, ws + W_NSA_OUT + (size_t)j * 1024 * 1024, 1024, 1024, T_TOK / 256, 4, G, cblk};
            EpiPlain<false> E{MB, 1024, 1.f / (S8_O * S8_WO)};
            gemm_phase<true>(lds, 1024, 1024, 1024, S, E);
        PH_END(PB + 3)
    } else if constexpr (kind == 1) {
        bf16_t* P = (bf16_t*)(ws + B_P); bf16_t* BGb = (bf16_t*)(ws + B_BG); bf16_t* Y = (bf16_t*)(ws + B_Y);
        PH_BEGIN(PB + 0)
            EpiScIn E{P, BGb};
            if constexpr (F8IN_MASK & 2) { DenseSched8 S{XA, ws + W_SC_IN, 1024, 1024, T_TOK / 256, 12, G, cblk};
                gemm_phase<true>(lds, 1024, 1024, 1024, S, E, 1.f / (S8_X * S8_WI)); }
            else { DenseSched S{(const bf16_t*)XA, (const bf16_t*)(ws + W_SC_IN), 1024, 1024, T_TOK / 256, 12, G, cblk};
                gemm_phase<false>(lds, 1024, 1024, 1024, S, E); }
        PH_END(PB + 0)
        PH_BEGIN(PB + 1)
            sc_conv_phase(P, BGb, Y, p.in[12], p.in[13]);
        PH_END(PB + 1)
        PH_BEGIN(PB + 2)
            DenseSched S{Y, (const bf16_t*)(ws + W_SC_OUT), 1024, 1024, T_TOK / 256, 4, G, cblk};
            EpiPlain<false> E{MB, 1024, 1.f};
            gemm_phase<false>(lds, 1024, 1024, 1024, S, E);
        PH_END(PB + 2)
    } else {
        bf16_t* GG = (bf16_t*)(ws + B_GG); bf16_t* R1 = (bf16_t*)(ws + B_R1); bf16_t* R2 = (bf16_t*)(ws + B_R2); bf16_t* R3 = (bf16_t*)(ws + B_R3);
        f32x4* carry = (f32x4*)(ws + WS_CARRY);
        PH_BEGIN(PB + 0)
            EpiLruIn E{GG, R1};
            if constexpr (F8IN_MASK & 4) { DenseSched8 S{XA, ws + W_LRU_IN, 1024, 1024, T_TOK / 256, 10, G, cblk};
                gemm_phase<true>(lds, 1024, 1024, 1024, S, E, 1.f / (S8_X * S8_WI)); }
            else { DenseSched S{(const bf16_t*)XA, (const bf16_t*)(ws + W_LRU_IN), 1024, 1024, T_TOK / 256, 10, G, cblk};
                gemm_phase<false>(lds, 1024, 1024, 1024, S, E); }
        PH_END(PB + 0)
        PH_BEGIN(PB + 1)
            lru_conv_phase(R1, R2, p.in[16], p.in[17]);
        PH_END(PB + 1)
        PH_BEGIN(PB + 2)
            BandSched S{R2, (const bf16_t*)(ws + W_LRU_G), LRU_W, LRU_W, T_TOK / 256, 10, G, cblk};
            EpiLruGate E{R2, R1, R3, p.in[19], p.in[21], p.in[22]};
            gemm_phase<false>(lds, 384, LRU_W, LRU_W, S, E);
        PH_END(PB + 2)
        PH_BEGIN(PB + 3)
            lru_scan1_phase(R1, R3, carry);
        PH_END(PB + 3)
        PH_BEGIN(PB + 4)
            lru_scan2_phase(R1, R3, GG, carry, R2);
        PH_END(PB + 4)
        PH_BEGIN(PB + 5)
            DenseSched S{R2, (const bf16_t*)(ws + W_LRU_OUT), LRU_W, LRU_W, T_TOK / 256, 4, G, cblk};
            EpiPlain<false> E{MB, 1024, 1.f};
            gemm_phase<false>(lds, LRU_W, LRU_W, LRU_W, S, E);
        PH_END(PB + 5)
    }
    constexpr int FB = PB + NMIX;
    unsigned char* X8 = ws + B_XG; int* invb = (int*)(ws + WS_INV); unsigned char* HID = ws + B_HID; unsigned char* YM = ws + B_YM; unsigned char* WGU = ws + B_WMOE + WMOE_GU; unsigned char* WDN = ws + B_WMOE + WMOE_DN;
    const float* lng = p.in[29] + (size_t)LAYER * 2048; const float* lnb = p.in[30] + (size_t)LAYER * 2048;
    PH_BEGIN(FB + 0)
#if defined(SHADOW_LN) && (SHADOW_LN & 1)
        ln1_router_phase(lds, LAYER == 0 ? p.in[0] : (const float*)XF, MB, (float*)(ws + WS_BIG + 192 * MiB), ws + WS_BIG + 448 * MiB, lng, lnb, p.in[24], p.in[25], (int*)(ws + WS_BIG + 300 * MiB), (float*)(ws + WS_BIG + 302 * MiB), (int*)(ws + WS_BIG + 304 * MiB));
#endif
        ln1_router_phase(lds, LAYER == 0 ? p.in[0] : (const float*)XF, MB, XF, X8, lng, lnb, p.in[24], p.in[25], route_e, route_w, cnt);
    PH_END(FB + 0)
    PH_BEGIN(FB + 1)
        moe_gather_phase(lds, route_e, cnt, posb, invb, tiles);
        convert_wt<true>(lds, WGU, 16, 2048, 1024, FetchPair{p.in[26] + (size_t)LAYER * 16 * 1048576, (long)(p.in[27] - p.in[26]), 1024, (size_t)1048576}, S8_WGU);
        convert_wt<true>(lds, WDN, 16, 1024, 1024, FetchPlain{p.in[28] + (size_t)LAYER * 16 * 1048576, 1024, (size_t)1048576}, S8_WD);
    PH_END(FB + 1)
    PH_BEGIN(FB + 2)
        const int NT = __builtin_amdgcn_readfirstlane(tiles[0].x);
        MoeSched S{X8, WGU, tiles, invb, NT, 8, 2048, 1024, G, cblk};
        EpiMoeGU E{HID};
        gemm_phase<true, true>(lds, 1024, 1024, 1024, S, E);
    PH_END(FB + 2)
    PH_BEGIN(FB + 3)
        const int NT = __builtin_amdgcn_readfirstlane(tiles[0].x);
        MoeSched S{HID, WDN, tiles, invb, NT, 4, 1024, 1024, G, cblk};
        EpiMoeDown8 E{YM, S8_Y / (S8_H * S8_WD)};
        gemm_phase<true>(lds, 1024, 1024, 1024, S, E);
    PH_END(FB + 3)
    PH_BEGIN(FB + 4)
#if defined(SHADOW_LN) && (SHADOW_LN & 2)
        ln2_combine_phase<LAYER == DEPTH - 1, ((F8IN_MASK >> ((LAYER + 1) % 3)) & 1) != 0>(XF, (float*)(ws + B_XG), YM, posb, route_w, lng + 1024, lnb + 1024, ws + WS_BIG + 512 * MiB);
#endif
        ln2_combine_phase<LAYER == DEPTH - 1, ((F8IN_MASK >> ((LAYER + 1) % 3)) & 1) != 0>(XF, XF, YM, posb, route_w, lng + 1024, lnb + 1024, XA);
    PH_END(FB + 4)
}

__global__ void __launch_bounds__(NTHR, 2) hybrid_fwd(Params p) {
    extern __shared__ __attribute__((aligned(16))) unsigned char lds_raw[];
    LAS unsigned char* lds = (LAS unsigned char*)lds_raw;
    volatile LAS unsigned* bst = (volatile LAS unsigned*)(lds + LDS_BYTES - 16);
    const bool use_bar = (p.ph_hi - p.ph_lo) > 1;
    if (threadIdx.x == 0) { bst[0] = 0u; bst[1] = 0u; bst[2] = 0u; bst[3] = 0u; }
    __syncthreads();
    XcdBarrier bar; bar.bar = (unsigned*)(p.ws + WS_CTL); bar.x = 0; bar.st = bst;
    if (use_bar) bar = xcd_barrier_post((unsigned*)(p.ws + WS_CTL), bst);
    PH_BEGIN(0)
        unsigned char* ws = p.ws;
        convert_x<(F8IN_MASK & 1) != 0>(p.in[0], ws + WS_XA);
        for (int j = 0; j < 2; ++j) {
            if constexpr (F8IN_MASK & 1) convert_wt<true>(lds, ws + W_NSA_IN + (size_t)j * NSA_NP * 1024, 1, NSA_NP, 1024, FetchNsaIn{p.in[2] + (size_t)j * 1024 * 2608}, S8_WI);
            else convert_wt(lds, (bf16_t*)(ws + W_NSA_IN) + (size_t)j * NSA_NP * 1024, 1, NSA_NP, 1024, FetchNsaIn{p.in[2] + (size_t)j * 1024 * 2608});
            convert_wt<true>(lds, ws + W_NSA_OUT + (size_t)j * 1024 * 1024, 1, 1024, 1024, FetchPlain{p.in[10] + (size_t)j * 1024 * 1024, 1024, 0}, S8_WO);
            convert_wt(lds, (bf16_t*)(ws + W_CMP1) + (size_t)(j * 2 + 0) * 64 * 2048, 1, 64, 2048, FetchIdent{p.in[5] + (size_t)j * 2048 * 64, 64, 0});
            convert_wt(lds, (bf16_t*)(ws + W_CMP1) + (size_t)(j * 2 + 1) * 64 * 2048, 1, 64, 2048, FetchIdent{p.in[8] + (size_t)j * 2048 * 64, 64, 0});
        }
        if constexpr (F8IN_MASK & 2) convert_wt<true>(lds, ws + W_SC_IN, 1, 3072, 1024, FetchScIn{p.in[11]}, S8_WI); else convert_wt(lds, (bf16_t*)(ws + W_SC_IN), 1, 3072, 1024, FetchScIn{p.in[11]});
        convert_wt(lds, (bf16_t*)(ws + W_SC_OUT), 1, 1024, 1024, FetchPlain{p.in[14], 1024, 0});
        if constexpr (F8IN_MASK & 4) convert_wt<true>(lds, ws + W_LRU_IN, 1, 2560, 1024, FetchPlain{p.in[15], 2560, 0}, S8_WI); else convert_wt(lds, (bf16_t*)(ws + W_LRU_IN), 1, 2560, 1024, FetchPlain{p.in[15], 2560, 0});
        convert_wt(lds, (bf16_t*)(ws + W_LRU_G), 1, 2560, 1280, FetchLruGate{p.in[18], (long)(p.in[20] - p.in[18])});
        convert_wt(lds, (bf16_t*)(ws + W_LRU_OUT), 1, 1024, 1280, FetchPlain{p.in[23], 1024, 0});
        cmp_bias_phase(lds, p.in[4], p.in[5], p.in[7], p.in[8], (float*)(ws + WS_BIAS1));
    PH_END(0)
    layer_body<0>(p, lds, bar);
    layer_body<1>(p, lds, bar);
    layer_body<2>(p, lds, bar);
    layer_body<3>(p, lds, bar);
}
#undef PH_BEGIN
#undef PH_END

#ifndef MK_SPLIT
#define MK_SPLIT 0
#endif
extern "C" void kernel_launch(void* const* d_in, const int* in_sizes, int n_in, void* d_out, int out_size, void* d_ws, size_t ws_size, hipStream_t stream) {
    static int grid = 0;
    if (grid == 0) {
        int dev = 0, cus = 0, per_cu = 0;
        if (n_in != 31 || ws_size < WS_END) { fprintf(stderr, "kernel_launch: unexpected n_in %d or ws_size %zu (need %zu)\n", n_in, ws_size, (size_t)WS_END); grid = -1; return; }
        if (hipGetDevice(&dev) != hipSuccess || hipDeviceGetAttribute(&cus, hipDeviceAttributeMultiprocessorCount, dev) != hipSuccess) { grid = -1; return; }
        if (hipFuncSetAttribute((const void*)hybrid_fwd, hipFuncAttributeMaxDynamicSharedMemorySize, LDS_BYTES) != hipSuccess) { fprintf(stderr, "kernel_launch: hipFuncSetAttribute failed\n"); grid = -1; return; }
        if (hipOccupancyMaxActiveBlocksPerMultiprocessor(&per_cu, (const void*)hybrid_fwd, NTHR, LDS_BYTES) != hipSuccess || per_cu < 1) fprintf(stderr, "kernel_launch: occupancy query says %d\n", per_cu);
        (void)hipGetLastError();
        grid = cus;
    }
    if (grid < 0) return;
    (void)hipMemsetAsync((char*)d_ws + WS_CTL, 0, 64 * 1024, stream);
    Params p{};
    for (int i = 0; i < 31; ++i) p.in[i] = (const float*)d_in[i];
    p.out = (float*)d_out; p.ws = (unsigned char*)d_ws;
#if MK_SPLIT
    for (int ph = 0; ph < N_PHASES; ++ph) { p.ph_lo = ph; p.ph_hi = ph + 1; hipLaunchKernelGGL(hybrid_fwd, dim3(grid), dim3(NTHR), LDS_BYTES, stream, p); }
#else
    p.ph_lo = 0; p.ph_hi = N_PHASES;
    hipLaunchKernelGGL(hybrid_fwd, dim3(grid), dim3(NTHR), LDS_BYTES, stream, p);
#endif
    const hipError_t le = hipPeekAtLastError();
    if (le != hipSuccess) fprintf(stderr, "kernel_launch: launch failed: %s\n", hipGetErrorName(le));
}
```

```cpp
#include <hip/hip_runtime.h>
#include <stdint.h>
#include <stdio.h>

#define LAS __attribute__((address_space(3)))
typedef unsigned short bf16_t;
typedef short bf16x8 __attribute__((ext_vector_type(8)));
typedef float f32x4 __attribute__((ext_vector_type(4)));
typedef float f32x2 __attribute__((ext_vector_type(2)));
typedef unsigned u32x4 __attribute__((ext_vector_type(4)));
typedef unsigned u32x2 __attribute__((ext_vector_type(2)));
typedef int i32x8 __attribute__((ext_vector_type(8)));

constexpr int T_TOK = 65536, DM = 1024, SEQ = 2048, NBATCH = 32, DEPTH = 4;
constexpr int NTHR = 512;
constexpr int NSA_NP = 2816;
constexpr int LRU_W = 1280;
constexpr int NEXP = 16;
constexpr float DN_ALPHA = 1.6817928305074292f;
constexpr float LN_EPS = 1e-5f;
constexpr float NEGBIG = -1e30f;
constexpr float LOG2E = 1.4426950408889634f;

constexpr size_t KiB = 1024, MiB = 1024 * 1024;
constexpr size_t WS_CTL = 0;
constexpr size_t WS_ROUTE_E = 64 * KiB;
constexpr size_t WS_ROUTE_W = WS_ROUTE_E + 256 * KiB;
constexpr size_t WS_POS = WS_ROUTE_W + 512 * KiB;
constexpr size_t WS_CNT = WS_POS + 512 * KiB;
constexpr size_t WS_TILE = WS_CNT + 16 * KiB;
constexpr size_t WS_BIAS1 = WS_TILE + 16 * KiB;
constexpr size_t WS_INV = 1408 * KiB;
constexpr size_t WS_KCMP = 2 * MiB;
constexpr size_t WS_VCMPT = 4 * MiB;
constexpr size_t WS_CARRY = 6 * MiB;
constexpr size_t WS_GATES = 16 * MiB;
constexpr size_t WS_W = 28 * MiB;
constexpr size_t W_NSA_IN = WS_W;
constexpr size_t W_NSA_OUT = W_NSA_IN + 2 * (size_t)NSA_NP * 1024 * 2;
constexpr size_t W_SC_IN = W_NSA_OUT + 2 * (size_t)1024 * 1024 * 2;
constexpr size_t W_SC_OUT = W_SC_IN + (size_t)3072 * 1024 * 2;
constexpr size_t W_LRU_IN = W_SC_OUT + (size_t)1024 * 1024 * 2;
constexpr size_t W_LRU_G = W_LRU_IN + (size_t)2560 * 1024 * 2;
constexpr size_t W_LRU_OUT = W_LRU_G + (size_t)2560 * 1280 * 2;
constexpr size_t W_CMP1 = W_LRU_OUT + (size_t)1024 * 1280 * 2;
constexpr size_t W_END = W_CMP1 + 4 * (size_t)64 * 2048 * 2;
constexpr size_t WS_XA = 66 * MiB;
constexpr size_t WS_WMOE = WS_XA + 128 * MiB;
constexpr size_t WS_BIG = WS_WMOE + 96 * MiB;
constexpr size_t WS_END = WS_BIG + 642 * MiB;
static_assert(W_END <= WS_XA, "weights overflow");
constexpr size_t B_Q = WS_BIG, B_KC = B_Q + 128 * MiB, B_VC = B_KC + 32 * MiB, B_KS = B_VC + 32 * MiB, B_VST = B_KS + 32 * MiB, B_KW = B_VST + 32 * MiB,
                 B_VWT = B_KW + 32 * MiB, B_O = B_VWT + 32 * MiB;
constexpr size_t B_P = WS_BIG, B_BG = B_P + 128 * MiB, B_Y = B_BG + 128 * MiB;
constexpr size_t B_GG = WS_BIG, B_R1 = B_GG + 160 * MiB, B_R2 = B_R1 + 160 * MiB, B_R3 = B_R2 + 160 * MiB;
constexpr size_t B_MB = WS_BIG;
constexpr size_t B_XG = WS_BIG + 128 * MiB, B_HID = B_XG + 64 * MiB, B_YM = B_HID + 128 * MiB, B_WMOE = WS_WMOE;
constexpr size_t WMOE_GU = 0, WMOE_DN = (size_t)16 * 2048 * 1024;
constexpr float S8_X = 16.f, S8_WGU = 256.f, S8_H = 16.f, S8_WD = 512.f, S8_Y = 128.f, S8_WI = 256.f, S8_O = 32.f, S8_WO = 512.f, S8_Q = 4.f, S8_K = 0.25f;

constexpr int LDS_BYTES = 163840;

__device__ __forceinline__ unsigned cvt_pk_bf16(float lo, float hi) { unsigned r; asm volatile("v_cvt_pk_bf16_f32 %0, %1, %2" : "=v"(r) : "v"(lo), "v"(hi)); return r; }
__device__ __forceinline__ float bf_lo(unsigned u) { return __uint_as_float(u << 16); }
__device__ __forceinline__ float bf_hi(unsigned u) { return __uint_as_float(u & 0xffff0000u); }
__device__ __forceinline__ float bf2f(bf16_t h) { return __uint_as_float(((unsigned)h) << 16); }
__device__ __forceinline__ bf16_t f2bf(float f) { return (bf16_t)(cvt_pk_bf16(f, 0.f) & 0xffffu); }
__device__ __forceinline__ float fast_exp2(float x) { return __builtin_amdgcn_exp2f(x); }
__device__ __forceinline__ float fast_exp(float x) { return __builtin_amdgcn_exp2f(x * LOG2E); }
__device__ __forceinline__ float fast_rcp(float x) { return __builtin_amdgcn_rcpf(x); }
__device__ __forceinline__ float sigmoidf_(float x) { return fast_rcp(1.f + fast_exp(-x)); }
__device__ __forceinline__ float gelu_tanh(float x) { const float u = 0.7978845608028654f * (x + 0.044715f * x * x * x); return x * fast_rcp(1.f + fast_exp(-2.f * u)); }
__device__ __forceinline__ float silu_(float x) { return x * fast_rcp(1.f + fast_exp(-x)); }
__device__ __forceinline__ void sincos_rad(float ang, float& s, float& c) {
    float r = ang * 0.15915494309189535f; r = __builtin_amdgcn_fractf(r); s = __builtin_amdgcn_sinf(r); c = __builtin_amdgcn_cosf(r); }
__device__ __forceinline__ float wave_sum(float v) {
#pragma unroll
    for (int o = 32; o >= 1; o >>= 1) v += __shfl_xor(v, o);
    return v; }
template <int CTRL> __device__ __forceinline__ float dpp_mov(float v) { return __builtin_bit_cast(float, __builtin_amdgcn_update_dpp(0, __builtin_bit_cast(int, v), CTRL, 0xf, 0xf, false)); }
template <int CTRL> __device__ __forceinline__ unsigned dpp_movu(unsigned v) { return (unsigned)__builtin_amdgcn_update_dpp(0, (int)v, CTRL, 0xf, 0xf, false); }
__device__ __forceinline__ float row16_sum(float v) { v += dpp_mov<0xB1>(v); v += dpp_mov<0x4E>(v); v += dpp_mov<0x141>(v); v += dpp_mov<0x140>(v); return v; }
__device__ __forceinline__ float wave_sum_dpp(float v) { v = row16_sum(v); v += __shfl_xor(v, 16); v += __shfl_xor(v, 32); return v; }
__device__ __forceinline__ int tid_opaque() { int t = threadIdx.x; asm volatile("" : "+v"(t)); return t; }
__device__ __forceinline__ u32x4 ld16(const void* p) { return *(const u32x4*)p; }
__device__ __forceinline__ void st16(void* p, u32x4 v) { *(u32x4*)p = v; }

#define XB_TMO      128
#define XB_XCNT(j)  (256  + 64 * (j))
#define XB_XSUB(j)  (1280 + 64 * (j))
#define XB_XGEN(j)  (2304 + 64 * (j))
#define XB_TOP      3328
#define XB_TOPGEN   3392
#define XCD_BAR_WORDS 3456
#define XB_SPIN_CAP (1u << 22)
__device__ __forceinline__ unsigned xb_ld(unsigned* p)              { return __hip_atomic_load(p, __ATOMIC_RELAXED, __HIP_MEMORY_SCOPE_AGENT); }
__device__ __forceinline__ unsigned xb_add(unsigned* p, unsigned v) { return __hip_atomic_fetch_add(p, v, __ATOMIC_RELAXED, __HIP_MEMORY_SCOPE_AGENT); }
__device__ __forceinline__ unsigned xb_xcc_id() { return (unsigned)__builtin_amdgcn_s_getreg((3 << 11) | 20) & 0xFu; }
#define XB_SPIN(cond, bar) do { unsigned _sp = 0; while (cond) { __builtin_amdgcn_s_sleep(1); \
    if ((++_sp & 255u) == 0u) { if (xb_ld(&(bar)[XB_TMO])) break; if (_sp > XB_SPIN_CAP) { atomicAdd(&(bar)[XB_TMO], 1u); break; } } } } while (0)
struct XcdBarrier { unsigned* bar; unsigned x; volatile LAS unsigned* st; };
__device__ __forceinline__ XcdBarrier xcd_barrier_post(unsigned* bar, volatile LAS unsigned* st) {
    XcdBarrier b; b.bar = bar; b.x = xb_xcc_id(); b.st = st;
    if (threadIdx.x == 0) (void)xb_add(&bar[XB_XCNT(b.x)], 1u);
    return b;
}
__device__ __forceinline__ void xcd_barrier_complete(unsigned* bar, unsigned x, unsigned& nloc, unsigned& nx) {
    const unsigned G = gridDim.x * gridDim.y * gridDim.z;
    unsigned sum, cnt, mine, sp = 0u;
    for (;;) {
        sum = 0u; cnt = 0u; mine = 0u;
#pragma unroll
        for (unsigned j = 0; j < 16; ++j) { const unsigned c = xb_ld(&bar[XB_XCNT(j)]); sum += c; cnt += (c > 0u) ? 1u : 0u; mine = (j == x) ? c : mine; }
        if (sum == G) break;
        __builtin_amdgcn_s_sleep(1);
        if ((++sp & 255u) == 0u) { if (xb_ld(&bar[XB_TMO])) break; if (sp > XB_SPIN_CAP) { atomicAdd(&bar[XB_TMO], 1u); break; } }
    }
    nloc = mine > 0u ? mine : 1u; nx = cnt > 0u ? cnt : 1u;
}
__device__ __forceinline__ void xcd_barrier(const XcdBarrier& b) {
    asm volatile("s_waitcnt vmcnt(0)" ::: "memory");
    __syncthreads();
    if (threadIdx.x == 0) {
        unsigned* bar = b.bar;
        __builtin_amdgcn_s_waitcnt(0);
        unsigned nloc = b.st[0], nx = b.st[1];
        if (nloc == 0u) { xcd_barrier_complete(bar, b.x, nloc, nx); b.st[0] = nloc; b.st[1] = nx; }
        const unsigned old = xb_add(&bar[XB_XSUB(b.x)], 1u);
        const unsigned gen = old / nloc;
        if (old + 1u == (gen + 1u) * nloc) {
            __builtin_amdgcn_fence(__ATOMIC_RELEASE, "agent");
            asm volatile("s_waitcnt vmcnt(0)" ::: "memory");
            const unsigned og = xb_add(&bar[XB_TOP], 1u);
            const unsigned tg = og / nx;
            if (og + 1u == (tg + 1u) * nx) xb_add(&bar[XB_TOPGEN], 1u);
            else XB_SPIN(xb_ld(&bar[XB_TOPGEN]) == tg, bar);
            __builtin_amdgcn_fence(__ATOMIC_ACQUIRE, "agent");
            xb_add(&bar[XB_XGEN(b.x)], 1u);
            asm volatile("s_waitcnt vmcnt(0)" ::: "memory");
        } else {
            XB_SPIN(xb_ld(&bar[XB_XGEN(b.x)]) == gen, bar);
            __builtin_amdgcn_fence(__ATOMIC_ACQUIRE, "agent");
            asm volatile("s_waitcnt vmcnt(0)" ::: "memory");
        }
    }
    __syncthreads();
}

constexpr int BM = 256, BK = 64, HALF = 128, HTB = HALF * BK * 2, STAGE_BYTES = 8 * HTB, NXCD = 8, WGM = 8;
__host__ __device__ __forceinline__ int lds_byte(int r, int c) { const int st = (r >> 4) * 2 + (c >> 5), rr = r & 15, cc = c & 31, ob = rr * 64 + cc * 2; return st * 1024 + (ob ^ (((ob >> 9) & 1) << 5)); }
__host__ __device__ __forceinline__ void stage_rc(int b, int& R, int& C) { const int st = b / 1024, sb = b % 1024, swz = sb ^ (((sb >> 9) & 1) << 5); R = (st >> 1) * 16 + swz / 64; C = (st & 1) * 32 + (swz % 64) / 2; }

struct GUnit { const char* a; const char* b; int pn; int row0; int nrows; int aux; };
__device__ __forceinline__ void map_unit(int L, int nM, int nN, int& pm, int& pn) {
    const int nwg = nM * nN; int wgid = L;
    { const int q = nwg / NXCD, r = nwg % NXCD, xcd = wgid % NXCD, off = wgid / NXCD; wgid = (xcd < r ? xcd * (q + 1) : r * (q + 1) + (xcd - r) * q) + off; }
    const int nig = WGM * nN, gid = wgid / nig, fm = gid * WGM, gsz = (nM - fm) < WGM ? (nM - fm) : WGM;
    pm = fm + ((wgid % nig) % gsz); pn = (wgid % nig) / gsz;
}
struct DenseSched {
    const bf16_t* A; const bf16_t* Bt; int lda, K, nM, nN, G, c;
    __device__ __forceinline__ bool next(int i, GUnit& u) const {
        const long L = (long)i * G + c; if (L >= (long)nM * nN) return false;
        int pm, pn; map_unit((int)L, nM, nN, pm, pn);
        u.a = (const char*)(A + (size_t)pm * BM * lda); u.b = (const char*)(Bt + (size_t)pn * BM * K); u.pn = pn; u.row0 = pm * BM; u.nrows = BM; u.aux = 0; return true;
    }
};
struct DenseSched8 {
    const unsigned char* A; const unsigned char* Bt; int lda, K, nM, nN, G, c;
    __device__ __forceinline__ bool next(int i, GUnit& u) const {
        const long L = (long)i * G + c; if (L >= (long)nM * nN) return false;
        int pm, pn; map_unit((int)L, nM, nN, pm, pn);
        u.a = (const char*)(A + (size_t)pm * BM * lda); u.b = (const char*)(Bt + (size_t)pn * BM * K); u.pn = pn; u.row0 = pm * BM; u.nrows = BM; u.aux = 0; return true;
    }
};
struct BandSched {
    const bf16_t* A; const bf16_t* Bt; int lda, ldb, nM, nN, G, c;
    __device__ __forceinline__ bool next(int i, GUnit& u) const {
        const long L = (long)i * G + c; if (L >= (long)nM * nN) return false;
        int pm, pn; map_unit((int)L, nM, nN, pm, pn);
        int k0 = ((128 * pn / 80) * 80 / 64) * 64; k0 = k0 > ldb - 384 ? ldb - 384 : k0;
        u.a = (const char*)(A + (size_t)pm * BM * lda + k0); u.b = (const char*)(Bt + (size_t)pn * BM * ldb + k0); u.pn = pn; u.row0 = pm * BM; u.nrows = BM; u.aux = 0; return true;
    }
};
struct MoeSched {
    const unsigned char* A; const unsigned char* W; const int4* tiles; const int* inv; int NT, nN, N, K, G, c;
    __device__ __forceinline__ bool next(int i, GUnit& u) const {
        const long L = (long)i * G + c; if (L >= (long)NT * nN) return false;
        int pm, pn; map_unit((int)L, NT, nN, pm, pn);
        const int4 t = tiles[1 + pm];
        const int e = __builtin_amdgcn_readfirstlane(t.x), r0 = __builtin_amdgcn_readfirstlane(t.y), nr = __builtin_amdgcn_readfirstlane(t.z);
        u.a = (const char*)(A + (size_t)r0 * K); u.b = (const char*)(W + ((size_t)e * N + (size_t)pn * BM) * K); u.pn = pn; u.row0 = r0; u.nrows = nr; u.aux = e; return true;
    }
};

template <bool F8, bool GATHER = false, class Epi, class Sched>
__device__ __forceinline__ void gemm_phase(LAS unsigned char* lds, const int K  , const int lda, const int ldb  , const Sched& S, const Epi& E, const float accs = 1.f  ) {
    const int tid = tid_opaque(), wid = __builtin_amdgcn_readfirstlane(tid >> 6), lane = tid & 63, wr = wid >> 2, wc = wid & 3, fr = lane & 15, fq = lane >> 4;
    const int nt = F8 ? K / 128 : K / BK;
    unsigned voffA[2], voffB[2];
#pragma unroll
    for (int i = 0; i < 2; ++i) { int R, C; stage_rc(tid * 16 + i * 8192, R, C); voffA[i] = F8 ? (unsigned)(R * lda + 2 * C) : (unsigned)(R * lda + C) * 2u; voffB[i] = F8 ? (unsigned)(R * ldb + 2 * C) : (unsigned)(R * ldb + C) * 2u; }
    int gR[2]; unsigned gC[2]; unsigned vc[2][2], vn[2][2];
#pragma unroll
    for (int i = 0; i < 2; ++i) { int R, C; stage_rc(tid * 16 + i * 8192, R, C); gR[i] = R; gC[i] = 2u * (unsigned)C; }
#define PG8_GLOAD(dst, unit) do { if constexpr (GATHER) { _Pragma("unroll") for (int _h = 0; _h < 2; ++_h) _Pragma("unroll") for (int _i = 0; _i < 2; ++_i) \
        dst[_h][_i] = (unsigned)S.inv[(unit).row0 + _h * HALF + gR[_i]] * (unsigned)lda + gC[_i]; } } while (0)
#define PG8_STAGE_A(bufoff, h, kofs, unext) do { if constexpr (GATHER) { _Pragma("unroll") for (int _i = 0; _i < 2; ++_i) \
        __builtin_amdgcn_global_load_lds((const unsigned*)((const char*)S.A + (kofs) + ((unext) ? vn[h][_i] : vc[h][_i])), (LAS unsigned*)(lds + (bufoff) + ldsw + _i * 8192), 16, 0, 0); } \
        else PG8_STAGE(bufoff, ((unext) ? nA : cA) + (h) * hstepA + (kofs), voffA); } while (0)
    const size_t kstep = (size_t)(BK * 2);
    const size_t hstepA = (size_t)HALF * lda * (F8 ? 1 : 2), hstepB = (size_t)HALF * ldb * (F8 ? 1 : 2);
    const unsigned ldsw = (unsigned)wid * 1024u;
    const int aoff = lds_byte(wr * 64 + fr, fq * 8), boff = lds_byte(wc * 32 + fr, fq * 8);
    const LAS unsigned char* ldsA = lds + aoff; const LAS unsigned char* ldsB = lds + 65536 + boff;
#define PG8_SA(b, h) (((b) * 2 + (h)) * HTB)
#define PG8_SB(b, h) ((4 + (b) * 2 + (h)) * HTB)
#define PG8_STAGE(bufoff, gbase, voff) do { _Pragma("unroll") for (int _i = 0; _i < 2; ++_i) \
        __builtin_amdgcn_global_load_lds((const unsigned*)((const char*)(gbase) + (voff)[_i]), (LAS unsigned*)(lds + (bufoff) + ldsw + _i * 8192), 16, 0, 0); } while (0)
#define PG8_LD16(off) (*(const LAS u32x4*)(lds + (off)))
#define PG8_LDA16(off) (*(const LAS u32x4*)(ldsA + (off)))
#define PG8_LDB16(off) (*(const LAS u32x4*)(ldsB + (off)))
#define PG8_LDA(dst, b, h) do { _Pragma("unroll") for (int m = 0; m < 4; ++m) { \
        if constexpr (F8) dst##8[m] = __builtin_shufflevector(PG8_LDA16(PG8_SA(b, h) + m * 2048), PG8_LDA16(PG8_SA(b, h) + m * 2048 + 1024), 0, 1, 2, 3, 4, 5, 6, 7); \
        else { _Pragma("unroll") for (int k = 0; k < 2; ++k) dst[m][k] = *(const LAS bf16x8*)(lds + PG8_SA(b, h) + aoff + m * 2048 + k * 1024); } } } while (0)
#define PG8_LDB(dst, b, h) do { _Pragma("unroll") for (int n = 0; n < 2; ++n) { \
        if constexpr (F8) dst##8[n] = __builtin_shufflevector(PG8_LDB16(PG8_SB(b, h) - 65536 + n * 2048), PG8_LDB16(PG8_SB(b, h) - 65536 + n * 2048 + 1024), 0, 1, 2, 3, 4, 5, 6, 7); \
        else { _Pragma("unroll") for (int k = 0; k < 2; ++k) dst[n][k] = *(const LAS bf16x8*)(lds + PG8_SB(b, h) + boff + n * 2048 + k * 1024); } } } while (0)
#define PG8_MMA(ai, bj, At, Bt) do { __builtin_amdgcn_s_setprio(1); _Pragma("unroll") for (int m = 0; m < 4; ++m) _Pragma("unroll") for (int n = 0; n < 2; ++n) { \
        if constexpr (F8) asm("v_mfma_f32_16x16x128_f8f6f4 %0, %1, %2, %0" : "+v"(acc[ai][bj][m][n]) : "v"(Bt##8[n]), "v"(At##8[m])); \
        else { _Pragma("unroll") for (int k = 0; k < 2; ++k) acc[ai][bj][m][n] = __builtin_amdgcn_mfma_f32_16x16x32_bf16(Bt[n][k], At[m][k], acc[ai][bj][m][n], 0, 0, 0); } } \
        __builtin_amdgcn_s_setprio(0); } while (0)
#define PG8_WAIT_V(n) asm volatile("s_waitcnt vmcnt(" #n ")" ::: "memory")
#define PG8_WAIT_L(n) asm volatile("s_waitcnt lgkmcnt(" #n ")" ::: "memory")
#define PG8_BAR __builtin_amdgcn_s_barrier()
#define PG8_SCHED __builtin_amdgcn_sched_barrier(0)
    GUnit cur, nxt; int ui = 0;
    if (!S.next(0, cur)) return;
    f32x4 acc[2][2][4][2];
#pragma unroll
    for (int a = 0; a < 2; ++a)
#pragma unroll
        for (int b = 0; b < 2; ++b)
#pragma unroll
            for (int m = 0; m < 4; ++m)
#pragma unroll
                for (int n = 0; n < 2; ++n) acc[a][b][m][n] = (f32x4){0.f, 0.f, 0.f, 0.f};
    bf16x8 At[4][2], B0[2][2], B1[2][2];
    typedef unsigned u32x8 __attribute__((ext_vector_type(8)));
    u32x8 At8[4], B08[2], B18[2];
    const char* cA = cur.a; const char* cB = cur.b; const char* nA = cA;
    PG8_GLOAD(vc, cur);
    PG8_STAGE(PG8_SB(0, 0), cB, voffB); PG8_STAGE_A(PG8_SA(0, 0), 0, (size_t)0, false); PG8_STAGE(PG8_SB(0, 1), cB + hstepB, voffB); PG8_STAGE_A(PG8_SA(0, 1), 1, (size_t)0, false);
    if (wr == 1) PG8_BAR;
    PG8_WAIT_V(4); PG8_BAR;
    PG8_STAGE(PG8_SB(1, 0), cB + kstep, voffB); PG8_STAGE_A(PG8_SA(1, 0), 0, kstep, false); PG8_STAGE(PG8_SB(1, 1), cB + hstepB + kstep, voffB);
    PG8_WAIT_V(6); PG8_BAR;
    for (;;) {
        const bool has_next = S.next(ui + 1, nxt);
        nA = has_next ? nxt.a : cA; const char* nB = has_next ? nxt.b : cB;
        if (has_next) PG8_GLOAD(vn, nxt); else { _Pragma("unroll") for (int _h = 0; _h < 2; ++_h) _Pragma("unroll") for (int _i = 0; _i < 2; ++_i) vn[_h][_i] = vc[_h][_i]; }
#pragma unroll 1
        for (int t = 0; t < nt; t += 2) {
            const bool last = (t == nt - 2);
            const size_t ka1 = (size_t)(t + 1) * kstep, ka2 = last ? (size_t)0 : (size_t)(t + 2) * kstep, ka3 = ka2 + kstep;
            const char* b2 = last ? nB : cB + (size_t)(t + 2) * kstep;
            const char* b3 = b2 + kstep;
            PG8_LDB(B0, 0, 0); PG8_SCHED; PG8_LDA(At, 0, 0); PG8_STAGE_A(PG8_SA(1, 1), 1, ka1, false);
            PG8_WAIT_L(8); PG8_BAR; PG8_WAIT_L(0); PG8_MMA(0, 0, At, B0); PG8_BAR; PG8_SCHED;
            PG8_LDB(B1, 0, 1); PG8_STAGE(PG8_SB(0, 0), b2, voffB);
            PG8_BAR; PG8_WAIT_L(0); PG8_MMA(0, 1, At, B1); PG8_BAR;
            PG8_LDA(At, 0, 1); PG8_STAGE_A(PG8_SA(0, 0), 0, ka2, last);
            PG8_BAR; PG8_WAIT_L(0); PG8_MMA(1, 0, At, B0); PG8_BAR; PG8_SCHED;
            PG8_STAGE(PG8_SB(0, 1), b2 + hstepB, voffB);
            PG8_WAIT_V(6); PG8_BAR; PG8_MMA(1, 1, At, B1); PG8_BAR;
            PG8_LDB(B0, 1, 0); PG8_SCHED; PG8_LDA(At, 1, 0); PG8_STAGE_A(PG8_SA(0, 1), 1, ka2, last);
            PG8_WAIT_L(8); PG8_BAR; PG8_WAIT_L(0); PG8_MMA(0, 0, At, B0); PG8_BAR; PG8_SCHED;
            PG8_LDB(B1, 1, 1); PG8_STAGE(PG8_SB(1, 0), b3, voffB);
            PG8_BAR; PG8_WAIT_L(0); PG8_MMA(0, 1, At, B1); PG8_BAR;
            PG8_LDA(At, 1, 1); PG8_STAGE_A(PG8_SA(1, 0), 0, ka3, last);
            PG8_BAR; PG8_WAIT_L(0); PG8_MMA(1, 0, At, B0); PG8_BAR; PG8_SCHED;
            PG8_STAGE(PG8_SB(1, 1), b3 + hstepB, voffB);
            PG8_WAIT_V(6); PG8_BAR; PG8_MMA(1, 1, At, B1); PG8_BAR;
        }
        if constexpr (F8) asm volatile("s_nop 15\n\ts_nop 15" ::: "memory");
        if (accs != 1.f) {
#pragma unroll
            for (int a = 0; a < 2; ++a)
#pragma unroll
                for (int b = 0; b < 2; ++b)
#pragma unroll
                    for (int m = 0; m < 4; ++m)
#pragma unroll
                        for (int n = 0; n < 2; ++n) acc[a][b][m][n] *= accs;
        }
        E(acc, cur, wr, wc, fr, fq);
        if (!has_next) break;
#pragma unroll
        for (int a = 0; a < 2; ++a)
#pragma unroll
            for (int b = 0; b < 2; ++b)
#pragma unroll
                for (int m = 0; m < 4; ++m)
#pragma unroll
                    for (int n = 0; n < 2; ++n) acc[a][b][m][n] = (f32x4){0.f, 0.f, 0.f, 0.f};
        cur = nxt; cA = nA; cB = nB; ++ui;
#pragma unroll
        for (int _h = 0; _h < 2; ++_h)
#pragma unroll
            for (int _i = 0; _i < 2; ++_i) vc[_h][_i] = vn[_h][_i];
    }
    PG8_WAIT_V(0);
    if (wr == 0) PG8_BAR;
    PG8_BAR;
#undef PG8_SA
#undef PG8_SB
#undef PG8_STAGE
#undef PG8_STAGE_A
#undef PG8_GLOAD
#undef PG8_LDA
#undef PG8_LDB
#undef PG8_MMA
#undef PG8_LD16
#undef PG8_LDA16
#undef PG8_LDB16
#undef PG8_WAIT_V
#undef PG8_WAIT_L
#undef PG8_BAR
#undef PG8_SCHED
}
typedef f32x4 acc_t[2][2][4][2];
__device__ __forceinline__ u32x4 pack8(f32x4 a, f32x4 b) { return (u32x4){cvt_pk_bf16(a[0], a[1]), cvt_pk_bf16(a[2], a[3]), cvt_pk_bf16(b[0], b[1]), cvt_pk_bf16(b[2], b[3])}; }
__device__ __forceinline__ void unpack8(u32x4 v, float* f) { f[0] = bf_lo(v[0]); f[1] = bf_hi(v[0]); f[2] = bf_lo(v[1]); f[3] = bf_hi(v[1]); f[4] = bf_lo(v[2]); f[5] = bf_hi(v[2]); f[6] = bf_lo(v[3]); f[7] = bf_hi(v[3]); }

template <bool MASK> struct EpiPlain {
    bf16_t* O; int ldo; float scale;
    __device__ __forceinline__ void operator()(const acc_t& acc, const GUnit& u, int wr, int wc, int fr, int fq) const {
        const int colb = u.pn * 256 + wc * 32 + fq * 8;
#pragma unroll
        for (int ai = 0; ai < 2; ++ai)
#pragma unroll
            for (int m = 0; m < 4; ++m) {
                const int r = ai * 128 + wr * 64 + m * 16 + fr;
                if (MASK && r >= u.nrows) continue;
                bf16_t* rowp = O + (size_t)(u.row0 + r) * ldo + colb;
#pragma unroll
                for (int bj = 0; bj < 2; ++bj) st16(rowp + bj * 128, pack8(acc[ai][bj][m][0] * scale, acc[ai][bj][m][1] * scale));
            }
    }
};

struct EpiResid {
    float* XF; const float* XR;
    __device__ __forceinline__ void operator()(const acc_t& acc, const GUnit& u, int wr, int wc, int fr, int fq) const {
        const int colb = u.pn * 256 + wc * 32 + fq * 8;
#pragma unroll
        for (int ai = 0; ai < 2; ++ai)
#pragma unroll
            for (int m = 0; m < 4; ++m) {
                const int r = ai * 128 + wr * 64 + m * 16 + fr;
                float* rowp = XF + (size_t)(u.row0 + r) * 1024 + colb; const float* rrow = XR + (size_t)(u.row0 + r) * 1024 + colb;
                asm volatile("" ::: "memory");
#pragma unroll
                for (int bj = 0; bj < 2; ++bj) {
                    const f32x4 x0 = *(const f32x4*)(rrow + bj * 128), x1 = *(const f32x4*)(rrow + bj * 128 + 4);
                    *(f32x4*)(rowp + bj * 128) = x0 * DN_ALPHA + acc[ai][bj][m][0]; *(f32x4*)(rowp + bj * 128 + 4) = x1 * DN_ALPHA + acc[ai][bj][m][1];
                }
            }
    }
};

__device__ __forceinline__ float clamp8(float x) { return __builtin_amdgcn_fmed3f(x, -448.f, 448.f); }
__device__ __forceinline__ u32x2 pack8_fp8(const float* f) {
    unsigned a = 0u, b = 0u;
    a = __builtin_amdgcn_cvt_pk_fp8_f32(clamp8(f[0]), clamp8(f[1]), a, false); a = __builtin_amdgcn_cvt_pk_fp8_f32(clamp8(f[2]), clamp8(f[3]), a, true);
    b = __builtin_amdgcn_cvt_pk_fp8_f32(clamp8(f[4]), clamp8(f[5]), b, false); b = __builtin_amdgcn_cvt_pk_fp8_f32(clamp8(f[6]), clamp8(f[7]), b, true);
    return (u32x2){a, b};
}
__device__ __forceinline__ void unpack8_fp8(u32x2 v, float* f) {
    const f32x2 a = __builtin_amdgcn_cvt_pk_f32_fp8(v[0], false), b = __builtin_amdgcn_cvt_pk_f32_fp8(v[0], true), c = __builtin_amdgcn_cvt_pk_f32_fp8(v[1], false), d = __builtin_amdgcn_cvt_pk_f32_fp8(v[1], true);
    f[0] = a[0]; f[1] = a[1]; f[2] = b[0]; f[3] = b[1]; f[4] = c[0]; f[5] = c[1]; f[6] = d[0]; f[7] = d[1]; }
__device__ __forceinline__ unsigned pack4_fp8(float a, float b, float c, float d) { unsigned r = 0u;
    r = __builtin_amdgcn_cvt_pk_fp8_f32(clamp8(a), clamp8(b), r, false); r = __builtin_amdgcn_cvt_pk_fp8_f32(clamp8(c), clamp8(d), r, true); return r; }
__device__ __forceinline__ int vperm32(int s) { const int k = s & 31; return (s & ~31) + 8 * ((k >> 2) & 3) + 4 * (k >> 4) + (k & 3); }
struct EpiMoeDown8 {
    unsigned char* O; float scale;
    __device__ __forceinline__ void operator()(const acc_t& acc, const GUnit& u, int wr, int wc, int fr, int fq) const {
        const int colb = u.pn * 256 + wc * 32 + fq * 8;
#pragma unroll
        for (int ai = 0; ai < 2; ++ai)
#pragma unroll
            for (int m = 0; m < 4; ++m) {
                const int r = ai * 128 + wr * 64 + m * 16 + fr;
                if (r >= u.nrows) continue;
                unsigned char* rowp = O + (size_t)(u.row0 + r) * 1024 + colb;
#pragma unroll
                for (int bj = 0; bj < 2; ++bj) { const f32x4 v0 = acc[ai][bj][m][0] * scale, v1 = acc[ai][bj][m][1] * scale;
                    const float f[8] = {v0[0], v0[1], v0[2], v0[3], v1[0], v1[1], v1[2], v1[3]}; *(u32x2*)(rowp + bj * 128) = pack8_fp8(f); }
            }
    }
};
struct EpiMoeGU {
    unsigned char* O;
    __device__ __forceinline__ void operator()(const acc_t& acc, const GUnit& u, int wr, int wc, int fr, int fq) const {
        const int colb = u.pn * 128 + wc * 32 + fq * 8;
#pragma unroll
        for (int ai = 0; ai < 2; ++ai)
#pragma unroll
            for (int m = 0; m < 4; ++m) {
                const int r = ai * 128 + wr * 64 + m * 16 + fr;
                if (r >= u.nrows) continue;
                float h[8];
                constexpr float DS = 1.f / (S8_X * S8_WGU);
#pragma unroll
                for (int bj = 0; bj < 2; ++bj)
#pragma unroll
                    for (int jj = 0; jj < 4; ++jj) h[bj * 4 + jj] = silu_(acc[ai][bj][m][0][jj] * DS) * (acc[ai][bj][m][1][jj] * (DS * S8_H));
                *(u32x2*)(O + (size_t)(u.row0 + r) * 1024 + colb) = pack8_fp8(h);
            }
    }
};

struct EpiScIn {
    bf16_t* P; bf16_t* BG;
    __device__ __forceinline__ void operator()(const acc_t& acc, const GUnit& u, int wr, int wc, int fr, int fq) const {
        if (u.pn < 8) {
            const int colb = u.pn * 128 + wc * 32 + fq * 8;
#pragma unroll
            for (int ai = 0; ai < 2; ++ai)
#pragma unroll
                for (int m = 0; m < 4; ++m) {
                    const int r = ai * 128 + wr * 64 + m * 16 + fr;
                    st16(P + (size_t)(u.row0 + r) * 1024 + colb, pack8(acc[ai][0][m][0] * acc[ai][0][m][1], acc[ai][1][m][0] * acc[ai][1][m][1]));
                }
        } else {
            const int colb = (u.pn - 8) * 256 + wc * 32 + fq * 8;
#pragma unroll
            for (int ai = 0; ai < 2; ++ai)
#pragma unroll
                for (int m = 0; m < 4; ++m) {
                    const int r = ai * 128 + wr * 64 + m * 16 + fr;
                    bf16_t* rowp = BG + (size_t)(u.row0 + r) * 1024 + colb;
#pragma unroll
                    for (int bj = 0; bj < 2; ++bj) st16(rowp + bj * 128, pack8(acc[ai][bj][m][0], acc[ai][bj][m][1]));
                }
        }
    }
};

struct EpiLruIn {
    bf16_t* GG; bf16_t* REC;
    __device__ __forceinline__ void operator()(const acc_t& acc, const GUnit& u, int wr, int wc, int fr, int fq) const {
        const bool isg = u.pn < 5;
        bf16_t* O = GG + (isg ? 0l : (REC - GG));
        const int colb = (isg ? u.pn : u.pn - 5) * 256 + wc * 32 + fq * 8;
#pragma unroll
        for (int ai = 0; ai < 2; ++ai)
#pragma unroll
            for (int m = 0; m < 4; ++m) {
                const int r = ai * 128 + wr * 64 + m * 16 + fr;
                bf16_t* rowp = O + (size_t)(u.row0 + r) * LRU_W + colb;
#pragma unroll
                for (int bj = 0; bj < 2; ++bj) {
                    f32x4 v0 = acc[ai][bj][m][0], v1 = acc[ai][bj][m][1];
                    if (isg) {
#pragma unroll
                        for (int jj = 0; jj < 4; ++jj) { v0[jj] = gelu_tanh(v0[jj]); v1[jj] = gelu_tanh(v1[jj]); }
                    }
                    st16(rowp + bj * 128, pack8(v0, v1));
                }
            }
    }
};

struct EpiLruGate {
    const bf16_t* U; bf16_t* LOGA; bf16_t* BIN; const float* ba; const float* bx; const float* lam;
    __device__ __forceinline__ void operator()(const acc_t& acc, const GUnit& u, int wr, int wc, int fr, int fq) const {
        const int ch0 = u.pn * 128 + wc * 32 + fq * 8;
        float ba8[8], bx8[8], ls8[8];
#pragma unroll
        for (int i = 0; i < 8; ++i) { ba8[i] = ba[ch0 + i]; bx8[i] = bx[ch0 + i]; const float l = lam[ch0 + i]; ls8[i] = -8.f * log1pf(__expf(-l)); }
#pragma unroll
        for (int ai = 0; ai < 2; ++ai)
#pragma unroll
            for (int m = 0; m < 4; ++m) {
                const int r = ai * 128 + wr * 64 + m * 16 + fr;
                const size_t off = (size_t)(u.row0 + r) * LRU_W + ch0;
                float u8[8]; unpack8(ld16(U + off), u8);
                f32x4 la[2], bi[2];
#pragma unroll
                for (int bj = 0; bj < 2; ++bj)
#pragma unroll
                    for (int jj = 0; jj < 4; ++jj) {
                        const int i = bj * 4 + jj;
                        const float rg = sigmoidf_(acc[ai][bj][m][0][jj] + ba8[i]);
                        const float ig = sigmoidf_(acc[ai][bj][m][1][jj] + bx8[i]);
                        const float l = rg * ls8[i];
                        const float om = fmaxf(1.f - fast_exp(2.f * l), 0.f);
                        la[bj][jj] = l; bi[bj][jj] = __builtin_sqrtf(om) * ig * u8[i];
                    }
                st16(LOGA + off, pack8(la[0], la[1]));
                st16(BIN + off, pack8(bi[0], bi[1]));
            }
    }
};

struct EpiNsaIn {
    unsigned char* Q; bf16_t* KC; bf16_t* VC; unsigned char* KS; unsigned char* VST; unsigned char* KW; unsigned char* VWT; float* GATES; const int* pos; const float* bgate;
    __device__ __forceinline__ void operator()(const acc_t& acc, const GUnit& u, int wr, int wc, int fr, int fq) const {
        const int pn = u.pn;
        if (pn <= 3 || pn == 6 || pn == 8) {
            unsigned char* O = Q + (pn <= 3 ? 0l : (pn == 6 ? (KS - Q) : (KW - Q)));
            const int ldo = pn <= 3 ? 1024 : 256;
            const int colbase = pn <= 3 ? pn * 256 : 0;
            const float scale = pn <= 3 ? 0.125f * LOG2E * S8_Q : S8_K;
            float invf[4];
#pragma unroll
            for (int jj = 0; jj < 4; ++jj) invf[jj] = exp2f(-(float)(16 * (wc & 1) + 4 * fq + jj) * (13.287712379549449f / 32.f));
#pragma unroll
            for (int ai = 0; ai < 2; ++ai)
#pragma unroll
                for (int m = 0; m < 4; ++m) {
                    const int row = u.row0 + ai * 128 + wr * 64 + m * 16 + fr;
                    const float p = (float)pos[row];
                    float sn[4], cs[4];
#pragma unroll
                    for (int jj = 0; jj < 4; ++jj) sincos_rad(p * invf[jj], sn[jj], cs[jj]);
#pragma unroll
                    for (int bj = 0; bj < 2; ++bj) {
                        const f32x4 x1 = acc[ai][bj][m][0], x2 = acc[ai][bj][m][1];
                        float o1[4], o2[4];
#pragma unroll
                        for (int jj = 0; jj < 4; ++jj) { o1[jj] = (x1[jj] * cs[jj] - x2[jj] * sn[jj]) * scale; o2[jj] = (x1[jj] * sn[jj] + x2[jj] * cs[jj]) * scale; }
                        unsigned char* p1 = O + (size_t)row * ldo + colbase + 64 * (2 * bj + (wc >> 1)) + 16 * (wc & 1) + 4 * fq;
                        *(unsigned*)p1 = pack4_fp8(o1[0], o1[1], o1[2], o1[3]);
                        *(unsigned*)(p1 + 32) = pack4_fp8(o2[0], o2[1], o2[2], o2[3]);
                    }
                }
        } else if (pn == 4 || pn == 5) {
            bf16_t* O = KC + (pn == 4 ? 0l : (VC - KC));
            const int colb = wc * 32 + fq * 8;
#pragma unroll
            for (int ai = 0; ai < 2; ++ai)
#pragma unroll
                for (int m = 0; m < 4; ++m) {
                    const int row = u.row0 + ai * 128 + wr * 64 + m * 16 + fr;
#pragma unroll
                    for (int bj = 0; bj < 2; ++bj) st16(O + (size_t)row * 256 + colb + bj * 128, pack8(acc[ai][bj][m][0], acc[ai][bj][m][1]));
                }
        } else if (pn == 7 || pn == 9) {
            unsigned char* O = VST + (pn == 7 ? 0l : (VWT - VST));
#pragma unroll
            for (int ai = 0; ai < 2; ++ai)
#pragma unroll
                for (int m = 0; m < 4; ++m) {
                    const int row = u.row0 + ai * 128 + wr * 64 + m * 16 + fr;
                    const int b = row >> 11, s = vperm32(row & 2047);
#pragma unroll
                    for (int bj = 0; bj < 2; ++bj) {
                        const int g = 2 * bj + (wc >> 1);
                        unsigned char* base = O + ((size_t)(b * 4 + g) * 64 + 32 * (wc & 1) + 8 * fq) * SEQ + s;
#pragma unroll
                        for (int n = 0; n < 2; ++n) { const unsigned pk = pack4_fp8(acc[ai][bj][m][n][0], acc[ai][bj][m][n][1], acc[ai][bj][m][n][2], acc[ai][bj][m][n][3]);
#pragma unroll
                            for (int jj = 0; jj < 4; ++jj) base[(size_t)(4 * n + jj) * SEQ] = (unsigned char)((pk >> (8 * jj)) & 0xffu); }
                    }
                }
        } else {
            if (wc < 2 && (wc == 0 || fq < 2)) {
                const int c0 = 32 * wc + 8 * fq;
                f32x4 bg[2];
#pragma unroll
                for (int n = 0; n < 2; ++n) bg[n] = *(const f32x4*)(bgate + c0 + 4 * n);
#pragma unroll
                for (int ai = 0; ai < 2; ++ai)
#pragma unroll
                    for (int m = 0; m < 4; ++m) {
                        const int row = u.row0 + ai * 128 + wr * 64 + m * 16 + fr;
#pragma unroll
                        for (int n = 0; n < 2; ++n) {
                            f32x4 v;
#pragma unroll
                            for (int jj = 0; jj < 4; ++jj) v[jj] = sigmoidf_(acc[ai][0][m][n][jj] + bg[n][jj]);
                            *(f32x4*)(GATES + (size_t)row * 48 + c0 + 4 * n) = v;
                        }
                    }
            }
        }
    }
};
__device__ __forceinline__ int map_plain8(int cc) { const int bj = cc >> 7, wc = (cc >> 5) & 3, n = (cc >> 4) & 1, fq = (cc >> 2) & 3; return 128 * bj + 32 * wc + 8 * fq + 4 * n; }
__device__ __forceinline__ int map_rope(int cc) { const int bj = cc >> 7, wc = (cc >> 5) & 3, n = (cc >> 4) & 1, fq = (cc >> 2) & 3; return 64 * (2 * bj + (wc >> 1)) + 32 * n + 16 * (wc & 1) + 4 * fq; }
__device__ __forceinline__ void map_pair(int cc, int& n, int& ch) { const int bj = cc >> 7, wc = (cc >> 5) & 3, fq = (cc >> 2) & 3; n = (cc >> 4) & 1; ch = 32 * wc + 8 * fq + 4 * bj; }
constexpr f32x4 F4ZERO = {0.f, 0.f, 0.f, 0.f};

struct FetchNsaIn { const float* W;
    __device__ __forceinline__ f32x4 operator()(int, int c4, int k) const { const int pn = c4 >> 8, cc = c4 & 255; const bool rope = (pn <= 3 || pn == 6 || pn == 8);
        const int col = pn * 256 + (rope ? map_rope(cc) : map_plain8(cc)); if (col >= 2608) return F4ZERO; return *(const f32x4*)(W + (size_t)k * 2608 + col); } };
struct FetchPlain { const float* W; int ld; size_t bstride;
    __device__ __forceinline__ f32x4 operator()(int bt, int c4, int k) const { const int col = (c4 & ~255) + map_plain8(c4 & 255); return *(const f32x4*)(W + (size_t)bt * bstride + (size_t)k * ld + col); } };
struct FetchPair { const float* W0; long d01; int ld; size_t bstride;
    __device__ __forceinline__ f32x4 operator()(int bt, int c4, int k) const { int n, ch; map_pair(c4 & 255, n, ch); ch += (c4 >> 8) * 128; return *(const f32x4*)(W0 + (n ? d01 : 0l) + (long)((size_t)bt * bstride + (size_t)k * ld + ch)); } };
struct FetchScIn { const float* W;
    __device__ __forceinline__ f32x4 operator()(int, int c4, int k) const { const int pn = c4 >> 8, cc = c4 & 255;
        if (pn < 8) { int n, ch; map_pair(cc, n, ch); ch += pn * 128; return *(const f32x4*)(W + (size_t)k * 3072 + (n ? 2048 : 0) + ch); }
        return *(const f32x4*)(W + (size_t)k * 3072 + 1024 + (pn - 8) * 256 + map_plain8(cc)); } };
struct FetchLruGate { const float* wa; long dax;
    __device__ __forceinline__ f32x4 operator()(int, int c4, int k) const { int n, ch; map_pair(c4 & 255, n, ch); ch += (c4 >> 8) * 128; const int h = ch / 80; if (k / 80 != h) return F4ZERO;
        return *(const f32x4*)(wa + (n ? dax : 0l) + (long)(h * 6400 + (k - 80 * h) * 80 + (ch - 80 * h))); } };
struct FetchIdent { const float* W; int ld; size_t bstride;
    __device__ __forceinline__ f32x4 operator()(int bt, int c4, int k) const { return *(const f32x4*)(W + (size_t)bt * bstride + (size_t)k * ld + c4); } };

template <bool OUT8 = false, class F>
__device__ __forceinline__ void convert_wt(LAS unsigned char* lds, void* dstv, int nbatch, int Nd, int K, const F& fetch, const float scale = 1.f) {
    constexpr int GRP = 4;
    LAS float* tile = (LAS float*)lds;
    const int tid = tid_opaque();
    const int ntk = K / 64, ntc = Nd / 64, per = ntc * ntk, total = per * nbatch;
    const bool split = (Nd & 255) == 0;
    const int c4i = tid & 15, kk = tid >> 4, rr4 = 4 * c4i, row = tid >> 3, k8 = (tid & 7) * 8;
    for (int t0 = blockIdx.x * GRP; t0 < total; t0 += gridDim.x * GRP) {
        f32x4 v[GRP][2];
#pragma unroll
        for (int gi = 0; gi < GRP; ++gi) {
            const int t = t0 + gi;
            if (t < total) {
                const int bt = t / per, tt = t - bt * per, tc = tt / ntk, tk = tt - tc * ntk, k0 = tk * 64;
                const int cbase = split ? (tc >> 2) * 256 + (tc & 3) * 32 : tc * 64;
                const int crow4 = cbase + (split ? ((rr4 & 31) + (rr4 >> 5) * 128) : rr4);
#pragma unroll
                for (int p = 0; p < 2; ++p) v[gi][p] = fetch(bt, crow4, k0 + kk + 32 * p);
            }
        }
        __syncthreads();
#pragma unroll
        for (int gi = 0; gi < GRP; ++gi)
            if (t0 + gi < total) {
#pragma unroll
                for (int p = 0; p < 2; ++p)
#pragma unroll
                    for (int j = 0; j < 4; ++j) tile[gi * 4160 + (4 * c4i + j) * 65 + kk + 32 * p] = v[gi][p][j];
            }
        __syncthreads();
#pragma unroll
        for (int gi = 0; gi < GRP; ++gi) {
            const int t = t0 + gi;
            if (t < total) {
                const int bt = t / per, tt = t - bt * per, tc = tt / ntk, tk = tt - tc * ntk, k0 = tk * 64;
                const int cbase = split ? (tc >> 2) * 256 + (tc & 3) * 32 : tc * 64;
                const int crow = cbase + (split ? ((row & 31) + (row >> 5) * 128) : row);
                float f[8];
#pragma unroll
                for (int i = 0; i < 8; ++i) f[i] = tile[gi * 4160 + row * 65 + k8 + i];
                if constexpr (OUT8) {
#pragma unroll
                    for (int i = 0; i < 8; ++i) f[i] *= scale;
                    *(u32x2*)((unsigned char*)dstv + ((size_t)bt * Nd + crow) * K + k0 + k8) = pack8_fp8(f);
                } else st16((bf16_t*)dstv + ((size_t)bt * Nd + crow) * K + k0 + k8, (u32x4){cvt_pk_bf16(f[0], f[1]), cvt_pk_bf16(f[2], f[3]), cvt_pk_bf16(f[4], f[5]), cvt_pk_bf16(f[6], f[7])});
            }
        }
    }
    __syncthreads();
}

template <bool X8OUT>
__device__ __forceinline__ void convert_x(const float* x, unsigned char* XA) {
    const size_t n8 = (size_t)T_TOK * DM / 8;
    const int tidx = tid_opaque();
    for (size_t i = (size_t)blockIdx.x * NTHR + tidx; i < n8; i += (size_t)gridDim.x * NTHR) {
        if constexpr (X8OUT) {
            const f32x4 a = *(const f32x4*)(x + i * 8) * S8_X, b = *(const f32x4*)(x + i * 8 + 4) * S8_X;
            const float f[8] = {a[0], a[1], a[2], a[3], b[0], b[1], b[2], b[3]};
            *(u32x2*)(XA + i * 8) = pack8_fp8(f);
        } else { const f32x4 a = *(const f32x4*)(x + i * 8), b = *(const f32x4*)(x + i * 8 + 4); st16((bf16_t*)XA + i * 8, pack8(a, b)); }
    }
}
__device__ __forceinline__ void cmp_bias_phase(LAS unsigned char* lds, const float* pek, const float* w1k, const float* pev, const float* w1v, float* bias1) {
    LAS float* red = (LAS float*)lds;
    const int tidx = tid_opaque();
    for (int blk = blockIdx.x; blk < 32; blk += gridDim.x) {
        const int v = blk >> 3, j = v >> 1, kv = v & 1, hid = (blk & 7) * 8 + (tidx & 7), part = tidx >> 3;
        const float* pe = pek + (kv ? (pev - pek) : 0l) + j * 2048; const float* w1 = w1k + (kv ? (w1v - w1k) : 0l) + (size_t)j * 2048 * 64;
        float s = 0.f;
#pragma unroll 8
        for (int i = part * 32; i < part * 32 + 32; ++i) s += pe[i] * w1[i * 64 + hid];
        __syncthreads();
        red[part * 8 + (tidx & 7)] = s;
        __syncthreads();
        if (tidx < 8) { float t = 0.f; for (int q = 0; q < 64; ++q) t += red[q * 8 + tidx]; bias1[v * 64 + (blk & 7) * 8 + tidx] = t; }
    }
    __syncthreads();
}

__device__ __forceinline__ void ln1_router_phase(LAS unsigned char* lds, const float* XF, const bf16_t* MBm, float* XW, unsigned char* X8, const float* gam, const float* bet,
                                                 const float* rw, const float* rb, int* route_e, float* route_w, int* cnt) {
    LAS f32x4* rwl = (LAS f32x4*)lds;
    LAS int* lcnt = (LAS int*)(lds + 65536);
    const int tid = tid_opaque(), lane = tid & 63, w = tid >> 6;
    __syncthreads();
    for (int i = tid; i < 4096; i += NTHR) { const int col = i >> 2, q = i & 3; const int seg = col >> 9, ln = (col >> 3) & 63, j = col & 7;
        rwl[((q * 2 + seg) * 8 + j) * 64 + ln] = *(const f32x4*)(rw + col * 16 + 4 * q); }
    for (int chunk = blockIdx.x; chunk < 256; chunk += gridDim.x) {
        __syncthreads();
        if (tid < 16) lcnt[tid] = 0;
        __syncthreads();
        const size_t row0 = (size_t)chunk * 256 + w * 32;
        f32x4 nx[2][4]; u32x4 nm[2][2];
#pragma unroll
        for (int rr = 0; rr < 2; ++rr)
#pragma unroll
            for (int sg = 0; sg < 2; ++sg) { nx[rr][sg * 2] = *(const f32x4*)(XF + (row0 + rr) * DM + sg * 512 + lane * 8); nx[rr][sg * 2 + 1] = *(const f32x4*)(XF + (row0 + rr) * DM + sg * 512 + lane * 8 + 4);
                nm[rr][sg] = ld16(MBm + (row0 + rr) * DM + sg * 512 + lane * 8); }
        for (int i = 0; i < 32; i += 2) {
            f32x2 y2[16];
            {
                float xv[2][16];
#pragma unroll
                for (int rr = 0; rr < 2; ++rr) {
#pragma unroll
                    for (int sg = 0; sg < 2; ++sg) { float mv[8]; unpack8(nm[rr][sg], mv);
#pragma unroll
                        for (int j = 0; j < 4; ++j) { xv[rr][sg * 8 + j] = DN_ALPHA * nx[rr][sg * 2][j] + mv[j]; xv[rr][sg * 8 + 4 + j] = DN_ALPHA * nx[rr][sg * 2 + 1][j] + mv[4 + j]; } }
                }
                if (i + 2 < 32) {
#pragma unroll
                    for (int rr = 0; rr < 2; ++rr)
#pragma unroll
                        for (int sg = 0; sg < 2; ++sg) { nx[rr][sg * 2] = *(const f32x4*)(XF + (row0 + i + 2 + rr) * DM + sg * 512 + lane * 8); nx[rr][sg * 2 + 1] = *(const f32x4*)(XF + (row0 + i + 2 + rr) * DM + sg * 512 + lane * 8 + 4);
                            nm[rr][sg] = ld16(MBm + (row0 + i + 2 + rr) * DM + sg * 512 + lane * 8); }
                }
                float mean[2], rstd[2];
#pragma unroll
                for (int rr = 0; rr < 2; ++rr) { float s = 0.f;
#pragma unroll
                    for (int j = 0; j < 16; ++j) s += xv[rr][j];
                    mean[rr] = wave_sum_dpp(s) * (1.f / 1024.f); }
#pragma unroll
                for (int rr = 0; rr < 2; ++rr) { float q = 0.f;
#pragma unroll
                    for (int j = 0; j < 16; ++j) { const float d = xv[rr][j] - mean[rr]; q += d * d; }
                    rstd[rr] = rsqrtf(wave_sum_dpp(q) * (1.f / 1024.f) + LN_EPS); }
#pragma unroll
                for (int sg = 0; sg < 2; ++sg) {
                    const f32x4 ga = *(const f32x4*)(gam + sg * 512 + lane * 8), gb = *(const f32x4*)(gam + sg * 512 + lane * 8 + 4);
                    const f32x4 ba = *(const f32x4*)(bet + sg * 512 + lane * 8), bb = *(const f32x4*)(bet + sg * 512 + lane * 8 + 4);
#pragma unroll
                    for (int rr = 0; rr < 2; ++rr) {
                        f32x4 o0, o1;
#pragma unroll
                        for (int j = 0; j < 4; ++j) { o0[j] = (xv[rr][sg * 8 + j] - mean[rr]) * rstd[rr] * ga[j] + ba[j]; o1[j] = (xv[rr][sg * 8 + 4 + j] - mean[rr]) * rstd[rr] * gb[j] + bb[j];
                            y2[sg * 8 + j][rr] = o0[j]; y2[sg * 8 + 4 + j][rr] = o1[j]; }
                        *(f32x4*)(XW + (row0 + i + rr) * DM + sg * 512 + lane * 8) = o0; *(f32x4*)(XW + (row0 + i + rr) * DM + sg * 512 + lane * 8 + 4) = o1;
                        { const f32x4 a8 = o0 * S8_X, b8 = o1 * S8_X; const float f8[8] = {a8[0], a8[1], a8[2], a8[3], b8[0], b8[1], b8[2], b8[3]};
                          *(u32x2*)(X8 + (row0 + i + rr) * DM + sg * 512 + lane * 8) = pack8_fp8(f8); }
                    }
                }
            }
            f32x2 lg2[16];
#pragma unroll
            for (int e = 0; e < 16; ++e) lg2[e] = (f32x2){0.f, 0.f};
#pragma unroll
            for (int sg = 0; sg < 2; ++sg)
#pragma unroll
                for (int j = 0; j < 8; ++j) {
                    if ((j & 1) == 0) __builtin_amdgcn_sched_barrier(0);
#pragma unroll
                    for (int q = 0; q < 4; ++q) {
                        const f32x4 wv = rwl[((q * 2 + sg) * 8 + j) * 64 + lane];
#pragma unroll
                        for (int e = 0; e < 4; ++e) lg2[q * 4 + e] += y2[sg * 8 + j] * (f32x2){wv[e], wv[e]};
                    }
                }
#pragma unroll
            for (int rr = 0; rr < 2; ++rr) {
                float sc[16], bi[16];
#pragma unroll
                for (int e = 0; e < 16; ++e) { const float l = wave_sum_dpp(lg2[e][rr]); sc[e] = 1.f / (1.f + __expf(-l)); bi[e] = sc[e] + rb[e]; }
                float gs[4];
#pragma unroll
                for (int g = 0; g < 4; ++g) { const float a = bi[4 * g], b = bi[4 * g + 1], c = bi[4 * g + 2], d = bi[4 * g + 3];
                    gs[g] = fmaxf(fmaxf(fmaxf(a + b, a + c), fmaxf(a + d, b + c)), fmaxf(b + d, c + d)); }
                int bg = 0; float bgs = gs[0];
#pragma unroll
                for (int g = 1; g < 4; ++g) if (gs[g] > bgs) { bgs = gs[g]; bg = g; }
                float vb[4], vs[4];
#pragma unroll
                for (int k = 0; k < 4; ++k) { vb[k] = bg == 0 ? bi[k] : (bg == 1 ? bi[4 + k] : (bg == 2 ? bi[8 + k] : bi[12 + k])); vs[k] = bg == 0 ? sc[k] : (bg == 1 ? sc[4 + k] : (bg == 2 ? sc[8 + k] : sc[12 + k])); }
                int i1 = 0; float b1 = vb[0], s1 = vs[0];
#pragma unroll
                for (int k = 1; k < 4; ++k) if (vb[k] > b1) { b1 = vb[k]; s1 = vs[k]; i1 = k; }
                int i2 = -1; float b2 = -3e38f, s2 = 0.f;
#pragma unroll
                for (int k = 0; k < 4; ++k) if (k != i1 && vb[k] > b2) { b2 = vb[k]; s2 = vs[k]; i2 = k; }
                const float inv = 1.f / (s1 + s2);
                if (lane == 0) {
                    const size_t row = row0 + i + rr;
                    const int e0 = bg * 4 + i1, e1 = bg * 4 + i2;
                    route_e[row] = e0 | (e1 << 8); route_w[row * 2] = s1 * inv; route_w[row * 2 + 1] = s2 * inv;
                    atomicAdd((int*)&lcnt[e0], 1); atomicAdd((int*)&lcnt[e1], 1);
                }
            }
        }
        __syncthreads();
        if (tid < 16) cnt[chunk * 16 + tid] = lcnt[tid];
    }
    __syncthreads();
}

__device__ __forceinline__ void moe_gather_phase(LAS unsigned char* lds, const int* route_e, const int* cnt, int* pos_out, int* inv, int4* tiles) {
    LAS int* s_tot = (LAS int*)lds; LAS int* s_pre = s_tot + 16; LAS int* s_off = s_pre + 16; LAS int* s_wcnt = s_off + 16; LAS int* s_lpos = s_wcnt + 128;
    const int tid = tid_opaque(), lane = tid & 63, w = tid >> 6;
    for (int chunk = blockIdx.x; chunk < 256; chunk += gridDim.x) {
        __syncthreads();
        { const int e = tid >> 5, j = tid & 31; int tot = 0, pre = 0;
            for (int c = j; c < 256; c += 32) { const int v = cnt[c * 16 + e]; tot += v; pre += (c < chunk) ? v : 0; }
#pragma unroll
            for (int o = 16; o >= 1; o >>= 1) { tot += __shfl_xor(tot, o); pre += __shfl_xor(pre, o); }
            if (j == 0) { s_tot[e] = tot; s_pre[e] = pre; } }
        __syncthreads();
        if (tid == 0) { int off = 0; for (int e = 0; e < 16; ++e) { s_off[e] = off; off += s_tot[e]; } }
        const int token = chunk * 256 + (tid >> 1), slot = tid & 1;
        const int re = route_e[token]; const int e = slot ? ((re >> 8) & 255) : (re & 255);
        int rk = 0;
#pragma unroll
        for (int e2 = 0; e2 < 16; ++e2) { const unsigned long long mk = __ballot(e == e2); if (e == e2) rk = __popcll(mk & ((1ull << lane) - 1ull)); if (lane == 0) s_wcnt[w * 16 + e2] = __popcll(mk); }
        __syncthreads();
        int base = s_off[e] + s_pre[e];
        for (int w2 = 0; w2 < w; ++w2) base += s_wcnt[w2 * 16 + e];
        const int p = base + rk;
        pos_out[token * 2 + slot] = p; inv[p] = token;
        if (chunk == 0 && tid == 0) {
            int nt = 0;
            for (int e2 = 0; e2 < 16; ++e2) { const int n = s_tot[e2]; for (int r = 0; r < n; r += 256) { tiles[1 + nt] = make_int4(e2, s_off[e2] + r, (n - r) < 256 ? (n - r) : 256, 0); ++nt; } }
            tiles[0] = make_int4(nt, 0, 0, 0);
        }
        if (chunk == 0 && tid < 256) inv[2 * T_TOK + tid] = 0;
    }
    __syncthreads();
}

template <bool LAST, bool X8OUT>
__device__ __forceinline__ void ln2_combine_phase(const float* XF, float* XW, const unsigned char* YM, const int* pos, const float* route_w, const float* gam, const float* bet, unsigned char* XO) {
    const int tid = tid_opaque(), lane = tid & 63, w = tid >> 6;
    float gm[16], bt[16];
#pragma unroll
    for (int s = 0; s < 2; ++s)
#pragma unroll
        for (int j = 0; j < 8; ++j) { gm[s * 8 + j] = gam[s * 512 + lane * 8 + j]; bt[s * 8 + j] = bet[s * 512 + lane * 8 + j]; }
    const size_t rstep = (size_t)gridDim.x * 8;
    int np0 = 0, np1 = 0; float nw0 = 0.f, nw1 = 0.f;
    { const size_t r0 = (size_t)blockIdx.x * 8 + w; if (r0 < (size_t)T_TOK) { np0 = pos[r0 * 2]; np1 = pos[r0 * 2 + 1]; nw0 = route_w[r0 * 2]; nw1 = route_w[r0 * 2 + 1]; } }
    for (size_t row = (size_t)blockIdx.x * 8 + w; row < (size_t)T_TOK; row += rstep) {
        const int p0 = np0, p1 = np1; const float w0 = nw0, w1 = nw1;
        { const size_t rn = row + rstep; if (rn < (size_t)T_TOK) { np0 = pos[rn * 2]; np1 = pos[rn * 2 + 1]; nw0 = route_w[rn * 2]; nw1 = route_w[rn * 2 + 1]; } }
        float xv[16], a[16], b[16];
#pragma unroll
        for (int sg = 0; sg < 2; ++sg) { const f32x4 c = *(const f32x4*)(XF + row * DM + sg * 512 + lane * 8), d = *(const f32x4*)(XF + row * DM + sg * 512 + lane * 8 + 4);
#pragma unroll
            for (int j = 0; j < 4; ++j) { xv[sg * 8 + j] = c[j]; xv[sg * 8 + 4 + j] = d[j]; } }
        unpack8_fp8(*(const u32x2*)(YM + (size_t)p0 * DM + lane * 8), a); unpack8_fp8(*(const u32x2*)(YM + (size_t)p0 * DM + 512 + lane * 8), a + 8);
        unpack8_fp8(*(const u32x2*)(YM + (size_t)p1 * DM + lane * 8), b); unpack8_fp8(*(const u32x2*)(YM + (size_t)p1 * DM + 512 + lane * 8), b + 8);
        float s = 0.f;
#pragma unroll
        for (int j = 0; j < 16; ++j) { xv[j] = DN_ALPHA * xv[j] + (w0 * a[j] + w1 * b[j]) * (1.f / S8_Y); s += xv[j]; }
        const float mean = wave_sum_dpp(s) * (1.f / 1024.f);
        float q = 0.f;
#pragma unroll
        for (int j = 0; j < 16; ++j) { const float d = xv[j] - mean; q += d * d; }
        const float rstd = rsqrtf(wave_sum_dpp(q) * (1.f / 1024.f) + LN_EPS);
        float y[16];
#pragma unroll
        for (int j = 0; j < 16; ++j) y[j] = (xv[j] - mean) * rstd * gm[j] + bt[j];
        float* outf = XW;
        *(f32x4*)(outf + row * DM + lane * 8) = (f32x4){y[0], y[1], y[2], y[3]}; *(f32x4*)(outf + row * DM + lane * 8 + 4) = (f32x4){y[4], y[5], y[6], y[7]};
        *(f32x4*)(outf + row * DM + 512 + lane * 8) = (f32x4){y[8], y[9], y[10], y[11]}; *(f32x4*)(outf + row * DM + 512 + lane * 8 + 4) = (f32x4){y[12], y[13], y[14], y[15]};
        if (!LAST) {
            if constexpr (X8OUT) {
                float ys[16];
#pragma unroll
                for (int j = 0; j < 16; ++j) ys[j] = y[j] * S8_X;
                *(u32x2*)(XO + row * DM + lane * 8) = pack8_fp8(ys); *(u32x2*)(XO + row * DM + 512 + lane * 8) = pack8_fp8(ys + 8);
            } else {
                bf16_t* XOb = (bf16_t*)XO;
                st16(XOb + row * DM + lane * 8, (u32x4){cvt_pk_bf16(y[0], y[1]), cvt_pk_bf16(y[2], y[3]), cvt_pk_bf16(y[4], y[5]), cvt_pk_bf16(y[6], y[7])});
                st16(XOb + row * DM + 512 + lane * 8, (u32x4){cvt_pk_bf16(y[8], y[9]), cvt_pk_bf16(y[10], y[11]), cvt_pk_bf16(y[12], y[13]), cvt_pk_bf16(y[14], y[15])});
            }
        }
    }
}

__device__ __forceinline__ void sc_conv_phase(const bf16_t* P, const bf16_t* BG, bf16_t* Y, const float* cw, const float* cb) {
    const int items = (T_TOK / 16) * 128; const int tidx = tid_opaque();
    for (int it = blockIdx.x * NTHR + tidx; it < items; it += gridDim.x * NTHR) {
        const int cg = it & 127, run = it >> 7, c0 = cg * 8; const size_t t0 = (size_t)run * 16; const int s = (int)(t0 & 2047);
        float w0[8], w1[8], w2[8], b8[8];
#pragma unroll
        for (int j = 0; j < 8; ++j) { w0[j] = cw[c0 + j]; w1[j] = cw[1024 + c0 + j]; w2[j] = cw[2048 + c0 + j]; b8[j] = cb[c0 + j]; }
        float pm2[8], pm1[8];
        if (s == 0) {
#pragma unroll
            for (int j = 0; j < 8; ++j) { pm2[j] = 0.f; pm1[j] = 0.f; }
        } else { unpack8(ld16(P + (t0 - 2) * DM + c0), pm2); unpack8(ld16(P + (t0 - 1) * DM + c0), pm1); }
#pragma unroll 4
        for (int i = 0; i < 16; ++i) {
            float cur[8], bg[8], y[8];
            unpack8(ld16(P + (t0 + i) * DM + c0), cur); unpack8(ld16(BG + (t0 + i) * DM + c0), bg);
#pragma unroll
            for (int j = 0; j < 8; ++j) { y[j] = bg[j] * (b8[j] + w0[j] * pm2[j] + w1[j] * pm1[j] + w2[j] * cur[j]); pm2[j] = pm1[j]; pm1[j] = cur[j]; }
            st16(Y + (t0 + i) * DM + c0, (u32x4){cvt_pk_bf16(y[0], y[1]), cvt_pk_bf16(y[2], y[3]), cvt_pk_bf16(y[4], y[5]), cvt_pk_bf16(y[6], y[7])});
        }
    }
}
__device__ __forceinline__ void lru_conv_phase(const bf16_t* REC, bf16_t* U, const float* cw, const float* cb) {
    const int items = (T_TOK / 16) * 160; const int tidx = tid_opaque();
    for (int it = blockIdx.x * NTHR + tidx; it < items; it += gridDim.x * NTHR) {
        const int cg = it % 160, run = it / 160, c0 = cg * 8; const size_t t0 = (size_t)run * 16; const int s = (int)(t0 & 2047);
        float w0[8], w1[8], w2[8], w3[8], b8[8];
#pragma unroll
        for (int j = 0; j < 8; ++j) { w0[j] = cw[c0 + j]; w1[j] = cw[LRU_W + c0 + j]; w2[j] = cw[2 * LRU_W + c0 + j]; w3[j] = cw[3 * LRU_W + c0 + j]; b8[j] = cb[c0 + j]; }
        float p3[8], p2[8], p1[8];
        if (s == 0) {
#pragma unroll
            for (int j = 0; j < 8; ++j) { p3[j] = 0.f; p2[j] = 0.f; p1[j] = 0.f; }
        } else { unpack8(ld16(REC + (t0 - 3) * LRU_W + c0), p3); unpack8(ld16(REC + (t0 - 2) * LRU_W + c0), p2); unpack8(ld16(REC + (t0 - 1) * LRU_W + c0), p1); }
#pragma unroll 4
        for (int i = 0; i < 16; ++i) {
            float cur[8], y[8];
            unpack8(ld16(REC + (t0 + i) * LRU_W + c0), cur);
#pragma unroll
            for (int j = 0; j < 8; ++j) { y[j] = b8[j] + w0[j] * p3[j] + w1[j] * p2[j] + w2[j] * p1[j] + w3[j] * cur[j]; p3[j] = p2[j]; p2[j] = p1[j]; p1[j] = cur[j]; }
            st16(U + (t0 + i) * LRU_W + c0, (u32x4){cvt_pk_bf16(y[0], y[1]), cvt_pk_bf16(y[2], y[3]), cvt_pk_bf16(y[4], y[5]), cvt_pk_bf16(y[6], y[7])});
        }
    }
}

__device__ __forceinline__ void lru_scan1_phase(const bf16_t* LOGA, const bf16_t* BIN, f32x4* carry) {
    const int tidx = tid_opaque(); const int lane = tidx & 63, w = tidx >> 6;
    for (int it = blockIdx.x * 8 + w; it < 10240; it += gridDim.x * 8) {
        const int cgp = it % 10, ck = (it / 10) & 31, b = it / 320, ch = cgp * 128 + lane * 2;
        const size_t base = ((size_t)b * SEQ + ck * 64) * LRU_W + ch;
        float h0 = 0.f, h1 = 0.f, s0 = 0.f, s1 = 0.f;
#pragma unroll 8
        for (int t = 0; t < 64; ++t) {
            const unsigned la = *(const unsigned*)(LOGA + base + (size_t)t * LRU_W), bi = *(const unsigned*)(BIN + base + (size_t)t * LRU_W);
            const float l0 = bf_lo(la), l1 = bf_hi(la);
            h0 = fast_exp(l0) * h0 + bf_lo(bi); h1 = fast_exp(l1) * h1 + bf_hi(bi); s0 += l0; s1 += l1;
        }
        carry[(((size_t)b * 32 + ck) * LRU_W + ch) >> 1] = (f32x4){s0, h0, s1, h1};
    }
}
__device__ __forceinline__ void lru_scan2_phase(const bf16_t* LOGA, const bf16_t* BIN, const bf16_t* GG, const f32x4* carry, bf16_t* Y) {
    const int tidx = tid_opaque(); const int lane = tidx & 63, w = tidx >> 6;
    for (int it = blockIdx.x * 8 + w; it < 10240; it += gridDim.x * 8) {
        const int cgp = it % 10, ck = (it / 10) & 31, b = it / 320, ch = cgp * 128 + lane * 2;
        float h0 = 0.f, h1 = 0.f;
        for (int c2 = 0; c2 < ck; ++c2) { const f32x4 cv = carry[(((size_t)b * 32 + c2) * LRU_W + ch) >> 1]; h0 = fast_exp(cv[0]) * h0 + cv[1]; h1 = fast_exp(cv[2]) * h1 + cv[3]; }
        const size_t base = ((size_t)b * SEQ + ck * 64) * LRU_W + ch;
#pragma unroll 8
        for (int t = 0; t < 64; ++t) {
            const unsigned la = *(const unsigned*)(LOGA + base + (size_t)t * LRU_W), bi = *(const unsigned*)(BIN + base + (size_t)t * LRU_W), gg = *(const unsigned*)(GG + base + (size_t)t * LRU_W);
            h0 = fast_exp(bf_lo(la)) * h0 + bf_lo(bi); h1 = fast_exp(bf_hi(la)) * h1 + bf_hi(bi);
            *(unsigned*)(Y + base + (size_t)t * LRU_W) = cvt_pk_bf16(bf_lo(gg) * h0, bf_hi(gg) * h1);
        }
    }
}
__device__ __forceinline__ bf16x8 pack8s(const float* f) {
    const unsigned a = cvt_pk_bf16(f[0], f[1]), b = cvt_pk_bf16(f[2], f[3]), c = cvt_pk_bf16(f[4], f[5]), d = cvt_pk_bf16(f[6], f[7]);
    u32x4 v = {a, b, c, d}; return __builtin_bit_cast(bf16x8, v);
}
__device__ __forceinline__ void nsa_compress_phase(const bf16_t* KC, const bf16_t* VC, const bf16_t* W1T, const float* w2k, const float* w2v, const float* bias1,
                                                   const int* pos, unsigned char* KCMP, unsigned char* VCMPT) {
    const int tidx = tid_opaque(); const int lane = tidx & 63, w = tidx >> 6, rowi = lane & 15, gq = lane >> 4;
    for (int task = blockIdx.x * 8 + w; task < 2048; task += gridDim.x * 8) {
        const int kv = task >> 10, tt = task & 1023, rho = tt * 16 + rowi, b = rho >> 9, n = (rho >> 2) & 127, g = rho & 3;
        const bf16_t* src = KC + (kv ? (VC - KC) : 0l) + (size_t)b * SEQ * 256 + g * 64 + 8 * gq;
        const bf16_t* w1t = W1T + (size_t)kv * 64 * 2048 + (size_t)rowi * 2048 + 8 * gq;
        f32x4 hacc[4];
#pragma unroll
        for (int ht = 0; ht < 4; ++ht) hacc[ht] = (f32x4){0.f, 0.f, 0.f, 0.f};
#pragma unroll 4
        for (int kk = 0; kk < 64; ++kk) {
            int tok = 16 * n + (kk >> 1); tok = tok > 2047 ? 2047 : tok;
            const bf16x8 af = *(const bf16x8*)(src + (size_t)tok * 256 + 32 * (kk & 1));
#pragma unroll
            for (int ht = 0; ht < 4; ++ht) { const bf16x8 wf = *(const bf16x8*)(w1t + (size_t)(16 * ht) * 2048 + kk * 32); hacc[ht] = __builtin_amdgcn_mfma_f32_16x16x32_bf16(wf, af, hacc[ht], 0, 0, 0); }
        }
        bf16x8 pf[2];
#pragma unroll
        for (int p = 0; p < 2; ++p) { float hv[8];
#pragma unroll
            for (int jj = 0; jj < 4; ++jj) { hv[jj] = gelu_tanh(hacc[2 * p][jj] + bias1[kv * 64 + 32 * p + 4 * gq + jj]); hv[4 + jj] = gelu_tanh(hacc[2 * p + 1][jj] + bias1[kv * 64 + 32 * p + 16 + 4 * gq + jj]); }
            pf[p] = pack8s(hv); }
        const float* w2 = w2k + (kv ? (w2v - w2k) : 0l);
        f32x4 oacc[4];
#pragma unroll
        for (int dt = 0; dt < 4; ++dt) { oacc[dt] = (f32x4){0.f, 0.f, 0.f, 0.f};
#pragma unroll
            for (int p = 0; p < 2; ++p) { float wv[8]; const int dout = 16 * dt + rowi;
#pragma unroll
                for (int i = 0; i < 4; ++i) { wv[i] = w2[(32 * p + 4 * gq + i) * 64 + dout]; wv[4 + i] = w2[(32 * p + 16 + 4 * gq + i) * 64 + dout]; }
                oacc[dt] = __builtin_amdgcn_mfma_f32_16x16x32_bf16(pack8s(wv), pf[p], oacc[dt], 0, 0, 0); } }
        const bool padrow = (n == 127);
        if (kv == 0) {
            int pidx = 16 * n + 31; pidx = pidx > 2047 ? 2047 : pidx;
            const float pp = (float)pos[b * SEQ + pidx];
            unsigned char* dst = KCMP + ((size_t)(b * 128 + n) * 4 + g) * 64;
#pragma unroll
            for (int dt = 0; dt < 2; ++dt) { float o1[4], o2[4];
#pragma unroll
                for (int jj = 0; jj < 4; ++jj) { const float inv = exp2f(-(float)(16 * dt + 4 * gq + jj) * (13.287712379549449f / 32.f)); float sn, cs; sincos_rad(pp * inv, sn, cs);
                    const float x1 = oacc[dt][jj], x2 = oacc[dt + 2][jj]; o1[jj] = padrow ? 0.f : (x1 * cs - x2 * sn) * S8_K; o2[jj] = padrow ? 0.f : (x1 * sn + x2 * cs) * S8_K; }
                *(unsigned*)(dst + 16 * dt + 4 * gq) = pack4_fp8(o1[0], o1[1], o1[2], o1[3]);
                *(unsigned*)(dst + 32 + 16 * dt + 4 * gq) = pack4_fp8(o2[0], o2[1], o2[2], o2[3]); }
        } else {
            unsigned char* dst = VCMPT + ((size_t)(b * 4 + g) * 64) * 128 + vperm32(n);
#pragma unroll
            for (int dt = 0; dt < 4; ++dt) { const unsigned pk = pack4_fp8(oacc[dt][0], oacc[dt][1], oacc[dt][2], oacc[dt][3]);
#pragma unroll
                for (int jj = 0; jj < 4; ++jj) dst[(size_t)(16 * dt + 4 * gq + jj) * 128] = padrow ? (unsigned char)0 : (unsigned char)((pk >> (8 * jj)) & 0xffu); }
        }
    }
}

struct AttnArgs { const unsigned char* Q; const unsigned char* KS; const unsigned char* VST; const unsigned char* KW; const unsigned char* VWT; const unsigned char* KCMP; const unsigned char* VCMPT; const float* GATES; unsigned char* O; };
constexpr int AL_KC = 0, AL_VC = 10240, AL_KB = 19456, AL_VB = 29696, AL_PS = 39936, AL_IMP = 56320, AL_SEL = 60416, AL_OT = 60544;
typedef long fp8x8;
__device__ __forceinline__ unsigned pk4p(float a, float b, float c, float d) { unsigned r = 0u; r = __builtin_amdgcn_cvt_pk_fp8_f32(a, b, r, false); r = __builtin_amdgcn_cvt_pk_fp8_f32(c, d, r, true); return r; }
__device__ __forceinline__ fp8x8 mk8(unsigned lo, unsigned hi) { return (fp8x8)(((unsigned long long)hi << 32) | (unsigned long long)lo); }
constexpr float ATT_THR = 8.f;

__device__ __forceinline__ float max16(const f32x4 (&a)[4]) {
    float m0 = fmaxf(fmaxf(a[0][0], a[0][1]), a[0][2]), m1 = fmaxf(fmaxf(a[0][3], a[1][0]), a[1][1]), m2 = fmaxf(fmaxf(a[1][2], a[1][3]), a[2][0]);
    float m3 = fmaxf(fmaxf(a[2][1], a[2][2]), a[2][3]), m4 = fmaxf(fmaxf(a[3][0], a[3][1]), a[3][2]);
    return fmaxf(fmaxf(fmaxf(m0, m1), fmaxf(m2, m3)), fmaxf(m4, a[3][3]));
}

template <int MODE>
__device__ __forceinline__ void attn_branch(LAS unsigned char* lds, const unsigned char* Kg, const unsigned char* Vg, const int kb_lo, const int kb_hi, const bool first_staged,
                                            const fp8x8 (&qf)[2][2], const int (&sq)[2], const unsigned (&selm)[2], const float* const (&gatep)[2], LAS f32x4* otl  ,
                                            const int n, const int gq, const int tid) {
    const bool isv = tid >= 256; const int st = tid & 255, srow = st >> 2, spc = st & 3;
    const unsigned char* sgp = isv ? Vg + (size_t)srow * SEQ + spc * 16 : Kg + (size_t)srow * 256 + spc * 16;
    const size_t sstep = isv ? (size_t)64 : (size_t)64 * 256;
    const int soff = (isv ? AL_VB : AL_KB) + srow * 80 + spc * 16;
    u32x4 sr;
    if (!first_staged) {
        sr = ld16(sgp + (size_t)kb_lo * sstep);
        *(LAS u32x4*)(lds + soff) = sr;
        __syncthreads();
    }
    float m_run[2] = {0.f, 0.f}, l_run[2] = {0.f, 0.f};
    const float gate[2] = {gatep[0][MODE + 1], gatep[1][MODE + 1]};
    f32x4 oacc[2][4];
#pragma unroll
    for (int ti = 0; ti < 2; ++ti)
#pragma unroll
        for (int dt = 0; dt < 4; ++dt) oacc[ti][dt] = (f32x4){0.f, 0.f, 0.f, 0.f};
    for (int kb = kb_lo; kb <= kb_hi; ++kb) {
        const int buf = (kb - kb_lo) & 1;
        if (kb < kb_hi) sr = ld16(sgp + (size_t)(kb + 1) * sstep);
        const LAS unsigned char* kbuf = lds + AL_KB + buf * 5120; const LAS unsigned char* vbuf = lds + AL_VB + buf * 5120;
        f32x4 sacc[2][4];
        bool selb[2];
#pragma unroll
        for (int ti = 0; ti < 2; ++ti) selb[ti] = MODE == 0 ? (((selm[ti] >> kb) & 1u) != 0u) : true;
#pragma unroll
        for (int kt = 0; kt < 4; ++kt) {
            const fp8x8 k0 = *(const LAS fp8x8*)(kbuf + (16 * kt + n) * 80 + gq * 8), k1 = *(const LAS fp8x8*)(kbuf + (16 * kt + n) * 80 + 32 + gq * 8);
#pragma unroll
            for (int ti = 0; ti < 2; ++ti) {
                sacc[ti][kt] = __builtin_amdgcn_mfma_f32_16x16x32_fp8_fp8(k0, qf[ti][0], (f32x4){0.f, 0.f, 0.f, 0.f}, 0, 0, 0);
                sacc[ti][kt] = __builtin_amdgcn_mfma_f32_16x16x32_fp8_fp8(k1, qf[ti][1], sacc[ti][kt], 0, 0, 0);
            }
        }
        const bool need_mask = (kb == kb_hi) || (MODE == 1 && kb == kb_lo);
        if (need_mask) {
#pragma unroll
            for (int ti = 0; ti < 2; ++ti) {
                const int rel = sq[ti] - kb * 64 - 4 * gq;
#pragma unroll
                for (int kt = 0; kt < 4; ++kt)
#pragma unroll
                    for (int jj = 0; jj < 4; ++jj) { const int tt = 16 * kt + jj; const bool v = MODE == 0 ? (tt <= rel) : (tt <= rel && tt > rel - 512); sacc[ti][kt][jj] = v ? sacc[ti][kt][jj] : NEGBIG; }
            }
        }
        float mx[2];
#pragma unroll
        for (int ti = 0; ti < 2; ++ti) { mx[ti] = max16(sacc[ti]) - m_run[ti]; mx[ti] = selb[ti] ? mx[ti] : NEGBIG; }
        const bool slow = (mx[0] > ATT_THR) || (mx[1] > ATT_THR) || (l_run[0] == 0.f && mx[0] > -1e29f && mx[0] < -ATT_THR) || (l_run[1] == 0.f && mx[1] > -1e29f && mx[1] < -ATT_THR);
        if (__any(slow)) {
#pragma unroll
            for (int ti = 0; ti < 2; ++ti) {
                float mr = fmaxf(mx[ti], __shfl_xor(mx[ti], 16)); mr = fmaxf(mr, __shfl_xor(mr, 32));
                float lr = l_run[ti] + __shfl_xor(l_run[ti], 16); lr += __shfl_xor(lr, 32);
                const bool has = mr > -1e29f;
                const float delta = !has ? 0.f : (lr == 0.f ? mr : fmaxf(mr, 0.f));
                const float alpha = lr == 0.f ? 1.f : fast_exp2(-delta);
                l_run[ti] *= alpha; m_run[ti] += delta;
#pragma unroll
                for (int dt = 0; dt < 4; ++dt) oacc[ti][dt] *= alpha;
            }
        }
        if (__any(m_run[0] != 0.f || m_run[1] != 0.f)) {
#pragma unroll
            for (int ti = 0; ti < 2; ++ti)
#pragma unroll
                for (int kt = 0; kt < 4; ++kt) sacc[ti][kt] -= m_run[ti];
        }
        fp8x8 pf[2][2];
#pragma unroll
        for (int ti = 0; ti < 2; ++ti) {
            float ps = 0.f;
#pragma unroll
            for (int kt = 0; kt < 4; ++kt)
#pragma unroll
                for (int jj = 0; jj < 4; ++jj) { const float e = fast_exp2(sacc[ti][kt][jj]); sacc[ti][kt][jj] = e; ps += e; }
            l_run[ti] += selb[ti] ? ps : 0.f;
#pragma unroll
            for (int p = 0; p < 2; ++p) { unsigned lo = pk4p(sacc[ti][2 * p][0], sacc[ti][2 * p][1], sacc[ti][2 * p][2], sacc[ti][2 * p][3]), hi = pk4p(sacc[ti][2 * p + 1][0], sacc[ti][2 * p + 1][1], sacc[ti][2 * p + 1][2], sacc[ti][2 * p + 1][3]);
                if (MODE == 0) { lo = selb[ti] ? lo : 0u; hi = selb[ti] ? hi : 0u; }
                pf[ti][p] = mk8(lo, hi); }
        }
#pragma unroll
        for (int dt = 0; dt < 4; ++dt)
#pragma unroll
            for (int p = 0; p < 2; ++p) {
                const fp8x8 vf = *(const LAS fp8x8*)(vbuf + (16 * dt + n) * 80 + 32 * p + 8 * gq);
#pragma unroll
                for (int ti = 0; ti < 2; ++ti) oacc[ti][dt] = __builtin_amdgcn_mfma_f32_16x16x32_fp8_fp8(vf, pf[ti][p], oacc[ti][dt], 0, 0, 0);
            }
        if (kb < kb_hi) *(LAS u32x4*)(lds + (buf ^ 1) * 5120 + soff) = sr;
        __syncthreads();
    }
#pragma unroll
    for (int ti = 0; ti < 2; ++ti) {
        float lt = l_run[ti] + __shfl_xor(l_run[ti], 16); lt += __shfl_xor(lt, 32);
        const float inv = lt > 0.f ? gate[ti] / lt : 0.f;
#pragma unroll
        for (int dt = 0; dt < 4; ++dt) otl[(ti * 4 + dt) * 64] += oacc[ti][dt] * inv;
    }
}

__device__ __forceinline__ unsigned attn_cmp_tile(LAS unsigned char* lds, const fp8x8 qf0, const fp8x8 qf1, const int s, const int sbase  , const float g0,
                                                  LAS f32x4* otl  , const int lane, const int w, const int n, const int gq, const int tl, const int r) {
    f32x4 sacc[8];
#pragma unroll
    for (int kt = 0; kt < 8; ++kt) {
        const fp8x8 k0 = *(const LAS fp8x8*)(lds + AL_KC + (16 * kt + n) * 80 + gq * 8), k1 = *(const LAS fp8x8*)(lds + AL_KC + (16 * kt + n) * 80 + 32 + gq * 8);
        sacc[kt] = __builtin_amdgcn_mfma_f32_16x16x32_fp8_fp8(k0, qf0, (f32x4){0.f, 0.f, 0.f, 0.f}, 0, 0, 0);
        sacc[kt] = __builtin_amdgcn_mfma_f32_16x16x32_fp8_fp8(k1, qf1, sacc[kt], 0, 0, 0);
    }
    float mx = NEGBIG;
    const int lim = ((s - 31) >> 4) - 4 * gq;
#pragma unroll
    for (int kt = 0; kt < 8; ++kt)
#pragma unroll
        for (int jj = 0; jj < 4; ++jj) { const bool v = (16 * kt + jj <= lim); sacc[kt][jj] = v ? sacc[kt][jj] : NEGBIG; mx = fmaxf(mx, sacc[kt][jj]); }
    mx = fmaxf(mx, __shfl_xor(mx, 16)); mx = fmaxf(mx, __shfl_xor(mx, 32));
    float ps = 0.f;
#pragma unroll
    for (int kt = 0; kt < 8; ++kt)
#pragma unroll
        for (int jj = 0; jj < 4; ++jj) { const float e = sacc[kt][jj] > -1e29f ? fast_exp2(sacc[kt][jj] - mx) : 0.f; sacc[kt][jj] = e; ps += e; }
    ps += __shfl_xor(ps, 16); ps += __shfl_xor(ps, 32);
    const float inv = ps > 0.f ? 1.f / ps : 0.f;
#pragma unroll
    for (int kt = 0; kt < 8; ++kt) {
        f32x4 pp;
#pragma unroll
        for (int jj = 0; jj < 4; ++jj) { sacc[kt][jj] *= inv; float t = sacc[kt][jj]; t += dpp_mov<0xB1>(t); t += dpp_mov<0x4E>(t); pp[jj] = t; }
        if (r == 0) *(LAS f32x4*)(lds + AL_PS + ((w * 4 + tl) * 128 + 16 * kt + 4 * gq) * 4) = pp;
    }
    f32x4 otot[4];
#pragma unroll
    for (int dt = 0; dt < 4; ++dt) otot[dt] = (f32x4){0.f, 0.f, 0.f, 0.f};
#pragma unroll
    for (int p = 0; p < 4; ++p) {
        const fp8x8 pf = mk8(pk4p(sacc[2 * p][0], sacc[2 * p][1], sacc[2 * p][2], sacc[2 * p][3]), pk4p(sacc[2 * p + 1][0], sacc[2 * p + 1][1], sacc[2 * p + 1][2], sacc[2 * p + 1][3]));
#pragma unroll
        for (int dt = 0; dt < 4; ++dt) {
            const fp8x8 vf = *(const LAS fp8x8*)(lds + AL_VC + (16 * dt + n) * 144 + 32 * p + 8 * gq);
            otot[dt] = __builtin_amdgcn_mfma_f32_16x16x32_fp8_fp8(vf, pf, otot[dt], 0, 0, 0);
        }
    }
#pragma unroll
    for (int dt = 0; dt < 4; ++dt) otl[dt * 64] = otot[dt] * g0;
    asm volatile("s_waitcnt lgkmcnt(0)" ::: "memory");
    __builtin_amdgcn_wave_barrier();
    const int tl2 = lane >> 4, q = lane & 15, s2 = sbase + tl2, blkq = s2 >> 6;
    const LAS float* psr = (const LAS float*)(lds + AL_PS + ((w * 4 + tl2) * 128) * 4);
    const f32x4 xa = *(const LAS f32x4*)(psr + 8 * q), xb = *(const LAS f32x4*)(psr + 8 * q + 4);
    const float prev = q > 0 ? psr[8 * q - 1] : 0.f;
    float a0 = prev + xa[0] + xa[1] + xa[2] + xa[3], a1 = xa[3] + xb[0] + xb[1] + xb[2] + xb[3];
    const int m0 = 2 * q, m1 = 2 * q + 1;
    { const int rel0 = blkq - m0, rel1 = blkq - m1;
        if (rel0 < 0) a0 = -1.f;
        if (rel1 < 0) a1 = -1.f;
        if (m0 == 0 || rel0 == 0 || rel0 == 1) a0 = 1e6f;
        if (rel1 == 0 || rel1 == 1) a1 = 1e6f; }
    LAS float* impw = (LAS float*)(lds + AL_IMP + ((w * 4 + tl2) * 32) * 4);
    *(LAS f32x2*)(impw + 2 * q) = (f32x2){a0, a1};
    asm volatile("s_waitcnt lgkmcnt(0)" ::: "memory");
    __builtin_amdgcn_wave_barrier();
    int rk0 = 0, rk1 = 0;
#pragma unroll
    for (int i4 = 0; i4 < 8; ++i4) { const f32x4 v = *(const LAS f32x4*)(impw + 4 * i4);
#pragma unroll
        for (int j = 0; j < 4; ++j) { const int mm = 4 * i4 + j; rk0 += (v[j] > a0 || (v[j] == a0 && mm < m0)) ? 1 : 0; rk1 += (v[j] > a1 || (v[j] == a1 && mm < m1)) ? 1 : 0; } }
    unsigned bits = (rk0 < 16 ? (1u << m0) : 0u) | (rk1 < 16 ? (1u << m1) : 0u);
    bits |= dpp_movu<0xB1>(bits); bits |= dpp_movu<0x4E>(bits); bits |= dpp_movu<0x141>(bits); bits |= dpp_movu<0x140>(bits);
    LAS unsigned* selw = (LAS unsigned*)(lds + AL_SEL + (w * 4) * 4);
    if (q == 0) selw[tl2] = bits;
    asm volatile("s_waitcnt lgkmcnt(0)" ::: "memory");
    __builtin_amdgcn_wave_barrier();
    const unsigned selm = selw[tl];
    asm volatile("s_waitcnt lgkmcnt(0)" ::: "memory");
    __builtin_amdgcn_wave_barrier();
    return selm;
}

__device__ __forceinline__ void nsa_attn_phase(LAS unsigned char* lds, const AttnArgs& A) {
    const int tid0 = tid_opaque();
    for (int u = blockIdx.x; u < 4096; u += gridDim.x) {
        int tid = tid0; asm volatile("" : "+v"(tid));
        const int lane = tid & 63, w = tid >> 6, n = lane & 15, gq = lane >> 4, tl = n >> 2, r = n & 3;
        const int kq = u >> 8, c = 2 * kq + ((((u >> 7) & 1) ^ kq) & 1), bgi = u & 127, b = bgi >> 2, g = bgi & 3, s0 = c * 64;
        int sq[2]; fp8x8 qf[2][2]; const float* gp[2];
#pragma unroll
        for (int ti = 0; ti < 2; ++ti) {
            sq[ti] = s0 + 8 * w + 4 * ti + tl;
            const size_t qrow = (size_t)b * SEQ + sq[ti];
            const unsigned char* qp = A.Q + qrow * 1024 + g * 256 + r * 64 + 8 * gq;
            qf[ti][0] = *(const fp8x8*)qp; qf[ti][1] = *(const fp8x8*)(qp + 32);
            gp[ti] = A.GATES + qrow * 48 + (g * 4 + r) * 3;
        }
        const unsigned char* KSg = A.KS + (size_t)b * SEQ * 256 + g * 64; const unsigned char* VSg = A.VST + (size_t)(b * 4 + g) * 64 * SEQ;
        const unsigned char* KWg = A.KW + (size_t)b * SEQ * 256 + g * 64; const unsigned char* VWg = A.VWT + (size_t)(b * 4 + g) * 64 * SEQ;
        __syncthreads();
        { const int key = tid >> 2, pc = tid & 3; *(LAS u32x4*)(lds + AL_KC + key * 80 + pc * 16) = ld16(A.KCMP + ((size_t)(b * 128 + key) * 4 + g) * 64 + pc * 16); }
        { const int d = tid >> 3, pc = tid & 7; *(LAS u32x4*)(lds + AL_VC + d * 144 + pc * 16) = ld16(A.VCMPT + ((size_t)(b * 4 + g) * 64 + d) * 128 + pc * 16); }
        { const bool isv = tid >= 256; const int st = tid & 255, srow = st >> 2, spc = st & 3;
            *(LAS u32x4*)(lds + (isv ? AL_VB : AL_KB) + srow * 80 + spc * 16) = ld16(isv ? VSg + (size_t)srow * SEQ + spc * 16 : KSg + (size_t)srow * 256 + spc * 16); }
        __syncthreads();
        LAS f32x4* otl = (LAS f32x4*)(lds + AL_OT) + w * 512 + lane;
        unsigned selm[2];
#pragma unroll
        for (int ti = 0; ti < 2; ++ti) { selm[ti] = attn_cmp_tile(lds, qf[ti][0], qf[ti][1], sq[ti], s0 + 8 * w + 4 * ti, gp[ti][0], otl + ti * 256, lane, w, n, gq, tl, r); }
        attn_branch<0>(lds, KSg, VSg, 0, c, true, qf, sq, selm, gp, otl, n, gq, tid);
        attn_branch<1>(lds, KWg, VWg, c >= 8 ? c - 8 : 0, c, false, qf, sq, selm, gp, otl, n, gq, tid);
#pragma unroll
        for (int ti = 0; ti < 2; ++ti) {
            unsigned char* op = A.O + ((size_t)b * SEQ + sq[ti]) * 1024 + g * 256 + r * 64 + 4 * gq;
#pragma unroll
            for (int dt = 0; dt < 4; ++dt) { const f32x4 o = otl[(ti * 4 + dt) * 64] * S8_O; unsigned pk = 0u;
                pk = __builtin_amdgcn_cvt_pk_fp8_f32(clamp8(o[0]), clamp8(o[1]), pk, false); pk = __builtin_amdgcn_cvt_pk_fp8_f32(clamp8(o[2]), clamp8(o[3]), pk, true);
                *(unsigned*)(op + 16 * dt) = pk; }
        }
    }
    __syncthreads();
}
#ifndef DBG_ZERO_KIND
#define DBG_ZERO_KIND -1
#endif
#ifndef F8IN_MASK
#define F8IN_MASK 1
#endif
struct Params { const float* in[31]; float* out; unsigned char* ws; int ph_lo, ph_hi; };
constexpr int N_PHASES = 38;

#ifndef DUP_MASK
#define DUP_MASK 0ull
#endif
#define PH_BEGIN(k) if ((k) >= p.ph_lo && (k) < p.ph_hi) { for (int rep_ = 0; rep_ < (((DUP_MASK >> (k)) & 1ull) ? 2 : 1); ++rep_) {
#define PH_END(k) } if ((k) + 1 < p.ph_hi) xcd_barrier(bar); }

template <int LAYER>
__device__ __forceinline__ void layer_body(const Params& p, LAS unsigned char* lds, const XcdBarrier& bar) {
    constexpr int kind = LAYER % 3, j = LAYER / 3;
    constexpr int PB = LAYER == 0 ? 1 : (LAYER == 1 ? 10 : (LAYER == 2 ? 18 : 29));
    constexpr int NMIX = kind == 0 ? 4 : (kind == 1 ? 3 : 6);
    unsigned char* ws = p.ws;
    const int G = gridDim.x, cblk = blockIdx.x;
    const int* positions = (const int*)p.in[1];
    unsigned char* XA = ws + WS_XA; float* XF = p.out; bf16_t* MB = (bf16_t*)(ws + B_MB);
    int* route_e = (int*)(ws + WS_ROUTE_E); float* route_w = (float*)(ws + WS_ROUTE_W); int* posb = (int*)(ws + WS_POS); int* cnt = (int*)(ws + WS_CNT);
    int4* tiles = (int4*)(ws + WS_TILE); float* bias1 = (float*)(ws + WS_BIAS1);
    if constexpr (kind == 0) {
        unsigned char* Q = ws + B_Q; bf16_t* KC = (bf16_t*)(ws + B_KC); bf16_t* VC = (bf16_t*)(ws + B_VC); unsigned char* KS = ws + B_KS; unsigned char* VST = ws + B_VST;
        unsigned char* KW = ws + B_KW; unsigned char* VWT = ws + B_VWT; unsigned char* OB = ws + B_O;
        float* GATES = (float*)(ws + WS_GATES); unsigned char* KCMP = ws + WS_KCMP; unsigned char* VCMPT = ws + WS_VCMPT;
        PH_BEGIN(PB + 0)
            EpiNsaIn E{Q, KC, VC, KS, VST, KW, VWT, GATES, positions, p.in[3] + j * 48};
            if constexpr (F8IN_MASK & 1) { DenseSched8 S{XA, ws + W_NSA_IN + (size_t)j * NSA_NP * 1024, 1024, 1024, T_TOK / 256, NSA_NP / 256, G, cblk};
                gemm_phase<true>(lds, 1024, 1024, 1024, S, E, 1.f / (S8_X * S8_WI)); }
            else { DenseSched S{(const bf16_t*)XA, (const bf16_t*)(ws + W_NSA_IN) + (size_t)j * NSA_NP * 1024, 1024, 1024, T_TOK / 256, NSA_NP / 256, G, cblk};
                gemm_phase<false>(lds, 1024, 1024, 1024, S, E); }
        PH_END(PB + 0)
        PH_BEGIN(PB + 1)
            nsa_compress_phase(KC, VC, (const bf16_t*)(ws + W_CMP1) + (size_t)j * 2 * 64 * 2048, p.in[6] + j * 4096, p.in[9] + j * 4096, bias1 + j * 128, positions, KCMP, VCMPT);
        PH_END(PB + 1)
        PH_BEGIN(PB + 2)
            AttnArgs A{Q, KS, VST, KW, VWT, KCMP, VCMPT, GATES, OB};
            nsa_attn_phase(lds, A);
        PH_END(PB + 2)
        PH_BEGIN(PB + 3)
            DenseSched8 S{OB, ws + W_NSA_OUT + (size_t)j * 1024 * 1024, 1024, 1024, T_TOK / 256, 4, G, cblk};
            EpiPlain<false> E{MB, 1024, 1.f / (S8_O * S8_WO)};
            gemm_phase<true>(lds, 1024, 1024, 1024, S, E);
        PH_END(PB + 3)
    } else if constexpr (kind == 1) {
        bf16_t* P = (bf16_t*)(ws + B_P); bf16_t* BGb = (bf16_t*)(ws + B_BG); bf16_t* Y = (bf16_t*)(ws + B_Y);
        PH_BEGIN(PB + 0)
            EpiScIn E{P, BGb};
            if constexpr (F8IN_MASK & 2) { DenseSched8 S{XA, ws + W_SC_IN, 1024, 1024, T_TOK / 256, 12, G, cblk};
                gemm_phase<true>(lds, 1024, 1024, 1024, S, E, 1.f / (S8_X * S8_WI)); }
            else { DenseSched S{(const bf16_t*)XA, (const bf16_t*)(ws + W_SC_IN), 1024, 1024, T_TOK / 256, 12, G, cblk};
                gemm_phase<false>(lds, 1024, 1024, 1024, S, E); }
        PH_END(PB + 0)
        PH_BEGIN(PB + 1)
            sc_conv_phase(P, BGb, Y, p.in[12], p.in[13]);
        PH_END(PB + 1)
        PH_BEGIN(PB + 2)
            DenseSched S{Y, (const bf16_t*)(ws + W_SC_OUT), 1024, 1024, T_TOK / 256, 4, G, cblk};
            EpiPlain<false> E{MB, 1024, 1.f};
            gemm_phase<false>(lds, 1024, 1024, 1024, S, E);
        PH_END(PB + 2)
    } else {
        bf16_t* GG = (bf16_t*)(ws + B_GG); bf16_t* R1 = (bf16_t*)(ws + B_R1); bf16_t* R2 = (bf16_t*)(ws + B_R2); bf16_t* R3 = (bf16_t*)(ws + B_R3);
        f32x4* carry = (f32x4*)(ws + WS_CARRY);
        PH_BEGIN(PB + 0)
            EpiLruIn E{GG, R1};
            if constexpr (F8IN_MASK & 4) { DenseSched8 S{XA, ws + W_LRU_IN, 1024, 1024, T_TOK / 256, 10, G, cblk};
                gemm_phase<true>(lds, 1024, 1024, 1024, S, E, 1.f / (S8_X * S8_WI)); }
            else { DenseSched S{(const bf16_t*)XA, (const bf16_t*)(ws + W_LRU_IN), 1024, 1024, T_TOK / 256, 10, G, cblk};
                gemm_phase<false>(lds, 1024, 1024, 1024, S, E); }
        PH_END(PB + 0)
        PH_BEGIN(PB + 1)
            lru_conv_phase(R1, R2, p.in[16], p.in[17]);
        PH_END(PB + 1)
        PH_BEGIN(PB + 2)
            BandSched S{R2, (const bf16_t*)(ws + W_LRU_G), LRU_W, LRU_W, T_TOK / 256, 10, G, cblk};
            EpiLruGate E{R2, R1, R3, p.in[19], p.in[21], p.in[22]};
            gemm_phase<false>(lds, 384, LRU_W, LRU_W, S, E);
        PH_END(PB + 2)
        PH_BEGIN(PB + 3)
            lru_scan1_phase(R1, R3, carry);
        PH_END(PB + 3)
        PH_BEGIN(PB + 4)
            lru_scan2_phase(R1, R3, GG, carry, R2);
        PH_END(PB + 4)
        PH_BEGIN(PB + 5)
            DenseSched S{R2, (const bf16_t*)(ws + W_LRU_OUT), LRU_W, LRU_W, T_TOK / 256, 4, G, cblk};
            EpiPlain<false> E{MB, 1024, 1.f};
            gemm_phase<false>(lds, LRU_W, LRU_W, LRU_W, S, E);
        PH_END(PB + 5)
    }
    constexpr int FB = PB + NMIX;
    unsigned char* X8 = ws + B_XG; int* invb = (int*)(ws + WS_INV); unsigned char* HID = ws + B_HID; unsigned char* YM = ws + B_YM; unsigned char* WGU = ws + B_WMOE + WMOE_GU; unsigned char* WDN = ws + B_WMOE + WMOE_DN;
    const float* lng = p.in[29] + (size_t)LAYER * 2048; const float* lnb = p.in[30] + (size_t)LAYER * 2048;
    PH_BEGIN(FB + 0)
#if defined(SHADOW_LN) && (SHADOW_LN & 1)
        ln1_router_phase(lds, LAYER == 0 ? p.in[0] : (const float*)XF, MB, (float*)(ws + WS_BIG + 192 * MiB), ws + WS_BIG + 448 * MiB, lng, lnb, p.in[24], p.in[25], (int*)(ws + WS_BIG + 300 * MiB), (float*)(ws + WS_BIG + 302 * MiB), (int*)(ws + WS_BIG + 304 * MiB));
#endif
        ln1_router_phase(lds, LAYER == 0 ? p.in[0] : (const float*)XF, MB, XF, X8, lng, lnb, p.in[24], p.in[25], route_e, route_w, cnt);
    PH_END(FB + 0)
    PH_BEGIN(FB + 1)
        moe_gather_phase(lds, route_e, cnt, posb, invb, tiles);
        convert_wt<true>(lds, WGU, 16, 2048, 1024, FetchPair{p.in[26] + (size_t)LAYER * 16 * 1048576, (long)(p.in[27] - p.in[26]), 1024, (size_t)1048576}, S8_WGU);
        convert_wt<true>(lds, WDN, 16, 1024, 1024, FetchPlain{p.in[28] + (size_t)LAYER * 16 * 1048576, 1024, (size_t)1048576}, S8_WD);
    PH_END(FB + 1)
    PH_BEGIN(FB + 2)
        const int NT = __builtin_amdgcn_readfirstlane(tiles[0].x);
        MoeSched S{X8, WGU, tiles, invb, NT, 8, 2048, 1024, G, cblk};
        EpiMoeGU E{HID};
        gemm_phase<true, true>(lds, 1024, 1024, 1024, S, E);
    PH_END(FB + 2)
    PH_BEGIN(FB + 3)
        const int NT = __builtin_amdgcn_readfirstlane(tiles[0].x);
        MoeSched S{HID, WDN, tiles, invb, NT, 4, 1024, 1024, G, cblk};
        EpiMoeDown8 E{YM, S8_Y / (S8_H * S8_WD)};
        gemm_phase<true>(lds, 1024, 1024, 1024, S, E);
    PH_END(FB + 3)
    PH_BEGIN(FB + 4)
#if defined(SHADOW_LN) && (SHADOW_LN & 2)
        ln2_combine_phase<LAYER == DEPTH - 1, ((F8IN_MASK >> ((LAYER + 1) % 3)) & 1) != 0>(XF, (float*)(ws + B_XG), YM, posb, route_w, lng + 1024, lnb + 1024, ws + WS_BIG + 512 * MiB);
#endif
        ln2_combine_phase<LAYER == DEPTH - 1, ((F8IN_MASK >> ((LAYER + 1) % 3)) & 1) != 0>(XF, XF, YM, posb, route_w, lng + 1024, lnb + 1024, XA);
    PH_END(FB + 4)
}

__global__ void __launch_bounds__(NTHR, 2) hybrid_fwd(Params p) {
    extern __shared__ __attribute__((aligned(16))) unsigned char lds_raw[];
    LAS unsigned char* lds = (LAS unsigned char*)lds_raw;
    volatile LAS unsigned* bst = (volatile LAS unsigned*)(lds + LDS_BYTES - 16);
    const bool use_bar = (p.ph_hi - p.ph_lo) > 1;
    if (threadIdx.x == 0) { bst[0] = 0u; bst[1] = 0u; bst[2] = 0u; bst[3] = 0u; }
    __syncthreads();
    XcdBarrier bar; bar.bar = (unsigned*)(p.ws + WS_CTL); bar.x = 0; bar.st = bst;
    if (use_bar) bar = xcd_barrier_post((unsigned*)(p.ws + WS_CTL), bst);
    PH_BEGIN(0)
        unsigned char* ws = p.ws;
        convert_x<(F8IN_MASK & 1) != 0>(p.in[0], ws + WS_XA);
        for (int j = 0; j < 2; ++j) {
            if constexpr (F8IN_MASK & 1) convert_wt<true>(lds, ws + W_NSA_IN + (size_t)j * NSA_NP * 1024, 1, NSA_NP, 1024, FetchNsaIn{p.in[2] + (size_t)j * 1024 * 2608}, S8_WI);
            else convert_wt(lds, (bf16_t*)(ws + W_NSA_IN) + (size_t)j * NSA_NP * 1024, 1, NSA_NP, 1024, FetchNsaIn{p.in[2] + (size_t)j * 1024 * 2608});
            convert_wt<true>(lds, ws + W_NSA_OUT + (size_t)j * 1024 * 1024, 1, 1024, 1024, FetchPlain{p.in[10] + (size_t)j * 1024 * 1024, 1024, 0}, S8_WO);
            convert_wt(lds, (bf16_t*)(ws + W_CMP1) + (size_t)(j * 2 + 0) * 64 * 2048, 1, 64, 2048, FetchIdent{p.in[5] + (size_t)j * 2048 * 64, 64, 0});
            convert_wt(lds, (bf16_t*)(ws + W_CMP1) + (size_t)(j * 2 + 1) * 64 * 2048, 1, 64, 2048, FetchIdent{p.in[8] + (size_t)j * 2048 * 64, 64, 0});
        }
        if constexpr (F8IN_MASK & 2) convert_wt<true>(lds, ws + W_SC_IN, 1, 3072, 1024, FetchScIn{p.in[11]}, S8_WI); else convert_wt(lds, (bf16_t*)(ws + W_SC_IN), 1, 3072, 1024, FetchScIn{p.in[11]});
        convert_wt(lds, (bf16_t*)(ws + W_SC_OUT), 1, 1024, 1024, FetchPlain{p.in[14], 1024, 0});
        if constexpr (F8IN_MASK & 4) convert_wt<true>(lds, ws + W_LRU_IN, 1, 2560, 1024, FetchPlain{p.in[15], 2560, 0}, S8_WI); else convert_wt(lds, (bf16_t*)(ws + W_LRU_IN), 1, 2560, 1024, FetchPlain{p.in[15], 2560, 0});
        convert_wt(lds, (bf16_t*)(ws + W_LRU_G), 1, 2560, 1280, FetchLruGate{p.in[18], (long)(p.in[20] - p.in[18])});
        convert_wt(lds, (bf16_t*)(ws + W_LRU_OUT), 1, 1024, 1280, FetchPlain{p.in[23], 1024, 0});
        cmp_bias_phase(lds, p.in[4], p.in[5], p.in[7], p.in[8], (float*)(ws + WS_BIAS1));
    PH_END(0)
    layer_body<0>(p, lds, bar);
    layer_body<1>(p, lds, bar);
    layer_body<2>(p, lds, bar);
    layer_body<3>(p, lds, bar);
}
#undef PH_BEGIN
#undef PH_END

#ifndef MK_SPLIT
#define MK_SPLIT 0
#endif
extern "C" void kernel_launch(void* const* d_in, const int* in_sizes, int n_in, void* d_out, int out_size, void* d_ws, size_t ws_size, hipStream_t stream) {
    static int grid = 0;
    if (grid == 0) {
        int dev = 0, cus = 0, per_cu = 0;
        if (n_in != 31 || ws_size < WS_END) { fprintf(stderr, "kernel_launch: unexpected n_in %d or ws_size %zu (need %zu)\n", n_in, ws_size, (size_t)WS_END); grid = -1; return; }
        if (hipGetDevice(&dev) != hipSuccess || hipDeviceGetAttribute(&cus, hipDeviceAttributeMultiprocessorCount, dev) != hipSuccess) { grid = -1; return; }
        if (hipFuncSetAttribute((const void*)hybrid_fwd, hipFuncAttributeMaxDynamicSharedMemorySize, LDS_BYTES) != hipSuccess) { fprintf(stderr, "kernel_launch: hipFuncSetAttribute failed\n"); grid = -1; return; }
        if (hipOccupancyMaxActiveBlocksPerMultiprocessor(&per_cu, (const void*)hybrid_fwd, NTHR, LDS_BYTES) != hipSuccess || per_cu < 1) fprintf(stderr, "kernel_launch: occupancy query says %d\n", per_cu);
        (void)hipGetLastError();
        grid = cus;
    }
    if (grid < 0) return;
    (void)hipMemsetAsync((char*)d_ws + WS_CTL, 0, 64 * 1024, stream);
    Params p{};
    for (int i = 0; i < 31; ++i) p.in[i] = (const float*)d_in[i];
    p.out = (float*)d_out; p.ws = (unsigned char*)d_ws;
#if MK_SPLIT
    for (int ph = 0; ph < N_PHASES; ++ph) { p.ph_lo = ph; p.ph_hi = ph + 1; hipLaunchKernelGGL(hybrid_fwd, dim3(grid), dim3(NTHR), LDS_BYTES, stream, p); }
#else
    p.ph_lo = 0; p.ph_hi = N_PHASES;
    hipLaunchKernelGGL(hybrid_fwd, dim3(grid), dim3(NTHR), LDS_BYTES, stream, p);
#endif
    const hipError_t le = hipPeekAtLastError();
    if (le != hipSuccess) fprintf(stderr, "kernel_launch: launch failed: %s\n", hipGetErrorName(le));
}
```

```cpp
#include <hip/hip_runtime.h>
#include <stdint.h>
#include <stdio.h>

#define LAS __attribute__((address_space(3)))
typedef unsigned short bf16_t;
typedef short bf16x8 __attribute__((ext_vector_type(8)));
typedef float f32x4 __attribute__((ext_vector_type(4)));
typedef float f32x2 __attribute__((ext_vector_type(2)));
typedef unsigned u32x4 __attribute__((ext_vector_type(4)));
typedef unsigned u32x2 __attribute__((ext_vector_type(2)));
typedef int i32x8 __attribute__((ext_vector_type(8)));

constexpr int T_TOK = 65536, DM = 1024, SEQ = 2048, NBATCH = 32, DEPTH = 4;
constexpr int NTHR = 512;
constexpr int NSA_NP = 2816;
constexpr int LRU_W = 1280;
constexpr int NEXP = 16;
constexpr float DN_ALPHA = 1.6817928305074292f;
constexpr float LN_EPS = 1e-5f;
constexpr float NEGBIG = -1e30f;
constexpr float LOG2E = 1.4426950408889634f;

constexpr size_t KiB = 1024, MiB = 1024 * 1024;
constexpr size_t WS_CTL = 0;
constexpr size_t WS_ROUTE_E = 64 * KiB;
constexpr size_t WS_ROUTE_W = WS_ROUTE_E + 256 * KiB;
constexpr size_t WS_POS = WS_ROUTE_W + 512 * KiB;
constexpr size_t WS_CNT = WS_POS + 512 * KiB;
constexpr size_t WS_TILE = WS_CNT + 16 * KiB;
constexpr size_t WS_BIAS1 = WS_TILE + 16 * KiB;
constexpr size_t WS_INV = 1408 * KiB;
constexpr size_t WS_KCMP = 2 * MiB;
constexpr size_t WS_VCMPT = 4 * MiB;
constexpr size_t WS_CARRY = 6 * MiB;
constexpr size_t WS_GATES = 16 * MiB;
constexpr size_t WS_W = 28 * MiB;
constexpr size_t W_NSA_IN = WS_W;
constexpr size_t W_NSA_OUT = W_NSA_IN + 2 * (size_t)NSA_NP * 1024 * 2;
constexpr size_t W_SC_IN = W_NSA_OUT + 2 * (size_t)1024 * 1024 * 2;
constexpr size_t W_SC_OUT = W_SC_IN + (size_t)3072 * 1024 * 2;
constexpr size_t W_LRU_IN = W_SC_OUT + (size_t)1024 * 1024 * 2;
constexpr size_t W_LRU_G = W_LRU_IN + (size_t)2560 * 1024 * 2;
constexpr size_t W_LRU_OUT = W_LRU_G + (size_t)2560 * 1280 * 2;
constexpr size_t W_CMP1 = W_LRU_OUT + (size_t)1024 * 1280 * 2;
constexpr size_t W_END = W_CMP1 + 4 * (size_t)64 * 2048 * 2;
constexpr size_t WS_XA = 66 * MiB;
constexpr size_t WS_WMOE = WS_XA + 128 * MiB;
constexpr size_t WS_BIG = WS_WMOE + 96 * MiB;
constexpr size_t WS_END = WS_BIG + 642 * MiB;
static_assert(W_END <= WS_XA, "weights overflow");
constexpr size_t B_Q = WS_BIG, B_KC = B_Q + 128 * MiB, B_VC = B_KC + 32 * MiB, B_KS = B_VC + 32 * MiB, B_VST = B_KS + 32 * MiB, B_KW = B_VST + 32 * MiB,
                 B_VWT = B_KW + 32 * MiB, B_O = B_VWT + 32 * MiB;
constexpr size_t B_P = WS_BIG, B_BG = B_P + 128 * MiB, B_Y = B_BG + 128 * MiB;
constexpr size_t B_GG = WS_BIG, B_R1 = B_GG + 160 * MiB, B_R2 = B_R1 + 160 * MiB, B_R3 = B_R2 + 160 * MiB;
constexpr size_t B_MB = WS_BIG;
constexpr size_t B_XG = WS_BIG + 128 * MiB, B_HID = B_XG + 64 * MiB, B_YM = B_HID + 128 * MiB, B_WMOE = WS_WMOE;
constexpr size_t WMOE_GU = 0, WMOE_DN = (size_t)16 * 2048 * 1024;
constexpr float S8_X = 16.f, S8_WGU = 256.f, S8_H = 16.f, S8_WD = 512.f, S8_Y = 128.f, S8_WI = 256.f, S8_O = 32.f, S8_WO = 512.f, S8_Q = 4.f, S8_K = 0.25f;

constexpr int LDS_BYTES = 163840;

__device__ __forceinline__ unsigned cvt_pk_bf16(float lo, float hi) { unsigned r; asm volatile("v_cvt_pk_bf16_f32 %0, %1, %2" : "=v"(r) : "v"(lo), "v"(hi)); return r; }
__device__ __forceinline__ float bf_lo(unsigned u) { return __uint_as_float(u << 16); }
__device__ __forceinline__ float bf_hi(unsigned u) { return __uint_as_float(u & 0xffff0000u); }
__device__ __forceinline__ float bf2f(bf16_t h) { return __uint_as_float(((unsigned)h) << 16); }
__device__ __forceinline__ bf16_t f2bf(float f) { return (bf16_t)(cvt_pk_bf16(f, 0.f) & 0xffffu); }
__device__ __forceinline__ float fast_exp2(float x) { return __builtin_amdgcn_exp2f(x); }
__device__ __forceinline__ float fast_exp(float x) { return __builtin_amdgcn_exp2f(x * LOG2E); }
__device__ __forceinline__ float fast_rcp(float x) { return __builtin_amdgcn_rcpf(x); }
__device__ __forceinline__ float sigmoidf_(float x) { return fast_rcp(1.f + fast_exp(-x)); }
__device__ __forceinline__ float gelu_tanh(float x) { const float u = 0.7978845608028654f * (x + 0.044715f * x * x * x); return x * fast_rcp(1.f + fast_exp(-2.f * u)); }
__device__ __forceinline__ float silu_(float x) { return x * fast_rcp(1.f + fast_exp(-x)); }
__device__ __forceinline__ void sincos_rad(float ang, float& s, float& c) {
    float r = ang * 0.15915494309189535f; r = __builtin_amdgcn_fractf(r); s = __builtin_amdgcn_sinf(r); c = __builtin_amdgcn_cosf(r); }
__device__ __forceinline__ float wave_sum(float v) {
#pragma unroll
    for (int o = 32; o >= 1; o >>= 1) v += __shfl_xor(v, o);
    return v; }
template <int CTRL> __device__ __forceinline__ float dpp_mov(float v) { return __builtin_bit_cast(float, __builtin_amdgcn_update_dpp(0, __builtin_bit_cast(int, v), CTRL, 0xf, 0xf, false)); }
template <int CTRL> __device__ __forceinline__ unsigned dpp_movu(unsigned v) { return (unsigned)__builtin_amdgcn_update_dpp(0, (int)v, CTRL, 0xf, 0xf, false); }
__device__ __forceinline__ float row16_sum(float v) { v += dpp_mov<0xB1>(v); v += dpp_mov<0x4E>(v); v += dpp_mov<0x141>(v); v += dpp_mov<0x140>(v); return v; }
__device__ __forceinline__ float wave_sum_dpp(float v) { v = row16_sum(v); v += __shfl_xor(v, 16); v += __shfl_xor(v, 32); return v; }
__device__ __forceinline__ int tid_opaque() { int t = threadIdx.x; asm volatile("" : "+v"(t)); return t; }
__device__ __forceinline__ u32x4 ld16(const void* p) { return *(const u32x4*)p; }
__device__ __forceinline__ void st16(void* p, u32x4 v) { *(u32x4*)p = v; }

#define XB_TMO      128
#define XB_XCNT(j)  (256  + 64 * (j))
#define XB_XSUB(j)  (1280 + 64 * (j))
#define XB_XGEN(j)  (2304 + 64 * (j))
#define XB_TOP      3328
#define XB_TOPGEN   3392
#define XCD_BAR_WORDS 3456
#define XB_SPIN_CAP (1u << 22)
__device__ __forceinline__ unsigned xb_ld(unsigned* p)              { return __hip_atomic_load(p, __ATOMIC_RELAXED, __HIP_MEMORY_SCOPE_AGENT); }
__device__ __forceinline__ unsigned xb_add(unsigned* p, unsigned v) { return __hip_atomic_fetch_add(p, v, __ATOMIC_RELAXED, __HIP_MEMORY_SCOPE_AGENT); }
__device__ __forceinline__ unsigned xb_xcc_id() { return (unsigned)__builtin_amdgcn_s_getreg((3 << 11) | 20) & 0xFu; }
#define XB_SPIN(cond, bar) do { unsigned _sp = 0; while (cond) { __builtin_amdgcn_s_sleep(1); \
    if ((++_sp & 255u) == 0u) { if (xb_ld(&(bar)[XB_TMO])) break; if (_sp > XB_SPIN_CAP) { atomicAdd(&(bar)[XB_TMO], 1u); break; } } } } while (0)
struct XcdBarrier { unsigned* bar; unsigned x; volatile LAS unsigned* st; };
__device__ __forceinline__ XcdBarrier xcd_barrier_post(unsigned* bar, volatile LAS unsigned* st) {
    XcdBarrier b; b.bar = bar; b.x = xb_xcc_id(); b.st = st;
    if (threadIdx.x == 0) (void)xb_add(&bar[XB_XCNT(b.x)], 1u);
    return b;
}
__device__ __forceinline__ void xcd_barrier_complete(unsigned* bar, unsigned x, unsigned& nloc, unsigned& nx) {
    const unsigned G = gridDim.x * gridDim.y * gridDim.z;
    unsigned sum, cnt, mine, sp = 0u;
    for (;;) {
        sum = 0u; cnt = 0u; mine = 0u;
#pragma unroll
        for (unsigned j = 0; j < 16; ++j) { const unsigned c = xb_ld(&bar[XB_XCNT(j)]); sum += c; cnt += (c > 0u) ? 1u : 0u; mine = (j == x) ? c : mine; }
        if (sum == G) break;
        __builtin_amdgcn_s_sleep(1);
        if ((++sp & 255u) == 0u) { if (xb_ld(&bar[XB_TMO])) break; if (sp > XB_SPIN_CAP) { atomicAdd(&bar[XB_TMO], 1u); break; } }
    }
    nloc = mine > 0u ? mine : 1u; nx = cnt > 0u ? cnt : 1u;
}
__device__ __forceinline__ void xcd_barrier(const XcdBarrier& b) {
    asm volatile("s_waitcnt vmcnt(0)" ::: "memory");
    __syncthreads();
    if (threadIdx.x == 0) {
        unsigned* bar = b.bar;
        __builtin_amdgcn_s_waitcnt(0);
        unsigned nloc = b.st[0], nx = b.st[1];
        if (nloc == 0u) { xcd_barrier_complete(bar, b.x, nloc, nx); b.st[0] = nloc; b.st[1] = nx; }
        const unsigned old = xb_add(&bar[XB_XSUB(b.x)], 1u);
        const unsigned gen = old / nloc;
        if (old + 1u == (gen + 1u) * nloc) {
            __builtin_amdgcn_fence(__ATOMIC_RELEASE, "agent");
            asm volatile("s_waitcnt vmcnt(0)" ::: "memory");
            const unsigned og = xb_add(&bar[XB_TOP], 1u);
            const unsigned tg = og / nx;
            if (og + 1u == (tg + 1u) * nx) xb_add(&bar[XB_TOPGEN], 1u);
            else XB_SPIN(xb_ld(&bar[XB_TOPGEN]) == tg, bar);
            __builtin_amdgcn_fence(__ATOMIC_ACQUIRE, "agent");
            xb_add(&bar[XB_XGEN(b.x)], 1u);
            asm volatile("s_waitcnt vmcnt(0)" ::: "memory");
        } else {
            XB_SPIN(xb_ld(&bar[XB_XGEN(b.x)]) == gen, bar);
            __builtin_amdgcn_fence(__ATOMIC_ACQUIRE, "agent");
            asm volatile("s_waitcnt vmcnt(0)" ::: "memory");
        }
    }
    __syncthreads();
}

constexpr int BM = 256, BK = 64, HALF = 128, HTB = HALF * BK * 2, STAGE_BYTES = 8 * HTB, NXCD = 8, WGM = 8;
__host__ __device__ __forceinline__ int lds_byte(int r, int c) { const int st = (r >> 4) * 2 + (c >> 5), rr = r & 15, cc = c & 31, ob = rr * 64 + cc * 2; return st * 1024 + (ob ^ (((ob >> 9) & 1) << 5)); }
__host__ __device__ __forceinline__ void stage_rc(int b, int& R, int& C) { const int st = b / 1024, sb = b % 1024, swz = sb ^ (((sb >> 9) & 1) << 5); R = (st >> 1) * 16 + swz / 64; C = (st & 1) * 32 + (swz % 64) / 2; }

struct GUnit { const char* a; const char* b; int pn; int row0; int nrows; int aux; };
__device__ __forceinline__ void map_unit(int L, int nM, int nN, int& pm, int& pn) {
    const int nwg = nM * nN; int wgid = L;
    { const int q = nwg / NXCD, r = nwg % NXCD, xcd = wgid % NXCD, off = wgid / NXCD; wgid = (xcd < r ? xcd * (q + 1) : r * (q + 1) + (xcd - r) * q) + off; }
    const int nig = WGM * nN, gid = wgid / nig, fm = gid * WGM, gsz = (nM - fm) < WGM ? (nM - fm) : WGM;
    pm = fm + ((wgid % nig) % gsz); pn = (wgid % nig) / gsz;
}
struct DenseSched {
    const bf16_t* A; const bf16_t* Bt; int lda, K, nM, nN, G, c;
    __device__ __forceinline__ bool next(int i, GUnit& u) const {
        const long L = (long)i * G + c; if (L >= (long)nM * nN) return false;
        int pm, pn; map_unit((int)L, nM, nN, pm, pn);
        u.a = (const char*)(A + (size_t)pm * BM * lda); u.b = (const char*)(Bt + (size_t)pn * BM * K); u.pn = pn; u.row0 = pm * BM; u.nrows = BM; u.aux = 0; return true;
    }
};
struct DenseSched8 {
    const unsigned char* A; const unsigned char* Bt; int lda, K, nM, nN, G, c;
    __device__ __forceinline__ bool next(int i, GUnit& u) const {
        const long L = (long)i * G + c; if (L >= (long)nM * nN) return false;
        int pm, pn; map_unit((int)L, nM, nN, pm, pn);
        u.a = (const char*)(A + (size_t)pm * BM * lda); u.b = (const char*)(Bt + (size_t)pn * BM * K); u.pn = pn; u.row0 = pm * BM; u.nrows = BM; u.aux = 0; return true;
    }
};
struct BandSched {
    const bf16_t* A; const bf16_t* Bt; int lda, ldb, nM, nN, G, c;
    __device__ __forceinline__ bool next(int i, GUnit& u) const {
        const long L = (long)i * G + c; if (L >= (long)nM * nN) return false;
        int pm, pn; map_unit((int)L, nM, nN, pm, pn);
        int k0 = ((128 * pn / 80) * 80 / 64) * 64; k0 = k0 > ldb - 384 ? ldb - 384 : k0;
        u.a = (const char*)(A + (size_t)pm * BM * lda + k0); u.b = (const char*)(Bt + (size_t)pn * BM * ldb + k0); u.pn = pn; u.row0 = pm * BM; u.nrows = BM; u.aux = 0; return true;
    }
};
struct MoeSched {
    const unsigned char* A; const unsigned char* W; const int4* tiles; const int* inv; int NT, nN, N, K, G, c;
    __device__ __forceinline__ bool next(int i, GUnit& u) const {
        const long L = (long)i * G + c; if (L >= (long)NT * nN) return false;
        int pm, pn; map_unit((int)L, NT, nN, pm, pn);
        const int4 t = tiles[1 + pm];
        const int e = __builtin_amdgcn_readfirstlane(t.x), r0 = __builtin_amdgcn_readfirstlane(t.y), nr = __builtin_amdgcn_readfirstlane(t.z);
        u.a = (const char*)(A + (size_t)r0 * K); u.b = (const char*)(W + ((size_t)e * N + (size_t)pn * BM) * K); u.pn = pn; u.row0 = r0; u.nrows = nr; u.aux = e; return true;
    }
};

template <bool F8, bool GATHER = false, class Epi, class Sched>
__device__ __forceinline__ void gemm_phase(LAS unsigned char* lds, const int K  , const int lda, const int ldb  , const Sched& S, const Epi& E, const float accs = 1.f  ) {
    const int tid = tid_opaque(), wid = __builtin_amdgcn_readfirstlane(tid >> 6), lane = tid & 63, wr = wid >> 2, wc = wid & 3, fr = lane & 15, fq = lane >> 4;
    const int nt = F8 ? K / 128 : K / BK;
    unsigned voffA[2], voffB[2];
#pragma unroll
    for (int i = 0; i < 2; ++i) { int R, C; stage_rc(tid * 16 + i * 8192, R, C); voffA[i] = F8 ? (unsigned)(R * lda + 2 * C) : (unsigned)(R * lda + C) * 2u; voffB[i] = F8 ? (unsigned)(R * ldb + 2 * C) : (unsigned)(R * ldb + C) * 2u; }
    int gR[2]; unsigned gC[2]; unsigned vc[2][2], vn[2][2];
#pragma unroll
    for (int i = 0; i < 2; ++i) { int R, C; stage_rc(tid * 16 + i * 8192, R, C); gR[i] = R; gC[i] = 2u * (unsigned)C; }
#define PG8_GLOAD(dst, unit) do { if constexpr (GATHER) { _Pragma("unroll") for (int _h = 0; _h < 2; ++_h) _Pragma("unroll") for (int _i = 0; _i < 2; ++_i) \
        dst[_h][_i] = (unsigned)S.inv[(unit).row0 + _h * HALF + gR[_i]] * (unsigned)lda + gC[_i]; } } while (0)
#define PG8_STAGE_A(bufoff, h, kofs, unext) do { if constexpr (GATHER) { _Pragma("unroll") for (int _i = 0; _i < 2; ++_i) \
        __builtin_amdgcn_global_load_lds((const unsigned*)((const char*)S.A + (kofs) + ((unext) ? vn[h][_i] : vc[h][_i])), (LAS unsigned*)(lds + (bufoff) + ldsw + _i * 8192), 16, 0, 0); } \
        else PG8_STAGE(bufoff, ((unext) ? nA : cA) + (h) * hstepA + (kofs), voffA); } while (0)
    const size_t kstep = (size_t)(BK * 2);
    const size_t hstepA = (size_t)HALF * lda * (F8 ? 1 : 2), hstepB = (size_t)HALF * ldb * (F8 ? 1 : 2);
    const unsigned ldsw = (unsigned)wid * 1024u;
    const int aoff = lds_byte(wr * 64 + fr, fq * 8), boff = lds_byte(wc * 32 + fr, fq * 8);
    const LAS unsigned char* ldsA = lds + aoff; const LAS unsigned char* ldsB = lds + 65536 + boff;
#define PG8_SA(b, h) (((b) * 2 + (h)) * HTB)
#define PG8_SB(b, h) ((4 + (b) * 2 + (h)) * HTB)
#define PG8_STAGE(bufoff, gbase, voff) do { _Pragma("unroll") for (int _i = 0; _i < 2; ++_i) \
        __builtin_amdgcn_global_load_lds((const unsigned*)((const char*)(gbase) + (voff)[_i]), (LAS unsigned*)(lds + (bufoff) + ldsw + _i * 8192), 16, 0, 0); } while (0)
#define PG8_LD16(off) (*(const LAS u32x4*)(lds + (off)))
#define PG8_LDA16(off) (*(const LAS u32x4*)(ldsA + (off)))
#define PG8_LDB16(off) (*(const LAS u32x4*)(ldsB + (off)))
#define PG8_LDA(dst, b, h) do { _Pragma("unroll") for (int m = 0; m < 4; ++m) { \
        if constexpr (F8) dst##8[m] = __builtin_shufflevector(PG8_LDA16(PG8_SA(b, h) + m * 2048), PG8_LDA16(PG8_SA(b, h) + m * 2048 + 1024), 0, 1, 2, 3, 4, 5, 6, 7); \
        else { _Pragma("unroll") for (int k = 0; k < 2; ++k) dst[m][k] = *(const LAS bf16x8*)(lds + PG8_SA(b, h) + aoff + m * 2048 + k * 1024); } } } while (0)
#define PG8_LDB(dst, b, h) do { _Pragma("unroll") for (int n = 0; n < 2; ++n) { \
        if constexpr (F8) dst##8[n] = __builtin_shufflevector(PG8_LDB16(PG8_SB(b, h) - 65536 + n * 2048), PG8_LDB16(PG8_SB(b, h) - 65536 + n * 2048 + 1024), 0, 1, 2, 3, 4, 5, 6, 7); \
        else { _Pragma("unroll") for (int k = 0; k < 2; ++k) dst[n][k] = *(const LAS bf16x8*)(lds + PG8_SB(b, h) + boff + n * 2048 + k * 1024); } } } while (0)
#define PG8_MMA(ai, bj, At, Bt) do { __builtin_amdgcn_s_setprio(1); _Pragma("unroll") for (int m = 0; m < 4; ++m) _Pragma("unroll") for (int n = 0; n < 2; ++n) { \
        if constexpr (F8) asm("v_mfma_f32_16x16x128_f8f6f4 %0, %1, %2, %0" : "+v"(acc[ai][bj][m][n]) : "v"(Bt##8[n]), "v"(At##8[m])); \
        else { _Pragma("unroll") for (int k = 0; k < 2; ++k) acc[ai][bj][m][n] = __builtin_amdgcn_mfma_f32_16x16x32_bf16(Bt[n][k], At[m][k], acc[ai][bj][m][n], 0, 0, 0); } } \
        __builtin_amdgcn_s_setprio(0); } while (0)
#define PG8_WAIT_V(n) asm volatile("s_waitcnt vmcnt(" #n ")" ::: "memory")
#define PG8_WAIT_L(n) asm volatile("s_waitcnt lgkmcnt(" #n ")" ::: "memory")
#define PG8_BAR __builtin_amdgcn_s_barrier()
#define PG8_SCHED __builtin_amdgcn_sched_barrier(0)
    GUnit cur, nxt; int ui = 0;
    if (!S.next(0, cur)) return;
    f32x4 acc[2][2][4][2];
#pragma unroll
    for (int a = 0; a < 2; ++a)
#pragma unroll
        for (int b = 0; b < 2; ++b)
#pragma unroll
            for (int m = 0; m < 4; ++m)
#pragma unroll
                for (int n = 0; n < 2; ++n) acc[a][b][m][n] = (f32x4){0.f, 0.f, 0.f, 0.f};
    bf16x8 At[4][2], B0[2][2], B1[2][2];
    typedef unsigned u32x8 __attribute__((ext_vector_type(8)));
    u32x8 At8[4], B08[2], B18[2];
    const char* cA = cur.a; const char* cB = cur.b; const char* nA = cA;
    PG8_GLOAD(vc, cur);
    PG8_STAGE(PG8_SB(0, 0), cB, voffB); PG8_STAGE_A(PG8_SA(0, 0), 0, (size_t)0, false); PG8_STAGE(PG8_SB(0, 1), cB + hstepB, voffB); PG8_STAGE_A(PG8_SA(0, 1), 1, (size_t)0, false);
    if (wr == 1) PG8_BAR;
    PG8_WAIT_V(4); PG8_BAR;
    PG8_STAGE(PG8_SB(1, 0), cB + kstep, voffB); PG8_STAGE_A(PG8_SA(1, 0), 0, kstep, false); PG8_STAGE(PG8_SB(1, 1), cB + hstepB + kstep, voffB);
    PG8_WAIT_V(6); PG8_BAR;
    for (;;) {
        const bool has_next = S.next(ui + 1, nxt);
        nA = has_next ? nxt.a : cA; const char* nB = has_next ? nxt.b : cB;
        if (has_next) PG8_GLOAD(vn, nxt); else { _Pragma("unroll") for (int _h = 0; _h < 2; ++_h) _Pragma("unroll") for (int _i = 0; _i < 2; ++_i) vn[_h][_i] = vc[_h][_i]; }
#pragma unroll 1
        for (int t = 0; t < nt; t += 2) {
            const bool last = (t == nt - 2);
            const size_t ka1 = (size_t)(t + 1) * kstep, ka2 = last ? (size_t)0 : (size_t)(t + 2) * kstep, ka3 = ka2 + kstep;
            const char* b2 = last ? nB : cB + (size_t)(t + 2) * kstep;
            const char* b3 = b2 + kstep;
            PG8_LDB(B0, 0, 0); PG8_SCHED; PG8_LDA(At, 0, 0); PG8_STAGE_A(PG8_SA(1, 1), 1, ka1, false);
            PG8_WAIT_L(8); PG8_BAR; PG8_WAIT_L(0); PG8_MMA(0, 0, At, B0); PG8_BAR; PG8_SCHED;
            PG8_LDB(B1, 0, 1); PG8_STAGE(PG8_SB(0, 0), b2, voffB);
            PG8_BAR; PG8_WAIT_L(0); PG8_MMA(0, 1, At, B1); PG8_BAR;
            PG8_LDA(At, 0, 1); PG8_STAGE_A(PG8_SA(0, 0), 0, ka2, last);
            PG8_BAR; PG8_WAIT_L(0); PG8_MMA(1, 0, At, B0); PG8_BAR; PG8_SCHED;
            PG8_STAGE(PG8_SB(0, 1), b2 + hstepB, voffB);
            PG8_WAIT_V(6); PG8_BAR; PG8_MMA(1, 1, At, B1); PG8_BAR;
            PG8_LDB(B0, 1, 0); PG8_SCHED; PG8_LDA(At, 1, 0); PG8_STAGE_A(PG8_SA(0, 1), 1, ka2, last);
            PG8_WAIT_L(8); PG8_BAR; PG8_WAIT_L(0); PG8_MMA(0, 0, At, B0); PG8_BAR; PG8_SCHED;
            PG8_LDB(B1, 1, 1); PG8_STAGE(PG8_SB(1, 0), b3, voffB);
            PG8_BAR; PG8_WAIT_L(0); PG8_MMA(0, 1, At, B1); PG8_BAR;
            PG8_LDA(At, 1, 1); PG8_STAGE_A(PG8_SA(1, 0), 0, ka3, last);
            PG8_BAR; PG8_WAIT_L(0); PG8_MMA(1, 0, At, B0); PG8_BAR; PG8_SCHED;
            PG8_STAGE(PG8_SB(1, 1), b3 + hstepB, voffB);
            PG8_WAIT_V(6); PG8_BAR; PG8_MMA(1, 1, At, B1); PG8_BAR;
        }
        if constexpr (F8) asm volatile("s_nop 15\n\ts_nop 15" ::: "memory");
        if (accs != 1.f) {
#pragma unroll
            for (int a = 0; a < 2; ++a)
#pragma unroll
                for (int b = 0; b < 2; ++b)
#pragma unroll
                    for (int m = 0; m < 4; ++m)
#pragma unroll
                        for (int n = 0; n < 2; ++n) acc[a][b][m][n] *= accs;
        }
        E(acc, cur, wr, wc, fr, fq);
        if (!has_next) break;
#pragma unroll
        for (int a = 0; a < 2; ++a)
#pragma unroll
            for (int b = 0; b < 2; ++b)
#pragma unroll
                for (int m = 0; m < 4; ++m)
#pragma unroll
                    for (int n = 0; n < 2; ++n) acc[a][b][m][n] = (f32x4){0.f, 0.f, 0.f, 0.f};
        cur = nxt; cA = nA; cB = nB; ++ui;
#pragma unroll
        for (int _h = 0; _h < 2; ++_h)
#pragma unroll
            for (int _i = 0; _i < 2; ++_i) vc[_h][_i] = vn[_h][_i];
    }
    PG8_WAIT_V(0);
    if (wr == 0) PG8_BAR;
    PG8_BAR;
#undef PG8_SA
#undef PG8_SB
#undef PG8_STAGE
#undef PG8_STAGE_A
#undef PG8_GLOAD
#undef PG8_LDA
#undef PG8_LDB
#undef PG8_MMA
#undef PG8_LD16
#undef PG8_LDA16
#undef PG8_LDB16
#undef PG8_WAIT_V
#undef PG8_WAIT_L
#undef PG8_BAR
#undef PG8_SCHED
}
typedef f32x4 acc_t[2][2][4][2];
__device__ __forceinline__ u32x4 pack8(f32x4 a, f32x4 b) { return (u32x4){cvt_pk_bf16(a[0], a[1]), cvt_pk_bf16(a[2], a[3]), cvt_pk_bf16(b[0], b[1]), cvt_pk_bf16(b[2], b[3])}; }
__device__ __forceinline__ void unpack8(u32x4 v, float* f) { f[0] = bf_lo(v[0]); f[1] = bf_hi(v[0]); f[2] = bf_lo(v[1]); f[3] = bf_hi(v[1]); f[4] = bf_lo(v[2]); f[5] = bf_hi(v[2]); f[6] = bf_lo(v[3]); f[7] = bf_hi(v[3]); }

template <bool MASK> struct EpiPlain {
    bf16_t* O; int ldo; float scale;
    __device__ __forceinline__ void operator()(const acc_t& acc, const GUnit& u, int wr, int wc, int fr, int fq) const {
        const int colb = u.pn * 256 + wc * 32 + fq * 8;
#pragma unroll
        for (int ai = 0; ai < 2; ++ai)
#pragma unroll
            for (int m = 0; m < 4; ++m) {
                const int r = ai * 128 + wr * 64 + m * 16 + fr;
                if (MASK && r >= u.nrows) continue;
                bf16_t* rowp = O + (size_t)(u.row0 + r) * ldo + colb;
#pragma unroll
                for (int bj = 0; bj < 2; ++bj) st16(rowp + bj * 128, pack8(acc[ai][bj][m][0] * scale, acc[ai][bj][m][1] * scale));
            }
    }
};

struct EpiResid {
    float* XF; const float* XR;
    __device__ __forceinline__ void operator()(const acc_t& acc, const GUnit& u, int wr, int wc, int fr, int fq) const {
        const int colb = u.pn * 256 + wc * 32 + fq * 8;
#pragma unroll
        for (int ai = 0; ai < 2; ++ai)
#pragma unroll
            for (int m = 0; m < 4; ++m) {
                const int r = ai * 128 + wr * 64 + m * 16 + fr;
                float* rowp = XF + (size_t)(u.row0 + r) * 1024 + colb; const float* rrow = XR + (size_t)(u.row0 + r) * 1024 + colb;
                asm volatile("" ::: "memory");
#pragma unroll
                for (int bj = 0; bj < 2; ++bj) {
                    const f32x4 x0 = *(const f32x4*)(rrow + bj * 128), x1 = *(const f32x4*)(rrow + bj * 128 + 4);
                    *(f32x4*)(rowp + bj * 128) = x0 * DN_ALPHA + acc[ai][bj][m][0]; *(f32x4*)(rowp + bj * 128 + 4) = x1 * DN_ALPHA + acc[ai][bj][m][1];
                }
            }
    }
};

__device__ __forceinline__ float clamp8(float x) { return __builtin_amdgcn_fmed3f(x, -448.f, 448.f); }
__device__ __forceinline__ u32x2 pack8_fp8(const float* f) {
    unsigned a = 0u, b = 0u;
    a = __builtin_amdgcn_cvt_pk_fp8_f32(clamp8(f[0]), clamp8(f[1]), a, false); a = __builtin_amdgcn_cvt_pk_fp8_f32(clamp8(f[2]), clamp8(f[3]), a, true);
    b = __builtin_amdgcn_cvt_pk_fp8_f32(clamp8(f[4]), clamp8(f[5]), b, false); b = __builtin_amdgcn_cvt_pk_fp8_f32(clamp8(f[6]), clamp8(f[7]), b, true);
    return (u32x2){a, b};
}
__device__ __forceinline__ void unpack8_fp8(u32x2 v, float* f) {
    const f32x2 a = __builtin_amdgcn_cvt_pk_f32_fp8(v[0], false), b = __builtin_amdgcn_cvt_pk_f32_fp8(v[0], true), c = __builtin_amdgcn_cvt_pk_f32_fp8(v[1], false), d = __builtin_amdgcn_cvt_pk_f32_fp8(v[1], true);
    f[0] = a[0]; f[1] = a[1]; f[2] = b[0]; f[3] = b[1]; f[4] = c[0]; f[5] = c[1]; f[6] = d[0]; f[7] = d[1]; }
__device__ __forceinline__ unsigned pack4_fp8(float a, float b, float c, float d) { unsigned r = 0u;
    r = __builtin_amdgcn_cvt_pk_fp8_f32(clamp8(a), clamp8(b), r, false); r = __builtin_amdgcn_cvt_pk_fp8_f32(clamp8(c), clamp8(d), r, true); return r; }
__device__ __forceinline__ int vperm32(int s) { const int k = s & 31; return (s & ~31) + 8 * ((k >> 2) & 3) + 4 * (k >> 4) + (k & 3); }
struct EpiMoeDown8 {
    unsigned char* O; float scale;
    __device__ __forceinline__ void operator()(const acc_t& acc, const GUnit& u, int wr, int wc, int fr, int fq) const {
        const int colb = u.pn * 256 + wc * 32 + fq * 8;
#pragma unroll
        for (int ai = 0; ai < 2; ++ai)
#pragma unroll
            for (int m = 0; m < 4; ++m) {
                const int r = ai * 128 + wr * 64 + m * 16 + fr;
                if (r >= u.nrows) continue;
                unsigned char* rowp = O + (size_t)(u.row0 + r) * 1024 + colb;
#pragma unroll
                for (int bj = 0; bj < 2; ++bj) { const f32x4 v0 = acc[ai][bj][m][0] * scale, v1 = acc[ai][bj][m][1] * scale;
                    const float f[8] = {v0[0], v0[1], v0[2], v0[3], v1[0], v1[1], v1[2], v1[3]}; *(u32x2*)(rowp + bj * 128) = pack8_fp8(f); }
            }
    }
};
struct EpiMoeGU {
    unsigned char* O;
    __device__ __forceinline__ void operator()(const acc_t& acc, const GUnit& u, int wr, int wc, int fr, int fq) const {
        const int colb = u.pn * 128 + wc * 32 + fq * 8;
#pragma unroll
        for (int ai = 0; ai < 2; ++ai)
#pragma unroll
            for (int m = 0; m < 4; ++m) {
                const int r = ai * 128 + wr * 64 + m * 16 + fr;
                if (r >= u.nrows) continue;
                float h[8];
                constexpr float DS = 1.f / (S8_X * S8_WGU);
#pragma unroll
                for (int bj = 0; bj < 2; ++bj)
#pragma unroll
                    for (int jj = 0; jj < 4; ++jj) h[bj * 4 + jj] = silu_(acc[ai][bj][m][0][jj] * DS) * (acc[ai][bj][m][1][jj] * (DS * S8_H));
                *(u32x2*)(O + (size_t)(u.row0 + r) * 1024 + colb) = pack8_fp8(h);
            }
    }
};

struct EpiScIn {
    bf16_t* P; bf16_t* BG;
    __device__ __forceinline__ void operator()(const acc_t& acc, const GUnit& u, int wr, int wc, int fr, int fq) const {
        if (u.pn < 8) {
            const int colb = u.pn * 128 + wc * 32 + fq * 8;
#pragma unroll
            for (int ai = 0; ai < 2; ++ai)
#pragma unroll
                for (int m = 0; m < 4; ++m) {
                    const int r = ai * 128 + wr * 64 + m * 16 + fr;
                    st16(P + (size_t)(u.row0 + r) * 1024 + colb, pack8(acc[ai][0][m][0] * acc[ai][0][m][1], acc[ai][1][m][0] * acc[ai][1][m][1]));
                }
        } else {
            const int colb = (u.pn - 8) * 256 + wc * 32 + fq * 8;
#pragma unroll
            for (int ai = 0; ai < 2; ++ai)
#pragma unroll
                for (int m = 0; m < 4; ++m) {
                    const int r = ai * 128 + wr * 64 + m * 16 + fr;
                    bf16_t* rowp = BG + (size_t)(u.row0 + r) * 1024 + colb;
#pragma unroll
                    for (int bj = 0; bj < 2; ++bj) st16(rowp + bj * 128, pack8(acc[ai][bj][m][0], acc[ai][bj][m][1]));
                }
        }
    }
};

struct EpiLruIn {
    bf16_t* GG; bf16_t* REC;
    __device__ __forceinline__ void operator()(const acc_t& acc, const GUnit& u, int wr, int wc, int fr, int fq) const {
        const bool isg = u.pn < 5;
        bf16_t* O = GG + (isg ? 0l : (REC - GG));
        const int colb = (isg ? u.pn : u.pn - 5) * 256 + wc * 32 + fq * 8;
#pragma unroll
        for (int ai = 0; ai < 2; ++ai)
#pragma unroll
            for (int m = 0; m < 4; ++m) {
                const int r = ai * 128 + wr * 64 + m * 16 + fr;
                bf16_t* rowp = O + (size_t)(u.row0 + r) * LRU_W + colb;
#pragma unroll
                for (int bj = 0; bj < 2; ++bj) {
                    f32x4 v0 = acc[ai][bj][m][0], v1 = acc[ai][bj][m][1];
                    if (isg) {
#pragma unroll
                        for (int jj = 0; jj < 4; ++jj) { v0[jj] = gelu_tanh(v0[jj]); v1[jj] = gelu_tanh(v1[jj]); }
                    }
                    st16(rowp + bj * 128, pack8(v0, v1));
                }
            }
    }
};

struct EpiLruGate {
    const bf16_t* U; bf16_t* LOGA; bf16_t* BIN; const float* ba; const float* bx; const float* lam;
    __device__ __forceinline__ void operator()(const acc_t& acc, const GUnit& u, int wr, int wc, int fr, int fq) const {
        const int ch0 = u.pn * 128 + wc * 32 + fq * 8;
        float ba8[8], bx8[8], ls8[8];
#pragma unroll
        for (int i = 0; i < 8; ++i) { ba8[i] = ba[ch0 + i]; bx8[i] = bx[ch0 + i]; const float l = lam[ch0 + i]; ls8[i] = -8.f * log1pf(__expf(-l)); }
#pragma unroll
        for (int ai = 0; ai < 2; ++ai)
#pragma unroll
            for (int m = 0; m < 4; ++m) {
                const int r = ai * 128 + wr * 64 + m * 16 + fr;
                const size_t off = (size_t)(u.row0 + r) * LRU_W + ch0;
                float u8[8]; unpack8(ld16(U + off), u8);
                f32x4 la[2], bi[2];
#pragma unroll
                for (int bj = 0; bj < 2; ++bj)
#pragma unroll
                    for (int jj = 0; jj < 4; ++jj) {
                        const int i = bj * 4 + jj;
                        const float rg = sigmoidf_(acc[ai][bj][m][0][jj] + ba8[i]);
                        const float ig = sigmoidf_(acc[ai][bj][m][1][jj] + bx8[i]);
                        const float l = rg * ls8[i];
                        const float om = fmaxf(1.f - fast_exp(2.f * l), 0.f);
                        la[bj][jj] = l; bi[bj][jj] = __builtin_sqrtf(om) * ig * u8[i];
                    }
                st16(LOGA + off, pack8(la[0], la[1]));
                st16(BIN + off, pack8(bi[0], bi[1]));
            }
    }
};

struct EpiNsaIn {
    unsigned char* Q; bf16_t* KC; bf16_t* VC; unsigned char* KS; unsigned char* VST; unsigned char* KW; unsigned char* VWT; float* GATES; const int* pos; const float* bgate;
    __device__ __forceinline__ void operator()(const acc_t& acc, const GUnit& u, int wr, int wc, int fr, int fq) const {
        const int pn = u.pn;
        if (pn <= 3 || pn == 6 || pn == 8) {
            unsigned char* O = Q + (pn <= 3 ? 0l : (pn == 6 ? (KS - Q) : (KW - Q)));
            const int ldo = pn <= 3 ? 1024 : 256;
            const int colbase = pn <= 3 ? pn * 256 : 0;
            const float scale = pn <= 3 ? 0.125f * LOG2E * S8_Q : S8_K;
            float invf[4];
#pragma unroll
            for (int jj = 0; jj < 4; ++jj) invf[jj] = exp2f(-(float)(16 * (wc & 1) + 4 * fq + jj) * (13.287712379549449f / 32.f));
#pragma unroll
            for (int ai = 0; ai < 2; ++ai)
#pragma unroll
                for (int m = 0; m < 4; ++m) {
                    const int row = u.row0 + ai * 128 + wr * 64 + m * 16 + fr;
                    const float p = (float)pos[row];
                    float sn[4], cs[4];
#pragma unroll
                    for (int jj = 0; jj < 4; ++jj) sincos_rad(p * invf[jj], sn[jj], cs[jj]);
#pragma unroll
                    for (int bj = 0; bj < 2; ++bj) {
                        const f32x4 x1 = acc[ai][bj][m][0], x2 = acc[ai][bj][m][1];
                        float o1[4], o2[4];
#pragma unroll
                        for (int jj = 0; jj < 4; ++jj) { o1[jj] = (x1[jj] * cs[jj] - x2[jj] * sn[jj]) * scale; o2[jj] = (x1[jj] * sn[jj] + x2[jj] * cs[jj]) * scale; }
                        unsigned char* p1 = O + (size_t)row * ldo + colbase + 64 * (2 * bj + (wc >> 1)) + 16 * (wc & 1) + 4 * fq;
                        *(unsigned*)p1 = pack4_fp8(o1[0], o1[1], o1[2], o1[3]);
                        *(unsigned*)(p1 + 32) = pack4_fp8(o2[0], o2[1], o2[2], o2[3]);
                    }
                }
        } else if (pn == 4 || pn == 5) {
            bf16_t* O = KC + (pn == 4 ? 0l : (VC - KC));
            const int colb = wc * 32 + fq * 8;
#pragma unroll
            for (int ai = 0; ai < 2; ++ai)
#pragma unroll
                for (int m = 0; m < 4; ++m) {
                    const int row = u.row0 + ai * 128 + wr * 64 + m * 16 + fr;
#pragma unroll
                    for (int bj = 0; bj < 2; ++bj) st16(O + (size_t)row * 256 + colb + bj * 128, pack8(acc[ai][bj][m][0], acc[ai][bj][m][1]));
                }
        } else if (pn == 7 || pn == 9) {
            unsigned char* O = VST + (pn == 7 ? 0l : (VWT - VST));
#pragma unroll
            for (int ai = 0; ai < 2; ++ai)
#pragma unroll
                for (int m = 0; m < 4; ++m) {
                    const int row = u.row0 + ai * 128 + wr * 64 + m * 16 + fr;
                    const int b = row >> 11, s = vperm32(row & 2047);
#pragma unroll
                    for (int bj = 0; bj < 2; ++bj) {
                        const int g = 2 * bj + (wc >> 1);
                        unsigned char* base = O + ((size_t)(b * 4 + g) * 64 + 32 * (wc & 1) + 8 * fq) * SEQ + s;
#pragma unroll
                        for (int n = 0; n < 2; ++n) { const unsigned pk = pack4_fp8(acc[ai][bj][m][n][0], acc[ai][bj][m][n][1], acc[ai][bj][m][n][2], acc[ai][bj][m][n][3]);
#pragma unroll
                            for (int jj = 0; jj < 4; ++jj) base[(size_t)(4 * n + jj) * SEQ] = (unsigned char)((pk >> (8 * jj)) & 0xffu); }
                    }
                }
        } else {
            if (wc < 2 && (wc == 0 || fq < 2)) {
                const int c0 = 32 * wc + 8 * fq;
                f32x4 bg[2];
#pragma unroll
                for (int n = 0; n < 2; ++n) bg[n] = *(const f32x4*)(bgate + c0 + 4 * n);
#pragma unroll
                for (int ai = 0; ai < 2; ++ai)
#pragma unroll
                    for (int m = 0; m < 4; ++m) {
                        const int row = u.row0 + ai * 128 + wr * 64 + m * 16 + fr;
#pragma unroll
                        for (int n = 0; n < 2; ++n) {
                            f32x4 v;
#pragma unroll
                            for (int jj = 0; jj < 4; ++jj) v[jj] = sigmoidf_(acc[ai][0][m][n][jj] + bg[n][jj]);
                            *(f32x4*)(GATES + (size_t)row * 48 + c0 + 4 * n) = v;
                        }
                    }
            }
        }
    }
};
__device__ __forceinline__ int map_plain8(int cc) { const int bj = cc >> 7, wc = (cc >> 5) & 3, n = (cc >> 4) & 1, fq = (cc >> 2) & 3; return 128 * bj + 32 * wc + 8 * fq + 4 * n; }
__device__ __forceinline__ int map_rope(int cc) { const int bj = cc >> 7, wc = (cc >> 5) & 3, n = (cc >> 4) & 1, fq = (cc >> 2) & 3; return 64 * (2 * bj + (wc >> 1)) + 32 * n + 16 * (wc & 1) + 4 * fq; }
__device__ __forceinline__ void map_pair(int cc, int& n, int& ch) { const int bj = cc >> 7, wc = (cc >> 5) & 3, fq = (cc >> 2) & 3; n = (cc >> 4) & 1; ch = 32 * wc + 8 * fq + 4 * bj; }
constexpr f32x4 F4ZERO = {0.f, 0.f, 0.f, 0.f};

struct FetchNsaIn { const float* W;
    __device__ __forceinline__ f32x4 operator()(int, int c4, int k) const { const int pn = c4 >> 8, cc = c4 & 255; const bool rope = (pn <= 3 || pn == 6 || pn == 8);
        const int col = pn * 256 + (rope ? map_rope(cc) : map_plain8(cc)); if (col >= 2608) return F4ZERO; return *(const f32x4*)(W + (size_t)k * 2608 + col); } };
struct FetchPlain { const float* W; int ld; size_t bstride;
    __device__ __forceinline__ f32x4 operator()(int bt, int c4, int k) const { const int col = (c4 & ~255) + map_plain8(c4 & 255); return *(const f32x4*)(W + (size_t)bt * bstride + (size_t)k * ld + col); } };
struct FetchPair { const float* W0; long d01; int ld; size_t bstride;
    __device__ __forceinline__ f32x4 operator()(int bt, int c4, int k) const { int n, ch; map_pair(c4 & 255, n, ch); ch += (c4 >> 8) * 128; return *(const f32x4*)(W0 + (n ? d01 : 0l) + (long)((size_t)bt * bstride + (size_t)k * ld + ch)); } };
struct FetchScIn { const float* W;
    __device__ __forceinline__ f32x4 operator()(int, int c4, int k) const { const int pn = c4 >> 8, cc = c4 & 255;
        if (pn < 8) { int n, ch; map_pair(cc, n, ch); ch += pn * 128; return *(const f32x4*)(W + (size_t)k * 3072 + (n ? 2048 : 0) + ch); }
        return *(const f32x4*)(W + (size_t)k * 3072 + 1024 + (pn - 8) * 256 + map_plain8(cc)); } };
struct FetchLruGate { const float* wa; long dax;
    __device__ __forceinline__ f32x4 operator()(int, int c4, int k) const { int n, ch; map_pair(c4 & 255, n, ch); ch += (c4 >> 8) * 128; const int h = ch / 80; if (k / 80 != h) return F4ZERO;
        return *(const f32x4*)(wa + (n ? dax : 0l) + (long)(h * 6400 + (k - 80 * h) * 80 + (ch - 80 * h))); } };
struct FetchIdent { const float* W; int ld; size_t bstride;
    __device__ __forceinline__ f32x4 operator()(int bt, int c4, int k) const { return *(const f32x4*)(W + (size_t)bt * bstride + (size_t)k * ld + c4); } };

template <bool OUT8 = false, class F>
__device__ __forceinline__ void convert_wt(LAS unsigned char* lds, void* dstv, int nbatch, int Nd, int K, const F& fetch, const float scale = 1.f) {
    constexpr int GRP = 4;
    LAS float* tile = (LAS float*)lds;
    const int tid = tid_opaque();
    const int ntk = K / 64, ntc = Nd / 64, per = ntc * ntk, total = per * nbatch;
    const bool split = (Nd & 255) == 0;
    const int c4i = tid & 15, kk = tid >> 4, rr4 = 4 * c4i, row = tid >> 3, k8 = (tid & 7) * 8;
    for (int t0 = blockIdx.x * GRP; t0 < total; t0 += gridDim.x * GRP) {
        f32x4 v[GRP][2];
#pragma unroll
        for (int gi = 0; gi < GRP; ++gi) {
            const int t = t0 + gi;
            if (t < total) {
                const int bt = t / per, tt = t - bt * per, tc = tt / ntk, tk = tt - tc * ntk, k0 = tk * 64;
                const int cbase = split ? (tc >> 2) * 256 + (tc & 3) * 32 : tc * 64;
                const int crow4 = cbase + (split ? ((rr4 & 31) + (rr4 >> 5) * 128) : rr4);
#pragma unroll
                for (int p = 0; p < 2; ++p) v[gi][p] = fetch(bt, crow4, k0 + kk + 32 * p);
            }
        }
        __syncthreads();
#pragma unroll
        for (int gi = 0; gi < GRP; ++gi)
            if (t0 + gi < total) {
#pragma unroll
                for (int p = 0; p < 2; ++p)
#pragma unroll
                    for (int j = 0; j < 4; ++j) tile[gi * 4160 + (4 * c4i + j) * 65 + kk + 32 * p] = v[gi][p][j];
            }
        __syncthreads();
#pragma unroll
        for (int gi = 0; gi < GRP; ++gi) {
            const int t = t0 + gi;
            if (t < total) {
                const int bt = t / per, tt = t - bt * per, tc = tt / ntk, tk = tt - tc * ntk, k0 = tk * 64;
                const int cbase = split ? (tc >> 2) * 256 + (tc & 3) * 32 : tc * 64;
                const int crow = cbase + (split ? ((row & 31) + (row >> 5) * 128) : row);
                float f[8];
#pragma unroll
                for (int i = 0; i < 8; ++i) f[i] = tile[gi * 4160 + row * 65 + k8 + i];
                if constexpr (OUT8) {
#pragma unroll
                    for (int i = 0; i < 8; ++i) f[i] *= scale;
                    *(u32x2*)((unsigned char*)dstv + ((size_t)bt * Nd + crow) * K + k0 + k8) = pack8_fp8(f);
                } else st16((bf16_t*)dstv + ((size_t)bt * Nd + crow) * K + k0 + k8, (u32x4){cvt_pk_bf16(f[0], f[1]), cvt_pk_bf16(f[2], f[3]), cvt_pk_bf16(f[4], f[5]), cvt_pk_bf16(f[6], f[7])});
            }
        }
    }
    __syncthreads();
}

template <bool X8OUT>
__device__ __forceinline__ void convert_x(const float* x, unsigned char* XA) {
    const size_t n8 = (size_t)T_TOK * DM / 8;
    const int tidx = tid_opaque();
    for (size_t i = (size_t)blockIdx.x * NTHR + tidx; i < n8; i += (size_t)gridDim.x * NTHR) {
        if constexpr (X8OUT) {
            const f32x4 a = *(const f32x4*)(x + i * 8) * S8_X, b = *(const f32x4*)(x + i * 8 + 4) * S8_X;
            const float f[8] = {a[0], a[1], a[2], a[3], b[0], b[1], b[2], b[3]};
            *(u32x2*)(XA + i * 8) = pack8_fp8(f);
        } else { const f32x4 a = *(const f32x4*)(x + i * 8), b = *(const f32x4*)(x + i * 8 + 4); st16((bf16_t*)XA + i * 8, pack8(a, b)); }
    }
}
__device__ __forceinline__ void cmp_bias_phase(LAS unsigned char* lds, const float* pek, const float* w1k, const float* pev, const float* w1v, float* bias1) {
    LAS float* red = (LAS float*)lds;
    const int tidx = tid_opaque();
    for (int blk = blockIdx.x; blk < 32; blk += gridDim.x) {
        const int v = blk >> 3, j = v >> 1, kv = v & 1, hid = (blk & 7) * 8 + (tidx & 7), part = tidx >> 3;
        const float* pe = pek + (kv ? (pev - pek) : 0l) + j * 2048; const float* w1 = w1k + (kv ? (w1v - w1k) : 0l) + (size_t)j * 2048 * 64;
        float s = 0.f;
#pragma unroll 8
        for (int i = part * 32; i < part * 32 + 32; ++i) s += pe[i] * w1[i * 64 + hid];
        __syncthreads();
        red[part * 8 + (tidx & 7)] = s;
        __syncthreads();
        if (tidx < 8) { float t = 0.f; for (int q = 0; q < 64; ++q) t += red[q * 8 + tidx]; bias1[v * 64 + (blk & 7) * 8 + tidx] = t; }
    }
    __syncthreads();
}

__device__ __forceinline__ void ln1_router_phase(LAS unsigned char* lds, const float* XF, const bf16_t* MBm, float* XW, unsigned char* X8, const float* gam, const float* bet,
                                                 const float* rw, const float* rb, int* route_e, float* route_w, int* cnt) {
    LAS f32x4* rwl = (LAS f32x4*)lds;
    LAS int* lcnt = (LAS int*)(lds + 65536);
    const int tid = tid_opaque(), lane = tid & 63, w = tid >> 6;
    __syncthreads();
    for (int i = tid; i < 4096; i += NTHR) { const int col = i >> 2, q = i & 3; const int seg = col >> 9, ln = (col >> 3) & 63, j = col & 7;
        rwl[((q * 2 + seg) * 8 + j) * 64 + ln] = *(const f32x4*)(rw + col * 16 + 4 * q); }
    for (int chunk = blockIdx.x; chunk < 256; chunk += gridDim.x) {
        __syncthreads();
        if (tid < 16) lcnt[tid] = 0;
        __syncthreads();
        const size_t row0 = (size_t)chunk * 256 + w * 32;
        f32x4 nx[2][4]; u32x4 nm[2][2];
#pragma unroll
        for (int rr = 0; rr < 2; ++rr)
#pragma unroll
            for (int sg = 0; sg < 2; ++sg) { nx[rr][sg * 2] = *(const f32x4*)(XF + (row0 + rr) * DM + sg * 512 + lane * 8); nx[rr][sg * 2 + 1] = *(const f32x4*)(XF + (row0 + rr) * DM + sg * 512 + lane * 8 + 4);
                nm[rr][sg] = ld16(MBm + (row0 + rr) * DM + sg * 512 + lane * 8); }
        for (int i = 0; i < 32; i += 2) {
            f32x2 y2[16];
            {
                float xv[2][16];
#pragma unroll
                for (int rr = 0; rr < 2; ++rr) {
#pragma unroll
                    for (int sg = 0; sg < 2; ++sg) { float mv[8]; unpack8(nm[rr][sg], mv);
#pragma unroll
                        for (int j = 0; j < 4; ++j) { xv[rr][sg * 8 + j] = DN_ALPHA * nx[rr][sg * 2][j] + mv[j]; xv[rr][sg * 8 + 4 + j] = DN_ALPHA * nx[rr][sg * 2 + 1][j] + mv[4 + j]; } }
                }
                if (i + 2 < 32) {
#pragma unroll
                    for (int rr = 0; rr < 2; ++rr)
#pragma unroll
                        for (int sg = 0; sg < 2; ++sg) { nx[rr][sg * 2] = *(const f32x4*)(XF + (row0 + i + 2 + rr) * DM + sg * 512 + lane * 8); nx[rr][sg * 2 + 1] = *(const f32x4*)(XF + (row0 + i + 2 + rr) * DM + sg * 512 + lane * 8 + 4);
                            nm[rr][sg] = ld16(MBm + (row0 + i + 2 + rr) * DM + sg * 512 + lane * 8); }
                }
                float mean[2], rstd[2];
#pragma unroll
                for (int rr = 0; rr < 2; ++rr) { float s = 0.f;
#pragma unroll
                    for (int j = 0; j < 16; ++j) s += xv[rr][j];
                    mean[rr] = wave_sum_dpp(s) * (1.f / 1024.f); }
#pragma unroll
                for (int rr = 0; rr < 2; ++rr) { float q = 0.f;
#pragma unroll
                    for (int j = 0; j < 16; ++j) { const float d = xv[rr][j] - mean[rr]; q += d * d; }
                    rstd[rr] = rsqrtf(wave_sum_dpp(q) * (1.f / 1024.f) + LN_EPS); }
#pragma unroll
                for (int sg = 0; sg < 2; ++sg) {
                    const f32x4 ga = *(const f32x4*)(gam + sg * 512 + lane * 8), gb = *(const f32x4*)(gam + sg * 512 + lane * 8 + 4);
                    const f32x4 ba = *(const f32x4*)(bet + sg * 512 + lane * 8), bb = *(const f32x4*)(bet + sg * 512 + lane * 8 + 4);
#pragma unroll
                    for (int rr = 0; rr < 2; ++rr) {
                        f32x4 o0, o1;
#pragma unroll
                        for (int j = 0; j < 4; ++j) { o0[j] = (xv[rr][sg * 8 + j] - mean[rr]) * rstd[rr] * ga[j] + ba[j]; o1[j] = (xv[rr][sg * 8 + 4 + j] - mean[rr]) * rstd[rr] * gb[j] + bb[j];
                            y2[sg * 8 + j][rr] = o0[j]; y2[sg * 8 + 4 + j][rr] = o1[j]; }
                        *(f32x4*)(XW + (row0 + i + rr) * DM + sg * 512 + lane * 8) = o0; *(f32x4*)(XW + (row0 + i + rr) * DM + sg * 512 + lane * 8 + 4) = o1;
                        { const f32x4 a8 = o0 * S8_X, b8 = o1 * S8_X; const float f8[8] = {a8[0], a8[1], a8[2], a8[3], b8[0], b8[1], b8[2], b8[3]};
                          *(u32x2*)(X8 + (row0 + i + rr) * DM + sg * 512 + lane * 8) = pack8_fp8(f8); }
                    }
                }
            }
            f32x2 lg2[16];
#pragma unroll
            for (int e = 0; e < 16; ++e) lg2[e] = (f32x2){0.f, 0.f};
#pragma unroll
            for (int sg = 0; sg < 2; ++sg)
#pragma unroll
                for (int j = 0; j < 8; ++j) {
                    if ((j & 1) == 0) __builtin_amdgcn_sched_barrier(0);
#pragma unroll
                    for (int q = 0; q < 4; ++q) {
                        const f32x4 wv = rwl[((q * 2 + sg) * 8 + j) * 64 + lane];
#pragma unroll
                        for (int e = 0; e < 4; ++e) lg2[q * 4 + e] += y2[sg * 8 + j] * (f32x2){wv[e], wv[e]};
                    }
                }
#pragma unroll
            for (int rr = 0; rr < 2; ++rr) {
                float sc[16], bi[16];
#pragma unroll
                for (int e = 0; e < 16; ++e) { const float l = wave_sum_dpp(lg2[e][rr]); sc[e] = 1.f / (1.f + __expf(-l)); bi[e] = sc[e] + rb[e]; }
                float gs[4];
#pragma unroll
                for (int g = 0; g < 4; ++g) { const float a = bi[4 * g], b = bi[4 * g + 1], c = bi[4 * g + 2], d = bi[4 * g + 3];
                    gs[g] = fmaxf(fmaxf(fmaxf(a + b, a + c), fmaxf(a + d, b + c)), fmaxf(b + d, c + d)); }
                int bg = 0; float bgs = gs[0];
#pragma unroll
                for (int g = 1; g < 4; ++g) if (gs[g] > bgs) { bgs = gs[g]; bg = g; }
                float vb[4], vs[4];
#pragma unroll
                for (int k = 0; k < 4; ++k) { vb[k] = bg == 0 ? bi[k] : (bg == 1 ? bi[4 + k] : (bg == 2 ? bi[8 + k] : bi[12 + k])); vs[k] = bg == 0 ? sc[k] : (bg == 1 ? sc[4 + k] : (bg == 2 ? sc[8 + k] : sc[12 + k])); }
                int i1 = 0; float b1 = vb[0], s1 = vs[0];
#pragma unroll
                for (int k = 1; k < 4; ++k) if (vb[k] > b1) { b1 = vb[k]; s1 = vs[k]; i1 = k; }
                int i2 = -1; float b2 = -3e38f, s2 = 0.f;
#pragma unroll
                for (int k = 0; k < 4; ++k) if (k != i1 && vb[k] > b2) { b2 = vb[k]; s2 = vs[k]; i2 = k; }
                const float inv = 1.f / (s1 + s2);
                if (lane == 0) {
                    const size_t row = row0 + i + rr;
                    const int e0 = bg * 4 + i1, e1 = bg * 4 + i2;
                    route_e[row] = e0 | (e1 << 8); route_w[row * 2] = s1 * inv; route_w[row * 2 + 1] = s2 * inv;
                    atomicAdd((int*)&lcnt[e0], 1); atomicAdd((int*)&lcnt[e1], 1);
                }
            }
        }
        __syncthreads();
        if (tid < 16) cnt[chunk * 16 + tid] = lcnt[tid];
    }
    __syncthreads();
}

__device__ __forceinline__ void moe_gather_phase(LAS unsigned char* lds, const int* route_e, const int* cnt, int* pos_out, int* inv, int4* tiles) {
    LAS int* s_tot = (LAS int*)lds; LAS int* s_pre = s_tot + 16; LAS int* s_off = s_pre + 16; LAS int* s_wcnt = s_off + 16; LAS int* s_lpos = s_wcnt + 128;
    const int tid = tid_opaque(), lane = tid & 63, w = tid >> 6;
    for (int chunk = blockIdx.x; chunk < 256; chunk += gridDim.x) {
        __syncthreads();
        { const int e = tid >> 5, j = tid & 31; int tot = 0, pre = 0;
            for (int c = j; c < 256; c += 32) { const int v = cnt[c * 16 + e]; tot += v; pre += (c < chunk) ? v : 0; }
#pragma unroll
            for (int o = 16; o >= 1; o >>= 1) { tot += __shfl_xor(tot, o); pre += __shfl_xor(pre, o); }
            if (j == 0) { s_tot[e] = tot; s_pre[e] = pre; } }
        __syncthreads();
        if (tid == 0) { int off = 0; for (int e = 0; e < 16; ++e) { s_off[e] = off; off += s_tot[e]; } }
        const int token = chunk * 256 + (tid >> 1), slot = tid & 1;
        const int re = route_e[token]; const int e = slot ? ((re >> 8) & 255) : (re & 255);
        int rk = 0;
#pragma unroll
        for (int e2 = 0; e2 < 16; ++e2) { const unsigned long long mk = __ballot(e == e2); if (e == e2) rk = __popcll(mk & ((1ull << lane) - 1ull)); if (lane == 0) s_wcnt[w * 16 + e2] = __popcll(mk); }
        __syncthreads();
        int base = s_off[e] + s_pre[e];
        for (int w2 = 0; w2 < w; ++w2) base += s_wcnt[w2 * 16 + e];
        const int p = base + rk;
        pos_out[token * 2 + slot] = p; inv[p] = token;
        if (chunk == 0 && tid == 0) {
            int nt = 0;
            for (int e2 = 0; e2 < 16; ++e2) { const int n = s_tot[e2]; for (int r = 0; r < n; r += 256) { tiles[1 + nt] = make_int4(e2, s_off[e2] + r, (n - r) < 256 ? (n - r) : 256, 0); ++nt; } }
            tiles[0] = make_int4(nt, 0, 0, 0);
        }
        if (chunk == 0 && tid < 256) inv[2 * T_TOK + tid] = 0;
    }
    __syncthreads();
}

template <bool LAST, bool X8OUT>
__device__ __forceinline__ void ln2_combine_phase(const float* XF, float* XW, const unsigned char* YM, const int* pos, const float* route_w, const float* gam, const float* bet, unsigned char* XO) {
    const int tid = tid_opaque(), lane = tid & 63, w = tid >> 6;
    float gm[16], bt[16];
#pragma unroll
    for (int s = 0; s < 2; ++s)
#pragma unroll
        for (int j = 0; j < 8; ++j) { gm[s * 8 + j] = gam[s * 512 + lane * 8 + j]; bt[s * 8 + j] = bet[s * 512 + lane * 8 + j]; }
    const size_t rstep = (size_t)gridDim.x * 8;
    int np0 = 0, np1 = 0; float nw0 = 0.f, nw1 = 0.f;
    { const size_t r0 = (size_t)blockIdx.x * 8 + w; if (r0 < (size_t)T_TOK) { np0 = pos[r0 * 2]; np1 = pos[r0 * 2 + 1]; nw0 = route_w[r0 * 2]; nw1 = route_w[r0 * 2 + 1]; } }
    for (size_t row = (size_t)blockIdx.x * 8 + w; row < (size_t)T_TOK; row += rstep) {
        const int p0 = np0, p1 = np1; const float w0 = nw0, w1 = nw1;
        { const size_t rn = row + rstep; if (rn < (size_t)T_TOK) { np0 = pos[rn * 2]; np1 = pos[rn * 2 + 1]; nw0 = route_w[rn * 2]; nw1 = route_w[rn * 2 + 1]; } }
        float xv[16], a[16], b[16];
#pragma unroll
        for (int sg = 0; sg < 2; ++sg) { const f32x4 c = *(const f32x4*)(XF + row * DM + sg * 512 + lane * 8), d = *(const f32x4*)(XF + row * DM + sg * 512 + lane * 8 + 4);
#pragma unroll
            for (int j = 0; j < 4; ++j) { xv[sg * 8 + j] = c[j]; xv[sg * 8 + 4 + j] = d[j]; } }
        unpack8_fp8(*(const u32x2*)(YM + (size_t)p0 * DM + lane * 8), a); unpack8_fp8(*(const u32x2*)(YM + (size_t)p0 * DM + 512 + lane * 8), a + 8);
        unpack8_fp8(*(const u32x2*)(YM + (size_t)p1 * DM + lane * 8), b); unpack8_fp8(*(const u32x2*)(YM + (size_t)p1 * DM + 512 + lane * 8), b + 8);
        float s = 0.f;
#pragma unroll
        for (int j = 0; j < 16; ++j) { xv[j] = DN_ALPHA * xv[j] + (w0 * a[j] + w1 * b[j]) * (1.f / S8_Y); s += xv[j]; }
        const float mean = wave_sum_dpp(s) * (1.f / 1024.f);
        float q = 0.f;
#pragma unroll
        for (int j = 0; j < 16; ++j) { const float d = xv[j] - mean; q += d * d; }
        const float rstd = rsqrtf(wave_sum_dpp(q) * (1.f / 1024.f) + LN_EPS);
        float y[16];
#pragma unroll
        for (int j = 0; j < 16; ++j) y[j] = (xv[j] - mean) * rstd * gm[j] + bt[j];
        float* outf = XW;
        *(f32x4*)(outf + row * DM + lane * 8) = (f32x4){y[0], y[1], y[2], y[3]}; *(f32x4*)(outf + row * DM + lane * 8 + 4) = (f32x4){y[4], y[5], y[6], y[7]};
        *(f32x4*)(outf + row * DM + 512 + lane * 8) = (f32x4){y[8], y[9], y[10], y[11]}; *(f32x4*)(outf + row * DM + 512 + lane * 8 + 4) = (f32x4){y[12], y[13], y[14], y[15]};
        if (!LAST) {
            if constexpr (X8OUT) {
                float ys[16];
#pragma unroll
                for (int j = 0; j < 16; ++j) ys[j] = y[j] * S8_X;
                *(u32x2*)(XO + row * DM + lane * 8) = pack8_fp8(ys); *(u32x2*)(XO + row * DM + 512 + lane * 8) = pack8_fp8(ys + 8);
            } else {
                bf16_t* XOb = (bf16_t*)XO;
                st16(XOb + row * DM + lane * 8, (u32x4){cvt_pk_bf16(y[0], y[1]), cvt_pk_bf16(y[2], y[3]), cvt_pk_bf16(y[4], y[5]), cvt_pk_bf16(y[6], y[7])});
                st16(XOb + row * DM + 512 + lane * 8, (u32x4){cvt_pk_bf16(y[8], y[9]), cvt_pk_bf16(y[10], y[11]), cvt_pk_bf16(y[12], y[13]), cvt_pk_bf16(y[14], y[15])});
            }
        }
    }
}

__device__ __forceinline__ void sc_conv_phase(const bf16_t* P, const bf16_t* BG, bf16_t* Y, const float* cw, const float* cb) {
    const int items = (T_TOK / 16) * 128; const int tidx = tid_opaque();
    for (int it = blockIdx.x * NTHR + tidx; it < items; it += gridDim.x * NTHR) {
        const int cg = it & 127, run = it >> 7, c0 = cg * 8; const size_t t0 = (size_t)run * 16; const int s = (int)(t0 & 2047);
        float w0[8], w1[8], w2[8], b8[8];
#pragma unroll
        for (int j = 0; j < 8; ++j) { w0[j] = cw[c0 + j]; w1[j] = cw[1024 + c0 + j]; w2[j] = cw[2048 + c0 + j]; b8[j] = cb[c0 + j]; }
        float pm2[8], pm1[8];
        if (s == 0) {
#pragma unroll
            for (int j = 0; j < 8; ++j) { pm2[j] = 0.f; pm1[j] = 0.f; }
        } else { unpack8(ld16(P + (t0 - 2) * DM + c0), pm2); unpack8(ld16(P + (t0 - 1) * DM + c0), pm1); }
#pragma unroll 4
        for (int i = 0; i < 16; ++i) {
            float cur[8], bg[8], y[8];
            unpack8(ld16(P + (t0 + i) * DM + c0), cur); unpack8(ld16(BG + (t0 + i) * DM + c0), bg);
#pragma unroll
            for (int j = 0; j < 8; ++j) { y[j] = bg[j] * (b8[j] + w0[j] * pm2[j] + w1[j] * pm1[j] + w2[j] * cur[j]); pm2[j] = pm1[j]; pm1[j] = cur[j]; }
            st16(Y + (t0 + i) * DM + c0, (u32x4){cvt_pk_bf16(y[0], y[1]), cvt_pk_bf16(y[2], y[3]), cvt_pk_bf16(y[4], y[5]), cvt_pk_bf16(y[6], y[7])});
        }
    }
}
__device__ __forceinline__ void lru_conv_phase(const bf16_t* REC, bf16_t* U, const float* cw, const float* cb) {
    const int items = (T_TOK / 16) * 160; const int tidx = tid_opaque();
    for (int it = blockIdx.x * NTHR + tidx; it < items; it += gridDim.x * NTHR) {
        const int cg = it % 160, run = it / 160, c0 = cg * 8; const size_t t0 = (size_t)run * 16; const int s = (int)(t0 & 2047);
        float w0[8], w1[8], w2[8], w3[8], b8[8];
#pragma unroll
        for (int j = 0; j < 8; ++j) { w0[j] = cw[c0 + j]; w1[j] = cw[LRU_W + c0 + j]; w2[j] = cw[2 * LRU_W + c0 + j]; w3[j] = cw[3 * LRU_W + c0 + j]; b8[j] = cb[c0 + j]; }
        float p3[8], p2[8], p1[8];
        if (s == 0) {
#pragma unroll
            for (int j = 0; j < 8; ++j) { p3[j] = 0.f; p2[j] = 0.f; p1[j] = 0.f; }
        } else { unpack8(ld16(REC + (t0 - 3) * LRU_W + c0), p3); unpack8(ld16(REC + (t0 - 2) * LRU_W + c0), p2); unpack8(ld16(REC + (t0 - 1) * LRU_W + c0), p1); }
#pragma unroll 4
        for (int i = 0; i < 16; ++i) {
            float cur[8], y[8];
            unpack8(ld16(REC + (t0 + i) * LRU_W + c0), cur);
#pragma unroll
            for (int j = 0; j < 8; ++j) { y[j] = b8[j] + w0[j] * p3[j] + w1[j] * p2[j] + w2[j] * p1[j] + w3[j] * cur[j]; p3[j] = p2[j]; p2[j] = p1[j]; p1[j] = cur[j]; }
            st16(U + (t0 + i) * LRU_W + c0, (u32x4){cvt_pk_bf16(y[0], y[1]), cvt_pk_bf16(y[2], y[3]), cvt_pk_bf16(y[4], y[5]), cvt_pk_bf16(y[6], y[7])});
        }
    }
}

__device__ __forceinline__ void lru_scan1_phase(const bf16_t* LOGA, const bf16_t* BIN, f32x4* carry) {
    const int tidx = tid_opaque(); const int lane = tidx & 63, w = tidx >> 6;
    for (int it = blockIdx.x * 8 + w; it < 10240; it += gridDim.x * 8) {
        const int cgp = it % 10, ck = (it / 10) & 31, b = it / 320, ch = cgp * 128 + lane * 2;
        const size_t base = ((size_t)b * SEQ + ck * 64) * LRU_W + ch;
        float h0 = 0.f, h1 = 0.f, s0 = 0.f, s1 = 0.f;
#pragma unroll 8
        for (int t = 0; t < 64; ++t) {
            const unsigned la = *(const unsigned*)(LOGA + base + (size_t)t * LRU_W), bi = *(const unsigned*)(BIN + base + (size_t)t * LRU_W);
            const float l0 = bf_lo(la), l1 = bf_hi(la);
            h0 = fast_exp(l0) * h0 + bf_lo(bi); h1 = fast_exp(l1) * h1 + bf_hi(bi); s0 += l0; s1 += l1;
        }
        carry[(((size_t)b * 32 + ck) * LRU_W + ch) >> 1] = (f32x4){s0, h0, s1, h1};
    }
}
__device__ __forceinline__ void lru_scan2_phase(const bf16_t* LOGA, const bf16_t* BIN, const bf16_t* GG, const f32x4* carry, bf16_t* Y) {
    const int tidx = tid_opaque(); const int lane = tidx & 63, w = tidx >> 6;
    for (int it = blockIdx.x * 8 + w; it < 10240; it += gridDim.x * 8) {
        const int cgp = it % 10, ck = (it / 10) & 31, b = it / 320, ch = cgp * 128 + lane * 2;
        float h0 = 0.f, h1 = 0.f;
        for (int c2 = 0; c2 < ck; ++c2) { const f32x4 cv = carry[(((size_t)b * 32 + c2) * LRU_W + ch) >> 1]; h0 = fast_exp(cv[0]) * h0 + cv[1]; h1 = fast_exp(cv[2]) * h1 + cv[3]; }
        const size_t base = ((size_t)b * SEQ + ck * 64) * LRU_W + ch;
#pragma unroll 8
        for (int t = 0; t < 64; ++t) {
            const unsigned la = *(const unsigned*)(LOGA + base + (size_t)t * LRU_W), bi = *(const unsigned*)(BIN + base + (size_t)t * LRU_W), gg = *(const unsigned*)(GG + base + (size_t)t * LRU_W);
            h0 = fast_exp(bf_lo(la)) * h0 + bf_lo(bi); h1 = fast_exp(bf_hi(la)) * h1 + bf_hi(bi);
            *(unsigned*)(Y + base + (size_t)t * LRU_W) = cvt_pk_bf16(bf_lo(gg) * h0, bf_hi(gg) * h1);
        }
    }
}
__device__ __forceinline__ bf16x8 pack8s(const float* f) {
    const unsigned a = cvt_pk_bf16(f[0], f[1]), b = cvt_pk_bf16(f[2], f[3]), c = cvt_pk_bf16(f[4], f[5]), d = cvt_pk_bf16(f[6], f[7]);
    u32x4 v = {a, b, c, d}; return __builtin_bit_cast(bf16x8, v);
}
__device__ __forceinline__ void nsa_compress_phase(const bf16_t* KC, const bf16_t* VC, const bf16_t* W1T, const float* w2k, const float* w2v, const float* bias1,
                                                   const int* pos, unsigned char* KCMP, unsigned char* VCMPT) {
    const int tidx = tid_opaque(); const int lane = tidx & 63, w = tidx >> 6, rowi = lane & 15, gq = lane >> 4;
    for (int task = blockIdx.x * 8 + w; task < 2048; task += gridDim.x * 8) {
        const int kv = task >> 10, tt = task & 1023, rho = tt * 16 + rowi, b = rho >> 9, n = (rho >> 2) & 127, g = rho & 3;
        const bf16_t* src = KC + (kv ? (VC - KC) : 0l) + (size_t)b * SEQ * 256 + g * 64 + 8 * gq;
        const bf16_t* w1t = W1T + (size_t)kv * 64 * 2048 + (size_t)rowi * 2048 + 8 * gq;
        f32x4 hacc[4];
#pragma unroll
        for (int ht = 0; ht < 4; ++ht) hacc[ht] = (f32x4){0.f, 0.f, 0.f, 0.f};
#pragma unroll 4
        for (int kk = 0; kk < 64; ++kk) {
            int tok = 16 * n + (kk >> 1); tok = tok > 2047 ? 2047 : tok;
            const bf16x8 af = *(const bf16x8*)(src + (size_t)tok * 256 + 32 * (kk & 1));
#pragma unroll
            for (int ht = 0; ht < 4; ++ht) { const bf16x8 wf = *(const bf16x8*)(w1t + (size_t)(16 * ht) * 2048 + kk * 32); hacc[ht] = __builtin_amdgcn_mfma_f32_16x16x32_bf16(wf, af, hacc[ht], 0, 0, 0); }
        }
        bf16x8 pf[2];
#pragma unroll
        for (int p = 0; p < 2; ++p) { float hv[8];
#pragma unroll
            for (int jj = 0; jj < 4; ++jj) { hv[jj] = gelu_tanh(hacc[2 * p][jj] + bias1[kv * 64 + 32 * p + 4 * gq + jj]); hv[4 + jj] = gelu_tanh(hacc[2 * p + 1][jj] + bias1[kv * 64 + 32 * p + 16 + 4 * gq + jj]); }
            pf[p] = pack8s(hv); }
        const float* w2 = w2k + (kv ? (w2v - w2k) : 0l);
        f32x4 oacc[4];
#pragma unroll
        for (int dt = 0; dt < 4; ++dt) { oacc[dt] = (f32x4){0.f, 0.f, 0.f, 0.f};
#pragma unroll
            for (int p = 0; p < 2; ++p) { float wv[8]; const int dout = 16 * dt + rowi;
#pragma unroll
                for (int i = 0; i < 4; ++i) { wv[i] = w2[(32 * p + 4 * gq + i) * 64 + dout]; wv[4 + i] = w2[(32 * p + 16 + 4 * gq + i) * 64 + dout]; }
                oacc[dt] = __builtin_amdgcn_mfma_f32_16x16x32_bf16(pack8s(wv), pf[p], oacc[dt], 0, 0, 0); } }
        const bool padrow = (n == 127);
        if (kv == 0) {
            int pidx = 16 * n + 31; pidx = pidx > 2047 ? 2047 : pidx;
            const float pp = (float)pos[b * SEQ + pidx];
            unsigned char* dst = KCMP + ((size_t)(b * 128 + n) * 4 + g) * 64;
#pragma unroll
            for (int dt = 0; dt < 2; ++dt) { float o1[4], o2[4];
#pragma unroll
                for (int jj = 0; jj < 4; ++jj) { const float inv = exp2f(-(float)(16 * dt + 4 * gq + jj) * (13.287712379549449f / 32.f)); float sn, cs; sincos_rad(pp * inv, sn, cs);
                    const float x1 = oacc[dt][jj], x2 = oacc[dt + 2][jj]; o1[jj] = padrow ? 0.f : (x1 * cs - x2 * sn) * S8_K; o2[jj] = padrow ? 0.f : (x1 * sn + x2 * cs) * S8_K; }
                *(unsigned*)(dst + 16 * dt + 4 * gq) = pack4_fp8(o1[0], o1[1], o1[2], o1[3]);
                *(unsigned*)(dst + 32 + 16 * dt + 4 * gq) = pack4_fp8(o2[0], o2[1], o2[2], o2[3]); }
        } else {
            unsigned char* dst = VCMPT + ((size_t)(b * 4 + g) * 64) * 128 + vperm32(n);
#pragma unroll
            for (int dt = 0; dt < 4; ++dt) { const unsigned pk = pack4_fp8(oacc[dt][0], oacc[dt][1], oacc[dt][2], oacc[dt][3]);
#pragma unroll
                for (int jj = 0; jj < 4; ++jj) dst[(size_t)(16 * dt + 4 * gq + jj) * 128] = padrow ? (unsigned char)0 : (unsigned char)((pk >> (8 * jj)) & 0xffu); }
        }
    }
}

struct AttnArgs { const unsigned char* Q; const unsigned char* KS; const unsigned char* VST; const unsigned char* KW; const unsigned char* VWT; const unsigned char* KCMP; const unsigned char* VCMPT; const float* GATES; unsigned char* O; };
constexpr int AL_KC = 0, AL_VC = 10240, AL_KB = 19456, AL_VB = 29696, AL_PS = 39936, AL_IMP = 56320, AL_SEL = 60416, AL_OT = 60544;
typedef long fp8x8;
__device__ __forceinline__ unsigned pk4p(float a, float b, float c, float d) { unsigned r = 0u; r = __builtin_amdgcn_cvt_pk_fp8_f32(a, b, r, false); r = __builtin_amdgcn_cvt_pk_fp8_f32(c, d, r, true); return r; }
__device__ __forceinline__ fp8x8 mk8(unsigned lo, unsigned hi) { return (fp8x8)(((unsigned long long)hi << 32) | (unsigned long long)lo); }
constexpr float ATT_THR = 8.f;

__device__ __forceinline__ float max16(const f32x4 (&a)[4]) {
    float m0 = fmaxf(fmaxf(a[0][0], a[0][1]), a[0][2]), m1 = fmaxf(fmaxf(a[0][3], a[1][0]), a[1][1]), m2 = fmaxf(fmaxf(a[1][2], a[1][3]), a[2][0]);
    float m3 = fmaxf(fmaxf(a[2][1], a[2][2]), a[2][3]), m4 = fmaxf(fmaxf(a[3][0], a[3][1]), a[3][2]);
    return fmaxf(fmaxf(fmaxf(m0, m1), fmaxf(m2, m3)), fmaxf(m4, a[3][3]));
}

template <int MODE>
__device__ __forceinline__ void attn_branch(LAS unsigned char* lds, const unsigned char* Kg, const unsigned char* Vg, const int kb_lo, const int kb_hi, const bool first_staged,
                                            const fp8x8 (&qf)[2][2], const int (&sq)[2], const unsigned (&selm)[2], const float* const (&gatep)[2], LAS f32x4* otl  ,
                                            const int n, const int gq, const int tid) {
    const bool isv = tid >= 256; const int st = tid & 255, srow = st >> 2, spc = st & 3;
    const unsigned char* sgp = isv ? Vg + (size_t)srow * SEQ + spc * 16 : Kg + (size_t)srow * 256 + spc * 16;
    const size_t sstep = isv ? (size_t)64 : (size_t)64 * 256;
    const int soff = (isv ? AL_VB : AL_KB) + srow * 80 + spc * 16;
    u32x4 sr;
    if (!first_staged) {
        sr = ld16(sgp + (size_t)kb_lo * sstep);
        *(LAS u32x4*)(lds + soff) = sr;
        __syncthreads();
    }
    float m_run[2] = {0.f, 0.f}, l_run[2] = {0.f, 0.f};
    const float gate[2] = {gatep[0][MODE + 1], gatep[1][MODE + 1]};
    f32x4 oacc[2][4];
#pragma unroll
    for (int ti = 0; ti < 2; ++ti)
#pragma unroll
        for (int dt = 0; dt < 4; ++dt) oacc[ti][dt] = (f32x4){0.f, 0.f, 0.f, 0.f};
    for (int kb = kb_lo; kb <= kb_hi; ++kb) {
        const int buf = (kb - kb_lo) & 1;
        if (kb < kb_hi) sr = ld16(sgp + (size_t)(kb + 1) * sstep);
        const LAS unsigned char* kbuf = lds + AL_KB + buf * 5120; const LAS unsigned char* vbuf = lds + AL_VB + buf * 5120;
        f32x4 sacc[2][4];
        bool selb[2];
#pragma unroll
        for (int ti = 0; ti < 2; ++ti) selb[ti] = MODE == 0 ? (((selm[ti] >> kb) & 1u) != 0u) : true;
#pragma unroll
        for (int kt = 0; kt < 4; ++kt) {
            const fp8x8 k0 = *(const LAS fp8x8*)(kbuf + (16 * kt + n) * 80 + gq * 8), k1 = *(const LAS fp8x8*)(kbuf + (16 * kt + n) * 80 + 32 + gq * 8);
#pragma unroll
            for (int ti = 0; ti < 2; ++ti) {
                sacc[ti][kt] = __builtin_amdgcn_mfma_f32_16x16x32_fp8_fp8(k0, qf[ti][0], (f32x4){0.f, 0.f, 0.f, 0.f}, 0, 0, 0);
                sacc[ti][kt] = __builtin_amdgcn_mfma_f32_16x16x32_fp8_fp8(k1, qf[ti][1], sacc[ti][kt], 0, 0, 0);
            }
        }
        const bool need_mask = (kb == kb_hi) || (MODE == 1 && kb == kb_lo);
        if (need_mask) {
#pragma unroll
            for (int ti = 0; ti < 2; ++ti) {
                const int rel = sq[ti] - kb * 64 - 4 * gq;
#pragma unroll
                for (int kt = 0; kt < 4; ++kt)
#pragma unroll
                    for (int jj = 0; jj < 4; ++jj) { const int tt = 16 * kt + jj; const bool v = MODE == 0 ? (tt <= rel) : (tt <= rel && tt > rel - 512); sacc[ti][kt][jj] = v ? sacc[ti][kt][jj] : NEGBIG; }
            }
        }
        float mx[2];
#pragma unroll
        for (int ti = 0; ti < 2; ++ti) { mx[ti] = max16(sacc[ti]) - m_run[ti]; mx[ti] = selb[ti] ? mx[ti] : NEGBIG; }
        const bool slow = (mx[0] > ATT_THR) || (mx[1] > ATT_THR) || (l_run[0] == 0.f && mx[0] > -1e29f && mx[0] < -ATT_THR) || (l_run[1] == 0.f && mx[1] > -1e29f && mx[1] < -ATT_THR);
        if (__any(slow)) {
#pragma unroll
            for (int ti = 0; ti < 2; ++ti) {
                float mr = fmaxf(mx[ti], __shfl_xor(mx[ti], 16)); mr = fmaxf(mr, __shfl_xor(mr, 32));
                float lr = l_run[ti] + __shfl_xor(l_run[ti], 16); lr += __shfl_xor(lr, 32);
                const bool has = mr > -1e29f;
                const float delta = !has ? 0.f : (lr == 0.f ? mr : fmaxf(mr, 0.f));
                const float alpha = lr == 0.f ? 1.f : fast_exp2(-delta);
                l_run[ti] *= alpha; m_run[ti] += delta;
#pragma unroll
                for (int dt = 0; dt < 4; ++dt) oacc[ti][dt] *= alpha;
            }
        }
        if (__any(m_run[0] != 0.f || m_run[1] != 0.f)) {
#pragma unroll
            for (int ti = 0; ti < 2; ++ti)
#pragma unroll
                for (int kt = 0; kt < 4; ++kt) sacc[ti][kt] -= m_run[ti];
        }
        fp8x8 pf[2][2];
#pragma unroll
        for (int ti = 0; ti < 2; ++ti) {
            float ps = 0.f;
#pragma unroll
            for (int kt = 0; kt < 4; ++kt)
#pragma unroll
                for (int jj = 0; jj < 4; ++jj) { const float e = fast_exp2(sacc[ti][kt][jj]); sacc[ti][kt][jj] = e; ps += e; }
            l_run[ti] += selb[ti] ? ps : 0.f;
#pragma unroll
            for (int p = 0; p < 2; ++p) { unsigned lo = pk4p(sacc[ti][2 * p][0], sacc[ti][2 * p][1], sacc[ti][2 * p][2], sacc[ti][2 * p][3]), hi = pk4p(sacc[ti][2 * p + 1][0], sacc[ti][2 * p + 1][1], sacc[ti][2 * p + 1][2], sacc[ti][2 * p + 1][3]);
                if (MODE == 0) { lo = selb[ti] ? lo : 0u; hi = selb[ti] ? hi : 0u; }
                pf[ti][p] = mk8(lo, hi); }
        }
#pragma unroll
        for (int dt = 0; dt < 4; ++dt)
#pragma unroll
            for (int p = 0; p < 2; ++p) {
                const fp8x8 vf = *(const LAS fp8x8*)(vbuf + (16 * dt + n) * 80 + 32 * p + 8 * gq);
#pragma unroll
                for (int ti = 0; ti < 2; ++ti) oacc[ti][dt] = __builtin_amdgcn_mfma_f32_16x16x32_fp8_fp8(vf, pf[ti][p], oacc[ti][dt], 0, 0, 0);
            }
        if (kb < kb_hi) *(LAS u32x4*)(lds + (buf ^ 1) * 5120 + soff) = sr;
        __syncthreads();
    }
#pragma unroll
    for (int ti = 0; ti < 2; ++ti) {
        float lt = l_run[ti] + __shfl_xor(l_run[ti], 16); lt += __shfl_xor(lt, 32);
        const float inv = lt > 0.f ? gate[ti] / lt : 0.f;
#pragma unroll
        for (int dt = 0; dt < 4; ++dt) otl[(ti * 4 + dt) * 64] += oacc[ti][dt] * inv;
    }
}

__device__ __forceinline__ unsigned attn_cmp_tile(LAS unsigned char* lds, const fp8x8 qf0, const fp8x8 qf1, const int s, const int sbase  , const float g0,
                                                  LAS f32x4* otl  , const int lane, const int w, const int n, const int gq, const int tl, const int r) {
    f32x4 sacc[8];
#pragma unroll
    for (int kt = 0; kt < 8; ++kt) {
        const fp8x8 k0 = *(const LAS fp8x8*)(lds + AL_KC + (16 * kt + n) * 80 + gq * 8), k1 = *(const LAS fp8x8*)(lds + AL_KC + (16 * kt + n) * 80 + 32 + gq * 8);
        sacc[kt] = __builtin_amdgcn_mfma_f32_16x16x32_fp8_fp8(k0, qf0, (f32x4){0.f, 0.f, 0.f, 0.f}, 0, 0, 0);
        sacc[kt] = __builtin_amdgcn_mfma_f32_16x16x32_fp8_fp8(k1, qf1, sacc[kt], 0, 0, 0);
    }
    float mx = NEGBIG;
    const int lim = ((s - 31) >> 4) - 4 * gq;
#pragma unroll
    for (int kt = 0; kt < 8; ++kt)
#pragma unroll
        for (int jj = 0; jj < 4; ++jj) { const bool v = (16 * kt + jj <= lim); sacc[kt][jj] = v ? sacc[kt][jj] : NEGBIG; mx = fmaxf(mx, sacc[kt][jj]); }
    mx = fmaxf(mx, __shfl_xor(mx, 16)); mx = fmaxf(mx, __shfl_xor(mx, 32));
    float ps = 0.f;
#pragma unroll
    for (int kt = 0; kt < 8; ++kt)
#pragma unroll
        for (int jj = 0; jj < 4; ++jj) { const float e = sacc[kt][jj] > -1e29f ? fast_exp2(sacc[kt][jj] - mx) : 0.f; sacc[kt][jj] = e; ps += e; }
    ps += __shfl_xor(ps, 16); ps += __shfl_xor(ps, 32);
    const float inv = ps > 0.f ? 1.f / ps : 0.f;
#pragma unroll
    for (int kt = 0; kt < 8; ++kt) {
        f32x4 pp;
#pragma unroll
        for (int jj = 0; jj < 4; ++jj) { sacc[kt][jj] *= inv; float t = sacc[kt][jj]; t += dpp_mov<0xB1>(t); t += dpp_mov<0x4E>(t); pp[jj] = t; }
        if (r == 0) *(LAS f32x4*)(lds + AL_PS + ((w * 4 + tl) * 128 + 16 * kt + 4 * gq) * 4) = pp;
    }
    f32x4 otot[4];
#pragma unroll
    for (int dt = 0; dt < 4; ++dt) otot[dt] = (f32x4){0.f, 0.f, 0.f, 0.f};
#pragma unroll
    for (int p = 0; p < 4; ++p) {
        const fp8x8 pf = mk8(pk4p(sacc[2 * p][0], sacc[2 * p][1], sacc[2 * p][2], sacc[2 * p][3]), pk4p(sacc[2 * p + 1][0], sacc[2 * p + 1][1], sacc[2 * p + 1][2], sacc[2 * p + 1][3]));
#pragma unroll
        for (int dt = 0; dt < 4; ++dt) {
            const fp8x8 vf = *(const LAS fp8x8*)(lds + AL_VC + (16 * dt + n) * 144 + 32 * p + 8 * gq);
            otot[dt] = __builtin_amdgcn_mfma_f32_16x16x32_fp8_fp8(vf, pf, otot[dt], 0, 0, 0);
        }
    }
#pragma unroll
    for (int dt = 0; dt < 4; ++dt) otl[dt * 64] = otot[dt] * g0;
    asm volatile("s_waitcnt lgkmcnt(0)" ::: "memory");
    __builtin_amdgcn_wave_barrier();
    const int tl2 = lane >> 4, q = lane & 15, s2 = sbase + tl2, blkq = s2 >> 6;
    const LAS float* psr = (const LAS float*)(lds + AL_PS + ((w * 4 + tl2) * 128) * 4);
    const f32x4 xa = *(const LAS f32x4*)(psr + 8 * q), xb = *(const LAS f32x4*)(psr + 8 * q + 4);
    const float prev = q > 0 ? psr[8 * q - 1] : 0.f;
    float a0 = prev + xa[0] + xa[1] + xa[2] + xa[3], a1 = xa[3] + xb[0] + xb[1] + xb[2] + xb[3];
    const int m0 = 2 * q, m1 = 2 * q + 1;
    { const int rel0 = blkq - m0, rel1 = blkq - m1;
        if (rel0 < 0) a0 = -1.f;
        if (rel1 < 0) a1 = -1.f;
        if (m0 == 0 || rel0 == 0 || rel0 == 1) a0 = 1e6f;
        if (rel1 == 0 || rel1 == 1) a1 = 1e6f; }
    LAS float* impw = (LAS float*)(lds + AL_IMP + ((w * 4 + tl2) * 32) * 4);
    *(LAS f32x2*)(impw + 2 * q) = (f32x2){a0, a1};
    asm volatile("s_waitcnt lgkmcnt(0)" ::: "memory");
    __builtin_amdgcn_wave_barrier();
    int rk0 = 0, rk1 = 0;
#pragma unroll
    for (int i4 = 0; i4 < 8; ++i4) { const f32x4 v = *(const LAS f32x4*)(impw + 4 * i4);
#pragma unroll
        for (int j = 0; j < 4; ++j) { const int mm = 4 * i4 + j; rk0 += (v[j] > a0 || (v[j] == a0 && mm < m0)) ? 1 : 0; rk1 += (v[j] > a1 || (v[j] == a1 && mm < m1)) ? 1 : 0; } }
    unsigned bits = (rk0 < 16 ? (1u << m0) : 0u) | (rk1 < 16 ? (1u << m1) : 0u);
    bits |= dpp_movu<0xB1>(bits); bits |= dpp_movu<0x4E>(bits); bits |= dpp_movu<0x141>(bits); bits |= dpp_movu<0x140>(bits);
    LAS unsigned* selw = (LAS unsigned*)(lds + AL_SEL + (w * 4) * 4);
    if (q == 0) selw[tl2] = bits;
    asm volatile("s_waitcnt lgkmcnt(0)" ::: "memory");
    __builtin_amdgcn_wave_barrier();
    const unsigned selm = selw[tl];
    asm volatile("s_waitcnt lgkmcnt(0)" ::: "memory");
    __builtin_amdgcn_wave_barrier();
    return selm;
}

__device__ __forceinline__ void nsa_attn_phase(LAS unsigned char* lds, const AttnArgs& A) {
    const int tid0 = tid_opaque();
    for (int u = blockIdx.x; u < 4096; u += gridDim.x) {
        int tid = tid0; asm volatile("" : "+v"(tid));
        const int lane = tid & 63, w = tid >> 6, n = lane & 15, gq = lane >> 4, tl = n >> 2, r = n & 3;
        const int kq = u >> 8, c = 2 * kq + ((((u >> 7) & 1) ^ kq) & 1), bgi = u & 127, b = bgi >> 2, g = bgi & 3, s0 = c * 64;
        int sq[2]; fp8x8 qf[2][2]; const float* gp[2];
#pragma unroll
        for (int ti = 0; ti < 2; ++ti) {
            sq[ti] = s0 + 8 * w + 4 * ti + tl;
            const size_t qrow = (size_t)b * SEQ + sq[ti];
            const unsigned char* qp = A.Q + qrow * 1024 + g * 256 + r * 64 + 8 * gq;
            qf[ti][0] = *(const fp8x8*)qp; qf[ti][1] = *(const fp8x8*)(qp + 32);
            gp[ti] = A.GATES + qrow * 48 + (g * 4 + r) * 3;
        }
        const unsigned char* KSg = A.KS + (size_t)b * SEQ * 256 + g * 64; const unsigned char* VSg = A.VST + (size_t)(b * 4 + g) * 64 * SEQ;
        const unsigned char* KWg = A.KW + (size_t)b * SEQ * 256 + g * 64; const unsigned char* VWg = A.VWT + (size_t)(b * 4 + g) * 64 * SEQ;
        __syncthreads();
        { const int key = tid >> 2, pc = tid & 3; *(LAS u32x4*)(lds + AL_KC + key * 80 + pc * 16) = ld16(A.KCMP + ((size_t)(b * 128 + key) * 4 + g) * 64 + pc * 16); }
        { const int d = tid >> 3, pc = tid & 7; *(LAS u32x4*)(lds + AL_VC + d * 144 + pc * 16) = ld16(A.VCMPT + ((size_t)(b * 4 + g) * 64 + d) * 128 + pc * 16); }
        { const bool isv = tid >= 256; const int st = tid & 255, srow = st >> 2, spc = st & 3;
            *(LAS u32x4*)(lds + (isv ? AL_VB : AL_KB) + srow * 80 + spc * 16) = ld16(isv ? VSg + (size_t)srow * SEQ + spc * 16 : KSg + (size_t)srow * 256 + spc * 16); }
        __syncthreads();
        LAS f32x4* otl = (LAS f32x4*)(lds + AL_OT) + w * 512 + lane;
        unsigned selm[2];
#pragma unroll
        for (int ti = 0; ti < 2; ++ti) { selm[ti] = attn_cmp_tile(lds, qf[ti][0], qf[ti][1], sq[ti], s0 + 8 * w + 4 * ti, gp[ti][0], otl + ti * 256, lane, w, n, gq, tl, r); }
        attn_branch<0>(lds, KSg, VSg, 0, c, true, qf, sq, selm, gp, otl, n, gq, tid);
        attn_branch<1>(lds, KWg, VWg, c >= 8 ? c - 8 : 0, c, false, qf, sq, selm, gp, otl, n, gq, tid);
#pragma unroll
        for (int ti = 0; ti < 2; ++ti) {
            unsigned char* op = A.O + ((size_t)b * SEQ + sq[ti]) * 1024 + g * 256 + r * 64 + 4 * gq;
#pragma unroll
            for (int dt = 0; dt < 4; ++dt) { const f32x4 o = otl[(ti * 4 + dt) * 64] * S8_O; unsigned pk = 0u;
                pk = __builtin_amdgcn_cvt_pk_fp8_f32(clamp8(o[0]), clamp8(o[1]), pk, false); pk = __builtin_amdgcn_cvt_pk_fp8_f32(clamp8(o[2]), clamp8(o[3]), pk, true);
                *(unsigned*)(op + 16 * dt) = pk; }
        }
    }
    __syncthreads();
}
#ifndef DBG_ZERO_KIND
#define DBG_ZERO_KIND -1
#endif
#ifndef F8IN_MASK
#define F8IN_MASK 5
#endif
struct Params { const float* in[31]; float* out; unsigned char* ws; int ph_lo, ph_hi; };
constexpr int N_PHASES = 38;

#ifndef DUP_MASK
#define DUP_MASK 0ull
#endif
#define PH_BEGIN(k) if ((k) >= p.ph_lo && (k) < p.ph_hi) { for (int rep_ = 0; rep_ < (((DUP_MASK >> (k)) & 1ull) ? 2 : 1); ++rep_) {
#define PH_END(k) } if ((k) + 1 < p.ph_hi) xcd_barrier(bar); }

template <int LAYER>
__device__ __forceinline__ void layer_body(const Params& p, LAS unsigned char* lds, const XcdBarrier& bar) {
    constexpr int kind = LAYER % 3, j = LAYER / 3;
    constexpr int PB = LAYER == 0 ? 1 : (LAYER == 1 ? 10 : (LAYER == 2 ? 18 : 29));
    constexpr int NMIX = kind == 0 ? 4 : (kind == 1 ? 3 : 6);
    unsigned char* ws = p.ws;
    const int G = gridDim.x, cblk = blockIdx.x;
    const int* positions = (const int*)p.in[1];
    unsigned char* XA = ws + WS_XA; float* XF = p.out; bf16_t* MB = (bf16_t*)(ws + B_MB);
    int* route_e = (int*)(ws + WS_ROUTE_E); float* route_w = (float*)(ws + WS_ROUTE_W); int* posb = (int*)(ws + WS_POS); int* cnt = (int*)(ws + WS_CNT);
    int4* tiles = (int4*)(ws + WS_TILE); float* bias1 = (float*)(ws + WS_BIAS1);
    if constexpr (kind == 0) {
        unsigned char* Q = ws + B_Q; bf16_t* KC = (bf16_t*)(ws + B_KC); bf16_t* VC = (bf16_t*)(ws + B_VC); unsigned char* KS = ws + B_KS; unsigned char* VST = ws + B_VST;
        unsigned char* KW = ws + B_KW; unsigned char* VWT = ws + B_VWT; unsigned char* OB = ws + B_O;
        float* GATES = (float*)(ws + WS_GATES); unsigned char* KCMP = ws + WS_KCMP; unsigned char* VCMPT = ws + WS_VCMPT;
        PH_BEGIN(PB + 0)
            EpiNsaIn E{Q, KC, VC, KS, VST, KW, VWT, GATES, positions, p.in[3] + j * 48};
            if constexpr (F8IN_MASK & 1) { DenseSched8 S{XA, ws + W_NSA_IN + (size_t)j * NSA_NP * 1024, 1024, 1024, T_TOK / 256, NSA_NP / 256, G, cblk};
                gemm_phase<true>(lds, 1024, 1024, 1024, S, E, 1.f / (S8_X * S8_WI)); }
            else { DenseSched S{(const bf16_t*)XA, (const bf16_t*)(ws + W_NSA_IN) + (size_t)j * NSA_NP * 1024, 1024, 1024, T_TOK / 256, NSA_NP / 256, G, cblk};
                gemm_phase<false>(lds, 1024, 1024, 1024, S, E); }
        PH_END(PB + 0)
        PH_BEGIN(PB + 1)
            nsa_compress_phase(KC, VC, (const bf16_t*)(ws + W_CMP1) + (size_t)j * 2 * 64 * 2048, p.in[6] + j * 4096, p.in[9] + j * 4096, bias1 + j * 128, positions, KCMP, VCMPT);
        PH_END(PB + 1)
        PH_BEGIN(PB + 2)
            AttnArgs A{Q, KS, VST, KW, VWT, KCMP, VCMPT, GATES, OB};
            nsa_attn_phase(lds, A);
        PH_END(PB + 2)
        PH_BEGIN(PB + 3)
            DenseSched8 S{OB, ws + W_NSA_OUT + (size_t)j * 1024 * 1024, 1024, 1024, T_TOK / 256, 4, G, cblk};
            EpiPlain<false> E{MB, 1024, 1.f / (S8_O * S8_WO)};
            gemm_phase<true>(lds, 1024, 1024, 1024, S, E);
        PH_END(PB + 3)
    } else if constexpr (kind == 1) {
        bf16_t* P = (bf16_t*)(ws + B_P); bf16_t* BGb = (bf16_t*)(ws + B_BG); bf16_t* Y = (bf16_t*)(ws + B_Y);
        PH_BEGIN(PB + 0)
            EpiScIn E{P, BGb};
            if constexpr (F8IN_MASK & 2) { DenseSched8 S{XA, ws + W_SC_IN, 1024, 1024, T_TOK / 256, 12, G, cblk};
                gemm_phase<true>(lds, 1024, 1024, 1024, S, E, 1.f / (S8_X * S8_WI)); }
            else { DenseSched S{(const bf16_t*)XA, (const bf16_t*)(ws + W_SC_IN), 1024, 1024, T_TOK / 256, 12, G, cblk};
                gemm_phase<false>(lds, 1024, 1024, 1024, S, E); }
        PH_END(PB + 0)
        PH_BEGIN(PB + 1)
            sc_conv_phase(P, BGb, Y, p.in[12], p.in[13]);
        PH_END(PB + 1)
        PH_BEGIN(PB + 2)
            DenseSched S{Y, (const bf16_t*)(ws + W_SC_OUT), 1024, 1024, T_TOK / 256, 4, G, cblk};
            EpiPlain<false> E{MB, 1024, 1.f};
            gemm_phase<false>(lds, 1024, 1024, 1024, S, E);
        PH_END(PB + 2)
    } else {
        bf16_t* GG = (bf16_t*)(ws + B_GG); bf16_t* R1 = (bf16_t*)(ws + B_R1); bf16_t* R2 = (bf16_t*)(ws + B_R2); bf16_t* R3 = (bf16_t*)(ws + B_R3);
        f32x4* carry = (f32x4*)(ws + WS_CARRY);
        PH_BEGIN(PB + 0)
            EpiLruIn E{GG, R1};
            if constexpr (F8IN_MASK & 4) { DenseSched8 S{XA, ws + W_LRU_IN, 1024, 1024, T_TOK / 256, 10, G, cblk};
                gemm_phase<true>(lds, 1024, 1024, 1024, S, E, 1.f / (S8_X * S8_WI)); }
            else { DenseSched S{(const bf16_t*)XA, (const bf16_t*)(ws + W_LRU_IN), 1024, 1024, T_TOK / 256, 10, G, cblk};
                gemm_phase<false>(lds, 1024, 1024, 1024, S, E); }
        PH_END(PB + 0)
        PH_BEGIN(PB + 1)
            lru_conv_phase(R1, R2, p.in[16], p.in[17]);
        PH_END(PB + 1)
        PH_BEGIN(PB + 2)
            BandSched S{R2, (const bf16_t*)(ws + W_LRU_G), LRU_W, LRU_W, T_TOK / 256, 10, G, cblk};
            EpiLruGate E{R2, R1, R3, p.in[19], p.in[21], p.in[22]};
            gemm_phase<false>(lds, 384, LRU_W, LRU_W, S, E);
        PH_END(PB + 2)
        PH_BEGIN(PB + 3)
            lru_scan1_phase(R1, R3, carry);
        PH_END(PB + 3)
        PH_BEGIN(PB + 4)
            lru_scan2_phase(R1, R3, GG, carry, R2);
        PH_END(PB + 4)
        PH_BEGIN(PB + 5)
            DenseSched S{R2, (const bf16_t*)(ws + W_LRU_OUT), LRU_W, LRU_W, T_TOK / 256, 4, G, cblk};
            EpiPlain<false> E{MB, 1024, 1.f};
            gemm_phase<false>(lds, LRU_W, LRU_W, LRU_W, S, E);
        PH_END(PB + 5)
    }
    constexpr int FB = PB + NMIX;
    unsigned char* X8 = ws + B_XG; int* invb = (int*)(ws + WS_INV); unsigned char* HID = ws + B_HID; unsigned char* YM = ws + B_YM; unsigned char* WGU = ws + B_WMOE + WMOE_GU; unsigned char* WDN = ws + B_WMOE + WMOE_DN;
    const float* lng = p.in[29] + (size_t)LAYER * 2048; const float* lnb = p.in[30] + (size_t)LAYER * 2048;
    PH_BEGIN(FB + 0)
#if defined(SHADOW_LN) && (SHADOW_LN & 1)
        ln1_router_phase(lds, LAYER == 0 ? p.in[0] : (const float*)XF, MB, (float*)(ws + WS_BIG + 192 * MiB), ws + WS_BIG + 448 * MiB, lng, lnb, p.in[24], p.in[25], (int*)(ws + WS_BIG + 300 * MiB), (float*)(ws + WS_BIG + 302 * MiB), (int*)(ws + WS_BIG + 304 * MiB));
#endif
        ln1_router_phase(lds, LAYER == 0 ? p.in[0] : (const float*)XF, MB, XF, X8, lng, lnb, p.in[24], p.in[25], route_e, route_w, cnt);
    PH_END(FB + 0)
    PH_BEGIN(FB + 1)
        moe_gather_phase(lds, route_e, cnt, posb, invb, tiles);
        convert_wt<true>(lds, WGU, 16, 2048, 1024, FetchPair{p.in[26] + (size_t)LAYER * 16 * 1048576, (long)(p.in[27] - p.in[26]), 1024, (size_t)1048576}, S8_WGU);
        convert_wt<true>(lds, WDN, 16, 1024, 1024, FetchPlain{p.in[28] + (size_t)LAYER * 16 * 1048576, 1024, (size_t)1048576}, S8_WD);
    PH_END(FB + 1)
    PH_BEGIN(FB + 2)
        const int NT = __builtin_amdgcn_readfirstlane(tiles[0].x);
        MoeSched S{X8, WGU, tiles, invb, NT, 8, 2048, 1024, G, cblk};
        EpiMoeGU E{HID};
        gemm_phase<true, true>(lds, 1024, 1024, 1024, S, E);
    PH_END(FB + 2)
    PH_BEGIN(FB + 3)
        const int NT = __builtin_amdgcn_readfirstlane(tiles[0].x);
        MoeSched S{HID, WDN, tiles, invb, NT, 4, 1024, 1024, G, cblk};
        EpiMoeDown8 E{YM, S8_Y / (S8_H * S8_WD)};
        gemm_phase<true>(lds, 1024, 1024, 1024, S, E);
    PH_END(FB + 3)
    PH_BEGIN(FB + 4)
#if defined(SHADOW_LN) && (SHADOW_LN & 2)
        ln2_combine_phase<LAYER == DEPTH - 1, ((F8IN_MASK >> ((LAYER + 1) % 3)) & 1) != 0>(XF, (float*)(ws + B_XG), YM, posb, route_w, lng + 1024, lnb + 1024, ws + WS_BIG + 512 * MiB);
#endif
        ln2_combine_phase<LAYER == DEPTH - 1, ((F8IN_MASK >> ((LAYER + 1) % 3)) & 1) != 0>(XF, XF, YM, posb, route_w, lng + 1024, lnb + 1024, XA);
    PH_END(FB + 4)
}

__global__ void __launch_bounds__(NTHR, 2) hybrid_fwd(Params p) {
    extern __shared__ __attribute__((aligned(16))) unsigned char lds_raw[];
    LAS unsigned char* lds = (LAS unsigned char*)lds_raw;
    volatile LAS unsigned* bst = (volatile LAS unsigned*)(lds + LDS_BYTES - 16);
    const bool use_bar = (p.ph_hi - p.ph_lo) > 1;
    if (threadIdx.x == 0) { bst[0] = 0u; bst[1] = 0u; bst[2] = 0u; bst[3] = 0u; }
    __syncthreads();
    XcdBarrier bar; bar.bar = (unsigned*)(p.ws + WS_CTL); bar.x = 0; bar.st = bst;
    if (use_bar) bar = xcd_barrier_post((unsigned*)(p.ws + WS_CTL), bst);
    PH_BEGIN(0)
        unsigned char* ws = p.ws;
        convert_x<(F8IN_MASK & 1) != 0>(p.in[0], ws + WS_XA);
        for (int j = 0; j < 2; ++j) {
            if constexpr (F8IN_MASK & 1) convert_wt<true>(lds, ws + W_NSA_IN + (size_t)j * NSA_NP * 1024, 1, NSA_NP, 1024, FetchNsaIn{p.in[2] + (size_t)j * 1024 * 2608}, S8_WI);
            else convert_wt(lds, (bf16_t*)(ws + W_NSA_IN) + (size_t)j * NSA_NP * 1024, 1, NSA_NP, 1024, FetchNsaIn{p.in[2] + (size_t)j * 1024 * 2608});
            convert_wt<true>(lds, ws + W_NSA_OUT + (size_t)j * 1024 * 1024, 1, 1024, 1024, FetchPlain{p.in[10] + (size_t)j * 1024 * 1024, 1024, 0}, S8_WO);
            convert_wt(lds, (bf16_t*)(ws + W_CMP1) + (size_t)(j * 2 + 0) * 64 * 2048, 1, 64, 2048, FetchIdent{p.in[5] + (size_t)j * 2048 * 64, 64, 0});
            convert_wt(lds, (bf16_t*)(ws + W_CMP1) + (size_t)(j * 2 + 1) * 64 * 2048, 1, 64, 2048, FetchIdent{p.in[8] + (size_t)j * 2048 * 64, 64, 0});
        }
        if constexpr (F8IN_MASK & 2) convert_wt<true>(lds, ws + W_SC_IN, 1, 3072, 1024, FetchScIn{p.in[11]}, S8_WI); else convert_wt(lds, (bf16_t*)(ws + W_SC_IN), 1, 3072, 1024, FetchScIn{p.in[11]});
        convert_wt(lds, (bf16_t*)(ws + W_SC_OUT), 1, 1024, 1024, FetchPlain{p.in[14], 1024, 0});
        if constexpr (F8IN_MASK & 4) convert_wt<true>(lds, ws + W_LRU_IN, 1, 2560, 1024, FetchPlain{p.in[15], 2560, 0}, S8_WI); else convert_wt(lds, (bf16_t*)(ws + W_LRU_IN), 1, 2560, 1024, FetchPlain{p.in[15], 2560, 0});
        convert_wt(lds, (bf16_t*)(ws + W_LRU_G), 1, 2560, 1280, FetchLruGate{p.in[18], (long)(p.in[20] - p.in[18])});
        convert_wt(lds, (bf16_t*)(ws + W_LRU_OUT), 1, 1024, 1280, FetchPlain{p.in[23], 1024, 0});
        cmp_bias_phase(lds, p.in[4], p.in[5], p.in[7], p.in[8], (float*)(ws + WS_BIAS1));
    PH_END(0)
    layer_body<0>(p, lds, bar);
    layer_body<1>(p, lds, bar);
    layer_body<2>(p, lds, bar);
    layer_body<3>(p, lds, bar);
}
#undef PH_BEGIN
#undef PH_END

#ifndef MK_SPLIT
#define MK_SPLIT 0
#endif
extern "C" void kernel_launch(void* const* d_in, const int* in_sizes, int n_in, void* d_out, int out_size, void* d_ws, size_t ws_size, hipStream_t stream) {
    static int grid = 0;
    if (grid == 0) {
        int dev = 0, cus = 0, per_cu = 0;
        if (n_in != 31 || ws_size < WS_END) { fprintf(stderr, "kernel_launch: unexpected n_in %d or ws_size %zu (need %zu)\n", n_in, ws_size, (size_t)WS_END); grid = -1; return; }
        if (hipGetDevice(&dev) != hipSuccess || hipDeviceGetAttribute(&cus, hipDeviceAttributeMultiprocessorCount, dev) != hipSuccess) { grid = -1; return; }
        if (hipFuncSetAttribute((const void*)hybrid_fwd, hipFuncAttributeMaxDynamicSharedMemorySize, LDS_BYTES) != hipSuccess) { fprintf(stderr, "kernel_launch: hipFuncSetAttribute failed\n"); grid = -1; return; }
        if (hipOccupancyMaxActiveBlocksPerMultiprocessor(&per_cu, (const void*)hybrid_fwd, NTHR, LDS_BYTES) != hipSuccess || per_cu < 1) fprintf(stderr, "kernel_launch: occupancy query says %d\n", per_cu);
        (void)hipGetLastError();
        grid = cus;
    }
    if (grid < 0) return;
    (void)hipMemsetAsync((char*)d_ws + WS_CTL, 0, 64 * 1024, stream);
    Params p{};
    for (int i = 0; i < 31; ++i) p.in[i] = (const float*)d_in[i];
    p.out = (float*)d_out; p.ws = (unsigned char*)d_ws;
#if MK_SPLIT
    for (int ph = 0; ph < N_PHASES; ++ph) { p.ph_lo = ph; p.ph_hi = ph + 1; hipLaunchKernelGGL(hybrid_fwd, dim3(grid), dim3(NTHR), LDS_BYTES, stream, p); }
#else
    p.ph_lo = 0; p.ph_hi = N_PHASES;
    hipLaunchKernelGGL(hybrid_fwd, dim3(grid), dim3(NTHR), LDS_BYTES, stream, p);
#endif
    const hipError_t le = hipPeekAtLastError();
    if (le != hipSuccess) fprintf(stderr, "kernel_launch: launch failed: %s\n", hipGetErrorName(le));
}
```

```cpp
#include <hip/hip_runtime.h>
#include <stdint.h>
#include <stdio.h>

#define LAS __attribute__((address_space(3)))
typedef unsigned short bf16_t;
typedef short bf16x8 __attribute__((ext_vector_type(8)));
typedef float f32x4 __attribute__((ext_vector_type(4)));
typedef float f32x2 __attribute__((ext_vector_type(2)));
typedef unsigned u32x4 __attribute__((ext_vector_type(4)));
typedef unsigned u32x2 __attribute__((ext_vector_type(2)));
typedef int i32x8 __attribute__((ext_vector_type(8)));

constexpr int T_TOK = 65536, DM = 1024, SEQ = 2048, NBATCH = 32, DEPTH = 4;
constexpr int NTHR = 512;
constexpr int NSA_NP = 2816;
constexpr int LRU_W = 1280;
constexpr int NEXP = 16;
constexpr float DN_ALPHA = 1.6817928305074292f;
constexpr float LN_EPS = 1e-5f;
constexpr float NEGBIG = -1e30f;
constexpr float LOG2E = 1.4426950408889634f;

constexpr size_t KiB = 1024, MiB = 1024 * 1024;
constexpr size_t WS_CTL = 0;
constexpr size_t WS_ROUTE_E = 64 * KiB;
constexpr size_t WS_ROUTE_W = WS_ROUTE_E + 256 * KiB;
constexpr size_t WS_POS = WS_ROUTE_W + 512 * KiB;
constexpr size_t WS_CNT = WS_POS + 512 * KiB;
constexpr size_t WS_TILE = WS_CNT + 16 * KiB;
constexpr size_t WS_BIAS1 = WS_TILE + 16 * KiB;
constexpr size_t WS_INV = 1408 * KiB;
constexpr size_t WS_KCMP = 2 * MiB;
constexpr size_t WS_VCMPT = 4 * MiB;
constexpr size_t WS_CARRY = 6 * MiB;
constexpr size_t WS_GATES = 16 * MiB;
constexpr size_t WS_W = 28 * MiB;
constexpr size_t W_NSA_IN = WS_W;
constexpr size_t W_NSA_OUT = W_NSA_IN + 2 * (size_t)NSA_NP * 1024 * 2;
constexpr size_t W_SC_IN = W_NSA_OUT + 2 * (size_t)1024 * 1024 * 2;
constexpr size_t W_SC_OUT = W_SC_IN + (size_t)3072 * 1024 * 2;
constexpr size_t W_LRU_IN = W_SC_OUT + (size_t)1024 * 1024 * 2;
constexpr size_t W_LRU_G = W_LRU_IN + (size_t)2560 * 1024 * 2;
constexpr size_t W_LRU_OUT = W_LRU_G + (size_t)2560 * 1280 * 2;
constexpr size_t W_CMP1 = W_LRU_OUT + (size_t)1024 * 1280 * 2;
constexpr size_t W_END = W_CMP1 + 4 * (size_t)64 * 2048 * 2;
constexpr size_t WS_XA = 66 * MiB;
constexpr size_t WS_WMOE = WS_XA + 128 * MiB;
constexpr size_t WS_BIG = WS_WMOE + 96 * MiB;
constexpr size_t WS_END = WS_BIG + 642 * MiB;
static_assert(W_END <= WS_XA, "weights overflow");
constexpr size_t B_Q = WS_BIG, B_KC = B_Q + 128 * MiB, B_VC = B_KC + 32 * MiB, B_KS = B_VC + 32 * MiB, B_VST = B_KS + 32 * MiB, B_KW = B_VST + 32 * MiB,
                 B_VWT = B_KW + 32 * MiB, B_O = B_VWT + 32 * MiB;
constexpr size_t B_P = WS_BIG, B_BG = B_P + 128 * MiB, B_Y = B_BG + 128 * MiB;
constexpr size_t B_GG = WS_BIG, B_R1 = B_GG + 160 * MiB, B_R2 = B_R1 + 160 * MiB, B_R3 = B_R2 + 160 * MiB;
constexpr size_t B_MB = WS_BIG;
constexpr size_t B_XG = WS_BIG + 128 * MiB, B_HID = B_XG + 64 * MiB, B_YM = B_HID + 128 * MiB, B_WMOE = WS_WMOE;
constexpr size_t WMOE_GU = 0, WMOE_DN = (size_t)16 * 2048 * 1024;
constexpr float S8_X = 16.f, S8_WGU = 256.f, S8_H = 16.f, S8_WD = 512.f, S8_Y = 128.f, S8_WI = 256.f, S8_O = 32.f, S8_WO = 512.f, S8_Q = 4.f, S8_K = 0.25f;

constexpr int LDS_BYTES = 163840;

__device__ __forceinline__ unsigned cvt_pk_bf16(float lo, float hi) { unsigned r; asm volatile("v_cvt_pk_bf16_f32 %0, %1, %2" : "=v"(r) : "v"(lo), "v"(hi)); return r; }
__device__ __forceinline__ float bf_lo(unsigned u) { return __uint_as_float(u << 16); }
__device__ __forceinline__ float bf_hi(unsigned u) { return __uint_as_float(u & 0xffff0000u); }
__device__ __forceinline__ float bf2f(bf16_t h) { return __uint_as_float(((unsigned)h) << 16); }
__device__ __forceinline__ bf16_t f2bf(float f) { return (bf16_t)(cvt_pk_bf16(f, 0.f) & 0xffffu); }
__device__ __forceinline__ float fast_exp2(float x) { return __builtin_amdgcn_exp2f(x); }
__device__ __forceinline__ float fast_exp(float x) { return __builtin_amdgcn_exp2f(x * LOG2E); }
__device__ __forceinline__ float fast_rcp(float x) { return __builtin_amdgcn_rcpf(x); }
__device__ __forceinline__ float sigmoidf_(float x) { return fast_rcp(1.f + fast_exp(-x)); }
__device__ __forceinline__ float gelu_tanh(float x) { const float u = 0.7978845608028654f * (x + 0.044715f * x * x * x); return x * fast_rcp(1.f + fast_exp(-2.f * u)); }
__device__ __forceinline__ float silu_(float x) { return x * fast_rcp(1.f + fast_exp(-x)); }
__device__ __forceinline__ void sincos_rad(float ang, float& s, float& c) {
    float r = ang * 0.15915494309189535f; r = __builtin_amdgcn_fractf(r); s = __builtin_amdgcn_sinf(r); c = __builtin_amdgcn_cosf(r); }
__device__ __forceinline__ float wave_sum(float v) {
#pragma unroll
    for (int o = 32; o >= 1; o >>= 1) v += __shfl_xor(v, o);
    return v; }
template <int CTRL> __device__ __forceinline__ float dpp_mov(float v) { return __builtin_bit_cast(float, __builtin_amdgcn_update_dpp(0, __builtin_bit_cast(int, v), CTRL, 0xf, 0xf, false)); }
template <int CTRL> __device__ __forceinline__ unsigned dpp_movu(unsigned v) { return (unsigned)__builtin_amdgcn_update_dpp(0, (int)v, CTRL, 0xf, 0xf, false); }
__device__ __forceinline__ float row16_sum(float v) { v += dpp_mov<0xB1>(v); v += dpp_mov<0x4E>(v); v += dpp_mov<0x141>(v); v += dpp_mov<0x140>(v); return v; }
__device__ __forceinline__ float wave_sum_dpp(float v) { v = row16_sum(v); v += __shfl_xor(v, 16); v += __shfl_xor(v, 32); return v; }
__device__ __forceinline__ int tid_opaque() { int t = threadIdx.x; asm volatile("" : "+v"(t)); return t; }
__device__ __forceinline__ u32x4 ld16(const void* p) { return *(const u32x4*)p; }
__device__ __forceinline__ void st16(void* p, u32x4 v) { *(u32x4*)p = v; }

#define XB_TMO      128
#define XB_XCNT(j)  (256  + 64 * (j))
#define XB_XSUB(j)  (1280 + 64 * (j))
#define XB_XGEN(j)  (2304 + 64 * (j))
#define XB_TOP      3328
#define XB_TOPGEN   3392
#define XCD_BAR_WORDS 3456
#define XB_SPIN_CAP (1u << 22)
__device__ __forceinline__ unsigned xb_ld(unsigned* p)              { return __hip_atomic_load(p, __ATOMIC_RELAXED, __HIP_MEMORY_SCOPE_AGENT); }
__device__ __forceinline__ unsigned xb_add(unsigned* p, unsigned v) { return __hip_atomic_fetch_add(p, v, __ATOMIC_RELAXED, __HIP_MEMORY_SCOPE_AGENT); }
__device__ __forceinline__ unsigned xb_xcc_id() { return (unsigned)__builtin_amdgcn_s_getreg((3 << 11) | 20) & 0xFu; }
#define XB_SPIN(cond, bar) do { unsigned _sp = 0; while (cond) { __builtin_amdgcn_s_sleep(1); \
    if ((++_sp & 255u) == 0u) { if (xb_ld(&(bar)[XB_TMO])) break; if (_sp > XB_SPIN_CAP) { atomicAdd(&(bar)[XB_TMO], 1u); break; } } } } while (0)
struct XcdBarrier { unsigned* bar; unsigned x; volatile LAS unsigned* st; };
__device__ __forceinline__ XcdBarrier xcd_barrier_post(unsigned* bar, volatile LAS unsigned* st) {
    XcdBarrier b; b.bar = bar; b.x = xb_xcc_id(); b.st = st;
    if (threadIdx.x == 0) (void)xb_add(&bar[XB_XCNT(b.x)], 1u);
    return b;
}
__device__ __forceinline__ void xcd_barrier_complete(unsigned* bar, unsigned x, unsigned& nloc, unsigned& nx) {
    const unsigned G = gridDim.x * gridDim.y * gridDim.z;
    unsigned sum, cnt, mine, sp = 0u;
    for (;;) {
        sum = 0u; cnt = 0u; mine = 0u;
#pragma unroll
        for (unsigned j = 0; j < 16; ++j) { const unsigned c = xb_ld(&bar[XB_XCNT(j)]); sum += c; cnt += (c > 0u) ? 1u : 0u; mine = (j == x) ? c : mine; }
        if (sum == G) break;
        __builtin_amdgcn_s_sleep(1);
        if ((++sp & 255u) == 0u) { if (xb_ld(&bar[XB_TMO])) break; if (sp > XB_SPIN_CAP) { atomicAdd(&bar[XB_TMO], 1u); break; } }
    }
    nloc = mine > 0u ? mine : 1u; nx = cnt > 0u ? cnt : 1u;
}
__device__ __forceinline__ void xcd_barrier(const XcdBarrier& b) {
    asm volatile("s_waitcnt vmcnt(0)" ::: "memory");
    __syncthreads();
    if (threadIdx.x == 0) {
        unsigned* bar = b.bar;
        __builtin_amdgcn_s_waitcnt(0);
        unsigned nloc = b.st[0], nx = b.st[1];
        if (nloc == 0u) { xcd_barrier_complete(bar, b.x, nloc, nx); b.st[0] = nloc; b.st[1] = nx; }
        const unsigned old = xb_add(&bar[XB_XSUB(b.x)], 1u);
        const unsigned gen = old / nloc;
        if (old + 1u == (gen + 1u) * nloc) {
            __builtin_amdgcn_fence(__ATOMIC_RELEASE, "agent");
            asm volatile("s_waitcnt vmcnt(0)" ::: "memory");
            const unsigned og = xb_add(&bar[XB_TOP], 1u);
            const unsigned tg = og / nx;
            if (og + 1u == (tg + 1u) * nx) xb_add(&bar[XB_TOPGEN], 1u);
            else XB_SPIN(xb_ld(&bar[XB_TOPGEN]) == tg, bar);
            __builtin_amdgcn_fence(__ATOMIC_ACQUIRE, "agent");
            xb_add(&bar[XB_XGEN(b.x)], 1u);
            asm volatile("s_waitcnt vmcnt(0)" ::: "memory");
        } else {
            XB_SPIN(xb_ld(&bar[XB_XGEN(b.x)]) == gen, bar);
            __builtin_amdgcn_fence(__ATOMIC_ACQUIRE, "agent");
            asm volatile("s_waitcnt vmcnt(0)" ::: "memory");
        }
    }
    __syncthreads();
}

constexpr int BM = 256, BK = 64, HALF = 128, HTB = HALF * BK * 2, STAGE_BYTES = 8 * HTB, NXCD = 8, WGM = 8;
__host__ __device__ __forceinline__ int lds_byte(int r, int c) { const int st = (r >> 4) * 2 + (c >> 5), rr = r & 15, cc = c & 31, ob = rr * 64 + cc * 2; return st * 1024 + (ob ^ (((ob >> 9) & 1) << 5)); }
__host__ __device__ __forceinline__ void stage_rc(int b, int& R, int& C) { const int st = b / 1024, sb = b % 1024, swz = sb ^ (((sb >> 9) & 1) << 5); R = (st >> 1) * 16 + swz / 64; C = (st & 1) * 32 + (swz % 64) / 2; }

struct GUnit { const char* a; const char* b; int pn; int row0; int nrows; int aux; };
__device__ __forceinline__ void map_unit(int L, int nM, int nN, int& pm, int& pn) {
    const int nwg = nM * nN; int wgid = L;
    { const int q = nwg / NXCD, r = nwg % NXCD, xcd = wgid % NXCD, off = wgid / NXCD; wgid = (xcd < r ? xcd * (q + 1) : r * (q + 1) + (xcd - r) * q) + off; }
    const int nig = WGM * nN, gid = wgid / nig, fm = gid * WGM, gsz = (nM - fm) < WGM ? (nM - fm) : WGM;
    pm = fm + ((wgid % nig) % gsz); pn = (wgid % nig) / gsz;
}
struct DenseSched {
    const bf16_t* A; const bf16_t* Bt; int lda, K, nM, nN, G, c;
    __device__ __forceinline__ bool next(int i, GUnit& u) const {
        const long L = (long)i * G + c; if (L >= (long)nM * nN) return false;
        int pm, pn; map_unit((int)L, nM, nN, pm, pn);
        u.a = (const char*)(A + (size_t)pm * BM * lda); u.b = (const char*)(Bt + (size_t)pn * BM * K); u.pn = pn; u.row0 = pm * BM; u.nrows = BM; u.aux = 0; return true;
    }
};
struct DenseSched8 {
    const unsigned char* A; const unsigned char* Bt; int lda, K, nM, nN, G, c;
    __device__ __forceinline__ bool next(int i, GUnit& u) const {
        const long L = (long)i * G + c; if (L >= (long)nM * nN) return false;
        int pm, pn; map_unit((int)L, nM, nN, pm, pn);
        u.a = (const char*)(A + (size_t)pm * BM * lda); u.b = (const char*)(Bt + (size_t)pn * BM * K); u.pn = pn; u.row0 = pm * BM; u.nrows = BM; u.aux = 0; return true;
    }
};
struct BandSched {
    const bf16_t* A; const bf16_t* Bt; int lda, ldb, nM, nN, G, c;
    __device__ __forceinline__ bool next(int i, GUnit& u) const {
        const long L = (long)i * G + c; if (L >= (long)nM * nN) return false;
        int pm, pn; map_unit((int)L, nM, nN, pm, pn);
        int k0 = ((128 * pn / 80) * 80 / 64) * 64; k0 = k0 > ldb - 384 ? ldb - 384 : k0;
        u.a = (const char*)(A + (size_t)pm * BM * lda + k0); u.b = (const char*)(Bt + (size_t)pn * BM * ldb + k0); u.pn = pn; u.row0 = pm * BM; u.nrows = BM; u.aux = 0; return true;
    }
};
struct MoeSched {
    const unsigned char* A; const unsigned char* W; const int4* tiles; const int* inv; int NT, nN, N, K, G, c;
    __device__ __forceinline__ bool next(int i, GUnit& u) const {
        const long L = (long)i * G + c; if (L >= (long)NT * nN) return false;
        int pm, pn; map_unit((int)L, NT, nN, pm, pn);
        const int4 t = tiles[1 + pm];
        const int e = __builtin_amdgcn_readfirstlane(t.x), r0 = __builtin_amdgcn_readfirstlane(t.y), nr = __builtin_amdgcn_readfirstlane(t.z);
        u.a = (const char*)(A + (size_t)r0 * K); u.b = (const char*)(W + ((size_t)e * N + (size_t)pn * BM) * K); u.pn = pn; u.row0 = r0; u.nrows = nr; u.aux = e; return true;
    }
};

template <bool F8, bool GATHER = false, class Epi, class Sched>
__device__ __forceinline__ void gemm_phase(LAS unsigned char* lds, const int K  , const int lda, const int ldb  , const Sched& S, const Epi& E, const float accs = 1.f  ) {
    const int tid = tid_opaque(), wid = __builtin_amdgcn_readfirstlane(tid >> 6), lane = tid & 63, wr = wid >> 2, wc = wid & 3, fr = lane & 15, fq = lane >> 4;
    const int nt = F8 ? K / 128 : K / BK;
    unsigned voffA[2], voffB[2];
#pragma unroll
    for (int i = 0; i < 2; ++i) { int R, C; stage_rc(tid * 16 + i * 8192, R, C); voffA[i] = F8 ? (unsigned)(R * lda + 2 * C) : (unsigned)(R * lda + C) * 2u; voffB[i] = F8 ? (unsigned)(R * ldb + 2 * C) : (unsigned)(R * ldb + C) * 2u; }
    int gR[2]; unsigned gC[2]; unsigned vc[2][2], vn[2][2];
#pragma unroll
    for (int i = 0; i < 2; ++i) { int R, C; stage_rc(tid * 16 + i * 8192, R, C); gR[i] = R; gC[i] = 2u * (unsigned)C; }
#define PG8_GLOAD(dst, unit) do { if constexpr (GATHER) { _Pragma("unroll") for (int _h = 0; _h < 2; ++_h) _Pragma("unroll") for (int _i = 0; _i < 2; ++_i) \
        dst[_h][_i] = (unsigned)S.inv[(unit).row0 + _h * HALF + gR[_i]] * (unsigned)lda + gC[_i]; } } while (0)
#define PG8_STAGE_A(bufoff, h, kofs, unext) do { if constexpr (GATHER) { _Pragma("unroll") for (int _i = 0; _i < 2; ++_i) \
        __builtin_amdgcn_global_load_lds((const unsigned*)((const char*)S.A + (kofs) + ((unext) ? vn[h][_i] : vc[h][_i])), (LAS unsigned*)(lds + (bufoff) + ldsw + _i * 8192), 16, 0, 0); } \
        else PG8_STAGE(bufoff, ((unext) ? nA : cA) + (h) * hstepA + (kofs), voffA); } while (0)
    const size_t kstep = (size_t)(BK * 2);
    const size_t hstepA = (size_t)HALF * lda * (F8 ? 1 : 2), hstepB = (size_t)HALF * ldb * (F8 ? 1 : 2);
    const unsigned ldsw = (unsigned)wid * 1024u;
    const int aoff = lds_byte(wr * 64 + fr, fq * 8), boff = lds_byte(wc * 32 + fr, fq * 8);
    const LAS unsigned char* ldsA = lds + aoff; const LAS unsigned char* ldsB = lds + 65536 + boff;
#define PG8_SA(b, h) (((b) * 2 + (h)) * HTB)
#define PG8_SB(b, h) ((4 + (b) * 2 + (h)) * HTB)
#define PG8_STAGE(bufoff, gbase, voff) do { _Pragma("unroll") for (int _i = 0; _i < 2; ++_i) \
        __builtin_amdgcn_global_load_lds((const unsigned*)((const char*)(gbase) + (voff)[_i]), (LAS unsigned*)(lds + (bufoff) + ldsw + _i * 8192), 16, 0, 0); } while (0)
#define PG8_LD16(off) (*(const LAS u32x4*)(lds + (off)))
#define PG8_LDA16(off) (*(const LAS u32x4*)(ldsA + (off)))
#define PG8_LDB16(off) (*(const LAS u32x4*)(ldsB + (off)))
#define PG8_LDA(dst, b, h) do { _Pragma("unroll") for (int m = 0; m < 4; ++m) { \
        if constexpr (F8) dst##8[m] = __builtin_shufflevector(PG8_LDA16(PG8_SA(b, h) + m * 2048), PG8_LDA16(PG8_SA(b, h) + m * 2048 + 1024), 0, 1, 2, 3, 4, 5, 6, 7); \
        else { _Pragma("unroll") for (int k = 0; k < 2; ++k) dst[m][k] = *(const LAS bf16x8*)(lds + PG8_SA(b, h) + aoff + m * 2048 + k * 1024); } } } while (0)
#define PG8_LDB(dst, b, h) do { _Pragma("unroll") for (int n = 0; n < 2; ++n) { \
        if constexpr (F8) dst##8[n] = __builtin_shufflevector(PG8_LDB16(PG8_SB(b, h) - 65536 + n * 2048), PG8_LDB16(PG8_SB(b, h) - 65536 + n * 2048 + 1024), 0, 1, 2, 3, 4, 5, 6, 7); \
        else { _Pragma("unroll") for (int k = 0; k < 2; ++k) dst[n][k] = *(const LAS bf16x8*)(lds + PG8_SB(b, h) + boff + n * 2048 + k * 1024); } } } while (0)
#define PG8_MMA(ai, bj, At, Bt) do { __builtin_amdgcn_s_setprio(1); _Pragma("unroll") for (int m = 0; m < 4; ++m) _Pragma("unroll") for (int n = 0; n < 2; ++n) { \
        if constexpr (F8) asm("v_mfma_f32_16x16x128_f8f6f4 %0, %1, %2, %0" : "+v"(acc[ai][bj][m][n]) : "v"(Bt##8[n]), "v"(At##8[m])); \
        else { _Pragma("unroll") for (int k = 0; k < 2; ++k) acc[ai][bj][m][n] = __builtin_amdgcn_mfma_f32_16x16x32_bf16(Bt[n][k], At[m][k], acc[ai][bj][m][n], 0, 0, 0); } } \
        __builtin_amdgcn_s_setprio(0); } while (0)
#define PG8_WAIT_V(n) asm volatile("s_waitcnt vmcnt(" #n ")" ::: "memory")
#define PG8_WAIT_L(n) asm volatile("s_waitcnt lgkmcnt(" #n ")" ::: "memory")
#define PG8_BAR __builtin_amdgcn_s_barrier()
#define PG8_SCHED __builtin_amdgcn_sched_barrier(0)
    GUnit cur, nxt; int ui = 0;
    if (!S.next(0, cur)) return;
    f32x4 acc[2][2][4][2];
#pragma unroll
    for (int a = 0; a < 2; ++a)
#pragma unroll
        for (int b = 0; b < 2; ++b)
#pragma unroll
            for (int m = 0; m < 4; ++m)
#pragma unroll
                for (int n = 0; n < 2; ++n) acc[a][b][m][n] = (f32x4){0.f, 0.f, 0.f, 0.f};
    bf16x8 At[4][2], B0[2][2], B1[2][2];
    typedef unsigned u32x8 __attribute__((ext_vector_type(8)));
    u32x8 At8[4], B08[2], B18[2];
    const char* cA = cur.a; const char* cB = cur.b; const char* nA = cA;
    PG8_GLOAD(vc, cur);
    PG8_STAGE(PG8_SB(0, 0), cB, voffB); PG8_STAGE_A(PG8_SA(0, 0), 0, (size_t)0, false); PG8_STAGE(PG8_SB(0, 1), cB + hstepB, voffB); PG8_STAGE_A(PG8_SA(0, 1), 1, (size_t)0, false);
    if (wr == 1) PG8_BAR;
    PG8_WAIT_V(4); PG8_BAR;
    PG8_STAGE(PG8_SB(1, 0), cB + kstep, voffB); PG8_STAGE_A(PG8_SA(1, 0), 0, kstep, false); PG8_STAGE(PG8_SB(1, 1), cB + hstepB + kstep, voffB);
    PG8_WAIT_V(6); PG8_BAR;
    for (;;) {
        const bool has_next = S.next(ui + 1, nxt);
        nA = has_next ? nxt.a : cA; const char* nB = has_next ? nxt.b : cB;
        if (has_next) PG8_GLOAD(vn, nxt); else { _Pragma("unroll") for (int _h = 0; _h < 2; ++_h) _Pragma("unroll") for (int _i = 0; _i < 2; ++_i) vn[_h][_i] = vc[_h][_i]; }
#pragma unroll 1
        for (int t = 0; t < nt; t += 2) {
            const bool last = (t == nt - 2);
            const size_t ka1 = (size_t)(t + 1) * kstep, ka2 = last ? (size_t)0 : (size_t)(t + 2) * kstep, ka3 = ka2 + kstep;
            const char* b2 = last ? nB : cB + (size_t)(t + 2) * kstep;
            const char* b3 = b2 + kstep;
            PG8_LDB(B0, 0, 0); PG8_SCHED; PG8_LDA(At, 0, 0); PG8_STAGE_A(PG8_SA(1, 1), 1, ka1, false);
            PG8_WAIT_L(8); PG8_BAR; PG8_WAIT_L(0); PG8_MMA(0, 0, At, B0); PG8_BAR; PG8_SCHED;
            PG8_LDB(B1, 0, 1); PG8_STAGE(PG8_SB(0, 0), b2, voffB);
            PG8_BAR; PG8_WAIT_L(0); PG8_MMA(0, 1, At, B1); PG8_BAR;
            PG8_LDA(At, 0, 1); PG8_STAGE_A(PG8_SA(0, 0), 0, ka2, last);
            PG8_BAR; PG8_WAIT_L(0); PG8_MMA(1, 0, At, B0); PG8_BAR; PG8_SCHED;
            PG8_STAGE(PG8_SB(0, 1), b2 + hstepB, voffB);
            PG8_WAIT_V(6); PG8_BAR; PG8_MMA(1, 1, At, B1); PG8_BAR;
            PG8_LDB(B0, 1, 0); PG8_SCHED; PG8_LDA(At, 1, 0); PG8_STAGE_A(PG8_SA(0, 1), 1, ka2, last);
            PG8_WAIT_L(8); PG8_BAR; PG8_WAIT_L(0); PG8_MMA(0, 0, At, B0); PG8_BAR; PG8_SCHED;
            PG8_LDB(B1, 1, 1); PG8_STAGE(PG8_SB(1, 0), b3, voffB);
            PG8_BAR; PG8_WAIT_L(0); PG8_MMA(0, 1, At, B1); PG8_BAR;
            PG8_LDA(At, 1, 1); PG8_STAGE_A(PG8_SA(1, 0), 0, ka3, last);
            PG8_BAR; PG8_WAIT_L(0); PG8_MMA(1, 0, At, B0); PG8_BAR; PG8_SCHED;
            PG8_STAGE(PG8_SB(1, 1), b3 + hstepB, voffB);
            PG8_WAIT_V(6); PG8_BAR; PG8_MMA(1, 1, At, B1); PG8_BAR;
        }
        if constexpr (F8) asm volatile("s_nop 15\n\ts_nop 15" ::: "memory");
        if (accs != 1.f) {
#pragma unroll
            for (int a = 0; a < 2; ++a)
#pragma unroll
                for (int b = 0; b < 2; ++b)
#pragma unroll
                    for (int m = 0; m < 4; ++m)
#pragma unroll
                        for (int n = 0; n < 2; ++n) acc[a][b][m][n] *= accs;
        }
        E(acc, cur, wr, wc, fr, fq);
        if (!has_next) break;
#pragma unroll
        for (int a = 0; a < 2; ++a)
#pragma unroll
            for (int b = 0; b < 2; ++b)
#pragma unroll
                for (int m = 0; m < 4; ++m)
#pragma unroll
                    for (int n = 0; n < 2; ++n) acc[a][b][m][n] = (f32x4){0.f, 0.f, 0.f, 0.f};
        cur = nxt; cA = nA; cB = nB; ++ui;
#pragma unroll
        for (int _h = 0; _h < 2; ++_h)
#pragma unroll
            for (int _i = 0; _i < 2; ++_i) vc[_h][_i] = vn[_h][_i];
    }
    PG8_WAIT_V(0);
    if (wr == 0) PG8_BAR;
    PG8_BAR;
#undef PG8_SA
#undef PG8_SB
#undef PG8_STAGE
#undef PG8_STAGE_A
#undef PG8_GLOAD
#undef PG8_LDA
#undef PG8_LDB
#undef PG8_MMA
#undef PG8_LD16
#undef PG8_LDA16
#undef PG8_LDB16
#undef PG8_WAIT_V
#undef PG8_WAIT_L
#undef PG8_BAR
#undef PG8_SCHED
}
typedef f32x4 acc_t[2][2][4][2];
__device__ __forceinline__ u32x4 pack8(f32x4 a, f32x4 b) { return (u32x4){cvt_pk_bf16(a[0], a[1]), cvt_pk_bf16(a[2], a[3]), cvt_pk_bf16(b[0], b[1]), cvt_pk_bf16(b[2], b[3])}; }
__device__ __forceinline__ void unpack8(u32x4 v, float* f) { f[0] = bf_lo(v[0]); f[1] = bf_hi(v[0]); f[2] = bf_lo(v[1]); f[3] = bf_hi(v[1]); f[4] = bf_lo(v[2]); f[5] = bf_hi(v[2]); f[6] = bf_lo(v[3]); f[7] = bf_hi(v[3]); }

template <bool MASK> struct EpiPlain {
    bf16_t* O; int ldo; float scale;
    __device__ __forceinline__ void operator()(const acc_t& acc, const GUnit& u, int wr, int wc, int fr, int fq) const {
        const int colb = u.pn * 256 + wc * 32 + fq * 8;
#pragma unroll
        for (int ai = 0; ai < 2; ++ai)
#pragma unroll
            for (int m = 0; m < 4; ++m) {
                const int r = ai * 128 + wr * 64 + m * 16 + fr;
                if (MASK && r >= u.nrows) continue;
                bf16_t* rowp = O + (size_t)(u.row0 + r) * ldo + colb;
#pragma unroll
                for (int bj = 0; bj < 2; ++bj) st16(rowp + bj * 128, pack8(acc[ai][bj][m][0] * scale, acc[ai][bj][m][1] * scale));
            }
    }
};

struct EpiResid {
    float* XF; const float* XR;
    __device__ __forceinline__ void operator()(const acc_t& acc, const GUnit& u, int wr, int wc, int fr, int fq) const {
        const int colb = u.pn * 256 + wc * 32 + fq * 8;
#pragma unroll
        for (int ai = 0; ai < 2; ++ai)
#pragma unroll
            for (int m = 0; m < 4; ++m) {
                const int r = ai * 128 + wr * 64 + m * 16 + fr;
                float* rowp = XF + (size_t)(u.row0 + r) * 1024 + colb; const float* rrow = XR + (size_t)(u.row0 + r) * 1024 + colb;
                asm volatile("" ::: "memory");
#pragma unroll
                for (int bj = 0; bj < 2; ++bj) {
                    const f32x4 x0 = *(const f32x4*)(rrow + bj * 128), x1 = *(const f32x4*)(rrow + bj * 128 + 4);
                    *(f32x4*)(rowp + bj * 128) = x0 * DN_ALPHA + acc[ai][bj][m][0]; *(f32x4*)(rowp + bj * 128 + 4) = x1 * DN_ALPHA + acc[ai][bj][m][1];
                }
            }
    }
};

__device__ __forceinline__ float clamp8(float x) { return __builtin_amdgcn_fmed3f(x, -448.f, 448.f); }
__device__ __forceinline__ u32x2 pack8_fp8(const float* f) {
    unsigned a = 0u, b = 0u;
    a = __builtin_amdgcn_cvt_pk_fp8_f32(clamp8(f[0]), clamp8(f[1]), a, false); a = __builtin_amdgcn_cvt_pk_fp8_f32(clamp8(f[2]), clamp8(f[3]), a, true);
    b = __builtin_amdgcn_cvt_pk_fp8_f32(clamp8(f[4]), clamp8(f[5]), b, false); b = __builtin_amdgcn_cvt_pk_fp8_f32(clamp8(f[6]), clamp8(f[7]), b, true);
    return (u32x2){a, b};
}
__device__ __forceinline__ void unpack8_fp8(u32x2 v, float* f) {
    const f32x2 a = __builtin_amdgcn_cvt_pk_f32_fp8(v[0], false), b = __builtin_amdgcn_cvt_pk_f32_fp8(v[0], true), c = __builtin_amdgcn_cvt_pk_f32_fp8(v[1], false), d = __builtin_amdgcn_cvt_pk_f32_fp8(v[1], true);
    f[0] = a[0]; f[1] = a[1]; f[2] = b[0]; f[3] = b[1]; f[4] = c[0]; f[5] = c[1]; f[6] = d[0]; f[7] = d[1]; }
__device__ __forceinline__ unsigned pack4_fp8(float a, float b, float c, float d) { unsigned r = 0u;
    r = __builtin_amdgcn_cvt_pk_fp8_f32(clamp8(a), clamp8(b), r, false); r = __builtin_amdgcn_cvt_pk_fp8_f32(clamp8(c), clamp8(d), r, true); return r; }
__device__ __forceinline__ int vperm32(int s) { const int k = s & 31; return (s & ~31) + 8 * ((k >> 2) & 3) + 4 * (k >> 4) + (k & 3); }
struct EpiMoeDown8 {
    unsigned char* O; float scale;
    __device__ __forceinline__ void operator()(const acc_t& acc, const GUnit& u, int wr, int wc, int fr, int fq) const {
        const int colb = u.pn * 256 + wc * 32 + fq * 8;
#pragma unroll
        for (int ai = 0; ai < 2; ++ai)
#pragma unroll
            for (int m = 0; m < 4; ++m) {
                const int r = ai * 128 + wr * 64 + m * 16 + fr;
                if (r >= u.nrows) continue;
                unsigned char* rowp = O + (size_t)(u.row0 + r) * 1024 + colb;
#pragma unroll
                for (int bj = 0; bj < 2; ++bj) { const f32x4 v0 = acc[ai][bj][m][0] * scale, v1 = acc[ai][bj][m][1] * scale;
                    const float f[8] = {v0[0], v0[1], v0[2], v0[3], v1[0], v1[1], v1[2], v1[3]}; *(u32x2*)(rowp + bj * 128) = pack8_fp8(f); }
            }
    }
};
struct EpiMoeGU {
    unsigned char* O;
    __device__ __forceinline__ void operator()(const acc_t& acc, const GUnit& u, int wr, int wc, int fr, int fq) const {
        const int colb = u.pn * 128 + wc * 32 + fq * 8;
#pragma unroll
        for (int ai = 0; ai < 2; ++ai)
#pragma unroll
            for (int m = 0; m < 4; ++m) {
                const int r = ai * 128 + wr * 64 + m * 16 + fr;
                if (r >= u.nrows) continue;
                float h[8];
                constexpr float DS = 1.f / (S8_X * S8_WGU);
#pragma unroll
                for (int bj = 0; bj < 2; ++bj)
#pragma unroll
                    for (int jj = 0; jj < 4; ++jj) h[bj * 4 + jj] = silu_(acc[ai][bj][m][0][jj] * DS) * (acc[ai][bj][m][1][jj] * (DS * S8_H));
                *(u32x2*)(O + (size_t)(u.row0 + r) * 1024 + colb) = pack8_fp8(h);
            }
    }
};

struct EpiScIn {
    bf16_t* P; bf16_t* BG;
    __device__ __forceinline__ void operator()(const acc_t& acc, const GUnit& u, int wr, int wc, int fr, int fq) const {
        if (u.pn < 8) {
            const int colb = u.pn * 128 + wc * 32 + fq * 8;
#pragma unroll
            for (int ai = 0; ai < 2; ++ai)
#pragma unroll
                for (int m = 0; m < 4; ++m) {
                    const int r = ai * 128 + wr * 64 + m * 16 + fr;
                    st16(P + (size_t)(u.row0 + r) * 1024 + colb, pack8(acc[ai][0][m][0] * acc[ai][0][m][1], acc[ai][1][m][0] * acc[ai][1][m][1]));
                }
        } else {
            const int colb = (u.pn - 8) * 256 + wc * 32 + fq * 8;
#pragma unroll
            for (int ai = 0; ai < 2; ++ai)
#pragma unroll
                for (int m = 0; m < 4; ++m) {
                    const int r = ai * 128 + wr * 64 + m * 16 + fr;
                    bf16_t* rowp = BG + (size_t)(u.row0 + r) * 1024 + colb;
#pragma unroll
                    for (int bj = 0; bj < 2; ++bj) st16(rowp + bj * 128, pack8(acc[ai][bj][m][0], acc[ai][bj][m][1]));
                }
        }
    }
};

struct EpiLruIn {
    bf16_t* GG; bf16_t* REC;
    __device__ __forceinline__ void operator()(const acc_t& acc, const GUnit& u, int wr, int wc, int fr, int fq) const {
        const bool isg = u.pn < 5;
        bf16_t* O = GG + (isg ? 0l : (REC - GG));
        const int colb = (isg ? u.pn : u.pn - 5) * 256 + wc * 32 + fq * 8;
#pragma unroll
        for (int ai = 0; ai < 2; ++ai)
#pragma unroll
            for (int m = 0; m < 4; ++m) {
                const int r = ai * 128 + wr * 64 + m * 16 + fr;
                bf16_t* rowp = O + (size_t)(u.row0 + r) * LRU_W + colb;
#pragma unroll
                for (int bj = 0; bj < 2; ++bj) {
                    f32x4 v0 = acc[ai][bj][m][0], v1 = acc[ai][bj][m][1];
                    if (isg) {
#pragma unroll
                        for (int jj = 0; jj < 4; ++jj) { v0[jj] = gelu_tanh(v0[jj]); v1[jj] = gelu_tanh(v1[jj]); }
                    }
                    st16(rowp + bj * 128, pack8(v0, v1));
                }
            }
    }
};

struct EpiLruGate {
    const bf16_t* U; bf16_t* LOGA; bf16_t* BIN; const float* ba; const float* bx; const float* lam;
    __device__ __forceinline__ void operator()(const acc_t& acc, const GUnit& u, int wr, int wc, int fr, int fq) const {
        const int ch0 = u.pn * 128 + wc * 32 + fq * 8;
        float ba8[8], bx8[8], ls8[8];
#pragma unroll
        for (int i = 0; i < 8; ++i) { ba8[i] = ba[ch0 + i]; bx8[i] = bx[ch0 + i]; const float l = lam[ch0 + i]; ls8[i] = -8.f * log1pf(__expf(-l)); }
#pragma unroll
        for (int ai = 0; ai < 2; ++ai)
#pragma unroll
            for (int m = 0; m < 4; ++m) {
                const int r = ai * 128 + wr * 64 + m * 16 + fr;
                const size_t off = (size_t)(u.row0 + r) * LRU_W + ch0;
                float u8[8]; unpack8(ld16(U + off), u8);
                f32x4 la[2], bi[2];
#pragma unroll
                for (int bj = 0; bj < 2; ++bj)
#pragma unroll
                    for (int jj = 0; jj < 4; ++jj) {
                        const int i = bj * 4 + jj;
                        const float rg = sigmoidf_(acc[ai][bj][m][0][jj] + ba8[i]);
                        const float ig = sigmoidf_(acc[ai][bj][m][1][jj] + bx8[i]);
                        const float l = rg * ls8[i];
                        const float om = fmaxf(1.f - fast_exp(2.f * l), 0.f);
                        la[bj][jj] = l; bi[bj][jj] = __builtin_sqrtf(om) * ig * u8[i];
                    }
                st16(LOGA + off, pack8(la[0], la[1]));
                st16(BIN + off, pack8(bi[0], bi[1]));
            }
    }
};

struct EpiNsaIn {
    unsigned char* Q; bf16_t* KC; bf16_t* VC; unsigned char* KS; unsigned char* VST; unsigned char* KW; unsigned char* VWT; float* GATES; const int* pos; const float* bgate;
    __device__ __forceinline__ void operator()(const acc_t& acc, const GUnit& u, int wr, int wc, int fr, int fq) const {
        const int pn = u.pn;
        if (pn <= 3 || pn == 6 || pn == 8) {
            unsigned char* O = Q + (pn <= 3 ? 0l : (pn == 6 ? (KS - Q) : (KW - Q)));
            const int ldo = pn <= 3 ? 1024 : 256;
            const int colbase = pn <= 3 ? pn * 256 : 0;
            const float scale = pn <= 3 ? 0.125f * LOG2E * S8_Q : S8_K;
            float invf[4];
#pragma unroll
            for (int jj = 0; jj < 4; ++jj) invf[jj] = exp2f(-(float)(16 * (wc & 1) + 4 * fq + jj) * (13.287712379549449f / 32.f));
#pragma unroll
            for (int ai = 0; ai < 2; ++ai)
#pragma unroll
                for (int m = 0; m < 4; ++m) {
                    const int row = u.row0 + ai * 128 + wr * 64 + m * 16 + fr;
                    const float p = (float)pos[row];
                    float sn[4], cs[4];
#pragma unroll
                    for (int jj = 0; jj < 4; ++jj) sincos_rad(p * invf[jj], sn[jj], cs[jj]);
#pragma unroll
                    for (int bj = 0; bj < 2; ++bj) {
                        const f32x4 x1 = acc[ai][bj][m][0], x2 = acc[ai][bj][m][1];
                        float o1[4], o2[4];
#pragma unroll
                        for (int jj = 0; jj < 4; ++jj) { o1[jj] = (x1[jj] * cs[jj] - x2[jj] * sn[jj]) * scale; o2[jj] = (x1[jj] * sn[jj] + x2[jj] * cs[jj]) * scale; }
                        unsigned char* p1 = O + (size_t)row * ldo + colbase + 64 * (2 * bj + (wc >> 1)) + 16 * (wc & 1) + 4 * fq;
                        *(unsigned*)p1 = pack4_fp8(o1[0], o1[1], o1[2], o1[3]);
                        *(unsigned*)(p1 + 32) = pack4_fp8(o2[0], o2[1], o2[2], o2[3]);
                    }
                }
        } else if (pn == 4 || pn == 5) {
            bf16_t* O = KC + (pn == 4 ? 0l : (VC - KC));
            const int colb = wc * 32 + fq * 8;
#pragma unroll
            for (int ai = 0; ai < 2; ++ai)
#pragma unroll
                for (int m = 0; m < 4; ++m) {
                    const int row = u.row0 + ai * 128 + wr * 64 + m * 16 + fr;
#pragma unroll
                    for (int bj = 0; bj < 2; ++bj) st16(O + (size_t)row * 256 + colb + bj * 128, pack8(acc[ai][bj][m][0], acc[ai][bj][m][1]));
                }
        } else if (pn == 7 || pn == 9) {
            unsigned char* O = VST + (pn == 7 ? 0l : (VWT - VST));
#pragma unroll
            for (int ai = 0; ai < 2; ++ai)
#pragma unroll
                for (int m = 0; m < 4; ++m) {
                    const int row = u.row0 + ai * 128 + wr * 64 + m * 16 + fr;
                    const int b = row >> 11, s = vperm32(row & 2047);
#pragma unroll
                    for (int bj = 0; bj < 2; ++bj) {
                        const int g = 2 * bj + (wc >> 1);
                        unsigned char* base = O + ((size_t)(b * 4 + g) * 64 + 32 * (wc & 1) + 8 * fq) * SEQ + s;
#pragma unroll
                        for (int n = 0; n < 2; ++n) { const unsigned pk = pack4_fp8(acc[ai][bj][m][n][0], acc[ai][bj][m][n][1], acc[ai][bj][m][n][2], acc[ai][bj][m][n][3]);
#pragma unroll
                            for (int jj = 0; jj < 4; ++jj) base[(size_t)(4 * n + jj) * SEQ] = (unsigned char)((pk >> (8 * jj)) & 0xffu); }
                    }
                }
        } else {
            if (wc < 2 && (wc == 0 || fq < 2)) {
                const int c0 = 32 * wc + 8 * fq;
                f32x4 bg[2];
#pragma unroll
                for (int n = 0; n < 2; ++n) bg[n] = *(const f32x4*)(bgate + c0 + 4 * n);
#pragma unroll
                for (int ai = 0; ai < 2; ++ai)
#pragma unroll
                    for (int m = 0; m < 4; ++m) {
                        const int row = u.row0 + ai * 128 + wr * 64 + m * 16 + fr;
#pragma unroll
                        for (int n = 0; n < 2; ++n) {
                            f32x4 v;
#pragma unroll
                            for (int jj = 0; jj < 4; ++jj) v[jj] = sigmoidf_(acc[ai][0][m][n][jj] + bg[n][jj]);
                            *(f32x4*)(GATES + (size_t)row * 48 + c0 + 4 * n) = v;
                        }
                    }
            }
        }
    }
};
__device__ __forceinline__ int map_plain8(int cc) { const int bj = cc >> 7, wc = (cc >> 5) & 3, n = (cc >> 4) & 1, fq = (cc >> 2) & 3; return 128 * bj + 32 * wc + 8 * fq + 4 * n; }
__device__ __forceinline__ int map_rope(int cc) { const int bj = cc >> 7, wc = (cc >> 5) & 3, n = (cc >> 4) & 1, fq = (cc >> 2) & 3; return 64 * (2 * bj + (wc >> 1)) + 32 * n + 16 * (wc & 1) + 4 * fq; }
__device__ __forceinline__ void map_pair(int cc, int& n, int& ch) { const int bj = cc >> 7, wc = (cc >> 5) & 3, fq = (cc >> 2) & 3; n = (cc >> 4) & 1; ch = 32 * wc + 8 * fq + 4 * bj; }
constexpr f32x4 F4ZERO = {0.f, 0.f, 0.f, 0.f};

struct FetchNsaIn { const float* W;
    __device__ __forceinline__ f32x4 operator()(int, int c4, int k) const { const int pn = c4 >> 8, cc = c4 & 255; const bool rope = (pn <= 3 || pn == 6 || pn == 8);
        const int col = pn * 256 + (rope ? map_rope(cc) : map_plain8(cc)); if (col >= 2608) return F4ZERO; return *(const f32x4*)(W + (size_t)k * 2608 + col); } };
struct FetchPlain { const float* W; int ld; size_t bstride;
    __device__ __forceinline__ f32x4 operator()(int bt, int c4, int k) const { const int col = (c4 & ~255) + map_plain8(c4 & 255); return *(const f32x4*)(W + (size_t)bt * bstride + (size_t)k * ld + col); } };
struct FetchPair { const float* W0; long d01; int ld; size_t bstride;
    __device__ __forceinline__ f32x4 operator()(int bt, int c4, int k) const { int n, ch; map_pair(c4 & 255, n, ch); ch += (c4 >> 8) * 128; return *(const f32x4*)(W0 + (n ? d01 : 0l) + (long)((size_t)bt * bstride + (size_t)k * ld + ch)); } };
struct FetchScIn { const float* W;
    __device__ __forceinline__ f32x4 operator()(int, int c4, int k) const { const int pn = c4 >> 8, cc = c4 & 255;
        if (pn < 8) { int n, ch; map_pair(cc, n, ch); ch += pn * 128; return *(const f32x4*)(W + (size_t)k * 3072 + (n ? 2048 : 0) + ch); }
        return *(const f32x4*)(W + (size_t)k * 3072 + 1024 + (pn - 8) * 256 + map_plain8(cc)); } };
struct FetchLruGate { const float* wa; long dax;
    __device__ __forceinline__ f32x4 operator()(int, int c4, int k) const { int n, ch; map_pair(c4 & 255, n, ch); ch += (c4 >> 8) * 128; const int h = ch / 80; if (k / 80 != h) return F4ZERO;
        return *(const f32x4*)(wa + (n ? dax : 0l) + (long)(h * 6400 + (k - 80 * h) * 80 + (ch - 80 * h))); } };
struct FetchIdent { const float* W; int ld; size_t bstride;
    __device__ __forceinline__ f32x4 operator()(int bt, int c4, int k) const { return *(const f32x4*)(W + (size_t)bt * bstride + (size_t)k * ld + c4); } };

template <bool OUT8 = false, class F>
__device__ __forceinline__ void convert_wt(LAS unsigned char* lds, void* dstv, int nbatch, int Nd, int K, const F& fetch, const float scale = 1.f) {
    constexpr int GRP = 4;
    LAS float* tile = (LAS float*)lds;
    const int tid = tid_opaque();
    const int ntk = K / 64, ntc = Nd / 64, per = ntc * ntk, total = per * nbatch;
    const bool split = (Nd & 255) == 0;
    const int c4i = tid & 15, kk = tid >> 4, rr4 = 4 * c4i, row = tid >> 3, k8 = (tid & 7) * 8;
    for (int t0 = blockIdx.x * GRP; t0 < total; t0 += gridDim.x * GRP) {
        f32x4 v[GRP][2];
#pragma unroll
        for (int gi = 0; gi < GRP; ++gi) {
            const int t = t0 + gi;
            if (t < total) {
                const int bt = t / per, tt = t - bt * per, tc = tt / ntk, tk = tt - tc * ntk, k0 = tk * 64;
                const int cbase = split ? (tc >> 2) * 256 + (tc & 3) * 32 : tc * 64;
                const int crow4 = cbase + (split ? ((rr4 & 31) + (rr4 >> 5) * 128) : rr4);
#pragma unroll
                for (int p = 0; p < 2; ++p) v[gi][p] = fetch(bt, crow4, k0 + kk + 32 * p);
            }
        }
        __syncthreads();
#pragma unroll
        for (int gi = 0; gi < GRP; ++gi)
            if (t0 + gi < total) {
#pragma unroll
                for (int p = 0; p < 2; ++p)
#pragma unroll
                    for (int j = 0; j < 4; ++j) tile[gi * 4160 + (4 * c4i + j) * 65 + kk + 32 * p] = v[gi][p][j];
            }
        __syncthreads();
#pragma unroll
        for (int gi = 0; gi < GRP; ++gi) {
            const int t = t0 + gi;
            if (t < total) {
                const int bt = t / per, tt = t - bt * per, tc = tt / ntk, tk = tt - tc * ntk, k0 = tk * 64;
                const int cbase = split ? (tc >> 2) * 256 + (tc & 3) * 32 : tc * 64;
                const int crow = cbase + (split ? ((row & 31) + (row >> 5) * 128) : row);
                float f[8];
#pragma unroll
                for (int i = 0; i < 8; ++i) f[i] = tile[gi * 4160 + row * 65 + k8 + i];
                if constexpr (OUT8) {
#pragma unroll
                    for (int i = 0; i < 8; ++i) f[i] *= scale;
                    *(u32x2*)((unsigned char*)dstv + ((size_t)bt * Nd + crow) * K + k0 + k8) = pack8_fp8(f);
                } else st16((bf16_t*)dstv + ((size_t)bt * Nd + crow) * K + k0 + k8, (u32x4){cvt_pk_bf16(f[0], f[1]), cvt_pk_bf16(f[2], f[3]), cvt_pk_bf16(f[4], f[5]), cvt_pk_bf16(f[6], f[7])});
            }
        }
    }
    __syncthreads();
}

template <bool X8OUT>
__device__ __forceinline__ void convert_x(const float* x, unsigned char* XA) {
    const size_t n8 = (size_t)T_TOK * DM / 8;
    const int tidx = tid_opaque();
    for (size_t i = (size_t)blockIdx.x * NTHR + tidx; i < n8; i += (size_t)gridDim.x * NTHR) {
        if constexpr (X8OUT) {
            const f32x4 a = *(const f32x4*)(x + i * 8) * S8_X, b = *(const f32x4*)(x + i * 8 + 4) * S8_X;
            const float f[8] = {a[0], a[1], a[2], a[3], b[0], b[1], b[2], b[3]};
            *(u32x2*)(XA + i * 8) = pack8_fp8(f);
        } else { const f32x4 a = *(const f32x4*)(x + i * 8), b = *(const f32x4*)(x + i * 8 + 4); st16((bf16_t*)XA + i * 8, pack8(a, b)); }
    }
}
__device__ __forceinline__ void cmp_bias_phase(LAS unsigned char* lds, const float* pek, const float* w1k, const float* pev, const float* w1v, float* bias1) {
    LAS float* red = (LAS float*)lds;
    const int tidx = tid_opaque();
    for (int blk = blockIdx.x; blk < 32; blk += gridDim.x) {
        const int v = blk >> 3, j = v >> 1, kv = v & 1, hid = (blk & 7) * 8 + (tidx & 7), part = tidx >> 3;
        const float* pe = pek + (kv ? (pev - pek) : 0l) + j * 2048; const float* w1 = w1k + (kv ? (w1v - w1k) : 0l) + (size_t)j * 2048 * 64;
        float s = 0.f;
#pragma unroll 8
        for (int i = part * 32; i < part * 32 + 32; ++i) s += pe[i] * w1[i * 64 + hid];
        __syncthreads();
        red[part * 8 + (tidx & 7)] = s;
        __syncthreads();
        if (tidx < 8) { float t = 0.f; for (int q = 0; q < 64; ++q) t += red[q * 8 + tidx]; bias1[v * 64 + (blk & 7) * 8 + tidx] = t; }
    }
    __syncthreads();
}

template <bool F32IN>
__device__ __forceinline__ void ln1_router_phase(LAS unsigned char* lds, const void* XRv  , const bf16_t* MBm, bf16_t* XW  , unsigned char* X8, const float* gam, const float* bet,
                                                 const float* rw, const float* rb, int* route_e, float* route_w, int* cnt) {
    LAS f32x4* rwl = (LAS f32x4*)lds;
    LAS int* lcnt = (LAS int*)(lds + 65536);
    const int tid = tid_opaque(), lane = tid & 63, w = tid >> 6;
    __syncthreads();
    for (int i = tid; i < 4096; i += NTHR) { const int col = i >> 2, q = i & 3; const int seg = col >> 9, ln = (col >> 3) & 63, j = col & 7;
        rwl[((q * 2 + seg) * 8 + j) * 64 + ln] = *(const f32x4*)(rw + col * 16 + 4 * q); }
    for (int chunk = blockIdx.x; chunk < 256; chunk += gridDim.x) {
        __syncthreads();
        if (tid < 16) lcnt[tid] = 0;
        __syncthreads();
        const size_t row0 = (size_t)chunk * 256 + w * 32;
        const float* XF = (const float*)XRv; const bf16_t* XH = (const bf16_t*)XRv;
        f32x4 nx[2][4]; u32x4 nh[2][2], nm[2][2];
#pragma unroll
        for (int rr = 0; rr < 2; ++rr)
#pragma unroll
            for (int sg = 0; sg < 2; ++sg) {
                if constexpr (F32IN) { nx[rr][sg * 2] = *(const f32x4*)(XF + (row0 + rr) * DM + sg * 512 + lane * 8); nx[rr][sg * 2 + 1] = *(const f32x4*)(XF + (row0 + rr) * DM + sg * 512 + lane * 8 + 4); }
                else nh[rr][sg] = ld16(XH + (row0 + rr) * DM + sg * 512 + lane * 8);
                nm[rr][sg] = ld16(MBm + (row0 + rr) * DM + sg * 512 + lane * 8); }
        for (int i = 0; i < 32; i += 2) {
            f32x2 y2[16];
            {
                float xv[2][16];
#pragma unroll
                for (int rr = 0; rr < 2; ++rr) {
#pragma unroll
                    for (int sg = 0; sg < 2; ++sg) { float mv[8]; unpack8(nm[rr][sg], mv);
                        if constexpr (F32IN) {
#pragma unroll
                            for (int j = 0; j < 4; ++j) { xv[rr][sg * 8 + j] = DN_ALPHA * nx[rr][sg * 2][j] + mv[j]; xv[rr][sg * 8 + 4 + j] = DN_ALPHA * nx[rr][sg * 2 + 1][j] + mv[4 + j]; }
                        } else { float hv[8]; unpack8(nh[rr][sg], hv);
#pragma unroll
                            for (int j = 0; j < 8; ++j) xv[rr][sg * 8 + j] = DN_ALPHA * hv[j] + mv[j]; } }
                }
                if (i + 2 < 32) {
#pragma unroll
                    for (int rr = 0; rr < 2; ++rr)
#pragma unroll
                        for (int sg = 0; sg < 2; ++sg) {
                            if constexpr (F32IN) { nx[rr][sg * 2] = *(const f32x4*)(XF + (row0 + i + 2 + rr) * DM + sg * 512 + lane * 8); nx[rr][sg * 2 + 1] = *(const f32x4*)(XF + (row0 + i + 2 + rr) * DM + sg * 512 + lane * 8 + 4); }
                            else nh[rr][sg] = ld16(XH + (row0 + i + 2 + rr) * DM + sg * 512 + lane * 8);
                            nm[rr][sg] = ld16(MBm + (row0 + i + 2 + rr) * DM + sg * 512 + lane * 8); }
                }
                float mean[2], rstd[2];
#pragma unroll
                for (int rr = 0; rr < 2; ++rr) { float s = 0.f;
#pragma unroll
                    for (int j = 0; j < 16; ++j) s += xv[rr][j];
                    mean[rr] = wave_sum_dpp(s) * (1.f / 1024.f); }
#pragma unroll
                for (int rr = 0; rr < 2; ++rr) { float q = 0.f;
#pragma unroll
                    for (int j = 0; j < 16; ++j) { const float d = xv[rr][j] - mean[rr]; q += d * d; }
                    rstd[rr] = rsqrtf(wave_sum_dpp(q) * (1.f / 1024.f) + LN_EPS); }
#pragma unroll
                for (int sg = 0; sg < 2; ++sg) {
                    const f32x4 ga = *(const f32x4*)(gam + sg * 512 + lane * 8), gb = *(const f32x4*)(gam + sg * 512 + lane * 8 + 4);
                    const f32x4 ba = *(const f32x4*)(bet + sg * 512 + lane * 8), bb = *(const f32x4*)(bet + sg * 512 + lane * 8 + 4);
#pragma unroll
                    for (int rr = 0; rr < 2; ++rr) {
                        f32x4 o0, o1;
#pragma unroll
                        for (int j = 0; j < 4; ++j) { o0[j] = (xv[rr][sg * 8 + j] - mean[rr]) * rstd[rr] * ga[j] + ba[j]; o1[j] = (xv[rr][sg * 8 + 4 + j] - mean[rr]) * rstd[rr] * gb[j] + bb[j];
                            y2[sg * 8 + j][rr] = o0[j]; y2[sg * 8 + 4 + j][rr] = o1[j]; }
                        st16(XW + (row0 + i + rr) * DM + sg * 512 + lane * 8, pack8(o0, o1));
                        { const f32x4 a8 = o0 * S8_X, b8 = o1 * S8_X; const float f8[8] = {a8[0], a8[1], a8[2], a8[3], b8[0], b8[1], b8[2], b8[3]};
                          *(u32x2*)(X8 + (row0 + i + rr) * DM + sg * 512 + lane * 8) = pack8_fp8(f8); }
                    }
                }
            }
            f32x2 lg2[16];
#pragma unroll
            for (int e = 0; e < 16; ++e) lg2[e] = (f32x2){0.f, 0.f};
#pragma unroll
            for (int sg = 0; sg < 2; ++sg)
#pragma unroll
                for (int j = 0; j < 8; ++j) {
                    if ((j & 1) == 0) __builtin_amdgcn_sched_barrier(0);
#pragma unroll
                    for (int q = 0; q < 4; ++q) {
                        const f32x4 wv = rwl[((q * 2 + sg) * 8 + j) * 64 + lane];
#pragma unroll
                        for (int e = 0; e < 4; ++e) lg2[q * 4 + e] += y2[sg * 8 + j] * (f32x2){wv[e], wv[e]};
                    }
                }
#pragma unroll
            for (int rr = 0; rr < 2; ++rr) {
                float sc[16], bi[16];
#pragma unroll
                for (int e = 0; e < 16; ++e) { const float l = wave_sum_dpp(lg2[e][rr]); sc[e] = 1.f / (1.f + __expf(-l)); bi[e] = sc[e] + rb[e]; }
                float gs[4];
#pragma unroll
                for (int g = 0; g < 4; ++g) { const float a = bi[4 * g], b = bi[4 * g + 1], c = bi[4 * g + 2], d = bi[4 * g + 3];
                    gs[g] = fmaxf(fmaxf(fmaxf(a + b, a + c), fmaxf(a + d, b + c)), fmaxf(b + d, c + d)); }
                int bg = 0; float bgs = gs[0];
#pragma unroll
                for (int g = 1; g < 4; ++g) if (gs[g] > bgs) { bgs = gs[g]; bg = g; }
                float vb[4], vs[4];
#pragma unroll
                for (int k = 0; k < 4; ++k) { vb[k] = bg == 0 ? bi[k] : (bg == 1 ? bi[4 + k] : (bg == 2 ? bi[8 + k] : bi[12 + k])); vs[k] = bg == 0 ? sc[k] : (bg == 1 ? sc[4 + k] : (bg == 2 ? sc[8 + k] : sc[12 + k])); }
                int i1 = 0; float b1 = vb[0], s1 = vs[0];
#pragma unroll
                for (int k = 1; k < 4; ++k) if (vb[k] > b1) { b1 = vb[k]; s1 = vs[k]; i1 = k; }
                int i2 = -1; float b2 = -3e38f, s2 = 0.f;
#pragma unroll
                for (int k = 0; k < 4; ++k) if (k != i1 && vb[k] > b2) { b2 = vb[k]; s2 = vs[k]; i2 = k; }
                const float inv = 1.f / (s1 + s2);
                if (lane == 0) {
                    const size_t row = row0 + i + rr;
                    const int e0 = bg * 4 + i1, e1 = bg * 4 + i2;
                    route_e[row] = e0 | (e1 << 8); route_w[row * 2] = s1 * inv; route_w[row * 2 + 1] = s2 * inv;
                    atomicAdd((int*)&lcnt[e0], 1); atomicAdd((int*)&lcnt[e1], 1);
                }
            }
        }
        __syncthreads();
        if (tid < 16) cnt[chunk * 16 + tid] = lcnt[tid];
    }
    __syncthreads();
}

__device__ __forceinline__ void moe_gather_phase(LAS unsigned char* lds, const int* route_e, const int* cnt, int* pos_out, int* inv, int4* tiles) {
    LAS int* s_tot = (LAS int*)lds; LAS int* s_pre = s_tot + 16; LAS int* s_off = s_pre + 16; LAS int* s_wcnt = s_off + 16; LAS int* s_lpos = s_wcnt + 128;
    const int tid = tid_opaque(), lane = tid & 63, w = tid >> 6;
    for (int chunk = blockIdx.x; chunk < 256; chunk += gridDim.x) {
        __syncthreads();
        { const int e = tid >> 5, j = tid & 31; int tot = 0, pre = 0;
            for (int c = j; c < 256; c += 32) { const int v = cnt[c * 16 + e]; tot += v; pre += (c < chunk) ? v : 0; }
#pragma unroll
            for (int o = 16; o >= 1; o >>= 1) { tot += __shfl_xor(tot, o); pre += __shfl_xor(pre, o); }
            if (j == 0) { s_tot[e] = tot; s_pre[e] = pre; } }
        __syncthreads();
        if (tid == 0) { int off = 0; for (int e = 0; e < 16; ++e) { s_off[e] = off; off += s_tot[e]; } }
        const int token = chunk * 256 + (tid >> 1), slot = tid & 1;
        const int re = route_e[token]; const int e = slot ? ((re >> 8) & 255) : (re & 255);
        int rk = 0;
#pragma unroll
        for (int e2 = 0; e2 < 16; ++e2) { const unsigned long long mk = __ballot(e == e2); if (e == e2) rk = __popcll(mk & ((1ull << lane) - 1ull)); if (lane == 0) s_wcnt[w * 16 + e2] = __popcll(mk); }
        __syncthreads();
        int base = s_off[e] + s_pre[e];
        for (int w2 = 0; w2 < w; ++w2) base += s_wcnt[w2 * 16 + e];
        const int p = base + rk;
        pos_out[token * 2 + slot] = p; inv[p] = token;
        if (chunk == 0 && tid == 0) {
            int nt = 0;
            for (int e2 = 0; e2 < 16; ++e2) { const int n = s_tot[e2]; for (int r = 0; r < n; r += 256) { tiles[1 + nt] = make_int4(e2, s_off[e2] + r, (n - r) < 256 ? (n - r) : 256, 0); ++nt; } }
            tiles[0] = make_int4(nt, 0, 0, 0);
        }
        if (chunk == 0 && tid < 256) inv[2 * T_TOK + tid] = 0;
    }
    __syncthreads();
}

template <bool LAST, bool X8OUT>
__device__ __forceinline__ void ln2_combine_phase(const bf16_t* X1, void* XWv  , const unsigned char* YM, const int* pos, const float* route_w, const float* gam, const float* bet, unsigned char* XO) {
    const int tid = tid_opaque(), lane = tid & 63, w = tid >> 6;
    float gm[16], bt[16];
#pragma unroll
    for (int s = 0; s < 2; ++s)
#pragma unroll
        for (int j = 0; j < 8; ++j) { gm[s * 8 + j] = gam[s * 512 + lane * 8 + j]; bt[s * 8 + j] = bet[s * 512 + lane * 8 + j]; }
    const size_t rstep = (size_t)gridDim.x * 8;
    int np0 = 0, np1 = 0; float nw0 = 0.f, nw1 = 0.f;
    { const size_t r0 = (size_t)blockIdx.x * 8 + w; if (r0 < (size_t)T_TOK) { np0 = pos[r0 * 2]; np1 = pos[r0 * 2 + 1]; nw0 = route_w[r0 * 2]; nw1 = route_w[r0 * 2 + 1]; } }
    for (size_t row = (size_t)blockIdx.x * 8 + w; row < (size_t)T_TOK; row += rstep) {
        const int p0 = np0, p1 = np1; const float w0 = nw0, w1 = nw1;
        { const size_t rn = row + rstep; if (rn < (size_t)T_TOK) { np0 = pos[rn * 2]; np1 = pos[rn * 2 + 1]; nw0 = route_w[rn * 2]; nw1 = route_w[rn * 2 + 1]; } }
        float xv[16], a[16], b[16];
#pragma unroll
        for (int sg = 0; sg < 2; ++sg) unpack8(ld16(X1 + row * DM + sg * 512 + lane * 8), xv + sg * 8);
        unpack8_fp8(*(const u32x2*)(YM + (size_t)p0 * DM + lane * 8), a); unpack8_fp8(*(const u32x2*)(YM + (size_t)p0 * DM + 512 + lane * 8), a + 8);
        unpack8_fp8(*(const u32x2*)(YM + (size_t)p1 * DM + lane * 8), b); unpack8_fp8(*(const u32x2*)(YM + (size_t)p1 * DM + 512 + lane * 8), b + 8);
        float s = 0.f;
#pragma unroll
        for (int j = 0; j < 16; ++j) { xv[j] = DN_ALPHA * xv[j] + (w0 * a[j] + w1 * b[j]) * (1.f / S8_Y); s += xv[j]; }
        const float mean = wave_sum_dpp(s) * (1.f / 1024.f);
        float q = 0.f;
#pragma unroll
        for (int j = 0; j < 16; ++j) { const float d = xv[j] - mean; q += d * d; }
        const float rstd = rsqrtf(wave_sum_dpp(q) * (1.f / 1024.f) + LN_EPS);
        float y[16];
#pragma unroll
        for (int j = 0; j < 16; ++j) y[j] = (xv[j] - mean) * rstd * gm[j] + bt[j];
        if constexpr (LAST) {
            float* outf = (float*)XWv;
            *(f32x4*)(outf + row * DM + lane * 8) = (f32x4){y[0], y[1], y[2], y[3]}; *(f32x4*)(outf + row * DM + lane * 8 + 4) = (f32x4){y[4], y[5], y[6], y[7]};
            *(f32x4*)(outf + row * DM + 512 + lane * 8) = (f32x4){y[8], y[9], y[10], y[11]}; *(f32x4*)(outf + row * DM + 512 + lane * 8 + 4) = (f32x4){y[12], y[13], y[14], y[15]};
        } else {
            bf16_t* xw = (bf16_t*)XWv;
            st16(xw + row * DM + lane * 8, (u32x4){cvt_pk_bf16(y[0], y[1]), cvt_pk_bf16(y[2], y[3]), cvt_pk_bf16(y[4], y[5]), cvt_pk_bf16(y[6], y[7])});
            st16(xw + row * DM + 512 + lane * 8, (u32x4){cvt_pk_bf16(y[8], y[9]), cvt_pk_bf16(y[10], y[11]), cvt_pk_bf16(y[12], y[13]), cvt_pk_bf16(y[14], y[15])});
            if constexpr (X8OUT) {
                float ys[16];
#pragma unroll
                for (int j = 0; j < 16; ++j) ys[j] = y[j] * S8_X;
                *(u32x2*)(XO + row * DM + lane * 8) = pack8_fp8(ys); *(u32x2*)(XO + row * DM + 512 + lane * 8) = pack8_fp8(ys + 8);
            }
        }
    }
}

__device__ __forceinline__ void sc_conv_phase(const bf16_t* P, const bf16_t* BG, bf16_t* Y, const float* cw, const float* cb) {
    const int items = (T_TOK / 16) * 128; const int tidx = tid_opaque();
    for (int it = blockIdx.x * NTHR + tidx; it < items; it += gridDim.x * NTHR) {
        const int cg = it & 127, run = it >> 7, c0 = cg * 8; const size_t t0 = (size_t)run * 16; const int s = (int)(t0 & 2047);
        float w0[8], w1[8], w2[8], b8[8];
#pragma unroll
        for (int j = 0; j < 8; ++j) { w0[j] = cw[c0 + j]; w1[j] = cw[1024 + c0 + j]; w2[j] = cw[2048 + c0 + j]; b8[j] = cb[c0 + j]; }
        float pm2[8], pm1[8];
        if (s == 0) {
#pragma unroll
            for (int j = 0; j < 8; ++j) { pm2[j] = 0.f; pm1[j] = 0.f; }
        } else { unpack8(ld16(P + (t0 - 2) * DM + c0), pm2); unpack8(ld16(P + (t0 - 1) * DM + c0), pm1); }
#pragma unroll 4
        for (int i = 0; i < 16; ++i) {
            float cur[8], bg[8], y[8];
            unpack8(ld16(P + (t0 + i) * DM + c0), cur); unpack8(ld16(BG + (t0 + i) * DM + c0), bg);
#pragma unroll
            for (int j = 0; j < 8; ++j) { y[j] = bg[j] * (b8[j] + w0[j] * pm2[j] + w1[j] * pm1[j] + w2[j] * cur[j]); pm2[j] = pm1[j]; pm1[j] = cur[j]; }
            st16(Y + (t0 + i) * DM + c0, (u32x4){cvt_pk_bf16(y[0], y[1]), cvt_pk_bf16(y[2], y[3]), cvt_pk_bf16(y[4], y[5]), cvt_pk_bf16(y[6], y[7])});
        }
    }
}
__device__ __forceinline__ void lru_conv_phase(const bf16_t* REC, bf16_t* U, const float* cw, const float* cb) {
    const int items = (T_TOK / 16) * 160; const int tidx = tid_opaque();
    for (int it = blockIdx.x * NTHR + tidx; it < items; it += gridDim.x * NTHR) {
        const int cg = it % 160, run = it / 160, c0 = cg * 8; const size_t t0 = (size_t)run * 16; const int s = (int)(t0 & 2047);
        float w0[8], w1[8], w2[8], w3[8], b8[8];
#pragma unroll
        for (int j = 0; j < 8; ++j) { w0[j] = cw[c0 + j]; w1[j] = cw[LRU_W + c0 + j]; w2[j] = cw[2 * LRU_W + c0 + j]; w3[j] = cw[3 * LRU_W + c0 + j]; b8[j] = cb[c0 + j]; }
        float p3[8], p2[8], p1[8];
        if (s == 0) {
#pragma unroll
            for (int j = 0; j < 8; ++j) { p3[j] = 0.f; p2[j] = 0.f; p1[j] = 0.f; }
        } else { unpack8(ld16(REC + (t0 - 3) * LRU_W + c0), p3); unpack8(ld16(REC + (t0 - 2) * LRU_W + c0), p2); unpack8(ld16(REC + (t0 - 1) * LRU_W + c0), p1); }
#pragma unroll 4
        for (int i = 0; i < 16; ++i) {
            float cur[8], y[8];
            unpack8(ld16(REC + (t0 + i) * LRU_W + c0), cur);
#pragma unroll
            for (int j = 0; j < 8; ++j) { y[j] = b8[j] + w0[j] * p3[j] + w1[j] * p2[j] + w2[j] * p1[j] + w3[j] * cur[j]; p3[j] = p2[j]; p2[j] = p1[j]; p1[j] = cur[j]; }
            st16(U + (t0 + i) * LRU_W + c0, (u32x4){cvt_pk_bf16(y[0], y[1]), cvt_pk_bf16(y[2], y[3]), cvt_pk_bf16(y[4], y[5]), cvt_pk_bf16(y[6], y[7])});
        }
    }
}

__device__ __forceinline__ void lru_scan1_phase(const bf16_t* LOGA, const bf16_t* BIN, f32x4* carry) {
    const int tidx = tid_opaque(); const int lane = tidx & 63, w = tidx >> 6;
    for (int it = blockIdx.x * 8 + w; it < 10240; it += gridDim.x * 8) {
        const int cgp = it % 10, ck = (it / 10) & 31, b = it / 320, ch = cgp * 128 + lane * 2;
        const size_t base = ((size_t)b * SEQ + ck * 64) * LRU_W + ch;
        float h0 = 0.f, h1 = 0.f, s0 = 0.f, s1 = 0.f;
#pragma unroll 8
        for (int t = 0; t < 64; ++t) {
            const unsigned la = *(const unsigned*)(LOGA + base + (size_t)t * LRU_W), bi = *(const unsigned*)(BIN + base + (size_t)t * LRU_W);
            const float l0 = bf_lo(la), l1 = bf_hi(la);
            h0 = fast_exp(l0) * h0 + bf_lo(bi); h1 = fast_exp(l1) * h1 + bf_hi(bi); s0 += l0; s1 += l1;
        }
        carry[(((size_t)b * 32 + ck) * LRU_W + ch) >> 1] = (f32x4){s0, h0, s1, h1};
    }
}
__device__ __forceinline__ void lru_scan2_phase(const bf16_t* LOGA, const bf16_t* BIN, const bf16_t* GG, const f32x4* carry, bf16_t* Y) {
    const int tidx = tid_opaque(); const int lane = tidx & 63, w = tidx >> 6;
    for (int it = blockIdx.x * 8 + w; it < 10240; it += gridDim.x * 8) {
        const int cgp = it % 10, ck = (it / 10) & 31, b = it / 320, ch = cgp * 128 + lane * 2;
        float h0 = 0.f, h1 = 0.f;
        for (int c2 = 0; c2 < ck; ++c2) { const f32x4 cv = carry[(((size_t)b * 32 + c2) * LRU_W + ch) >> 1]; h0 = fast_exp(cv[0]) * h0 + cv[1]; h1 = fast_exp(cv[2]) * h1 + cv[3]; }
        const size_t base = ((size_t)b * SEQ + ck * 64) * LRU_W + ch;
#pragma unroll 8
        for (int t = 0; t < 64; ++t) {
            const unsigned la = *(const unsigned*)(LOGA + base + (size_t)t * LRU_W), bi = *(const unsigned*)(BIN + base + (size_t)t * LRU_W), gg = *(const unsigned*)(GG + base + (size_t)t * LRU_W);
            h0 = fast_exp(bf_lo(la)) * h0 + bf_lo(bi); h1 = fast_exp(bf_hi(la)) * h1 + bf_hi(bi);
            *(unsigned*)(Y + base + (size_t)t * LRU_W) = cvt_pk_bf16(bf_lo(gg) * h0, bf_hi(gg) * h1);
        }
    }
}
__device__ __forceinline__ bf16x8 pack8s(const float* f) {
    const unsigned a = cvt_pk_bf16(f[0], f[1]), b = cvt_pk_bf16(f[2], f[3]), c = cvt_pk_bf16(f[4], f[5]), d = cvt_pk_bf16(f[6], f[7]);
    u32x4 v = {a, b, c, d}; return __builtin_bit_cast(bf16x8, v);
}
__device__ __forceinline__ void nsa_compress_phase(const bf16_t* KC, const bf16_t* VC, const bf16_t* W1T, const float* w2k, const float* w2v, const float* bias1,
                                                   const int* pos, unsigned char* KCMP, unsigned char* VCMPT) {
    const int tidx = tid_opaque(); const int lane = tidx & 63, w = tidx >> 6, rowi = lane & 15, gq = lane >> 4;
    for (int task = blockIdx.x * 8 + w; task < 2048; task += gridDim.x * 8) {
        const int kv = task >> 10, tt = task & 1023, rho = tt * 16 + rowi, b = rho >> 9, n = (rho >> 2) & 127, g = rho & 3;
        const bf16_t* src = KC + (kv ? (VC - KC) : 0l) + (size_t)b * SEQ * 256 + g * 64 + 8 * gq;
        const bf16_t* w1t = W1T + (size_t)kv * 64 * 2048 + (size_t)rowi * 2048 + 8 * gq;
        f32x4 hacc[4];
#pragma unroll
        for (int ht = 0; ht < 4; ++ht) hacc[ht] = (f32x4){0.f, 0.f, 0.f, 0.f};
#pragma unroll 4
        for (int kk = 0; kk < 64; ++kk) {
            int tok = 16 * n + (kk >> 1); tok = tok > 2047 ? 2047 : tok;
            const bf16x8 af = *(const bf16x8*)(src + (size_t)tok * 256 + 32 * (kk & 1));
#pragma unroll
            for (int ht = 0; ht < 4; ++ht) { const bf16x8 wf = *(const bf16x8*)(w1t + (size_t)(16 * ht) * 2048 + kk * 32); hacc[ht] = __builtin_amdgcn_mfma_f32_16x16x32_bf16(wf, af, hacc[ht], 0, 0, 0); }
        }
        bf16x8 pf[2];
#pragma unroll
        for (int p = 0; p < 2; ++p) { float hv[8];
#pragma unroll
            for (int jj = 0; jj < 4; ++jj) { hv[jj] = gelu_tanh(hacc[2 * p][jj] + bias1[kv * 64 + 32 * p + 4 * gq + jj]); hv[4 + jj] = gelu_tanh(hacc[2 * p + 1][jj] + bias1[kv * 64 + 32 * p + 16 + 4 * gq + jj]); }
            pf[p] = pack8s(hv); }
        const float* w2 = w2k + (kv ? (w2v - w2k) : 0l);
        f32x4 oacc[4];
#pragma unroll
        for (int dt = 0; dt < 4; ++dt) { oacc[dt] = (f32x4){0.f, 0.f, 0.f, 0.f};
#pragma unroll
            for (int p = 0; p < 2; ++p) { float wv[8]; const int dout = 16 * dt + rowi;
#pragma unroll
                for (int i = 0; i < 4; ++i) { wv[i] = w2[(32 * p + 4 * gq + i) * 64 + dout]; wv[4 + i] = w2[(32 * p + 16 + 4 * gq + i) * 64 + dout]; }
                oacc[dt] = __builtin_amdgcn_mfma_f32_16x16x32_bf16(pack8s(wv), pf[p], oacc[dt], 0, 0, 0); } }
        const bool padrow = (n == 127);
        if (kv == 0) {
            int pidx = 16 * n + 31; pidx = pidx > 2047 ? 2047 : pidx;
            const float pp = (float)pos[b * SEQ + pidx];
            unsigned char* dst = KCMP + ((size_t)(b * 128 + n) * 4 + g) * 64;
#pragma unroll
            for (int dt = 0; dt < 2; ++dt) { float o1[4], o2[4];
#pragma unroll
                for (int jj = 0; jj < 4; ++jj) { const float inv = exp2f(-(float)(16 * dt + 4 * gq + jj) * (13.287712379549449f / 32.f)); float sn, cs; sincos_rad(pp * inv, sn, cs);
                    const float x1 = oacc[dt][jj], x2 = oacc[dt + 2][jj]; o1[jj] = padrow ? 0.f : (x1 * cs - x2 * sn) * S8_K; o2[jj] = padrow ? 0.f : (x1 * sn + x2 * cs) * S8_K; }
                *(unsigned*)(dst + 16 * dt + 4 * gq) = pack4_fp8(o1[0], o1[1], o1[2], o1[3]);
                *(unsigned*)(dst + 32 + 16 * dt + 4 * gq) = pack4_fp8(o2[0], o2[1], o2[2], o2[3]); }
        } else {
            unsigned char* dst = VCMPT + ((size_t)(b * 4 + g) * 64) * 128 + vperm32(n);
#pragma unroll
            for (int dt = 0; dt < 4; ++dt) { const unsigned pk = pack4_fp8(oacc[dt][0], oacc[dt][1], oacc[dt][2], oacc[dt][3]);
#pragma unroll
                for (int jj = 0; jj < 4; ++jj) dst[(size_t)(16 * dt + 4 * gq + jj) * 128] = padrow ? (unsigned char)0 : (unsigned char)((pk >> (8 * jj)) & 0xffu); }
        }
    }
}

struct AttnArgs { const unsigned char* Q; const unsigned char* KS; const unsigned char* VST; const unsigned char* KW; const unsigned char* VWT; const unsigned char* KCMP; const unsigned char* VCMPT; const float* GATES; unsigned char* O; };
constexpr int AL_KC = 0, AL_VC = 10240, AL_KB = 19456, AL_VB = 29696, AL_PS = 39936, AL_IMP = 56320, AL_SEL = 60416, AL_OT = 60544;
typedef long fp8x8;
__device__ __forceinline__ unsigned pk4p(float a, float b, float c, float d) { unsigned r = 0u; r = __builtin_amdgcn_cvt_pk_fp8_f32(a, b, r, false); r = __builtin_amdgcn_cvt_pk_fp8_f32(c, d, r, true); return r; }
__device__ __forceinline__ fp8x8 mk8(unsigned lo, unsigned hi) { return (fp8x8)(((unsigned long long)hi << 32) | (unsigned long long)lo); }
constexpr float ATT_THR = 8.f;

__device__ __forceinline__ float max16(const f32x4 (&a)[4]) {
    float m0 = fmaxf(fmaxf(a[0][0], a[0][1]), a[0][2]), m1 = fmaxf(fmaxf(a[0][3], a[1][0]), a[1][1]), m2 = fmaxf(fmaxf(a[1][2], a[1][3]), a[2][0]);
    float m3 = fmaxf(fmaxf(a[2][1], a[2][2]), a[2][3]), m4 = fmaxf(fmaxf(a[3][0], a[3][1]), a[3][2]);
    return fmaxf(fmaxf(fmaxf(m0, m1), fmaxf(m2, m3)), fmaxf(m4, a[3][3]));
}

template <int MODE>
__device__ __forceinline__ void attn_branch(LAS unsigned char* lds, const unsigned char* Kg, const unsigned char* Vg, const int kb_lo, const int kb_hi, const bool first_staged,
                                            const fp8x8 (&qf)[2][2], const int (&sq)[2], const unsigned (&selm)[2], const float* const (&gatep)[2], LAS f32x4* otl  ,
                                            const int n, const int gq, const int tid) {
    const bool isv = tid >= 256; const int st = tid & 255, srow = st >> 2, spc = st & 3;
    const unsigned char* sgp = isv ? Vg + (size_t)srow * SEQ + spc * 16 : Kg + (size_t)srow * 256 + spc * 16;
    const size_t sstep = isv ? (size_t)64 : (size_t)64 * 256;
    const int soff = (isv ? AL_VB : AL_KB) + srow * 80 + spc * 16;
    u32x4 sr;
    if (!first_staged) {
        sr = ld16(sgp + (size_t)kb_lo * sstep);
        *(LAS u32x4*)(lds + soff) = sr;
        __syncthreads();
    }
    float m_run[2] = {0.f, 0.f}, l_run[2] = {0.f, 0.f};
    const float gate[2] = {gatep[0][MODE + 1], gatep[1][MODE + 1]};
    f32x4 oacc[2][4];
#pragma unroll
    for (int ti = 0; ti < 2; ++ti)
#pragma unroll
        for (int dt = 0; dt < 4; ++dt) oacc[ti][dt] = (f32x4){0.f, 0.f, 0.f, 0.f};
    for (int kb = kb_lo; kb <= kb_hi; ++kb) {
        const int buf = (kb - kb_lo) & 1;
        if (kb < kb_hi) sr = ld16(sgp + (size_t)(kb + 1) * sstep);
        const LAS unsigned char* kbuf = lds + AL_KB + buf * 5120; const LAS unsigned char* vbuf = lds + AL_VB + buf * 5120;
        f32x4 sacc[2][4];
        bool selb[2];
#pragma unroll
        for (int ti = 0; ti < 2; ++ti) selb[ti] = MODE == 0 ? (((selm[ti] >> kb) & 1u) != 0u) : true;
#pragma unroll
        for (int kt = 0; kt < 4; ++kt) {
            const fp8x8 k0 = *(const LAS fp8x8*)(kbuf + (16 * kt + n) * 80 + gq * 8), k1 = *(const LAS fp8x8*)(kbuf + (16 * kt + n) * 80 + 32 + gq * 8);
#pragma unroll
            for (int ti = 0; ti < 2; ++ti) {
                sacc[ti][kt] = __builtin_amdgcn_mfma_f32_16x16x32_fp8_fp8(k0, qf[ti][0], (f32x4){0.f, 0.f, 0.f, 0.f}, 0, 0, 0);
                sacc[ti][kt] = __builtin_amdgcn_mfma_f32_16x16x32_fp8_fp8(k1, qf[ti][1], sacc[ti][kt], 0, 0, 0);
            }
        }
        const bool need_mask = (kb == kb_hi) || (MODE == 1 && kb == kb_lo);
        if (need_mask) {
#pragma unroll
            for (int ti = 0; ti < 2; ++ti) {
                const int rel = sq[ti] - kb * 64 - 4 * gq;
#pragma unroll
                for (int kt = 0; kt < 4; ++kt)
#pragma unroll
                    for (int jj = 0; jj < 4; ++jj) { const int tt = 16 * kt + jj; const bool v = MODE == 0 ? (tt <= rel) : (tt <= rel && tt > rel - 512); sacc[ti][kt][jj] = v ? sacc[ti][kt][jj] : NEGBIG; }
            }
        }
        float mx[2];
#pragma unroll
        for (int ti = 0; ti < 2; ++ti) { mx[ti] = max16(sacc[ti]) - m_run[ti]; mx[ti] = selb[ti] ? mx[ti] : NEGBIG; }
        const bool slow = (mx[0] > ATT_THR) || (mx[1] > ATT_THR) || (l_run[0] == 0.f && mx[0] > -1e29f && mx[0] < -ATT_THR) || (l_run[1] == 0.f && mx[1] > -1e29f && mx[1] < -ATT_THR);
        if (__any(slow)) {
#pragma unroll
            for (int ti = 0; ti < 2; ++ti) {
                float mr = fmaxf(mx[ti], __shfl_xor(mx[ti], 16)); mr = fmaxf(mr, __shfl_xor(mr, 32));
                float lr = l_run[ti] + __shfl_xor(l_run[ti], 16); lr += __shfl_xor(lr, 32);
                const bool has = mr > -1e29f;
                const float delta = !has ? 0.f : (lr == 0.f ? mr : fmaxf(mr, 0.f));
                const float alpha = lr == 0.f ? 1.f : fast_exp2(-delta);
                l_run[ti] *= alpha; m_run[ti] += delta;
#pragma unroll
                for (int dt = 0; dt < 4; ++dt) oacc[ti][dt] *= alpha;
            }
        }
        if (__any(m_run[0] != 0.f || m_run[1] != 0.f)) {
#pragma unroll
            for (int ti = 0; ti < 2; ++ti)
#pragma unroll
                for (int kt = 0; kt < 4; ++kt) sacc[ti][kt] -= m_run[ti];
        }
        fp8x8 pf[2][2];
#pragma unroll
        for (int ti = 0; ti < 2; ++ti) {
            float ps = 0.f;
#pragma unroll
            for (int kt = 0; kt < 4; ++kt)
#pragma unroll
                for (int jj = 0; jj < 4; ++jj) { const float e = fast_exp2(sacc[ti][kt][jj]); sacc[ti][kt][jj] = e; ps += e; }
            l_run[ti] += selb[ti] ? ps : 0.f;
#pragma unroll
            for (int p = 0; p < 2; ++p) { unsigned lo = pk4p(sacc[ti][2 * p][0], sacc[ti][2 * p][1], sacc[ti][2 * p][2], sacc[ti][2 * p][3]), hi = pk4p(sacc[ti][2 * p + 1][0], sacc[ti][2 * p + 1][1], sacc[ti][2 * p + 1][2], sacc[ti][2 * p + 1][3]);
                if (MODE == 0) { lo = selb[ti] ? lo : 0u; hi = selb[ti] ? hi : 0u; }
                pf[ti][p] = mk8(lo, hi); }
        }
#pragma unroll
        for (int dt = 0; dt < 4; ++dt)
#pragma unroll
            for (int p = 0; p < 2; ++p) {
                const fp8x8 vf = *(const LAS fp8x8*)(vbuf + (16 * dt + n) * 80 + 32 * p + 8 * gq);
#pragma unroll
                for (int ti = 0; ti < 2; ++ti) oacc[ti][dt] = __builtin_amdgcn_mfma_f32_16x16x32_fp8_fp8(vf, pf[ti][p], oacc[ti][dt], 0, 0, 0);
            }
        if (kb < kb_hi) *(LAS u32x4*)(lds + (buf ^ 1) * 5120 + soff) = sr;
        __syncthreads();
    }
#pragma unroll
    for (int ti = 0; ti < 2; ++ti) {
        float lt = l_run[ti] + __shfl_xor(l_run[ti], 16); lt += __shfl_xor(lt, 32);
        const float inv = lt > 0.f ? gate[ti] / lt : 0.f;
#pragma unroll
        for (int dt = 0; dt < 4; ++dt) otl[(ti * 4 + dt) * 64] += oacc[ti][dt] * inv;
    }
}

__device__ __forceinline__ unsigned attn_cmp_tile(LAS unsigned char* lds, const fp8x8 qf0, const fp8x8 qf1, const int s, const int sbase  , const float g0,
                                                  LAS f32x4* otl  , const int lane, const int w, const int n, const int gq, const int tl, const int r) {
    f32x4 sacc[8];
#pragma unroll
    for (int kt = 0; kt < 8; ++kt) {
        const fp8x8 k0 = *(const LAS fp8x8*)(lds + AL_KC + (16 * kt + n) * 80 + gq * 8), k1 = *(const LAS fp8x8*)(lds + AL_KC + (16 * kt + n) * 80 + 32 + gq * 8);
        sacc[kt] = __builtin_amdgcn_mfma_f32_16x16x32_fp8_fp8(k0, qf0, (f32x4){0.f, 0.f, 0.f, 0.f}, 0, 0, 0);
        sacc[kt] = __builtin_amdgcn_mfma_f32_16x16x32_fp8_fp8(k1, qf1, sacc[kt], 0, 0, 0);
    }
    float mx = NEGBIG;
    const int lim = ((s - 31) >> 4) - 4 * gq;
#pragma unroll
    for (int kt = 0; kt < 8; ++kt)
#pragma unroll
        for (int jj = 0; jj < 4; ++jj) { const bool v = (16 * kt + jj <= lim); sacc[kt][jj] = v ? sacc[kt][jj] : NEGBIG; mx = fmaxf(mx, sacc[kt][jj]); }
    mx = fmaxf(mx, __shfl_xor(mx, 16)); mx = fmaxf(mx, __shfl_xor(mx, 32));
    float ps = 0.f;
#pragma unroll
    for (int kt = 0; kt < 8; ++kt)
#pragma unroll
        for (int jj = 0; jj < 4; ++jj) { const float e = sacc[kt][jj] > -1e29f ? fast_exp2(sacc[kt][jj] - mx) : 0.f; sacc[kt][jj] = e; ps += e; }
    ps += __shfl_xor(ps, 16); ps += __shfl_xor(ps, 32);
    const float inv = ps > 0.f ? 1.f / ps : 0.f;
#pragma unroll
    for (int kt = 0; kt < 8; ++kt) {
        f32x4 pp;
#pragma unroll
        for (int jj = 0; jj < 4; ++jj) { sacc[kt][jj] *= inv; float t = sacc[kt][jj]; t += dpp_mov<0xB1>(t); t += dpp_mov<0x4E>(t); pp[jj] = t; }
        if (r == 0) *(LAS f32x4*)(lds + AL_PS + ((w * 4 + tl) * 128 + 16 * kt + 4 * gq) * 4) = pp;
    }
    f32x4 otot[4];
#pragma unroll
    for (int dt = 0; dt < 4; ++dt) otot[dt] = (f32x4){0.f, 0.f, 0.f, 0.f};
#pragma unroll
    for (int p = 0; p < 4; ++p) {
        const fp8x8 pf = mk8(pk4p(sacc[2 * p][0], sacc[2 * p][1], sacc[2 * p][2], sacc[2 * p][3]), pk4p(sacc[2 * p + 1][0], sacc[2 * p + 1][1], sacc[2 * p + 1][2], sacc[2 * p + 1][3]));
#pragma unroll
        for (int dt = 0; dt < 4; ++dt) {
            const fp8x8 vf = *(const LAS fp8x8*)(lds + AL_VC + (16 * dt + n) * 144 + 32 * p + 8 * gq);
            otot[dt] = __builtin_amdgcn_mfma_f32_16x16x32_fp8_fp8(vf, pf, otot[dt], 0, 0, 0);
        }
    }
#pragma unroll
    for (int dt = 0; dt < 4; ++dt) otl[dt * 64] = otot[dt] * g0;
    asm volatile("s_waitcnt lgkmcnt(0)" ::: "memory");
    __builtin_amdgcn_wave_barrier();
    const int tl2 = lane >> 4, q = lane & 15, s2 = sbase + tl2, blkq = s2 >> 6;
    const LAS float* psr = (const LAS float*)(lds + AL_PS + ((w * 4 + tl2) * 128) * 4);
    const f32x4 xa = *(const LAS f32x4*)(psr + 8 * q), xb = *(const LAS f32x4*)(psr + 8 * q + 4);
    const float prev = q > 0 ? psr[8 * q - 1] : 0.f;
    float a0 = prev + xa[0] + xa[1] + xa[2] + xa[3], a1 = xa[3] + xb[0] + xb[1] + xb[2] + xb[3];
    const int m0 = 2 * q, m1 = 2 * q + 1;
    { const int rel0 = blkq - m0, rel1 = blkq - m1;
        if (rel0 < 0) a0 = -1.f;
        if (rel1 < 0) a1 = -1.f;
        if (m0 == 0 || rel0 == 0 || rel0 == 1) a0 = 1e6f;
        if (rel1 == 0 || rel1 == 1) a1 = 1e6f; }
    LAS float* impw = (LAS float*)(lds + AL_IMP + ((w * 4 + tl2) * 32) * 4);
    *(LAS f32x2*)(impw + 2 * q) = (f32x2){a0, a1};
    asm volatile("s_waitcnt lgkmcnt(0)" ::: "memory");
    __builtin_amdgcn_wave_barrier();
    int rk0 = 0, rk1 = 0;
#pragma unroll
    for (int i4 = 0; i4 < 8; ++i4) { const f32x4 v = *(const LAS f32x4*)(impw + 4 * i4);
#pragma unroll
        for (int j = 0; j < 4; ++j) { const int mm = 4 * i4 + j; rk0 += (v[j] > a0 || (v[j] == a0 && mm < m0)) ? 1 : 0; rk1 += (v[j] > a1 || (v[j] == a1 && mm < m1)) ? 1 : 0; } }
    unsigned bits = (rk0 < 16 ? (1u << m0) : 0u) | (rk1 < 16 ? (1u << m1) : 0u);
    bits |= dpp_movu<0xB1>(bits); bits |= dpp_movu<0x4E>(bits); bits |= dpp_movu<0x141>(bits); bits |= dpp_movu<0x140>(bits);
    LAS unsigned* selw = (LAS unsigned*)(lds + AL_SEL + (w * 4) * 4);
    if (q == 0) selw[tl2] = bits;
    asm volatile("s_waitcnt lgkmcnt(0)" ::: "memory");
    __builtin_amdgcn_wave_barrier();
    const unsigned selm = selw[tl];
    asm volatile("s_waitcnt lgkmcnt(0)" ::: "memory");
    __builtin_amdgcn_wave_barrier();
    return selm;
}

__device__ __forceinline__ void nsa_attn_phase(LAS unsigned char* lds, const AttnArgs& A) {
    const int tid0 = tid_opaque();
    for (int u = blockIdx.x; u < 4096; u += gridDim.x) {
        int tid = tid0; asm volatile("" : "+v"(tid));
        const int lane = tid & 63, w = tid >> 6, n = lane & 15, gq = lane >> 4, tl = n >> 2, r = n & 3;
        const int kq = u >> 8, c = 2 * kq + ((((u >> 7) & 1) ^ kq) & 1), bgi = u & 127, b = bgi >> 2, g = bgi & 3, s0 = c * 64;
        int sq[2]; fp8x8 qf[2][2]; const float* gp[2];
#pragma unroll
        for (int ti = 0; ti < 2; ++ti) {
            sq[ti] = s0 + 8 * w + 4 * ti + tl;
            const size_t qrow = (size_t)b * SEQ + sq[ti];
            const unsigned char* qp = A.Q + qrow * 1024 + g * 256 + r * 64 + 8 * gq;
            qf[ti][0] = *(const fp8x8*)qp; qf[ti][1] = *(const fp8x8*)(qp + 32);
            gp[ti] = A.GATES + qrow * 48 + (g * 4 + r) * 3;
        }
        const unsigned char* KSg = A.KS + (size_t)b * SEQ * 256 + g * 64; const unsigned char* VSg = A.VST + (size_t)(b * 4 + g) * 64 * SEQ;
        const unsigned char* KWg = A.KW + (size_t)b * SEQ * 256 + g * 64; const unsigned char* VWg = A.VWT + (size_t)(b * 4 + g) * 64 * SEQ;
        __syncthreads();
        { const int key = tid >> 2, pc = tid & 3; *(LAS u32x4*)(lds + AL_KC + key * 80 + pc * 16) = ld16(A.KCMP + ((size_t)(b * 128 + key) * 4 + g) * 64 + pc * 16); }
        { const int d = tid >> 3, pc = tid & 7; *(LAS u32x4*)(lds + AL_VC + d * 144 + pc * 16) = ld16(A.VCMPT + ((size_t)(b * 4 + g) * 64 + d) * 128 + pc * 16); }
        { const bool isv = tid >= 256; const int st = tid & 255, srow = st >> 2, spc = st & 3;
            *(LAS u32x4*)(lds + (isv ? AL_VB : AL_KB) + srow * 80 + spc * 16) = ld16(isv ? VSg + (size_t)srow * SEQ + spc * 16 : KSg + (size_t)srow * 256 + spc * 16); }
        __syncthreads();
        LAS f32x4* otl = (LAS f32x4*)(lds + AL_OT) + w * 512 + lane;
        unsigned selm[2];
#pragma unroll
        for (int ti = 0; ti < 2; ++ti) { selm[ti] = attn_cmp_tile(lds, qf[ti][0], qf[ti][1], sq[ti], s0 + 8 * w + 4 * ti, gp[ti][0], otl + ti * 256, lane, w, n, gq, tl, r); }
        attn_branch<0>(lds, KSg, VSg, 0, c, true, qf, sq, selm, gp, otl, n, gq, tid);
        attn_branch<1>(lds, KWg, VWg, c >= 8 ? c - 8 : 0, c, false, qf, sq, selm, gp, otl, n, gq, tid);
#pragma unroll
        for (int ti = 0; ti < 2; ++ti) {
            unsigned char* op = A.O + ((size_t)b * SEQ + sq[ti]) * 1024 + g * 256 + r * 64 + 4 * gq;
#pragma unroll
            for (int dt = 0; dt < 4; ++dt) { const f32x4 o = otl[(ti * 4 + dt) * 64] * S8_O; unsigned pk = 0u;
                pk = __builtin_amdgcn_cvt_pk_fp8_f32(clamp8(o[0]), clamp8(o[1]), pk, false); pk = __builtin_amdgcn_cvt_pk_fp8_f32(clamp8(o[2]), clamp8(o[3]), pk, true);
                *(unsigned*)(op + 16 * dt) = pk; }
        }
    }
    __syncthreads();
}
#ifndef DBG_ZERO_KIND
#define DBG_ZERO_KIND -1
#endif
#ifndef F8IN_MASK
#define F8IN_MASK 5
#endif
struct Params { const float* in[31]; float* out; unsigned char* ws; int ph_lo, ph_hi; };
constexpr int N_PHASES = 38;

#ifndef DUP_MASK
#define DUP_MASK 0ull
#endif
#define PH_BEGIN(k) if ((k) >= p.ph_lo && (k) < p.ph_hi) { for (int rep_ = 0; rep_ < (((DUP_MASK >> (k)) & 1ull) ? 2 : 1); ++rep_) {
#define PH_END(k) } if ((k) + 1 < p.ph_hi) xcd_barrier(bar); }

template <int LAYER>
__device__ __forceinline__ void layer_body(const Params& p, LAS unsigned char* lds, const XcdBarrier& bar) {
    constexpr int kind = LAYER % 3, j = LAYER / 3;
    constexpr int PB = LAYER == 0 ? 1 : (LAYER == 1 ? 10 : (LAYER == 2 ? 18 : 29));
    constexpr int NMIX = kind == 0 ? 4 : (kind == 1 ? 3 : 6);
    unsigned char* ws = p.ws;
    const int G = gridDim.x, cblk = blockIdx.x;
    const int* positions = (const int*)p.in[1];
    unsigned char* XA = ws + WS_XA; bf16_t* MB = (bf16_t*)(ws + B_MB);
    bf16_t* XR = (bf16_t*)p.out;
    bf16_t* X1 = LAYER == DEPTH - 1 ? (bf16_t*)(ws + WS_XA) : (bf16_t*)p.out + (size_t)T_TOK * DM;
    int* route_e = (int*)(ws + WS_ROUTE_E); float* route_w = (float*)(ws + WS_ROUTE_W); int* posb = (int*)(ws + WS_POS); int* cnt = (int*)(ws + WS_CNT);
    int4* tiles = (int4*)(ws + WS_TILE); float* bias1 = (float*)(ws + WS_BIAS1);
    if constexpr (kind == 0) {
        unsigned char* Q = ws + B_Q; bf16_t* KC = (bf16_t*)(ws + B_KC); bf16_t* VC = (bf16_t*)(ws + B_VC); unsigned char* KS = ws + B_KS; unsigned char* VST = ws + B_VST;
        unsigned char* KW = ws + B_KW; unsigned char* VWT = ws + B_VWT; unsigned char* OB = ws + B_O;
        float* GATES = (float*)(ws + WS_GATES); unsigned char* KCMP = ws + WS_KCMP; unsigned char* VCMPT = ws + WS_VCMPT;
        PH_BEGIN(PB + 0)
            EpiNsaIn E{Q, KC, VC, KS, VST, KW, VWT, GATES, positions, p.in[3] + j * 48};
            if constexpr (F8IN_MASK & 1) { DenseSched8 S{XA, ws + W_NSA_IN + (size_t)j * NSA_NP * 1024, 1024, 1024, T_TOK / 256, NSA_NP / 256, G, cblk};
                gemm_phase<true>(lds, 1024, 1024, 1024, S, E, 1.f / (S8_X * S8_WI)); }
            else { DenseSched S{XR, (const bf16_t*)(ws + W_NSA_IN) + (size_t)j * NSA_NP * 1024, 1024, 1024, T_TOK / 256, NSA_NP / 256, G, cblk};
                gemm_phase<false>(lds, 1024, 1024, 1024, S, E); }
        PH_END(PB + 0)
        PH_BEGIN(PB + 1)
            nsa_compress_phase(KC, VC, (const bf16_t*)(ws + W_CMP1) + (size_t)j * 2 * 64 * 2048, p.in[6] + j * 4096, p.in[9] + j * 4096, bias1 + j * 128, positions, KCMP, VCMPT);
        PH_END(PB + 1)
        PH_BEGIN(PB + 2)
            AttnArgs A{Q, KS, VST, KW, VWT, KCMP, VCMPT, GATES, OB};
            nsa_attn_phase(lds, A);
        PH_END(PB + 2)
        PH_BEGIN(PB + 3)
            DenseSched8 S{OB, ws + W_NSA_OUT + (size_t)j * 1024 * 1024, 1024, 1024, T_TOK / 256, 4, G, cblk};
            EpiPlain<false> E{MB, 1024, 1.f / (S8_O * S8_WO)};
            gemm_phase<true>(lds, 1024, 1024, 1024, S, E);
        PH_END(PB + 3)
    } else if constexpr (kind == 1) {
        bf16_t* P = (bf16_t*)(ws + B_P); bf16_t* BGb = (bf16_t*)(ws + B_BG); bf16_t* Y = (bf16_t*)(ws + B_Y);
        PH_BEGIN(PB + 0)
            EpiScIn E{P, BGb};
            if constexpr (F8IN_MASK & 2) { DenseSched8 S{XA, ws + W_SC_IN, 1024, 1024, T_TOK / 256, 12, G, cblk};
                gemm_phase<true>(lds, 1024, 1024, 1024, S, E, 1.f / (S8_X * S8_WI)); }
            else { DenseSched S{XR, (const bf16_t*)(ws + W_SC_IN), 1024, 1024, T_TOK / 256, 12, G, cblk};
                gemm_phase<false>(lds, 1024, 1024, 1024, S, E); }
        PH_END(PB + 0)
        PH_BEGIN(PB + 1)
            sc_conv_phase(P, BGb, Y, p.in[12], p.in[13]);
        PH_END(PB + 1)
        PH_BEGIN(PB + 2)
            DenseSched S{Y, (const bf16_t*)(ws + W_SC_OUT), 1024, 1024, T_TOK / 256, 4, G, cblk};
            EpiPlain<false> E{MB, 1024, 1.f};
            gemm_phase<false>(lds, 1024, 1024, 1024, S, E);
        PH_END(PB + 2)
    } else {
        bf16_t* GG = (bf16_t*)(ws + B_GG); bf16_t* R1 = (bf16_t*)(ws + B_R1); bf16_t* R2 = (bf16_t*)(ws + B_R2); bf16_t* R3 = (bf16_t*)(ws + B_R3);
        f32x4* carry = (f32x4*)(ws + WS_CARRY);
        PH_BEGIN(PB + 0)
            EpiLruIn E{GG, R1};
            if constexpr (F8IN_MASK & 4) { DenseSched8 S{XA, ws + W_LRU_IN, 1024, 1024, T_TOK / 256, 10, G, cblk};
                gemm_phase<true>(lds, 1024, 1024, 1024, S, E, 1.f / (S8_X * S8_WI)); }
            else { DenseSched S{XR, (const bf16_t*)(ws + W_LRU_IN), 1024, 1024, T_TOK / 256, 10, G, cblk};
                gemm_phase<false>(lds, 1024, 1024, 1024, S, E); }
        PH_END(PB + 0)
        PH_BEGIN(PB + 1)
            lru_conv_phase(R1, R2, p.in[16], p.in[17]);
        PH_END(PB + 1)
        PH_BEGIN(PB + 2)
            BandSched S{R2, (const bf16_t*)(ws + W_LRU_G), LRU_W, LRU_W, T_TOK / 256, 10, G, cblk};
            EpiLruGate E{R2, R1, R3, p.in[19], p.in[21], p.in[22]};
            gemm_phase<false>(lds, 384, LRU_W, LRU_W, S, E);
        PH_END(PB + 2)
        PH_BEGIN(PB + 3)
            lru_scan1_phase(R1, R3, carry);
        PH_END(PB + 3)
        PH_BEGIN(PB + 4)
            lru_scan2_phase(R1, R3, GG, carry, R2);
        PH_END(PB + 4)
        PH_BEGIN(PB + 5)
            DenseSched S{R2, (const bf16_t*)(ws + W_LRU_OUT), LRU_W, LRU_W, T_TOK / 256, 4, G, cblk};
            EpiPlain<false> E{MB, 1024, 1.f};
            gemm_phase<false>(lds, LRU_W, LRU_W, LRU_W, S, E);
        PH_END(PB + 5)
    }
    constexpr int FB = PB + NMIX;
    unsigned char* X8 = ws + B_XG; int* invb = (int*)(ws + WS_INV); unsigned char* HID = ws + B_HID; unsigned char* YM = ws + B_YM; unsigned char* WGU = ws + B_WMOE + WMOE_GU; unsigned char* WDN = ws + B_WMOE + WMOE_DN;
    const float* lng = p.in[29] + (size_t)LAYER * 2048; const float* lnb = p.in[30] + (size_t)LAYER * 2048;
    PH_BEGIN(FB + 0)
        ln1_router_phase<LAYER == 0>(lds, LAYER == 0 ? (const void*)p.in[0] : (const void*)XR, MB, X1, X8, lng, lnb, p.in[24], p.in[25], route_e, route_w, cnt);
    PH_END(FB + 0)
    PH_BEGIN(FB + 1)
        moe_gather_phase(lds, route_e, cnt, posb, invb, tiles);
        convert_wt<true>(lds, WGU, 16, 2048, 1024, FetchPair{p.in[26] + (size_t)LAYER * 16 * 1048576, (long)(p.in[27] - p.in[26]), 1024, (size_t)1048576}, S8_WGU);
        convert_wt<true>(lds, WDN, 16, 1024, 1024, FetchPlain{p.in[28] + (size_t)LAYER * 16 * 1048576, 1024, (size_t)1048576}, S8_WD);
    PH_END(FB + 1)
    PH_BEGIN(FB + 2)
        const int NT = __builtin_amdgcn_readfirstlane(tiles[0].x);
        MoeSched S{X8, WGU, tiles, invb, NT, 8, 2048, 1024, G, cblk};
        EpiMoeGU E{HID};
        gemm_phase<true, true>(lds, 1024, 1024, 1024, S, E);
    PH_END(FB + 2)
    PH_BEGIN(FB + 3)
        const int NT = __builtin_amdgcn_readfirstlane(tiles[0].x);
        MoeSched S{HID, WDN, tiles, invb, NT, 4, 1024, 1024, G, cblk};
        EpiMoeDown8 E{YM, S8_Y / (S8_H * S8_WD)};
        gemm_phase<true>(lds, 1024, 1024, 1024, S, E);
    PH_END(FB + 3)
    PH_BEGIN(FB + 4)
        ln2_combine_phase<LAYER == DEPTH - 1, ((F8IN_MASK >> ((LAYER + 1) % 3)) & 1) != 0>(X1, LAYER == DEPTH - 1 ? (void*)p.out : (void*)XR, YM, posb, route_w, lng + 1024, lnb + 1024, XA);
    PH_END(FB + 4)
}

__global__ void __launch_bounds__(NTHR, 2) hybrid_fwd(Params p) {
    extern __shared__ __attribute__((aligned(16))) unsigned char lds_raw[];
    LAS unsigned char* lds = (LAS unsigned char*)lds_raw;
    volatile LAS unsigned* bst = (volatile LAS unsigned*)(lds + LDS_BYTES - 16);
    const bool use_bar = (p.ph_hi - p.ph_lo) > 1;
    if (threadIdx.x == 0) { bst[0] = 0u; bst[1] = 0u; bst[2] = 0u; bst[3] = 0u; }
    __syncthreads();
    XcdBarrier bar; bar.bar = (unsigned*)(p.ws + WS_CTL); bar.x = 0; bar.st = bst;
    if (use_bar) bar = xcd_barrier_post((unsigned*)(p.ws + WS_CTL), bst);
    PH_BEGIN(0)
        unsigned char* ws = p.ws;
        convert_x<(F8IN_MASK & 1) != 0>(p.in[0], ws + WS_XA);
        for (int j = 0; j < 2; ++j) {
            if constexpr (F8IN_MASK & 1) convert_wt<true>(lds, ws + W_NSA_IN + (size_t)j * NSA_NP * 1024, 1, NSA_NP, 1024, FetchNsaIn{p.in[2] + (size_t)j * 1024 * 2608}, S8_WI);
            else convert_wt(lds, (bf16_t*)(ws + W_NSA_IN) + (size_t)j * NSA_NP * 1024, 1, NSA_NP, 1024, FetchNsaIn{p.in[2] + (size_t)j * 1024 * 2608});
            convert_wt<true>(lds, ws + W_NSA_OUT + (size_t)j * 1024 * 1024, 1, 1024, 1024, FetchPlain{p.in[10] + (size_t)j * 1024 * 1024, 1024, 0}, S8_WO);
            convert_wt(lds, (bf16_t*)(ws + W_CMP1) + (size_t)(j * 2 + 0) * 64 * 2048, 1, 64, 2048, FetchIdent{p.in[5] + (size_t)j * 2048 * 64, 64, 0});
            convert_wt(lds, (bf16_t*)(ws + W_CMP1) + (size_t)(j * 2 + 1) * 64 * 2048, 1, 64, 2048, FetchIdent{p.in[8] + (size_t)j * 2048 * 64, 64, 0});
        }
        if constexpr (F8IN_MASK & 2) convert_wt<true>(lds, ws + W_SC_IN, 1, 3072, 1024, FetchScIn{p.in[11]}, S8_WI); else convert_wt(lds, (bf16_t*)(ws + W_SC_IN), 1, 3072, 1024, FetchScIn{p.in[11]});
        convert_wt(lds, (bf16_t*)(ws + W_SC_OUT), 1, 1024, 1024, FetchPlain{p.in[14], 1024, 0});
        if constexpr (F8IN_MASK & 4) convert_wt<true>(lds, ws + W_LRU_IN, 1, 2560, 1024, FetchPlain{p.in[15], 2560, 0}, S8_WI); else convert_wt(lds, (bf16_t*)(ws + W_LRU_IN), 1, 2560, 1024, FetchPlain{p.in[15], 2560, 0});
        convert_wt(lds, (bf16_t*)(ws + W_LRU_G), 1, 2560, 1280, FetchLruGate{p.in[18], (long)(p.in[20] - p.in[18])});
        convert_wt(lds, (bf16_t*)(ws + W_LRU_OUT), 1, 1024, 1280, FetchPlain{p.in[23], 1024, 0});
        cmp_bias_phase(lds, p.in[4], p.in[5], p.in[7], p.in[8], (float*)(ws + WS_BIAS1));
    PH_END(0)
    layer_body<0>(p, lds, bar);
    layer_body<1>(p, lds, bar);
    layer_body<2>(p, lds, bar);
    layer_body<3>(p, lds, bar);
}
#undef PH_BEGIN
#undef PH_END

#ifndef MK_SPLIT
#define MK_SPLIT 0
#endif
extern "C" void kernel_launch(void* const* d_in, const int* in_sizes, int n_in, void* d_out, int out_size, void* d_ws, size_t ws_size, hipStream_t stream) {
    static int grid = 0;
    if (grid == 0) {
        int dev = 0, cus = 0, per_cu = 0;
        if (n_in != 31 || ws_size < WS_END) { fprintf(stderr, "kernel_launch: unexpected n_in %d or ws_size %zu (need %zu)\n", n_in, ws_size, (size_t)WS_END); grid = -1; return; }
        if (hipGetDevice(&dev) != hipSuccess || hipDeviceGetAttribute(&cus, hipDeviceAttributeMultiprocessorCount, dev) != hipSuccess) { grid = -1; return; }
        if (hipFuncSetAttribute((const void*)hybrid_fwd, hipFuncAttributeMaxDynamicSharedMemorySize, LDS_BYTES) != hipSuccess) { fprintf(stderr, "kernel_launch: hipFuncSetAttribute failed\n"); grid = -1; return; }
        if (hipOccupancyMaxActiveBlocksPerMultiprocessor(&per_cu, (const void*)hybrid_fwd, NTHR, LDS_BYTES) != hipSuccess || per_cu < 1) fprintf(stderr, "kernel_launch: occupancy query says %d\n", per_cu);
        (void)hipGetLastError();
        grid = cus;
    }
    if (grid < 0) return;
    (void)hipMemsetAsync((char*)d_ws + WS_CTL, 0, 64 * 1024, stream);
    Params p{};
    for (int i = 0; i < 31; ++i) p.in[i] = (const float*)d_in[i];
    p.out = (float*)d_out; p.ws = (unsigned char*)d_ws;
#if MK_SPLIT
    for (int ph = 0; ph < N_PHASES; ++ph) { p.ph_lo = ph; p.ph_hi = ph + 1; hipLaunchKernelGGL(hybrid_fwd, dim3(grid), dim3(NTHR), LDS_BYTES, stream, p); }
#else
    p.ph_lo = 0; p.ph_hi = N_PHASES;
    hipLaunchKernelGGL(hybrid_fwd, dim3(grid), dim3(NTHR), LDS_BYTES, stream, p);
#endif
    const hipError_t le = hipPeekAtLastError();
    if (le != hipSuccess) fprintf(stderr, "kernel_launch: launch failed: %s\n", hipGetErrorName(le));
}
```

```cpp
#include <hip/hip_runtime.h>
#include <stdint.h>
#include <stdio.h>

#define LAS __attribute__((address_space(3)))
typedef unsigned short bf16_t;
typedef short bf16x8 __attribute__((ext_vector_type(8)));
typedef float f32x4 __attribute__((ext_vector_type(4)));
typedef float f32x2 __attribute__((ext_vector_type(2)));
typedef unsigned u32x4 __attribute__((ext_vector_type(4)));
typedef unsigned u32x2 __attribute__((ext_vector_type(2)));
typedef int i32x8 __attribute__((ext_vector_type(8)));

constexpr int T_TOK = 65536, DM = 1024, SEQ = 2048, NBATCH = 32, DEPTH = 4;
constexpr int NTHR = 512;
constexpr int NSA_NP = 2816;
constexpr int LRU_W = 1280;
constexpr int NEXP = 16;
constexpr float DN_ALPHA = 1.6817928305074292f;
constexpr float LN_EPS = 1e-5f;
constexpr float NEGBIG = -1e30f;
constexpr float LOG2E = 1.4426950408889634f;

constexpr size_t KiB = 1024, MiB = 1024 * 1024;
constexpr size_t WS_CTL = 0;
constexpr size_t WS_ROUTE_E = 64 * KiB;
constexpr size_t WS_ROUTE_W = WS_ROUTE_E + 256 * KiB;
constexpr size_t WS_POS = WS_ROUTE_W + 512 * KiB;
constexpr size_t WS_CNT = WS_POS + 512 * KiB;
constexpr size_t WS_TILE = WS_CNT + 16 * KiB;
constexpr size_t WS_BIAS1 = WS_TILE + 16 * KiB;
constexpr size_t WS_INV = 1408 * KiB;
constexpr size_t WS_KCMP = 2 * MiB;
constexpr size_t WS_VCMPT = 4 * MiB;
constexpr size_t WS_CARRY = 6 * MiB;
constexpr size_t WS_GATES = 16 * MiB;
constexpr size_t WS_W = 28 * MiB;
constexpr size_t W_NSA_IN = WS_W;
constexpr size_t W_NSA_OUT = W_NSA_IN + 2 * (size_t)NSA_NP * 1024 * 2;
constexpr size_t W_SC_IN = W_NSA_OUT + 2 * (size_t)1024 * 1024 * 2;
constexpr size_t W_SC_OUT = W_SC_IN + (size_t)3072 * 1024 * 2;
constexpr size_t W_LRU_IN = W_SC_OUT + (size_t)1024 * 1024 * 2;
constexpr size_t W_LRU_G = W_LRU_IN + (size_t)2560 * 1024 * 2;
constexpr size_t W_LRU_OUT = W_LRU_G + (size_t)2560 * 1280 * 2;
constexpr size_t W_CMP1 = W_LRU_OUT + (size_t)1024 * 1280 * 2;
constexpr size_t W_END = W_CMP1 + 4 * (size_t)64 * 2048 * 2;
constexpr size_t WS_XA = 66 * MiB;
constexpr size_t WS_WMOE = WS_XA + 128 * MiB;
constexpr size_t WS_BIG = WS_WMOE + 96 * MiB;
constexpr size_t WS_END = WS_BIG + 642 * MiB;
static_assert(W_END <= WS_XA, "weights overflow");
constexpr size_t B_Q = WS_BIG, B_KC = B_Q + 128 * MiB, B_VC = B_KC + 32 * MiB, B_KS = B_VC + 32 * MiB, B_VST = B_KS + 32 * MiB, B_KW = B_VST + 32 * MiB,
                 B_VWT = B_KW + 32 * MiB, B_O = B_VWT + 32 * MiB;
constexpr size_t B_P = WS_BIG, B_BG = B_P + 128 * MiB, B_Y = B_BG + 128 * MiB;
constexpr size_t B_GG = WS_BIG, B_R1 = B_GG + 160 * MiB, B_R2 = B_R1 + 160 * MiB, B_R3 = B_R2 + 160 * MiB;
constexpr size_t B_MB = WS_BIG;
constexpr size_t B_XG = WS_BIG + 128 * MiB, B_HID = B_XG + 64 * MiB, B_YM = B_HID + 128 * MiB, B_WMOE = WS_WMOE;
constexpr size_t WMOE_GU = 0, WMOE_DN = (size_t)16 * 2048 * 1024;
constexpr float S8_X = 16.f, S8_WGU = 256.f, S8_H = 16.f, S8_WD = 512.f, S8_Y = 128.f, S8_WI = 256.f, S8_O = 32.f, S8_WO = 512.f, S8_Q = 4.f, S8_K = 0.25f;

constexpr int LDS_BYTES = 163840;

__device__ __forceinline__ unsigned cvt_pk_bf16(float lo, float hi) { unsigned r; asm volatile("v_cvt_pk_bf16_f32 %0, %1, %2" : "=v"(r) : "v"(lo), "v"(hi)); return r; }
__device__ __forceinline__ float bf_lo(unsigned u) { return __uint_as_float(u << 16); }
__device__ __forceinline__ float bf_hi(unsigned u) { return __uint_as_float(u & 0xffff0000u); }
__device__ __forceinline__ float bf2f(bf16_t h) { return __uint_as_float(((unsigned)h) << 16); }
__device__ __forceinline__ bf16_t f2bf(float f) { return (bf16_t)(cvt_pk_bf16(f, 0.f) & 0xffffu); }
__device__ __forceinline__ float fast_exp2(float x) { return __builtin_amdgcn_exp2f(x); }
__device__ __forceinline__ float fast_exp(float x) { return __builtin_amdgcn_exp2f(x * LOG2E); }
__device__ __forceinline__ float fast_rcp(float x) { return __builtin_amdgcn_rcpf(x); }
__device__ __forceinline__ float sigmoidf_(float x) { return fast_rcp(1.f + fast_exp(-x)); }
__device__ __forceinline__ float gelu_tanh(float x) { const float u = 0.7978845608028654f * (x + 0.044715f * x * x * x); return x * fast_rcp(1.f + fast_exp(-2.f * u)); }
__device__ __forceinline__ float silu_(float x) { return x * fast_rcp(1.f + fast_exp(-x)); }
__device__ __forceinline__ void sincos_rad(float ang, float& s, float& c) {
    float r = ang * 0.15915494309189535f; r = __builtin_amdgcn_fractf(r); s = __builtin_amdgcn_sinf(r); c = __builtin_amdgcn_cosf(r); }
__device__ __forceinline__ float wave_sum(float v) {
#pragma unroll
    for (int o = 32; o >= 1; o >>= 1) v += __shfl_xor(v, o);
    return v; }
template <int CTRL> __device__ __forceinline__ float dpp_mov(float v) { return __builtin_bit_cast(float, __builtin_amdgcn_update_dpp(0, __builtin_bit_cast(int, v), CTRL, 0xf, 0xf, false)); }
template <int CTRL> __device__ __forceinline__ unsigned dpp_movu(unsigned v) { return (unsigned)__builtin_amdgcn_update_dpp(0, (int)v, CTRL, 0xf, 0xf, false); }
__device__ __forceinline__ float row16_sum(float v) { v += dpp_mov<0xB1>(v); v += dpp_mov<0x4E>(v); v += dpp_mov<0x141>(v); v += dpp_mov<0x140>(v); return v; }
__device__ __forceinline__ float wave_sum_dpp(float v) { v = row16_sum(v); v += __shfl_xor(v, 16); v += __shfl_xor(v, 32); return v; }
__device__ __forceinline__ void lds_barrier() { asm volatile("s_waitcnt lgkmcnt(0)" ::: "memory"); __builtin_amdgcn_s_barrier(); asm volatile("" ::: "memory"); }
__device__ __forceinline__ int tid_opaque() { int t = threadIdx.x; asm volatile("" : "+v"(t)); return t; }
__device__ __forceinline__ u32x4 ld16(const void* p) { return *(const u32x4*)p; }
__device__ __forceinline__ void st16(void* p, u32x4 v) { *(u32x4*)p = v; }

#ifndef BAR_FIRST_WB
#define BAR_FIRST_WB 0
#endif
#ifndef BAR_EARLY_WB
#define BAR_EARLY_WB 0
#endif
#define XB_TMO      128
#define XB_XCNT(j)  (256  + 64 * (j))
#define XB_XSUB(j)  (1280 + 64 * (j))
#define XB_XGEN(j)  (2304 + 64 * (j))
#define XB_TOP      3328
#define XB_TOPGEN   3392
#define XCD_BAR_WORDS 3456
#define XB_SPIN_CAP (1u << 22)
__device__ __forceinline__ unsigned xb_ld(unsigned* p)              { return __hip_atomic_load(p, __ATOMIC_RELAXED, __HIP_MEMORY_SCOPE_AGENT); }
__device__ __forceinline__ unsigned xb_add(unsigned* p, unsigned v) { return __hip_atomic_fetch_add(p, v, __ATOMIC_RELAXED, __HIP_MEMORY_SCOPE_AGENT); }
__device__ __forceinline__ unsigned xb_xcc_id() { return (unsigned)__builtin_amdgcn_s_getreg((3 << 11) | 20) & 0xFu; }
#define XB_SPIN(cond, bar) do { unsigned _sp = 0; while (cond) { __builtin_amdgcn_s_sleep(1); \
    if ((++_sp & 255u) == 0u) { if (xb_ld(&(bar)[XB_TMO])) break; if (_sp > XB_SPIN_CAP) { atomicAdd(&(bar)[XB_TMO], 1u); break; } } } } while (0)
struct XcdBarrier { unsigned* bar; unsigned x; volatile LAS unsigned* st; };
__device__ __forceinline__ XcdBarrier xcd_barrier_post(unsigned* bar, volatile LAS unsigned* st) {
    XcdBarrier b; b.bar = bar; b.x = xb_xcc_id(); b.st = st;
    if (threadIdx.x == 0) (void)xb_add(&bar[XB_XCNT(b.x)], 1u);
    return b;
}
__device__ __forceinline__ void xcd_barrier_complete(unsigned* bar, unsigned x, unsigned& nloc, unsigned& nx) {
    const unsigned G = gridDim.x * gridDim.y * gridDim.z;
    unsigned sum, cnt, mine, sp = 0u;
    for (;;) {
        sum = 0u; cnt = 0u; mine = 0u;
#pragma unroll
        for (unsigned j = 0; j < 16; ++j) { const unsigned c = xb_ld(&bar[XB_XCNT(j)]); sum += c; cnt += (c > 0u) ? 1u : 0u; mine = (j == x) ? c : mine; }
        if (sum == G) break;
        __builtin_amdgcn_s_sleep(1);
        if ((++sp & 255u) == 0u) { if (xb_ld(&bar[XB_TMO])) break; if (sp > XB_SPIN_CAP) { atomicAdd(&bar[XB_TMO], 1u); break; } }
    }
    nloc = mine > 0u ? mine : 1u; nx = cnt > 0u ? cnt : 1u;
}
#ifndef WAIT_MASK
#define WAIT_MASK 0ull
#endif
#ifndef BUSY_MASK
#define BUSY_MASK 0ull
#endif
template <int TIMED = 0>
__device__ __forceinline__ void xcd_barrier(const XcdBarrier& b) {
    asm volatile("s_waitcnt vmcnt(0)" ::: "memory");
    __syncthreads();
    if (threadIdx.x == 0) {
        unsigned* bar = b.bar;
        __builtin_amdgcn_s_waitcnt(0);
#ifdef PROBE_WAIT
        const unsigned t0_ = (unsigned)__builtin_amdgcn_s_memrealtime();
        if constexpr (TIMED & 2) b.st[2] = b.st[2] + (t0_ - b.st[3]);
#endif
        unsigned nloc = b.st[0], nx = b.st[1];
        if (nloc == 0u) { xcd_barrier_complete(bar, b.x, nloc, nx); b.st[0] = nloc; b.st[1] = nx; }
#if BAR_EARLY_WB
        __builtin_amdgcn_fence(__ATOMIC_RELEASE, "agent");
        asm volatile("s_waitcnt vmcnt(0)" ::: "memory");
#endif
        const unsigned old = xb_add(&bar[XB_XSUB(b.x)], 1u);
        const unsigned gen = old / nloc;
#if BAR_FIRST_WB
        if (old == gen * nloc && nloc > 1u) {
            __builtin_amdgcn_fence(__ATOMIC_RELEASE, "agent");
            asm volatile("s_waitcnt vmcnt(0)" ::: "memory");
        }
#endif
        if (old + 1u == (gen + 1u) * nloc) {
            __builtin_amdgcn_fence(__ATOMIC_RELEASE, "agent");
            asm volatile("s_waitcnt vmcnt(0)" ::: "memory");
            const unsigned og = xb_add(&bar[XB_TOP], 1u);
            const unsigned tg = og / nx;
            if (og + 1u == (tg + 1u) * nx) xb_add(&bar[XB_TOPGEN], 1u);
            else XB_SPIN(xb_ld(&bar[XB_TOPGEN]) == tg, bar);
            __builtin_amdgcn_fence(__ATOMIC_ACQUIRE, "agent");
            xb_add(&bar[XB_XGEN(b.x)], 1u);
            asm volatile("s_waitcnt vmcnt(0)" ::: "memory");
        } else {
            XB_SPIN(xb_ld(&bar[XB_XGEN(b.x)]) == gen, bar);
            __builtin_amdgcn_fence(__ATOMIC_ACQUIRE, "agent");
            asm volatile("s_waitcnt vmcnt(0)" ::: "memory");
        }
#ifdef PROBE_WAIT
        { const unsigned t1_ = (unsigned)__builtin_amdgcn_s_memrealtime(); if constexpr (TIMED & 1) b.st[2] = b.st[2] + (t1_ - t0_); b.st[3] = t1_; }
#endif
    }
    __syncthreads();
}

#ifndef GEMM_SKEW
#define GEMM_SKEW 0
#endif
#ifndef GEMM_SKEW_NG
#define GEMM_SKEW_NG 2u
#endif
constexpr int BM = 256, BK = 64, HALF = 128, HTB = HALF * BK * 2, STAGE_BYTES = 8 * HTB, NXCD = 8, WGM = 8;
__host__ __device__ __forceinline__ int lds_byte(int r, int c) { const int st = (r >> 4) * 2 + (c >> 5), rr = r & 15, cc = c & 31, ob = rr * 64 + cc * 2; return st * 1024 + (ob ^ (((ob >> 9) & 1) << 5)); }
__host__ __device__ __forceinline__ void stage_rc(int b, int& R, int& C) { const int st = b / 1024, sb = b % 1024, swz = sb ^ (((sb >> 9) & 1) << 5); R = (st >> 1) * 16 + swz / 64; C = (st & 1) * 32 + (swz % 64) / 2; }

struct GUnit { const char* a; const char* b; int pn; int row0; int nrows; int aux; };
__device__ __forceinline__ void map_unit(int L, int nM, int nN, int& pm, int& pn) {
    const int nwg = nM * nN; int wgid = L;
    { const int q = nwg / NXCD, r = nwg % NXCD, xcd = wgid % NXCD, off = wgid / NXCD; wgid = (xcd < r ? xcd * (q + 1) : r * (q + 1) + (xcd - r) * q) + off; }
    const int nig = WGM * nN, gid = wgid / nig, fm = gid * WGM, gsz = (nM - fm) < WGM ? (nM - fm) : WGM;
    pm = fm + ((wgid % nig) % gsz); pn = (wgid % nig) / gsz;
}
struct DenseSched {
    const bf16_t* A; const bf16_t* Bt; int lda, K, nM, nN, G, c;
    __device__ __forceinline__ bool next(int i, GUnit& u) const {
        const long L = (long)i * G + c; if (L >= (long)nM * nN) return false;
        int pm, pn; map_unit((int)L, nM, nN, pm, pn);
        u.a = (const char*)(A + (size_t)pm * BM * lda); u.b = (const char*)(Bt + (size_t)pn * BM * K); u.pn = pn; u.row0 = pm * BM; u.nrows = BM; u.aux = 0; return true;
    }
};
struct DenseSched8 {
    const unsigned char* A; const unsigned char* Bt; int lda, K, nM, nN, G, c;
    __device__ __forceinline__ bool next(int i, GUnit& u) const {
        const long L = (long)i * G + c; if (L >= (long)nM * nN) return false;
        int pm, pn; map_unit((int)L, nM, nN, pm, pn);
        u.a = (const char*)(A + (size_t)pm * BM * lda); u.b = (const char*)(Bt + (size_t)pn * BM * K); u.pn = pn; u.row0 = pm * BM; u.nrows = BM; u.aux = 0; return true;
    }
};
struct BandSched {
    const bf16_t* A; const bf16_t* Bt; int lda, ldb, nM, nN, G, c;
    __device__ __forceinline__ bool next(int i, GUnit& u) const {
        const long L = (long)i * G + c; if (L >= (long)nM * nN) return false;
        int pm, pn; map_unit((int)L, nM, nN, pm, pn);
        int k0 = ((128 * pn / 80) * 80 / 64) * 64; k0 = k0 > ldb - 384 ? ldb - 384 : k0;
        u.a = (const char*)(A + (size_t)pm * BM * lda + k0); u.b = (const char*)(Bt + (size_t)pn * BM * ldb + k0); u.pn = pn; u.row0 = pm * BM; u.nrows = BM; u.aux = 0; return true;
    }
};
struct MoeSched {
    const unsigned char* A; const unsigned char* W; const int4* tiles; const int* inv; int NT, nN, N, K, G, c;
    __device__ __forceinline__ bool next(int i, GUnit& u) const {
        const long L = (long)i * G + c; if (L >= (long)NT * nN) return false;
        int pm, pn; map_unit((int)L, NT, nN, pm, pn);
        const int4 t = tiles[1 + pm];
        const int e = __builtin_amdgcn_readfirstlane(t.x), r0 = __builtin_amdgcn_readfirstlane(t.y), nr = __builtin_amdgcn_readfirstlane(t.z);
        u.a = (const char*)(A + (size_t)r0 * K); u.b = (const char*)(W + ((size_t)e * N + (size_t)pn * BM) * K); u.pn = pn; u.row0 = r0; u.nrows = nr; u.aux = e; return true;
    }
};

constexpr int MOE_MAXU = 18, MOE_LDS_DESC = 131072, MOE_LDS_ROWS = 131072 + 512;
struct MoeSchedL {
    const unsigned char* A; const unsigned char* W; const LAS u32x4* desc; const LAS int* rows; int nu, N, K; bool fix;
    __device__ __forceinline__ bool next(int i, GUnit& u) const {
        if (i >= nu) return false;
        const u32x4 t = desc[i];
        const int e = __builtin_amdgcn_readfirstlane((int)t[0]), r0 = __builtin_amdgcn_readfirstlane((int)t[1]), nr = __builtin_amdgcn_readfirstlane((int)t[2]), pn = __builtin_amdgcn_readfirstlane((int)t[3]);
        u.a = (const char*)(A + (size_t)r0 * K); u.b = (const char*)(W + ((size_t)e * N + (size_t)pn * BM) * K); u.pn = pn; u.row0 = r0; u.nrows = nr; u.aux = i;
#if defined(EXP_FIXA)
        if (nu < 0) { }
        if (fix) { u.a = (const char*)A; }
#endif
#if defined(EXP_FIXB)
        if (fix) { u.b = (const char*)W; }
#endif
        return true;
    }
    __device__ __forceinline__ int arow(const GUnit& u, int r) const { return rows[u.aux * 256 + r]; }
};
template <bool GATHER>
__device__ __forceinline__ int moe_sched_fill(LAS unsigned char* lds, const int4* tiles, const int* inv, int NT, int nN, int G, int c) {
    const int tid = tid_opaque();
    const int total = NT * nN;
    int nu = c < total ? (total - c + G - 1) / G : 0; nu = nu > MOE_MAXU ? MOE_MAXU : nu;
    LAS u32x4* desc = (LAS u32x4*)(lds + MOE_LDS_DESC); LAS int* rows = (LAS int*)(lds + MOE_LDS_ROWS);
#pragma unroll
    for (int k = 0; k < MOE_MAXU * 256 / NTHR; ++k) {
        const int x = tid + k * NTHR, i = x >> 8, r = x & 255;
        if (i < nu) {
            int pm, pn; map_unit(i * G + c, NT, nN, pm, pn);
            const int4 t = tiles[1 + pm];
            if (r == 0) desc[i] = (u32x4){(unsigned)t.x, (unsigned)t.y, (unsigned)t.z, (unsigned)pn};
            if constexpr (GATHER) rows[x] = inv[t.y + r];
        }
    }
    __syncthreads();
    return nu;
}

template <bool F8, bool GATHER = false, class Epi, class Sched>
__device__ __forceinline__ void gemm_phase(LAS unsigned char* lds, const int K  , const int lda, const int ldb  , const Sched& S, const Epi& E, const float accs = 1.f  ) {
    const int tid = tid_opaque(), wid = __builtin_amdgcn_readfirstlane(tid >> 6), lane = tid & 63, wr = wid >> 2, wc = wid & 3, fr = lane & 15, fq = lane >> 4;
    const int nt = F8 ? K / 128 : K / BK;
    unsigned voffA[2], voffB[2];
#pragma unroll
    for (int i = 0; i < 2; ++i) { int R, C; stage_rc(tid * 16 + i * 8192, R, C); voffA[i] = F8 ? (unsigned)(R * lda + 2 * C) : (unsigned)(R * lda + C) * 2u; voffB[i] = F8 ? (unsigned)(R * ldb + 2 * C) : (unsigned)(R * ldb + C) * 2u; }
    int gR[2]; unsigned gC[2]; unsigned vc[2][2], vn[2][2];
#pragma unroll
    for (int i = 0; i < 2; ++i) { int R, C; stage_rc(tid * 16 + i * 8192, R, C); gR[i] = R; gC[i] = 2u * (unsigned)C; }
#define PG8_GLOAD(dst, unit) do { if constexpr (GATHER) { _Pragma("unroll") for (int _h = 0; _h < 2; ++_h) _Pragma("unroll") for (int _i = 0; _i < 2; ++_i) \
        dst[_h][_i] = (unsigned)S.arow((unit), _h * HALF + gR[_i]) * (unsigned)lda + gC[_i]; } } while (0)
#define PG8_STAGE_A(bufoff, h, kofs, unext) do { if constexpr (GATHER) { _Pragma("unroll") for (int _i = 0; _i < 2; ++_i) \
        __builtin_amdgcn_global_load_lds((const unsigned*)((const char*)S.A + (kofs) + ((unext) ? vn[h][_i] : vc[h][_i])), (LAS unsigned*)(lds + (bufoff) + ldsw + _i * 8192), 16, 0, 0); } \
        else PG8_STAGE(bufoff, ((unext) ? nA : cA) + (h) * hstepA + (kofs), voffA); } while (0)
    const size_t kstep = (size_t)(BK * 2);
    const size_t hstepA = (size_t)HALF * lda * (F8 ? 1 : 2), hstepB = (size_t)HALF * ldb * (F8 ? 1 : 2);
    const unsigned ldsw = (unsigned)wid * 1024u;
    const int aoff = lds_byte(wr * 64 + fr, fq * 8), boff = lds_byte(wc * 32 + fr, fq * 8);
    const LAS unsigned char* ldsA = lds + aoff; const LAS unsigned char* ldsB = lds + 65536 + boff;
#define PG8_SA(b, h) (((b) * 2 + (h)) * HTB)
#define PG8_SB(b, h) ((4 + (b) * 2 + (h)) * HTB)
#define PG8_STAGE(bufoff, gbase, voff) do { _Pragma("unroll") for (int _i = 0; _i < 2; ++_i) \
        __builtin_amdgcn_global_load_lds((const unsigned*)((const char*)(gbase) + (voff)[_i]), (LAS unsigned*)(lds + (bufoff) + ldsw + _i * 8192), 16, 0, 0); } while (0)
#define PG8_LD16(off) (*(const LAS u32x4*)(lds + (off)))
#define PG8_LDA16(off) (*(const LAS u32x4*)(ldsA + (off)))
#define PG8_LDB16(off) (*(const LAS u32x4*)(ldsB + (off)))
#define PG8_LDA(dst, b, h) do { _Pragma("unroll") for (int m = 0; m < 4; ++m) { \
        if constexpr (F8) dst##8[m] = __builtin_shufflevector(PG8_LDA16(PG8_SA(b, h) + m * 2048), PG8_LDA16(PG8_SA(b, h) + m * 2048 + 1024), 0, 1, 2, 3, 4, 5, 6, 7); \
        else { _Pragma("unroll") for (int k = 0; k < 2; ++k) dst[m][k] = *(const LAS bf16x8*)(lds + PG8_SA(b, h) + aoff + m * 2048 + k * 1024); } } } while (0)
#define PG8_LDB(dst, b, h) do { _Pragma("unroll") for (int n = 0; n < 2; ++n) { \
        if constexpr (F8) dst##8[n] = __builtin_shufflevector(PG8_LDB16(PG8_SB(b, h) - 65536 + n * 2048), PG8_LDB16(PG8_SB(b, h) - 65536 + n * 2048 + 1024), 0, 1, 2, 3, 4, 5, 6, 7); \
        else { _Pragma("unroll") for (int k = 0; k < 2; ++k) dst[n][k] = *(const LAS bf16x8*)(lds + PG8_SB(b, h) + boff + n * 2048 + k * 1024); } } } while (0)
#define PG8_MMA(ai, bj, At, Bt) do { __builtin_amdgcn_s_setprio(1); _Pragma("unroll") for (int m = 0; m < 4; ++m) _Pragma("unroll") for (int n = 0; n < 2; ++n) { \
        if constexpr (F8) asm("v_mfma_f32_16x16x128_f8f6f4 %0, %1, %2, %0" : "+v"(acc[ai][bj][m][n]) : "v"(Bt##8[n]), "v"(At##8[m])); \
        else { _Pragma("unroll") for (int k = 0; k < 2; ++k) acc[ai][bj][m][n] = __builtin_amdgcn_mfma_f32_16x16x32_bf16(Bt[n][k], At[m][k], acc[ai][bj][m][n], 0, 0, 0); } } \
        __builtin_amdgcn_s_setprio(0); } while (0)
#define PG8_WAIT_V(n) asm volatile("s_waitcnt vmcnt(" #n ")" ::: "memory")
#define PG8_WAIT_L(n) asm volatile("s_waitcnt lgkmcnt(" #n ")" ::: "memory")
#define PG8_BAR __builtin_amdgcn_s_barrier()
#define PG8_SCHED __builtin_amdgcn_sched_barrier(0)
    GUnit cur, nxt; int ui = 0;
    if (!S.next(0, cur)) return;
#if GEMM_SKEW
    {
        const unsigned g_ = ((unsigned)blockIdx.x >> 3) % GEMM_SKEW_NG;
        if (g_ != 0u) { const unsigned long long t0_ = __builtin_amdgcn_s_memrealtime(); const unsigned long long dl_ = (unsigned long long)(g_ * (unsigned)(F8 ? GEMM_SKEW : GEMM_SKEW * 3 / 2));
            while (__builtin_amdgcn_s_memrealtime() - t0_ < dl_) __builtin_amdgcn_s_sleep(8); }
    }
#endif
    f32x4 acc[2][2][4][2];
#pragma unroll
    for (int a = 0; a < 2; ++a)
#pragma unroll
        for (int b = 0; b < 2; ++b)
#pragma unroll
            for (int m = 0; m < 4; ++m)
#pragma unroll
                for (int n = 0; n < 2; ++n) acc[a][b][m][n] = (f32x4){0.f, 0.f, 0.f, 0.f};
    bf16x8 At[4][2], B0[2][2], B1[2][2];
    typedef unsigned u32x8 __attribute__((ext_vector_type(8)));
    u32x8 At8[4], B08[2], B18[2];
    const char* cA = cur.a; const char* cB = cur.b; const char* nA = cA;
    PG8_GLOAD(vc, cur);
    PG8_STAGE(PG8_SB(0, 0), cB, voffB); PG8_STAGE_A(PG8_SA(0, 0), 0, (size_t)0, false); PG8_STAGE(PG8_SB(0, 1), cB + hstepB, voffB); PG8_STAGE_A(PG8_SA(0, 1), 1, (size_t)0, false);
    if (wr == 1) PG8_BAR;
    PG8_WAIT_V(4); PG8_BAR;
    PG8_STAGE(PG8_SB(1, 0), cB + kstep, voffB); PG8_STAGE_A(PG8_SA(1, 0), 0, kstep, false); PG8_STAGE(PG8_SB(1, 1), cB + hstepB + kstep, voffB);
    PG8_WAIT_V(6); PG8_BAR;
    for (;;) {
        const bool has_next = S.next(ui + 1, nxt);
        nA = has_next ? nxt.a : cA; const char* nB = has_next ? nxt.b : cB;
        if (has_next) PG8_GLOAD(vn, nxt); else { _Pragma("unroll") for (int _h = 0; _h < 2; ++_h) _Pragma("unroll") for (int _i = 0; _i < 2; ++_i) vn[_h][_i] = vc[_h][_i]; }
#pragma unroll 1
        for (int t = 0; t < nt; t += 2) {
            const bool last = (t == nt - 2);
            const size_t ka1 = (size_t)(t + 1) * kstep, ka2 = last ? (size_t)0 : (size_t)(t + 2) * kstep, ka3 = ka2 + kstep;
            const char* b2 = last ? nB : cB + (size_t)(t + 2) * kstep;
            const char* b3 = b2 + kstep;
            PG8_LDB(B0, 0, 0); PG8_SCHED; PG8_LDA(At, 0, 0); PG8_STAGE_A(PG8_SA(1, 1), 1, ka1, false);
            PG8_WAIT_L(8); PG8_BAR; PG8_WAIT_L(0); PG8_MMA(0, 0, At, B0); PG8_BAR; PG8_SCHED;
            PG8_LDB(B1, 0, 1); PG8_STAGE(PG8_SB(0, 0), b2, voffB);
            PG8_BAR; PG8_WAIT_L(0); PG8_MMA(0, 1, At, B1); PG8_BAR;
            PG8_LDA(At, 0, 1); PG8_STAGE_A(PG8_SA(0, 0), 0, ka2, last);
            PG8_BAR; PG8_WAIT_L(0); PG8_MMA(1, 0, At, B0); PG8_BAR; PG8_SCHED;
            PG8_STAGE(PG8_SB(0, 1), b2 + hstepB, voffB);
            PG8_WAIT_V(6); PG8_BAR; PG8_MMA(1, 1, At, B1); PG8_BAR;
            PG8_LDB(B0, 1, 0); PG8_SCHED; PG8_LDA(At, 1, 0); PG8_STAGE_A(PG8_SA(0, 1), 1, ka2, last);
            PG8_WAIT_L(8); PG8_BAR; PG8_WAIT_L(0); PG8_MMA(0, 0, At, B0); PG8_BAR; PG8_SCHED;
            PG8_LDB(B1, 1, 1); PG8_STAGE(PG8_SB(1, 0), b3, voffB);
            PG8_BAR; PG8_WAIT_L(0); PG8_MMA(0, 1, At, B1); PG8_BAR;
            PG8_LDA(At, 1, 1); PG8_STAGE_A(PG8_SA(1, 0), 0, ka3, last);
            PG8_BAR; PG8_WAIT_L(0); PG8_MMA(1, 0, At, B0); PG8_BAR; PG8_SCHED;
            PG8_STAGE(PG8_SB(1, 1), b3 + hstepB, voffB);
            PG8_WAIT_V(6); PG8_BAR; PG8_MMA(1, 1, At, B1); PG8_BAR;
        }
        if constexpr (F8) asm volatile("s_nop 15\n\ts_nop 15" ::: "memory");
        if (accs != 1.f) {
#pragma unroll
            for (int a = 0; a < 2; ++a)
#pragma unroll
                for (int b = 0; b < 2; ++b)
#pragma unroll
                    for (int m = 0; m < 4; ++m)
#pragma unroll
                        for (int n = 0; n < 2; ++n) acc[a][b][m][n] *= accs;
        }
        E(acc, cur, wr, wc, fr, fq);
        if (!has_next) break;
#pragma unroll
        for (int a = 0; a < 2; ++a)
#pragma unroll
            for (int b = 0; b < 2; ++b)
#pragma unroll
                for (int m = 0; m < 4; ++m)
#pragma unroll
                    for (int n = 0; n < 2; ++n) acc[a][b][m][n] = (f32x4){0.f, 0.f, 0.f, 0.f};
        cur = nxt; cA = nA; cB = nB; ++ui;
#pragma unroll
        for (int _h = 0; _h < 2; ++_h)
#pragma unroll
            for (int _i = 0; _i < 2; ++_i) vc[_h][_i] = vn[_h][_i];
    }
    PG8_WAIT_V(0);
    if (wr == 0) PG8_BAR;
    PG8_BAR;
#undef PG8_SA
#undef PG8_SB
#undef PG8_STAGE
#undef PG8_STAGE_A
#undef PG8_GLOAD
#undef PG8_LDA
#undef PG8_LDB
#undef PG8_MMA
#undef PG8_LD16
#undef PG8_LDA16
#undef PG8_LDB16
#undef PG8_WAIT_V
#undef PG8_WAIT_L
#undef PG8_BAR
#undef PG8_SCHED
}
typedef f32x4 acc_t[2][2][4][2];
#ifndef EPI_NT
#define EPI_NT 0
#endif
__device__ __forceinline__ void est16(void* p, u32x4 v) { if (EPI_NT == 2) { __hip_atomic_store((unsigned long long*)p, ((unsigned long long)v[1] << 32) | v[0], __ATOMIC_RELAXED, __HIP_MEMORY_SCOPE_AGENT); __hip_atomic_store((unsigned long long*)p + 1, ((unsigned long long)v[3] << 32) | v[2], __ATOMIC_RELAXED, __HIP_MEMORY_SCOPE_AGENT); } else if (EPI_NT) __builtin_nontemporal_store(v, (u32x4*)p); else *(u32x4*)p = v; }
__device__ __forceinline__ void est8(void* p, u32x2 v) { if (EPI_NT == 2) __hip_atomic_store((unsigned long long*)p, ((unsigned long long)v[1] << 32) | v[0], __ATOMIC_RELAXED, __HIP_MEMORY_SCOPE_AGENT); else if (EPI_NT) __builtin_nontemporal_store(v, (u32x2*)p); else *(u32x2*)p = v; }
__device__ __forceinline__ void est4(void* p, unsigned v) { if (EPI_NT == 2) __hip_atomic_store((unsigned*)p, v, __ATOMIC_RELAXED, __HIP_MEMORY_SCOPE_AGENT); else if (EPI_NT) __builtin_nontemporal_store(v, (unsigned*)p); else *(unsigned*)p = v; }

__device__ __forceinline__ u32x4 pack8(f32x4 a, f32x4 b) { return (u32x4){cvt_pk_bf16(a[0], a[1]), cvt_pk_bf16(a[2], a[3]), cvt_pk_bf16(b[0], b[1]), cvt_pk_bf16(b[2], b[3])}; }
__device__ __forceinline__ void unpack8(u32x4 v, float* f) { f[0] = bf_lo(v[0]); f[1] = bf_hi(v[0]); f[2] = bf_lo(v[1]); f[3] = bf_hi(v[1]); f[4] = bf_lo(v[2]); f[5] = bf_hi(v[2]); f[6] = bf_lo(v[3]); f[7] = bf_hi(v[3]); }

template <bool MASK> struct EpiPlain {
    bf16_t* O; int ldo; float scale;
    __device__ __forceinline__ void operator()(const acc_t& acc, const GUnit& u, int wr, int wc, int fr, int fq) const {
        const int colb = u.pn * 256 + wc * 32 + fq * 8;
#pragma unroll
        for (int ai = 0; ai < 2; ++ai)
#pragma unroll
            for (int m = 0; m < 4; ++m) {
                const int r = ai * 128 + wr * 64 + m * 16 + fr;
                if (MASK && r >= u.nrows) continue;
                bf16_t* rowp = O + (size_t)(u.row0 + r) * ldo + colb;
#pragma unroll
                for (int bj = 0; bj < 2; ++bj) est16(rowp + bj * 128, pack8(acc[ai][bj][m][0] * scale, acc[ai][bj][m][1] * scale));
            }
    }
};

struct EpiResid {
    float* XF; const float* XR;
    __device__ __forceinline__ void operator()(const acc_t& acc, const GUnit& u, int wr, int wc, int fr, int fq) const {
        const int colb = u.pn * 256 + wc * 32 + fq * 8;
#pragma unroll
        for (int ai = 0; ai < 2; ++ai)
#pragma unroll
            for (int m = 0; m < 4; ++m) {
                const int r = ai * 128 + wr * 64 + m * 16 + fr;
                float* rowp = XF + (size_t)(u.row0 + r) * 1024 + colb; const float* rrow = XR + (size_t)(u.row0 + r) * 1024 + colb;
                asm volatile("" ::: "memory");
#pragma unroll
                for (int bj = 0; bj < 2; ++bj) {
                    const f32x4 x0 = *(const f32x4*)(rrow + bj * 128), x1 = *(const f32x4*)(rrow + bj * 128 + 4);
                    *(f32x4*)(rowp + bj * 128) = x0 * DN_ALPHA + acc[ai][bj][m][0]; *(f32x4*)(rowp + bj * 128 + 4) = x1 * DN_ALPHA + acc[ai][bj][m][1];
                }
            }
    }
};

__device__ __forceinline__ float clamp8(float x) { return __builtin_amdgcn_fmed3f(x, -448.f, 448.f); }
__device__ __forceinline__ u32x2 pack8_fp8(const float* f) {
    unsigned a = 0u, b = 0u;
    a = __builtin_amdgcn_cvt_pk_fp8_f32(clamp8(f[0]), clamp8(f[1]), a, false); a = __builtin_amdgcn_cvt_pk_fp8_f32(clamp8(f[2]), clamp8(f[3]), a, true);
    b = __builtin_amdgcn_cvt_pk_fp8_f32(clamp8(f[4]), clamp8(f[5]), b, false); b = __builtin_amdgcn_cvt_pk_fp8_f32(clamp8(f[6]), clamp8(f[7]), b, true);
    return (u32x2){a, b};
}
__device__ __forceinline__ void unpack8_fp8(u32x2 v, float* f) {
    const f32x2 a = __builtin_amdgcn_cvt_pk_f32_fp8(v[0], false), b = __builtin_amdgcn_cvt_pk_f32_fp8(v[0], true), c = __builtin_amdgcn_cvt_pk_f32_fp8(v[1], false), d = __builtin_amdgcn_cvt_pk_f32_fp8(v[1], true);
    f[0] = a[0]; f[1] = a[1]; f[2] = b[0]; f[3] = b[1]; f[4] = c[0]; f[5] = c[1]; f[6] = d[0]; f[7] = d[1]; }
__device__ __forceinline__ unsigned pack4_fp8(float a, float b, float c, float d) { unsigned r = 0u;
    r = __builtin_amdgcn_cvt_pk_fp8_f32(clamp8(a), clamp8(b), r, false); r = __builtin_amdgcn_cvt_pk_fp8_f32(clamp8(c), clamp8(d), r, true); return r; }
__device__ __forceinline__ int vperm32(int s) { const int k = s & 31; return (s & ~31) + 8 * ((k >> 2) & 3) + 4 * (k >> 4) + (k & 3); }
struct EpiMoeDown8 {
    unsigned char* O; float scale; bool skip;
    __device__ __forceinline__ void operator()(const acc_t& acc, const GUnit& u, int wr, int wc, int fr, int fq) const {
#if defined(EXP_F4_NOEPI)
        if (skip) {
        _Pragma("unroll") for (int ai = 0; ai < 2; ++ai) _Pragma("unroll") for (int bj = 0; bj < 2; ++bj) _Pragma("unroll") for (int m = 0; m < 4; ++m) _Pragma("unroll") for (int n = 0; n < 2; ++n) asm volatile("" :: "v"(acc[ai][bj][m][n]));
        return; }
#endif
        const int colb = u.pn * 256 + wc * 32 + fq * 8;
#pragma unroll
        for (int ai = 0; ai < 2; ++ai)
#pragma unroll
            for (int m = 0; m < 4; ++m) {
                const int r = ai * 128 + wr * 64 + m * 16 + fr;
                if (r >= u.nrows) continue;
                unsigned char* rowp = O + (size_t)(u.row0 + r) * 1024 + colb;
#pragma unroll
                for (int bj = 0; bj < 2; ++bj) { const f32x4 v0 = acc[ai][bj][m][0] * scale, v1 = acc[ai][bj][m][1] * scale;
                    const float f[8] = {v0[0], v0[1], v0[2], v0[3], v1[0], v1[1], v1[2], v1[3]};
#if defined(EXP_F4_NOSTORE)
                    if (skip) { const u32x2 pk_ = pack8_fp8(f); asm volatile("" :: "v"(pk_), "v"(rowp)); continue; }
#endif
                    est8(rowp + bj * 128, pack8_fp8(f)); }
            }
    }
};
struct EpiMoeDown16 {
    unsigned char* O; float scale;
    __device__ __forceinline__ void operator()(const acc_t& acc, const GUnit& u, int wr, int wc, int fr, int fq) const {
        const int colb = u.pn * 256 + wc * 64 + fq * 16;
#pragma unroll
        for (int ai = 0; ai < 2; ++ai)
#pragma unroll
            for (int m = 0; m < 4; ++m) {
                const int r = ai * 128 + wr * 64 + m * 16 + fr;
                if (r >= u.nrows) continue;
                u32x4 pk;
#pragma unroll
                for (int bj = 0; bj < 2; ++bj)
#pragma unroll
                    for (int n = 0; n < 2; ++n) { const f32x4 v = acc[ai][bj][m][n] * scale; pk[2 * bj + n] = pack4_fp8(v[0], v[1], v[2], v[3]); }
                est16(O + (size_t)(u.row0 + r) * 1024 + colb, pk);
            }
    }
};
struct EpiMoeGU {
    unsigned char* O;
    __device__ __forceinline__ void operator()(const acc_t& acc, const GUnit& u, int wr, int wc, int fr, int fq) const {
        const int colb = u.pn * 128 + wc * 32 + fq * 8;
#pragma unroll
        for (int ai = 0; ai < 2; ++ai)
#pragma unroll
            for (int m = 0; m < 4; ++m) {
                const int r = ai * 128 + wr * 64 + m * 16 + fr;
                if (r >= u.nrows) continue;
                float h[8];
                constexpr float DS = 1.f / (S8_X * S8_WGU), C1 = -DS * LOG2E, IC2 = 1.f / (DS * DS * S8_H);
#pragma unroll
                for (int bj = 0; bj < 2; ++bj)
#pragma unroll
                    for (int jp = 0; jp < 2; ++jp) {
                        const f32x2 g = {acc[ai][bj][m][0][2 * jp], acc[ai][bj][m][0][2 * jp + 1]}, uu = {acc[ai][bj][m][1][2 * jp], acc[ai][bj][m][1][2 * jp + 1]};
                        const f32x2 t = g * uu, a = g * (f32x2){C1, C1};
                        const f32x2 e = {__builtin_amdgcn_exp2f(a[0]), __builtin_amdgcn_exp2f(a[1])};
                        const f32x2 d = __builtin_elementwise_fma(e, (f32x2){IC2, IC2}, (f32x2){IC2, IC2});
                        const f32x2 rr = {__builtin_amdgcn_rcpf(d[0]), __builtin_amdgcn_rcpf(d[1])};
                        const f32x2 hh = t * rr;
                        h[bj * 4 + 2 * jp] = hh[0]; h[bj * 4 + 2 * jp + 1] = hh[1];
                    }
                est8(O + (size_t)(u.row0 + r) * 1024 + colb, pack8_fp8(h));
            }
    }
};

struct EpiScIn {
    bf16_t* P; bf16_t* BG; float sc;
    __device__ __forceinline__ void operator()(const acc_t& acc, const GUnit& u, int wr, int wc, int fr, int fq) const {
        if (u.pn < 8) {
            const int colb = u.pn * 128 + wc * 32 + fq * 8;
            const float s2 = sc * sc;
#pragma unroll
            for (int ai = 0; ai < 2; ++ai)
#pragma unroll
                for (int m = 0; m < 4; ++m) {
                    const int r = ai * 128 + wr * 64 + m * 16 + fr;
                    est16(P + (size_t)(u.row0 + r) * 1024 + colb, pack8(acc[ai][0][m][0] * acc[ai][0][m][1] * s2, acc[ai][1][m][0] * acc[ai][1][m][1] * s2));
                }
        } else {
            const int colb = (u.pn - 8) * 256 + wc * 32 + fq * 8;
#pragma unroll
            for (int ai = 0; ai < 2; ++ai)
#pragma unroll
                for (int m = 0; m < 4; ++m) {
                    const int r = ai * 128 + wr * 64 + m * 16 + fr;
                    bf16_t* rowp = BG + (size_t)(u.row0 + r) * 1024 + colb;
#pragma unroll
                    for (int bj = 0; bj < 2; ++bj) est16(rowp + bj * 128, pack8(acc[ai][bj][m][0] * sc, acc[ai][bj][m][1] * sc));
                }
        }
    }
};

struct EpiLruIn {
    bf16_t* GG; bf16_t* REC; float sc;
    __device__ __forceinline__ void operator()(const acc_t& acc, const GUnit& u, int wr, int wc, int fr, int fq) const {
        const bool isg = u.pn < 5;
        bf16_t* O = GG + (isg ? 0l : (REC - GG));
        const int colb = (isg ? u.pn : u.pn - 5) * 256 + wc * 32 + fq * 8;
        constexpr float CG = -2.f * 0.7978845608028654f * LOG2E, CG3 = CG * 0.044715f;
        const f32x2 sc2 = {sc, sc};
#pragma unroll
        for (int ai = 0; ai < 2; ++ai)
#pragma unroll
            for (int m = 0; m < 4; ++m) {
                const int r = ai * 128 + wr * 64 + m * 16 + fr;
                bf16_t* rowp = O + (size_t)(u.row0 + r) * LRU_W + colb;
#pragma unroll
                for (int bj = 0; bj < 2; ++bj) {
                    f32x4 v[2];
#pragma unroll
                    for (int n = 0; n < 2; ++n)
#pragma unroll
                        for (int jp = 0; jp < 2; ++jp) {
                            f32x2 x = (f32x2){acc[ai][bj][m][n][2 * jp], acc[ai][bj][m][n][2 * jp + 1]} * sc2;
                            if (isg) {
                                const f32x2 p = __builtin_elementwise_fma(x * x, (f32x2){CG3, CG3}, (f32x2){CG, CG});
                                const f32x2 a = p * x;
                                const f32x2 d = (f32x2){__builtin_amdgcn_exp2f(a[0]), __builtin_amdgcn_exp2f(a[1])} + (f32x2){1.f, 1.f};
                                x = x * (f32x2){__builtin_amdgcn_rcpf(d[0]), __builtin_amdgcn_rcpf(d[1])};
                            }
                            v[n][2 * jp] = x[0]; v[n][2 * jp + 1] = x[1];
                        }
                    est16(rowp + bj * 128, pack8(v[0], v[1]));
                }
            }
    }
};

struct EpiLruGate {
    const bf16_t* U; bf16_t* LOGA; bf16_t* BIN; const float* ba; const float* bx; const float* lam;
    __device__ __forceinline__ void operator()(const acc_t& acc, const GUnit& u, int wr, int wc, int fr, int fq) const {
        const int ch0 = u.pn * 128 + wc * 32 + fq * 8;
        float ba8[8], bx8[8], ls8[8];
#pragma unroll
        for (int i = 0; i < 8; ++i) { ba8[i] = -LOG2E * ba[ch0 + i]; bx8[i] = -LOG2E * bx[ch0 + i]; const float l = lam[ch0 + i]; ls8[i] = -8.f * log1pf(__expf(-l)); }
        const f32x2 nl2 = {-LOG2E, -LOG2E}, one2 = {1.f, 1.f}, l22 = {2.f * LOG2E, 2.f * LOG2E};
#pragma unroll
        for (int ai = 0; ai < 2; ++ai)
#pragma unroll
            for (int m = 0; m < 4; ++m) {
                const int r = ai * 128 + wr * 64 + m * 16 + fr;
                const size_t off = (size_t)(u.row0 + r) * LRU_W + ch0;
                float u8[8]; unpack8(ld16(U + off), u8);
                f32x4 la[2], bi[2];
#pragma unroll
                for (int bj = 0; bj < 2; ++bj)
#pragma unroll
                    for (int jp = 0; jp < 2; ++jp) {
                        const int i = bj * 4 + 2 * jp;
                        const f32x2 a0 = __builtin_elementwise_fma((f32x2){acc[ai][bj][m][0][2 * jp], acc[ai][bj][m][0][2 * jp + 1]}, nl2, (f32x2){ba8[i], ba8[i + 1]});
                        const f32x2 a1 = __builtin_elementwise_fma((f32x2){acc[ai][bj][m][1][2 * jp], acc[ai][bj][m][1][2 * jp + 1]}, nl2, (f32x2){bx8[i], bx8[i + 1]});
                        const f32x2 d0 = (f32x2){__builtin_amdgcn_exp2f(a0[0]), __builtin_amdgcn_exp2f(a0[1])} + one2;
                        const f32x2 d1 = (f32x2){__builtin_amdgcn_exp2f(a1[0]), __builtin_amdgcn_exp2f(a1[1])} + one2;
                        const f32x2 rg = {__builtin_amdgcn_rcpf(d0[0]), __builtin_amdgcn_rcpf(d0[1])}, ig = {__builtin_amdgcn_rcpf(d1[0]), __builtin_amdgcn_rcpf(d1[1])};
                        const f32x2 l = rg * (f32x2){ls8[i], ls8[i + 1]};
                        const f32x2 e2 = l * l22;
                        const f32x2 om = one2 - (f32x2){__builtin_amdgcn_exp2f(e2[0]), __builtin_amdgcn_exp2f(e2[1])};
                        const f32x2 sq = {__builtin_sqrtf(fmaxf(om[0], 0.f)), __builtin_sqrtf(fmaxf(om[1], 0.f))};
                        const f32x2 b = sq * ig * (f32x2){u8[i], u8[i + 1]};
                        la[bj][2 * jp] = l[0]; la[bj][2 * jp + 1] = l[1]; bi[bj][2 * jp] = b[0]; bi[bj][2 * jp + 1] = b[1];
                    }
                est16(LOGA + off, pack8(la[0], la[1]));
                est16(BIN + off, pack8(bi[0], bi[1]));
            }
    }
};

struct EpiNsaIn {
    unsigned char* Q; bf16_t* KC; bf16_t* VC; unsigned char* KS; unsigned char* VST; unsigned char* KW; unsigned char* VWT; float* GATES; const int* pos; const float* bgate; float sc; bool exp_;
    __device__ __forceinline__ void operator()(const acc_t& acc, const GUnit& u, int wr, int wc, int fr, int fq) const {
        const int pn = u.pn;
        if (pn <= 3 || pn == 6 || pn == 8) {
            unsigned char* O = Q + (pn <= 3 ? 0l : (pn == 6 ? (KS - Q) : (KW - Q)));
            const int ldo = pn <= 3 ? 1024 : 256;
            const int colbase = pn <= 3 ? pn * 256 : 0;
            const float scale = (pn <= 3 ? 0.125f * LOG2E * S8_Q : S8_K) * sc;
            float invf[4];
#pragma unroll
            for (int jj = 0; jj < 4; ++jj) invf[jj] = exp2f(-(float)(16 * (wc & 1) + 4 * fq + jj) * (13.287712379549449f / 32.f));
#pragma unroll
            for (int ai = 0; ai < 2; ++ai)
#pragma unroll
                for (int m = 0; m < 4; ++m) {
                    const int row = u.row0 + ai * 128 + wr * 64 + m * 16 + fr;
                    const float p = (float)pos[row];
                    float sn[4], cs[4];
#pragma unroll
                    for (int jj = 0; jj < 4; ++jj) { sincos_rad(p * invf[jj], sn[jj], cs[jj]); sn[jj] *= scale; cs[jj] *= scale; }
#pragma unroll
                    for (int bj = 0; bj < 2; ++bj) {
                        const f32x4 x1 = acc[ai][bj][m][0], x2 = acc[ai][bj][m][1];
                        float o1[4], o2[4];
#pragma unroll
                        for (int jp = 0; jp < 2; ++jp) {
                            const f32x2 a1 = {x1[2 * jp], x1[2 * jp + 1]}, a2 = {x2[2 * jp], x2[2 * jp + 1]}, c2 = {cs[2 * jp], cs[2 * jp + 1]}, s2 = {sn[2 * jp], sn[2 * jp + 1]};
                            const f32x2 r1 = __builtin_elementwise_fma(a1, c2, -(a2 * s2)), r2 = __builtin_elementwise_fma(a1, s2, a2 * c2);
                            o1[2 * jp] = r1[0]; o1[2 * jp + 1] = r1[1]; o2[2 * jp] = r2[0]; o2[2 * jp + 1] = r2[1];
                        }
                        unsigned char* p1 = O + (size_t)row * ldo + colbase + 64 * (2 * bj + (wc >> 1)) + 16 * (wc & 1) + 4 * fq;
                        est4(p1, pack4_fp8(o1[0], o1[1], o1[2], o1[3]));
                        est4(p1 + 32, pack4_fp8(o2[0], o2[1], o2[2], o2[3]));
                    }
                }
        } else if (pn == 4 || pn == 5) {
            bf16_t* O = KC + (pn == 4 ? 0l : (VC - KC));
            const int colb = wc * 32 + fq * 8;
#pragma unroll
            for (int ai = 0; ai < 2; ++ai)
#pragma unroll
                for (int m = 0; m < 4; ++m) {
                    const int row = u.row0 + ai * 128 + wr * 64 + m * 16 + fr;
#pragma unroll
                    for (int bj = 0; bj < 2; ++bj) est16(O + (size_t)row * 256 + colb + bj * 128, pack8(acc[ai][bj][m][0] * sc, acc[ai][bj][m][1] * sc));
                }
        } else if (pn == 7 || pn == 9) {
            unsigned char* O = VST + (pn == 7 ? 0l : (VWT - VST));
#pragma unroll
            for (int ai = 0; ai < 2; ++ai)
#pragma unroll
                for (int m = 0; m < 4; ++m) {
                    const int row = u.row0 + ai * 128 + wr * 64 + m * 16 + fr;
                    const int b = row >> 11, s = vperm32(row & 2047);
#pragma unroll
                    for (int bj = 0; bj < 2; ++bj) {
                        const int g = 2 * bj + (wc >> 1);
                        unsigned char* base = O + ((size_t)(b * 4 + g) * 64 + 32 * (wc & 1) + 8 * fq) * SEQ + s;
#pragma unroll
                        for (int n = 0; n < 2; ++n) { const f32x4 vv = acc[ai][bj][m][n] * sc; const unsigned pk = pack4_fp8(vv[0], vv[1], vv[2], vv[3]);
#pragma unroll
                            for (int jj = 0; jj < 4; ++jj) {
#if defined(EXP_N1_NOVT)
                                if (exp_) { asm volatile("" :: "v"(pk), "v"(base)); continue; }
#endif
                                base[(size_t)(4 * n + jj) * SEQ] = (unsigned char)((pk >> (8 * jj)) & 0xffu); } }
                    }
                }
        } else {
            if (wc < 2 && (wc == 0 || fq < 2)) {
                const int c0 = 32 * wc + 8 * fq;
                f32x4 bg[2];
#pragma unroll
                for (int n = 0; n < 2; ++n) bg[n] = *(const f32x4*)(bgate + c0 + 4 * n);
#pragma unroll
                for (int ai = 0; ai < 2; ++ai)
#pragma unroll
                    for (int m = 0; m < 4; ++m) {
                        const int row = u.row0 + ai * 128 + wr * 64 + m * 16 + fr;
#pragma unroll
                        for (int n = 0; n < 2; ++n) {
                            f32x4 v;
#pragma unroll
                            for (int jj = 0; jj < 4; ++jj) v[jj] = sigmoidf_(acc[ai][0][m][n][jj] * sc + bg[n][jj]);
                            *(f32x4*)(GATES + (size_t)row * 48 + c0 + 4 * n) = v;
                        }
                    }
            }
        }
    }
};
__device__ __forceinline__ int map_plain8(int cc) { const int bj = cc >> 7, wc = (cc >> 5) & 3, n = (cc >> 4) & 1, fq = (cc >> 2) & 3; return 128 * bj + 32 * wc + 8 * fq + 4 * n; }
__device__ __forceinline__ int map_rope(int cc) { const int bj = cc >> 7, wc = (cc >> 5) & 3, n = (cc >> 4) & 1, fq = (cc >> 2) & 3; return 64 * (2 * bj + (wc >> 1)) + 32 * n + 16 * (wc & 1) + 4 * fq; }
__device__ __forceinline__ void map_pair(int cc, int& n, int& ch) { const int bj = cc >> 7, wc = (cc >> 5) & 3, fq = (cc >> 2) & 3; n = (cc >> 4) & 1; ch = 32 * wc + 8 * fq + 4 * bj; }
constexpr f32x4 F4ZERO = {0.f, 0.f, 0.f, 0.f};

struct FetchNsaIn { const float* W;
    __device__ __forceinline__ f32x4 operator()(int, int c4, int k) const { const int pn = c4 >> 8, cc = c4 & 255; const bool rope = (pn <= 3 || pn == 6 || pn == 8);
        const int col = pn * 256 + (rope ? map_rope(cc) : map_plain8(cc)); if (col >= 2608) return F4ZERO; return *(const f32x4*)(W + (size_t)k * 2608 + col); } };
struct FetchPlain { const float* W; int ld; size_t bstride;
    __device__ __forceinline__ f32x4 operator()(int bt, int c4, int k) const { const int col = (c4 & ~255) + map_plain8(c4 & 255); return *(const f32x4*)(W + (size_t)bt * bstride + (size_t)k * ld + col); } };
__device__ __forceinline__ int map_plain16(int cc) { const int bj = cc >> 7, wc = (cc >> 5) & 3, n = (cc >> 4) & 1, fq = (cc >> 2) & 3; return 64 * wc + 16 * fq + 8 * bj + 4 * n; }
struct FetchPlain16 { const float* W; int ld; size_t bstride;
    __device__ __forceinline__ f32x4 operator()(int bt, int c4, int k) const { const int col = (c4 & ~255) + map_plain16(c4 & 255); return *(const f32x4*)(W + (size_t)bt * bstride + (size_t)k * ld + col); } };
struct FetchPair { const float* W0; long d01; int ld; size_t bstride;
    __device__ __forceinline__ f32x4 operator()(int bt, int c4, int k) const { int n, ch; map_pair(c4 & 255, n, ch); ch += (c4 >> 8) * 128; return *(const f32x4*)(W0 + (n ? d01 : 0l) + (long)((size_t)bt * bstride + (size_t)k * ld + ch)); } };
struct FetchScIn { const float* W;
    __device__ __forceinline__ f32x4 operator()(int, int c4, int k) const { const int pn = c4 >> 8, cc = c4 & 255;
        if (pn < 8) { int n, ch; map_pair(cc, n, ch); ch += pn * 128; return *(const f32x4*)(W + (size_t)k * 3072 + (n ? 2048 : 0) + ch); }
        return *(const f32x4*)(W + (size_t)k * 3072 + 1024 + (pn - 8) * 256 + map_plain8(cc)); } };
struct FetchLruGate { const float* wa; long dax;
    __device__ __forceinline__ f32x4 operator()(int, int c4, int k) const { int n, ch; map_pair(c4 & 255, n, ch); ch += (c4 >> 8) * 128; const int h = ch / 80; if (k / 80 != h) return F4ZERO;
        return *(const f32x4*)(wa + (n ? dax : 0l) + (long)(h * 6400 + (k - 80 * h) * 80 + (ch - 80 * h))); } };
struct FetchIdent { const float* W; int ld; size_t bstride;
    __device__ __forceinline__ f32x4 operator()(int bt, int c4, int k) const { return *(const f32x4*)(W + (size_t)bt * bstride + (size_t)k * ld + c4); } };

template <bool OUT8 = false, class F>
__device__ __forceinline__ void convert_wt(LAS unsigned char* lds, void* dstv, int nbatch, int Nd, int K, const F& fetch, const float scale = 1.f, const int boff = 0  ) {
    constexpr int GRP = 8;
    LAS float* tile = (LAS float*)lds;
    const int tid = tid_opaque();
    const int ntk = K / 64, ntc = Nd / 64, per = ntc * ntk, total = per * nbatch;
    const bool split = (Nd & 255) == 0;
    const int c4i = tid & 15, kk = tid >> 4, rr4 = 4 * c4i, row = tid >> 3, k8 = (tid & 7) * 8;
    const int bid = (int)((blockIdx.x + (unsigned)boff) % gridDim.x);
    for (int t0 = bid * GRP; t0 < total; t0 += gridDim.x * GRP) {
        f32x4 v[GRP][2];
#pragma unroll
        for (int gi = 0; gi < GRP; ++gi) {
            const int t = t0 + gi;
            if (t < total) {
                const int bt = t / per, tt = t - bt * per, tc = tt / ntk, tk = tt - tc * ntk, k0 = tk * 64;
                const int cbase = split ? (tc >> 2) * 256 + (tc & 3) * 32 : tc * 64;
                const int crow4 = cbase + (split ? ((rr4 & 31) + (rr4 >> 5) * 128) : rr4);
#pragma unroll
                for (int p = 0; p < 2; ++p) v[gi][p] = fetch(bt, crow4, k0 + kk + 32 * p);
            }
        }
        __syncthreads();
#pragma unroll
        for (int gi = 0; gi < GRP; ++gi)
            if (t0 + gi < total) {
#pragma unroll
                for (int p = 0; p < 2; ++p)
#pragma unroll
                    for (int j = 0; j < 4; ++j) tile[gi * 4160 + (4 * c4i + j) * 65 + kk + 32 * p] = v[gi][p][j];
            }
        __syncthreads();
#pragma unroll
        for (int gi = 0; gi < GRP; ++gi) {
            const int t = t0 + gi;
            if (t < total) {
                const int bt = t / per, tt = t - bt * per, tc = tt / ntk, tk = tt - tc * ntk, k0 = tk * 64;
                const int cbase = split ? (tc >> 2) * 256 + (tc & 3) * 32 : tc * 64;
                const int crow = cbase + (split ? ((row & 31) + (row >> 5) * 128) : row);
                float f[8];
#pragma unroll
                for (int i = 0; i < 8; ++i) f[i] = tile[gi * 4160 + row * 65 + k8 + i];
                if constexpr (OUT8) {
#pragma unroll
                    for (int i = 0; i < 8; ++i) f[i] *= scale;
                    *(u32x2*)((unsigned char*)dstv + ((size_t)bt * Nd + crow) * K + k0 + k8) = pack8_fp8(f);
                } else st16((bf16_t*)dstv + ((size_t)bt * Nd + crow) * K + k0 + k8, (u32x4){cvt_pk_bf16(f[0], f[1]), cvt_pk_bf16(f[2], f[3]), cvt_pk_bf16(f[4], f[5]), cvt_pk_bf16(f[6], f[7])});
            }
        }
    }
    __syncthreads();
}

template <bool X8OUT>
__device__ __forceinline__ void convert_x(const float* x, unsigned char* XA) {
    const size_t n8 = (size_t)T_TOK * DM / 8;
    const int tidx = tid_opaque();
    const size_t step = (size_t)gridDim.x * NTHR;
    size_t i = (size_t)blockIdx.x * NTHR + tidx;
    for (; i + 7 * step < n8; i += 8 * step) {
        f32x4 a[8], b[8];
#pragma unroll
        for (int j = 0; j < 8; ++j) { a[j] = *(const f32x4*)(x + (i + j * step) * 8); b[j] = *(const f32x4*)(x + (i + j * step) * 8 + 4); }
#pragma unroll
        for (int j = 0; j < 8; ++j) {
            if constexpr (X8OUT) { const f32x4 aa = a[j] * S8_X, bb = b[j] * S8_X; const float f[8] = {aa[0], aa[1], aa[2], aa[3], bb[0], bb[1], bb[2], bb[3]}; *(u32x2*)(XA + (i + j * step) * 8) = pack8_fp8(f); }
            else st16((bf16_t*)XA + (i + j * step) * 8, pack8(a[j], b[j]));
        }
    }
    for (; i < n8; i += step) {
        if constexpr (X8OUT) {
            const f32x4 a = *(const f32x4*)(x + i * 8) * S8_X, b = *(const f32x4*)(x + i * 8 + 4) * S8_X;
            const float f[8] = {a[0], a[1], a[2], a[3], b[0], b[1], b[2], b[3]};
            *(u32x2*)(XA + i * 8) = pack8_fp8(f);
        } else { const f32x4 a = *(const f32x4*)(x + i * 8), b = *(const f32x4*)(x + i * 8 + 4); st16((bf16_t*)XA + i * 8, pack8(a, b)); }
    }
}
__device__ __forceinline__ void cmp_bias_phase(LAS unsigned char* lds, const float* pek, const float* w1k, const float* pev, const float* w1v, float* bias1) {
    LAS float* red = (LAS float*)lds;
    const int tidx = tid_opaque();
    for (int blk = (int)((blockIdx.x + 160u) % gridDim.x); blk < 32; blk += gridDim.x) {
        const int v = blk >> 3, j = v >> 1, kv = v & 1, hid = (blk & 7) * 8 + (tidx & 7), part = tidx >> 3;
        const float* pe = pek + (kv ? (pev - pek) : 0l) + j * 2048; const float* w1 = w1k + (kv ? (w1v - w1k) : 0l) + (size_t)j * 2048 * 64;
        float s = 0.f;
#pragma unroll 8
        for (int i = part * 32; i < part * 32 + 32; ++i) s += pe[i] * w1[i * 64 + hid];
        __syncthreads();
        red[part * 8 + (tidx & 7)] = s;
        __syncthreads();
        if (tidx < 8) { float t = 0.f; for (int q = 0; q < 64; ++q) t += red[q * 8 + tidx]; bias1[v * 64 + (blk & 7) * 8 + tidx] = t; }
    }
    __syncthreads();
}

template <bool F32IN>
__device__ __forceinline__ void ln1_router_phase(LAS unsigned char* lds, const void* XRv  , const bf16_t* MBm, bf16_t* XW  , unsigned char* X8, const float* gam, const float* bet,
                                                 const float* rw, const float* rb, int* route_e, float* route_w, int* cnt) {
    LAS f32x4* rwl = (LAS f32x4*)lds;
    LAS int* lcnt = (LAS int*)(lds + 65536);
    const int tid = tid_opaque(), lane = tid & 63, w = tid >> 6;
    const float rbl = rb[lane >> 2];
    __syncthreads();
    for (int i = tid; i < 4096; i += NTHR) { const int col = i >> 2, q = i & 3; const int seg = col >> 9, ln = (col >> 3) & 63, j = col & 7;
        rwl[((q * 2 + seg) * 8 + j) * 64 + ln] = *(const f32x4*)(rw + col * 16 + 4 * q); }
    f32x4 gmr[2][2], btr[2][2];
#pragma unroll
    for (int sg = 0; sg < 2; ++sg) { gmr[sg][0] = *(const f32x4*)(gam + sg * 512 + lane * 8); gmr[sg][1] = *(const f32x4*)(gam + sg * 512 + lane * 8 + 4);
        btr[sg][0] = *(const f32x4*)(bet + sg * 512 + lane * 8); btr[sg][1] = *(const f32x4*)(bet + sg * 512 + lane * 8 + 4); }
    for (int chunk = blockIdx.x; chunk < 256; chunk += gridDim.x) {
        __syncthreads();
        if (tid < 16) lcnt[tid] = 0;
        __syncthreads();
        const size_t row0 = (size_t)chunk * 256 + w * 32;
        const float* XF = (const float*)XRv; const bf16_t* XH = (const bf16_t*)XRv;
        f32x4 nx[2][4]; u32x4 nh[2][2], nm[2][2];
#pragma unroll
        for (int rr = 0; rr < 2; ++rr)
#pragma unroll
            for (int sg = 0; sg < 2; ++sg) {
                if constexpr (F32IN) { nx[rr][sg * 2] = *(const f32x4*)(XF + (row0 + rr) * DM + sg * 512 + lane * 8); nx[rr][sg * 2 + 1] = *(const f32x4*)(XF + (row0 + rr) * DM + sg * 512 + lane * 8 + 4); }
                else nh[rr][sg] = ld16(XH + (row0 + rr) * DM + sg * 512 + lane * 8);
                nm[rr][sg] = ld16(MBm + (row0 + rr) * DM + sg * 512 + lane * 8); }
        for (int i = 0; i < 32; i += 2) {
            f32x2 y2[16];
            {
                float xv[2][16];
#pragma unroll
                for (int rr = 0; rr < 2; ++rr) {
#pragma unroll
                    for (int sg = 0; sg < 2; ++sg) { float mv[8]; unpack8(nm[rr][sg], mv);
                        if constexpr (F32IN) {
#pragma unroll
                            for (int j = 0; j < 4; ++j) { xv[rr][sg * 8 + j] = DN_ALPHA * nx[rr][sg * 2][j] + mv[j]; xv[rr][sg * 8 + 4 + j] = DN_ALPHA * nx[rr][sg * 2 + 1][j] + mv[4 + j]; }
                        } else { float hv[8]; unpack8(nh[rr][sg], hv);
#pragma unroll
                            for (int j = 0; j < 8; ++j) xv[rr][sg * 8 + j] = DN_ALPHA * hv[j] + mv[j]; } }
                }
                if (i + 2 < 32) {
#pragma unroll
                    for (int rr = 0; rr < 2; ++rr)
#pragma unroll
                        for (int sg = 0; sg < 2; ++sg) {
                            if constexpr (F32IN) { nx[rr][sg * 2] = *(const f32x4*)(XF + (row0 + i + 2 + rr) * DM + sg * 512 + lane * 8); nx[rr][sg * 2 + 1] = *(const f32x4*)(XF + (row0 + i + 2 + rr) * DM + sg * 512 + lane * 8 + 4); }
                            else nh[rr][sg] = ld16(XH + (row0 + i + 2 + rr) * DM + sg * 512 + lane * 8);
                            nm[rr][sg] = ld16(MBm + (row0 + i + 2 + rr) * DM + sg * 512 + lane * 8); }
                }
                float mean[2], rstd[2];
#pragma unroll
                for (int rr = 0; rr < 2; ++rr) { float s = 0.f;
#pragma unroll
                    for (int j = 0; j < 16; ++j) s += xv[rr][j];
                    mean[rr] = wave_sum_dpp(s) * (1.f / 1024.f); }
#pragma unroll
                for (int rr = 0; rr < 2; ++rr) { float q = 0.f;
#pragma unroll
                    for (int j = 0; j < 16; ++j) { const float d = xv[rr][j] - mean[rr]; q += d * d; }
                    rstd[rr] = rsqrtf(wave_sum_dpp(q) * (1.f / 1024.f) + LN_EPS); }
#pragma unroll
                for (int sg = 0; sg < 2; ++sg) {
                    const f32x4 ga = gmr[sg][0], gb = gmr[sg][1], ba = btr[sg][0], bb = btr[sg][1];
#pragma unroll
                    for (int rr = 0; rr < 2; ++rr) {
                        f32x4 o0, o1;
#pragma unroll
                        for (int j = 0; j < 4; ++j) { o0[j] = (xv[rr][sg * 8 + j] - mean[rr]) * rstd[rr] * ga[j] + ba[j]; o1[j] = (xv[rr][sg * 8 + 4 + j] - mean[rr]) * rstd[rr] * gb[j] + bb[j];
                            y2[sg * 8 + j][rr] = o0[j]; y2[sg * 8 + 4 + j][rr] = o1[j]; }
                        st16(XW + (row0 + i + rr) * DM + sg * 512 + lane * 8, pack8(o0, o1));
                        { const f32x4 a8 = o0 * S8_X, b8 = o1 * S8_X; const float f8[8] = {a8[0], a8[1], a8[2], a8[3], b8[0], b8[1], b8[2], b8[3]};
                          *(u32x2*)(X8 + (row0 + i + rr) * DM + sg * 512 + lane * 8) = pack8_fp8(f8); }
                    }
                }
            }
            f32x2 lg2[16];
#pragma unroll
            for (int e = 0; e < 16; ++e) lg2[e] = (f32x2){0.f, 0.f};
            f32x4 wc[2][4], wn[2][4];
#pragma unroll
            for (int jj = 0; jj < 2; ++jj)
#pragma unroll
                for (int q = 0; q < 4; ++q) wc[jj][q] = rwl[((q * 2 + 0) * 8 + jj) * 64 + lane];
#pragma unroll
            for (int sgm = 0; sgm < 8; ++sgm) {
                const int sg = sgm >> 2, j2 = sgm & 3;
                __builtin_amdgcn_sched_barrier(0);
                if (sgm + 1 < 8) { const int sgn = (sgm + 1) >> 2, jn = (sgm + 1) & 3;
#pragma unroll
                    for (int jj = 0; jj < 2; ++jj)
#pragma unroll
                        for (int q = 0; q < 4; ++q) wn[jj][q] = rwl[((q * 2 + sgn) * 8 + 2 * jn + jj) * 64 + lane]; }
#pragma unroll
                for (int jj = 0; jj < 2; ++jj)
#pragma unroll
                    for (int q = 0; q < 4; ++q)
#pragma unroll
                        for (int e = 0; e < 4; ++e) lg2[q * 4 + e] += y2[sg * 8 + 2 * j2 + jj] * (f32x2){wc[jj][q][e], wc[jj][q][e]};
                __builtin_amdgcn_sched_barrier(0);
#pragma unroll
                for (int jj = 0; jj < 2; ++jj)
#pragma unroll
                    for (int q = 0; q < 4; ++q) wc[jj][q] = wn[jj][q];
            }
            f32x2 lgf;
            {
                f32x2 r8[8], r4[4], r2[2];
#pragma unroll
                for (int e = 0; e < 8; ++e)
#pragma unroll
                    for (int rr = 0; rr < 2; ++rr) { const auto sw = __builtin_amdgcn_permlane32_swap(__float_as_uint(lg2[e][rr]), __float_as_uint(lg2[e + 8][rr]), false, false);
                        r8[e][rr] = __uint_as_float(sw[0]) + __uint_as_float(sw[1]); }
#pragma unroll
                for (int e = 0; e < 4; ++e)
#pragma unroll
                    for (int rr = 0; rr < 2; ++rr) { const auto sw = __builtin_amdgcn_permlane16_swap(__float_as_uint(r8[e][rr]), __float_as_uint(r8[e + 4][rr]), false, false);
                        r4[e][rr] = __uint_as_float(sw[0]) + __uint_as_float(sw[1]); }
                const bool b3 = (lane & 8) != 0, b2 = (lane & 4) != 0;
#pragma unroll
                for (int e = 0; e < 2; ++e)
#pragma unroll
                    for (int rr = 0; rr < 2; ++rr) { const float kp = b3 ? r4[e + 2][rr] : r4[e][rr], gv = b3 ? r4[e][rr] : r4[e + 2][rr]; r2[e][rr] = kp + dpp_mov<0x128>(gv); }
#pragma unroll
                for (int rr = 0; rr < 2; ++rr) { const float kp = b2 ? r2[1][rr] : r2[0][rr], gv = b2 ? r2[0][rr] : r2[1][rr]; float v = kp + dpp_mov<0x141>(gv);
                    v += dpp_mov<0x4E>(v); v += dpp_mov<0xB1>(v); lgf[rr] = v; }
            }
#pragma unroll
            for (int rr = 0; rr < 2; ++rr) {
                const float scl = 1.f / (1.f + __expf(-lgf[rr])), bil = scl + rbl;
                const float a = bil, b = dpp_mov<0x124>(bil), c = dpp_mov<0x128>(bil), d = dpp_mov<0x12C>(bil);
                const float gsl = fmaxf(fmaxf(fmaxf(a + b, a + c), fmaxf(a + d, b + c)), fmaxf(b + d, c + d));
                float gs[4];
#pragma unroll
                for (int g = 0; g < 4; ++g) gs[g] = __uint_as_float((unsigned)__builtin_amdgcn_readlane((int)__float_as_uint(gsl), 16 * g));
                int bg = 0; float bgs = gs[0];
#pragma unroll
                for (int g = 1; g < 4; ++g) if (gs[g] > bgs) { bgs = gs[g]; bg = g; }
                bg = __builtin_amdgcn_readfirstlane(bg);
                float vb[4], vs[4];
#pragma unroll
                for (int k = 0; k < 4; ++k) { vb[k] = __uint_as_float((unsigned)__builtin_amdgcn_readlane((int)__float_as_uint(bil), 16 * bg + 4 * k)); vs[k] = __uint_as_float((unsigned)__builtin_amdgcn_readlane((int)__float_as_uint(scl), 16 * bg + 4 * k)); }
                int i1 = 0; float b1 = vb[0], s1 = vs[0];
#pragma unroll
                for (int k = 1; k < 4; ++k) if (vb[k] > b1) { b1 = vb[k]; s1 = vs[k]; i1 = k; }
                int i2 = -1; float b2v = -3e38f, s2 = 0.f;
#pragma unroll
                for (int k = 0; k < 4; ++k) if (k != i1 && vb[k] > b2v) { b2v = vb[k]; s2 = vs[k]; i2 = k; }
                const float inv = 1.f / (s1 + s2);
                if (lane == 0) {
                    const size_t row = row0 + i + rr;
                    const int e0 = bg * 4 + i1, e1 = bg * 4 + i2;
                    route_e[row] = e0 | (e1 << 8); route_w[row * 2] = s1 * inv; route_w[row * 2 + 1] = s2 * inv;
                    atomicAdd((int*)&lcnt[e0], 1); atomicAdd((int*)&lcnt[e1], 1);
                }
            }
        }
        __syncthreads();
        if (tid < 16) cnt[chunk * 16 + tid] = lcnt[tid];
    }
    __syncthreads();
}

__device__ __forceinline__ void moe_gather_phase(LAS unsigned char* lds, const int* route_e, const int* cnt, int* pos_out, int* inv, int4* tiles) {
    LAS int* s_tot = (LAS int*)lds; LAS int* s_pre = s_tot + 16; LAS int* s_off = s_pre + 16; LAS int* s_wcnt = s_off + 16; LAS int* s_lpos = s_wcnt + 128;
    const int tid = tid_opaque(), lane = tid & 63, w = tid >> 6;
    for (int chunk = blockIdx.x; chunk < 256; chunk += gridDim.x) {
        __syncthreads();
        { const int e = tid >> 5, j = tid & 31; int tot = 0, pre = 0;
            for (int c = j; c < 256; c += 32) { const int v = cnt[c * 16 + e]; tot += v; pre += (c < chunk) ? v : 0; }
#pragma unroll
            for (int o = 16; o >= 1; o >>= 1) { tot += __shfl_xor(tot, o); pre += __shfl_xor(pre, o); }
            if (j == 0) { s_tot[e] = tot; s_pre[e] = pre; } }
        __syncthreads();
        if (tid == 0) { int off = 0; for (int e = 0; e < 16; ++e) { s_off[e] = off; off += s_tot[e]; } }
        const int token = chunk * 256 + (tid >> 1), slot = tid & 1;
        const int re = route_e[token]; const int e = slot ? ((re >> 8) & 255) : (re & 255);
        int rk = 0;
#pragma unroll
        for (int e2 = 0; e2 < 16; ++e2) { const unsigned long long mk = __ballot(e == e2); if (e == e2) rk = __popcll(mk & ((1ull << lane) - 1ull)); if (lane == 0) s_wcnt[w * 16 + e2] = __popcll(mk); }
        __syncthreads();
        int base = s_off[e] + s_pre[e];
        for (int w2 = 0; w2 < w; ++w2) base += s_wcnt[w2 * 16 + e];
        const int p = base + rk;
        pos_out[token * 2 + slot] = p; inv[p] = token;
        if (chunk == 0 && tid == 0) {
            int nt = 0;
            for (int e2 = 0; e2 < 16; ++e2) { const int n = s_tot[e2]; for (int r = 0; r < n; r += 256) { tiles[1 + nt] = make_int4(e2, s_off[e2] + r, (n - r) < 256 ? (n - r) : 256, 0); ++nt; } }
            tiles[0] = make_int4(nt, 0, 0, 0);
        }
        if (chunk == 0 && tid < 256) inv[2 * T_TOK + tid] = 0;
    }
    __syncthreads();
}

template <bool LAST, bool X8OUT>
__device__ __forceinline__ void ln2_combine_phase(const bf16_t* X1, void* XWv  , const unsigned char* YM, const int* pos, const float* route_w, const float* gam, const float* bet, unsigned char* XO) {
    const int tid = tid_opaque(), lane = tid & 63, w = tid >> 6;
    float gm[16], bt[16];
#pragma unroll
    for (int s = 0; s < 2; ++s)
#pragma unroll
        for (int j = 0; j < 8; ++j) { gm[s * 8 + j] = gam[s * 512 + lane * 8 + j]; bt[s * 8 + j] = bet[s * 512 + lane * 8 + j]; }
    const size_t rstep = (size_t)gridDim.x * 8;
    int np0 = 0, np1 = 0; float nw0 = 0.f, nw1 = 0.f;
    { const size_t r0 = (size_t)blockIdx.x * 8 + w; if (r0 < (size_t)T_TOK) { np0 = pos[r0 * 2]; np1 = pos[r0 * 2 + 1]; nw0 = route_w[r0 * 2]; nw1 = route_w[r0 * 2 + 1]; } }
    for (size_t row = (size_t)blockIdx.x * 8 + w; row < (size_t)T_TOK; row += rstep) {
        const int p0 = np0, p1 = np1; const float w0 = nw0, w1 = nw1;
        { const size_t rn = row + rstep; if (rn < (size_t)T_TOK) { np0 = pos[rn * 2]; np1 = pos[rn * 2 + 1]; nw0 = route_w[rn * 2]; nw1 = route_w[rn * 2 + 1]; } }
        float xv[16], a[16], b[16];
#pragma unroll
        for (int sg = 0; sg < 2; ++sg) unpack8(ld16(X1 + row * DM + sg * 512 + lane * 8), xv + sg * 8);
        unpack8_fp8(*(const u32x2*)(YM + (size_t)p0 * DM + lane * 8), a); unpack8_fp8(*(const u32x2*)(YM + (size_t)p0 * DM + 512 + lane * 8), a + 8);
        unpack8_fp8(*(const u32x2*)(YM + (size_t)p1 * DM + lane * 8), b); unpack8_fp8(*(const u32x2*)(YM + (size_t)p1 * DM + 512 + lane * 8), b + 8);
        float s = 0.f;
#pragma unroll
        for (int j = 0; j < 16; ++j) { xv[j] = DN_ALPHA * xv[j] + (w0 * a[j] + w1 * b[j]) * (1.f / S8_Y); s += xv[j]; }
        const float mean = wave_sum_dpp(s) * (1.f / 1024.f);
        float q = 0.f;
#pragma unroll
        for (int j = 0; j < 16; ++j) { const float d = xv[j] - mean; q += d * d; }
        const float rstd = rsqrtf(wave_sum_dpp(q) * (1.f / 1024.f) + LN_EPS);
        float y[16];
#pragma unroll
        for (int j = 0; j < 16; ++j) y[j] = (xv[j] - mean) * rstd * gm[j] + bt[j];
        if constexpr (LAST) {
            float* outf = (float*)XWv;
            *(f32x4*)(outf + row * DM + lane * 8) = (f32x4){y[0], y[1], y[2], y[3]}; *(f32x4*)(outf + row * DM + lane * 8 + 4) = (f32x4){y[4], y[5], y[6], y[7]};
            *(f32x4*)(outf + row * DM + 512 + lane * 8) = (f32x4){y[8], y[9], y[10], y[11]}; *(f32x4*)(outf + row * DM + 512 + lane * 8 + 4) = (f32x4){y[12], y[13], y[14], y[15]};
        } else {
            bf16_t* xw = (bf16_t*)XWv;
            st16(xw + row * DM + lane * 8, (u32x4){cvt_pk_bf16(y[0], y[1]), cvt_pk_bf16(y[2], y[3]), cvt_pk_bf16(y[4], y[5]), cvt_pk_bf16(y[6], y[7])});
            st16(xw + row * DM + 512 + lane * 8, (u32x4){cvt_pk_bf16(y[8], y[9]), cvt_pk_bf16(y[10], y[11]), cvt_pk_bf16(y[12], y[13]), cvt_pk_bf16(y[14], y[15])});
            if constexpr (X8OUT) {
                float ys[16];
#pragma unroll
                for (int j = 0; j < 16; ++j) ys[j] = y[j] * S8_X;
                *(u32x2*)(XO + row * DM + lane * 8) = pack8_fp8(ys); *(u32x2*)(XO + row * DM + 512 + lane * 8) = pack8_fp8(ys + 8);
            }
        }
    }
}

template <int TAPS, int CW, bool GATE>
__device__ __forceinline__ void conv_phase(LAS unsigned char* lds, const bf16_t* X, const bf16_t* BG, bf16_t* Y, const float* cw, const float* cb) {
    LAS float* wl = (LAS float*)lds;
    const int tidx = tid_opaque();
    __syncthreads();
    for (int i = tidx; i < (TAPS + 1) * CW; i += NTHR) wl[i] = i < TAPS * CW ? cw[i] : cb[i - TAPS * CW];
    __syncthreads();
    constexpr int NCG = CW / 8, HL = TAPS - 1;
    const int items = (T_TOK / 16) * NCG, stride = gridDim.x * NTHR;
    int it = blockIdx.x * NTHR + tidx;
    if (it < items) {
        u32x4 cx[8], cg[8], nx[8], ng[8], hl[HL], nhl[HL];
        int c0 = (it % NCG) * 8; size_t t0 = (size_t)(it / NCG) * 16;
#pragma unroll
        for (int i = 0; i < 8; ++i) { cx[i] = ld16(X + (t0 + i) * CW + c0); if constexpr (GATE) cg[i] = ld16(BG + (t0 + i) * CW + c0); }
#pragma unroll
        for (int k = 0; k < HL; ++k) hl[k] = (t0 & 2047) == 0 ? (u32x4){0u, 0u, 0u, 0u} : ld16(X + (t0 - HL + k) * CW + c0);
        for (;;) {
            float wt[TAPS][8], b8[8], pv[HL][8];
#pragma unroll
            for (int k = 0; k < TAPS; ++k) { const f32x4 a = *(const LAS f32x4*)(wl + k * CW + c0), b = *(const LAS f32x4*)(wl + k * CW + c0 + 4);
#pragma unroll
                for (int j = 0; j < 4; ++j) { wt[k][j] = a[j]; wt[k][4 + j] = b[j]; } }
            { const f32x4 a = *(const LAS f32x4*)(wl + TAPS * CW + c0), b = *(const LAS f32x4*)(wl + TAPS * CW + c0 + 4);
#pragma unroll
                for (int j = 0; j < 4; ++j) { b8[j] = a[j]; b8[4 + j] = b[j]; } }
#pragma unroll
            for (int k = 0; k < HL; ++k) unpack8(hl[k], pv[k]);
            const int nit = it + stride; const bool has_next = nit < items;
            const int nc0 = (nit % NCG) * 8; const size_t nt0 = (size_t)(nit / NCG) * 16;
#pragma unroll
            for (int g = 0; g < 2; ++g) {
                if (g == 0) {
#pragma unroll
                    for (int i = 0; i < 8; ++i) { nx[i] = ld16(X + (t0 + 8 + i) * CW + c0); if constexpr (GATE) ng[i] = ld16(BG + (t0 + 8 + i) * CW + c0); }
                } else if (has_next) {
#pragma unroll
                    for (int i = 0; i < 8; ++i) { nx[i] = ld16(X + (nt0 + i) * CW + nc0); if constexpr (GATE) ng[i] = ld16(BG + (nt0 + i) * CW + nc0); }
#pragma unroll
                    for (int k = 0; k < HL; ++k) nhl[k] = (nt0 & 2047) == 0 ? (u32x4){0u, 0u, 0u, 0u} : ld16(X + (nt0 - HL + k) * CW + nc0);
                }
#pragma unroll
                for (int i = 0; i < 8; ++i) {
                    float cur[8], y[8]; unpack8(cx[i], cur);
#pragma unroll
                    for (int j = 0; j < 8; ++j) { float a = b8[j] + wt[TAPS - 1][j] * cur[j];
#pragma unroll
                        for (int k = 0; k < HL; ++k) a += wt[k][j] * pv[k][j];
                        y[j] = a; }
                    if constexpr (GATE) { float gv[8]; unpack8(cg[i], gv);
#pragma unroll
                        for (int j = 0; j < 8; ++j) y[j] *= gv[j]; }
#pragma unroll
                    for (int j = 0; j < 8; ++j) {
#pragma unroll
                        for (int k = 0; k + 1 < HL; ++k) pv[k][j] = pv[k + 1][j];
                        pv[HL - 1][j] = cur[j]; }
                    st16(Y + (t0 + g * 8 + i) * CW + c0, (u32x4){cvt_pk_bf16(y[0], y[1]), cvt_pk_bf16(y[2], y[3]), cvt_pk_bf16(y[4], y[5]), cvt_pk_bf16(y[6], y[7])});
                }
#pragma unroll
                for (int i = 0; i < 8; ++i) { cx[i] = nx[i]; if constexpr (GATE) cg[i] = ng[i]; }
            }
            if (!has_next) break;
            it = nit; c0 = nc0; t0 = nt0;
#pragma unroll
            for (int k = 0; k < HL; ++k) hl[k] = nhl[k];
        }
    }
}
__device__ __forceinline__ void sc_conv_phase(LAS unsigned char* lds, const bf16_t* P, const bf16_t* BG, bf16_t* Y, const float* cw, const float* cb) { conv_phase<3, 1024, true>(lds, P, BG, Y, cw, cb); }
__device__ __forceinline__ void lru_conv_phase(LAS unsigned char* lds, const bf16_t* REC, bf16_t* U, const float* cw, const float* cb) { conv_phase<4, LRU_W, false>(lds, REC, nullptr, U, cw, cb); }

#define LRU_LD16(dl, db, dg, bs, g) do { _Pragma("unroll") for (int t_ = 0; t_ < 16; ++t_) { const size_t o_ = (bs) + (size_t)((g) * 16 + t_) * LRU_W; \
        dl[t_] = *(const unsigned*)(LOGA + o_); db[t_] = *(const unsigned*)(BIN + o_); if constexpr (P2) dg[t_] = *(const unsigned*)(GG + o_); } } while (0)
template <bool P2>
__device__ __forceinline__ void lru_scan_phase(const bf16_t* LOGA, const bf16_t* BIN, const bf16_t* GG, f32x4* carry, bf16_t* Y) {
    const int tidx = tid_opaque(); const int lane = tidx & 63, w = tidx >> 6;
    const int istep = gridDim.x * 8;
    int it = blockIdx.x * 8 + w;
    if (it >= 10240) return;
    unsigned la[16], bi[16], gg[16], nla[16], nbi[16], ngg[16];
    size_t base; { const int cgp = it % 10, ck = (it / 10) & 31, b = it / 320; base = ((size_t)b * SEQ + ck * 64) * LRU_W + cgp * 128 + lane * 2; }
    LRU_LD16(la, bi, gg, base, 0);
    for (;;) {
        const int cgp = it % 10, ck = (it / 10) & 31, b = it / 320, ch = cgp * 128 + lane * 2;
        float h0 = 0.f, h1 = 0.f, s0 = 0.f, s1 = 0.f;
        if constexpr (P2) {
            for (int c0 = 0; c0 < ck; c0 += 16) {
                f32x4 cv[16];
#pragma unroll
                for (int j = 0; j < 16; ++j) { const int c2 = (c0 + j) < ck ? (c0 + j) : (ck - 1); cv[j] = carry[(((size_t)b * 32 + c2) * LRU_W + ch) >> 1]; }
#pragma unroll
                for (int j = 0; j < 16; ++j) if (c0 + j < ck) { h0 = fast_exp(cv[j][0]) * h0 + cv[j][1]; h1 = fast_exp(cv[j][2]) * h1 + cv[j][3]; }
            }
        }
        const int nit = it + istep; const bool has_next = nit < 10240;
        size_t nbase = base; if (has_next) { const int cgp2 = nit % 10, ck2 = (nit / 10) & 31, b2 = nit / 320; nbase = ((size_t)b2 * SEQ + ck2 * 64) * LRU_W + cgp2 * 128 + lane * 2; }
#pragma unroll
        for (int g = 0; g < 4; ++g) {
            if (g < 3) LRU_LD16(nla, nbi, ngg, base, g + 1); else if (has_next) LRU_LD16(nla, nbi, ngg, nbase, 0);
#pragma unroll
            for (int t = 0; t < 16; ++t) {
                const float l0 = bf_lo(la[t]), l1 = bf_hi(la[t]);
                h0 = fast_exp(l0) * h0 + bf_lo(bi[t]); h1 = fast_exp(l1) * h1 + bf_hi(bi[t]);
                if constexpr (P2) *(unsigned*)(Y + base + (size_t)(g * 16 + t) * LRU_W) = cvt_pk_bf16(bf_lo(gg[t]) * h0, bf_hi(gg[t]) * h1);
                else { s0 += l0; s1 += l1; }
            }
#pragma unroll
            for (int t = 0; t < 16; ++t) { la[t] = nla[t]; bi[t] = nbi[t]; if constexpr (P2) gg[t] = ngg[t]; }
        }
        if constexpr (!P2) carry[(((size_t)b * 32 + ck) * LRU_W + ch) >> 1] = (f32x4){s0, h0, s1, h1};
        if (!has_next) break;
        it = nit; base = nbase;
    }
}
#undef LRU_LD16
__device__ __forceinline__ void lru_scan1_phase(const bf16_t* LOGA, const bf16_t* BIN, f32x4* carry) { lru_scan_phase<false>(LOGA, BIN, nullptr, carry, nullptr); }
__device__ __forceinline__ void lru_scan2_phase(const bf16_t* LOGA, const bf16_t* BIN, const bf16_t* GG, const f32x4* carry, bf16_t* Y) { lru_scan_phase<true>(LOGA, BIN, GG, (f32x4*)carry, Y); }
__device__ __forceinline__ bf16x8 pack8s(const float* f) {
    const unsigned a = cvt_pk_bf16(f[0], f[1]), b = cvt_pk_bf16(f[2], f[3]), c = cvt_pk_bf16(f[4], f[5]), d = cvt_pk_bf16(f[6], f[7]);
    u32x4 v = {a, b, c, d}; return __builtin_bit_cast(bf16x8, v);
}
__device__ __forceinline__ void nsa_compress_phase(LAS unsigned char* lds, const bf16_t* KC, const bf16_t* VC, const bf16_t* W1T, const float* w2k, const float* w2v, const float* bias1,
                                                   const int* pos, unsigned char* KCMP, unsigned char* VCMPT) {
    constexpr int WROW = 528, WBUF = 64 * WROW;
    const int tidx = tid_opaque(); const int lane = tidx & 63, w = tidx >> 6, rowi = lane & 15, gq = lane >> 4;
    const int srow = tidx >> 3, spc = tidx & 7;
    for (int tb = blockIdx.x; tb < 256; tb += gridDim.x) {
        const int task = tb * 8 + w;
        const int kv = task >> 10, tt = task & 1023, rho = tt * 16 + rowi, b = rho >> 9, n = (rho >> 2) & 127, g = rho & 3;
        const bf16_t* src = KC + (kv ? (VC - KC) : 0l) + (size_t)b * SEQ * 256 + g * 64 + 8 * gq;
        const bf16_t* wsrc = W1T + (size_t)kv * 64 * 2048 + (size_t)srow * 2048 + spc * 8;
        f32x4 hacc[4];
#pragma unroll
        for (int ht = 0; ht < 4; ++ht) hacc[ht] = (f32x4){0.f, 0.f, 0.f, 0.f};
        u32x4 wr[4];
        __syncthreads();
#pragma unroll
        for (int i = 0; i < 4; ++i) wr[i] = ld16(wsrc + i * 64);
#pragma unroll
        for (int i = 0; i < 4; ++i) *(LAS u32x4*)(lds + srow * WROW + (spc + 8 * i) * 16) = wr[i];
        __syncthreads();
        for (int sl = 0; sl < 8; ++sl) {
            const int buf = sl & 1;
            if (sl < 7) {
#pragma unroll
                for (int i = 0; i < 4; ++i) wr[i] = ld16(wsrc + (sl + 1) * 256 + i * 64);
            }
            bf16x8 af[8];
#pragma unroll
            for (int k8 = 0; k8 < 8; ++k8) { const int kk = sl * 8 + k8; int tok = 16 * n + (kk >> 1); tok = tok > 2047 ? 2047 : tok;
                af[k8] = *(const bf16x8*)(src + (size_t)tok * 256 + 32 * (kk & 1)); }
#pragma unroll
            for (int k8 = 0; k8 < 8; ++k8)
#pragma unroll
                for (int ht = 0; ht < 4; ++ht) { const bf16x8 wf = *(const LAS bf16x8*)(lds + buf * WBUF + (16 * ht + rowi) * WROW + k8 * 64 + gq * 16);
                    hacc[ht] = __builtin_amdgcn_mfma_f32_16x16x32_bf16(wf, af[k8], hacc[ht], 0, 0, 0); }
            if (sl < 7) {
#pragma unroll
                for (int i = 0; i < 4; ++i) *(LAS u32x4*)(lds + (buf ^ 1) * WBUF + srow * WROW + (spc + 8 * i) * 16) = wr[i];
            }
            __syncthreads();
        }
        bf16x8 pf[2];
#pragma unroll
        for (int p = 0; p < 2; ++p) { float hv[8];
#pragma unroll
            for (int jj = 0; jj < 4; ++jj) { hv[jj] = gelu_tanh(hacc[2 * p][jj] + bias1[kv * 64 + 32 * p + 4 * gq + jj]); hv[4 + jj] = gelu_tanh(hacc[2 * p + 1][jj] + bias1[kv * 64 + 32 * p + 16 + 4 * gq + jj]); }
            pf[p] = pack8s(hv); }
        const float* w2 = w2k + (kv ? (w2v - w2k) : 0l);
        f32x4 oacc[4];
#pragma unroll
        for (int dt = 0; dt < 4; ++dt) { oacc[dt] = (f32x4){0.f, 0.f, 0.f, 0.f};
#pragma unroll
            for (int p = 0; p < 2; ++p) { float wv[8]; const int dout = 16 * dt + rowi;
#pragma unroll
                for (int i = 0; i < 4; ++i) { wv[i] = w2[(32 * p + 4 * gq + i) * 64 + dout]; wv[4 + i] = w2[(32 * p + 16 + 4 * gq + i) * 64 + dout]; }
                oacc[dt] = __builtin_amdgcn_mfma_f32_16x16x32_bf16(pack8s(wv), pf[p], oacc[dt], 0, 0, 0); } }
        const bool padrow = (n == 127);
        if (kv == 0) {
            int pidx = 16 * n + 31; pidx = pidx > 2047 ? 2047 : pidx;
            const float pp = (float)pos[b * SEQ + pidx];
            unsigned char* dst = KCMP + ((size_t)(b * 128 + n) * 4 + g) * 64;
#pragma unroll
            for (int dt = 0; dt < 2; ++dt) { float o1[4], o2[4];
#pragma unroll
                for (int jj = 0; jj < 4; ++jj) { const float inv = exp2f(-(float)(16 * dt + 4 * gq + jj) * (13.287712379549449f / 32.f)); float sn, cs; sincos_rad(pp * inv, sn, cs);
                    const float x1 = oacc[dt][jj], x2 = oacc[dt + 2][jj]; o1[jj] = padrow ? 0.f : (x1 * cs - x2 * sn) * S8_K; o2[jj] = padrow ? 0.f : (x1 * sn + x2 * cs) * S8_K; }
                *(unsigned*)(dst + 16 * dt + 4 * gq) = pack4_fp8(o1[0], o1[1], o1[2], o1[3]);
                *(unsigned*)(dst + 32 + 16 * dt + 4 * gq) = pack4_fp8(o2[0], o2[1], o2[2], o2[3]); }
        } else {
            unsigned char* dst = VCMPT + ((size_t)(b * 4 + g) * 64) * 128 + vperm32(n);
#pragma unroll
            for (int dt = 0; dt < 4; ++dt) { const unsigned pk = pack4_fp8(oacc[dt][0], oacc[dt][1], oacc[dt][2], oacc[dt][3]);
#pragma unroll
                for (int jj = 0; jj < 4; ++jj) dst[(size_t)(16 * dt + 4 * gq + jj) * 128] = padrow ? (unsigned char)0 : (unsigned char)((pk >> (8 * jj)) & 0xffu); }
        }
    }
}

struct AttnArgs { const unsigned char* Q; const unsigned char* KS; const unsigned char* VST; const unsigned char* KW; const unsigned char* VWT; const unsigned char* KCMP; const unsigned char* VCMPT; const float* GATES; unsigned char* O; int exp_; };
constexpr int AL_KC = 0, AL_VC = 10240, AL_KB = 19456, AL_VB = 29696, AL_PS = 39936, AL_IMP = 56320, AL_SEL = 60416, AL_OT = 60544, AL_VR = 126080;
typedef long fp8x8;
__device__ __forceinline__ unsigned pk4p(float a, float b, float c, float d) { unsigned r = 0u; r = __builtin_amdgcn_cvt_pk_fp8_f32(a, b, r, false); r = __builtin_amdgcn_cvt_pk_fp8_f32(c, d, r, true); return r; }
__device__ __forceinline__ fp8x8 mk8(unsigned lo, unsigned hi) { return (fp8x8)(((unsigned long long)hi << 32) | (unsigned long long)lo); }
constexpr float ATT_THR = 8.f;

__device__ __forceinline__ float max16(const f32x4 (&a)[4]) {
    float m0 = fmaxf(fmaxf(a[0][0], a[0][1]), a[0][2]), m1 = fmaxf(fmaxf(a[0][3], a[1][0]), a[1][1]), m2 = fmaxf(fmaxf(a[1][2], a[1][3]), a[2][0]);
    float m3 = fmaxf(fmaxf(a[2][1], a[2][2]), a[2][3]), m4 = fmaxf(fmaxf(a[3][0], a[3][1]), a[3][2]);
    return fmaxf(fmaxf(fmaxf(m0, m1), fmaxf(m2, m3)), fmaxf(m4, a[3][3]));
}

template <int MODE>
__device__ __forceinline__ void attn_branch(LAS unsigned char* lds, const unsigned char* Kg, const unsigned char* Vg, const int kb_lo, const int kb_hi, const bool first_staged,
                                            const fp8x8 (&qf)[2][2], const int (&sq)[2], const unsigned (&selm)[2], const float* const (&gatep)[2], LAS f32x4* otl  ,
                                            const int n, const int gq, const int tid) {
    const bool isv = tid >= 256; const int st = tid & 255, srow = st >> 2, spc = st & 3;
    const unsigned char* sgp = isv ? Vg + (size_t)srow * SEQ + spc * 16 : Kg + (size_t)srow * 256 + spc * 16;
    const size_t sstep = isv ? (size_t)64 : (size_t)64 * 256;
    const int soff = (isv ? AL_VR : AL_KB) + srow * 80 + spc * 16;
    u32x4 sr;
    if (!first_staged) {
        sr = ld16(sgp + (size_t)kb_lo * sstep);
        *(LAS u32x4*)(lds + soff) = sr;
        __syncthreads();
    }
    typedef unsigned u32x2_t __attribute__((ext_vector_type(2)));
    fp8x8 pfA[2][2]; bool pend = false; int vi = 0, vp = 0;
#define ATT_PV128(vX, PX, vY, PY, HASY) do { _Pragma("unroll") for (int dt = 0; dt < 4; ++dt) { \
        const u32x2_t a0 = *(const LAS u32x2_t*)((vX) + (16 * dt + n) * 80 + 8 * gq), a1 = *(const LAS u32x2_t*)((vX) + (16 * dt + n) * 80 + 32 + 8 * gq); \
        u32x2_t b0 = {0u, 0u}, b1 = {0u, 0u}; if (HASY) { b0 = *(const LAS u32x2_t*)((vY) + (16 * dt + n) * 80 + 8 * gq); b1 = *(const LAS u32x2_t*)((vY) + (16 * dt + n) * 80 + 32 + 8 * gq); } \
        const i32x8 va = {(int)a0[0], (int)a0[1], (int)a1[0], (int)a1[1], (int)b0[0], (int)b0[1], (int)b1[0], (int)b1[1]}; \
        _Pragma("unroll") for (int ti = 0; ti < 2; ++ti) { \
            const unsigned long long x0 = (unsigned long long)PX[ti][0], x1 = (unsigned long long)PX[ti][1], y0 = (HASY) ? (unsigned long long)PY[ti][0] : 0ull, y1 = (HASY) ? (unsigned long long)PY[ti][1] : 0ull; \
            const i32x8 vb = {(int)(unsigned)x0, (int)(unsigned)(x0 >> 32), (int)(unsigned)x1, (int)(unsigned)(x1 >> 32), (int)(unsigned)y0, (int)(unsigned)(y0 >> 32), (int)(unsigned)y1, (int)(unsigned)(y1 >> 32)}; \
            oacc[ti][dt] = __builtin_amdgcn_mfma_scale_f32_16x16x128_f8f6f4(va, vb, oacc[ti][dt], 0, 0, 0, 0, 0, 0); } } } while (0)
    float m_run[2] = {0.f, 0.f}, l_run[2] = {0.f, 0.f};
    const float gate[2] = {gatep[0][MODE + 1], gatep[1][MODE + 1]};
    f32x4 oacc[2][4];
#pragma unroll
    for (int ti = 0; ti < 2; ++ti)
#pragma unroll
        for (int dt = 0; dt < 4; ++dt) oacc[ti][dt] = (f32x4){0.f, 0.f, 0.f, 0.f};
    for (int kb = kb_lo; kb <= kb_hi; ++kb) {
        const int buf = (kb - kb_lo) & 1;
        if (kb < kb_hi) sr = ld16(sgp + (size_t)(kb + 1) * sstep);
        const LAS unsigned char* kbuf = lds + AL_KB + buf * 5120; const LAS unsigned char* vbuf = lds + AL_VR + vi * 5120; const LAS unsigned char* vprev = lds + AL_VR + vp * 5120;
        const int vn = vi == 2 ? 0 : vi + 1;
        f32x4 sacc[2][4];
        bool selb[2];
#pragma unroll
        for (int ti = 0; ti < 2; ++ti) selb[ti] = MODE == 0 ? (((selm[ti] >> kb) & 1u) != 0u) : true;
#pragma unroll
        for (int kt = 0; kt < 4; ++kt) {
            const fp8x8 k0 = *(const LAS fp8x8*)(kbuf + (16 * kt + n) * 80 + gq * 8), k1 = *(const LAS fp8x8*)(kbuf + (16 * kt + n) * 80 + 32 + gq * 8);
#pragma unroll
            for (int ti = 0; ti < 2; ++ti) {
                sacc[ti][kt] = __builtin_amdgcn_mfma_f32_16x16x32_fp8_fp8(k0, qf[ti][0], (f32x4){0.f, 0.f, 0.f, 0.f}, 0, 0, 0);
                sacc[ti][kt] = __builtin_amdgcn_mfma_f32_16x16x32_fp8_fp8(k1, qf[ti][1], sacc[ti][kt], 0, 0, 0);
            }
        }
        const bool need_mask = (kb == kb_hi) || (MODE == 1 && kb == kb_lo);
        if (need_mask) {
#pragma unroll
            for (int ti = 0; ti < 2; ++ti) {
                const int rel = sq[ti] - kb * 64 - 4 * gq;
#pragma unroll
                for (int kt = 0; kt < 4; ++kt)
#pragma unroll
                    for (int jj = 0; jj < 4; ++jj) { const int tt = 16 * kt + jj; const bool v = MODE == 0 ? (tt <= rel) : (tt <= rel && tt > rel - 512); sacc[ti][kt][jj] = v ? sacc[ti][kt][jj] : NEGBIG; }
            }
        }
        float mx[2];
#pragma unroll
        for (int ti = 0; ti < 2; ++ti) { mx[ti] = max16(sacc[ti]) - m_run[ti]; mx[ti] = selb[ti] ? mx[ti] : NEGBIG; }
        const bool slow = (mx[0] > ATT_THR) || (mx[1] > ATT_THR) || (l_run[0] == 0.f && mx[0] > -1e29f && mx[0] < -ATT_THR) || (l_run[1] == 0.f && mx[1] > -1e29f && mx[1] < -ATT_THR);
        if (__any(slow)) {
            if (pend) { ATT_PV128(vprev, pfA, vprev, pfA, false); pend = false; }
#pragma unroll
            for (int ti = 0; ti < 2; ++ti) {
                float mr = fmaxf(mx[ti], __shfl_xor(mx[ti], 16)); mr = fmaxf(mr, __shfl_xor(mr, 32));
                float lr = l_run[ti] + __shfl_xor(l_run[ti], 16); lr += __shfl_xor(lr, 32);
                const bool has = mr > -1e29f;
                const float delta = !has ? 0.f : (lr == 0.f ? mr : fmaxf(mr, 0.f));
                const float alpha = lr == 0.f ? 1.f : fast_exp2(-delta);
                l_run[ti] *= alpha; m_run[ti] += delta;
#pragma unroll
                for (int dt = 0; dt < 4; ++dt) oacc[ti][dt] *= alpha;
            }
        }
        if (__any(m_run[0] != 0.f || m_run[1] != 0.f)) {
#pragma unroll
            for (int ti = 0; ti < 2; ++ti)
#pragma unroll
                for (int kt = 0; kt < 4; ++kt) sacc[ti][kt] -= m_run[ti];
        }
        fp8x8 pf[2][2];
#pragma unroll
        for (int ti = 0; ti < 2; ++ti) {
            float ps = 0.f;
#pragma unroll
            for (int kt = 0; kt < 4; ++kt)
#pragma unroll
                for (int jj = 0; jj < 4; ++jj) { const float e = fast_exp2(sacc[ti][kt][jj]); sacc[ti][kt][jj] = e; ps += e; }
            l_run[ti] += selb[ti] ? ps : 0.f;
#pragma unroll
            for (int p = 0; p < 2; ++p) { unsigned lo = pk4p(sacc[ti][2 * p][0], sacc[ti][2 * p][1], sacc[ti][2 * p][2], sacc[ti][2 * p][3]), hi = pk4p(sacc[ti][2 * p + 1][0], sacc[ti][2 * p + 1][1], sacc[ti][2 * p + 1][2], sacc[ti][2 * p + 1][3]);
                if (MODE == 0) { lo = selb[ti] ? lo : 0u; hi = selb[ti] ? hi : 0u; }
                pf[ti][p] = mk8(lo, hi); }
        }
        if (pend) { ATT_PV128(vprev, pfA, vbuf, pf, true); pend = false; }
        else if (kb == kb_hi) { ATT_PV128(vbuf, pf, vbuf, pf, false); }
        else {
#pragma unroll
            for (int ti = 0; ti < 2; ++ti) { pfA[ti][0] = pf[ti][0]; pfA[ti][1] = pf[ti][1]; }
            pend = true;
        }
        if (kb < kb_hi) *(LAS u32x4*)(lds + (isv ? vn * 5120 : (buf ^ 1) * 5120) + soff) = sr;
        __syncthreads();
        vp = vi; vi = vn;
    }
#undef ATT_PV128
#pragma unroll
    for (int ti = 0; ti < 2; ++ti) {
        float lt = l_run[ti] + __shfl_xor(l_run[ti], 16); lt += __shfl_xor(lt, 32);
        const float inv = lt > 0.f ? gate[ti] / lt : 0.f;
#pragma unroll
        for (int dt = 0; dt < 4; ++dt) otl[(ti * 4 + dt) * 64] += oacc[ti][dt] * inv;
    }
}

__device__ __forceinline__ unsigned attn_cmp_tile(LAS unsigned char* lds, const fp8x8 qf0, const fp8x8 qf1, const int s, const int sbase  , const float g0,
                                                  LAS f32x4* otl  , const int lane, const int w, const int n, const int gq, const int tl, const int r) {
    f32x4 sacc[8];
#pragma unroll
    for (int kt = 0; kt < 8; ++kt) {
        const fp8x8 k0 = *(const LAS fp8x8*)(lds + AL_KC + (16 * kt + n) * 80 + gq * 8), k1 = *(const LAS fp8x8*)(lds + AL_KC + (16 * kt + n) * 80 + 32 + gq * 8);
        sacc[kt] = __builtin_amdgcn_mfma_f32_16x16x32_fp8_fp8(k0, qf0, (f32x4){0.f, 0.f, 0.f, 0.f}, 0, 0, 0);
        sacc[kt] = __builtin_amdgcn_mfma_f32_16x16x32_fp8_fp8(k1, qf1, sacc[kt], 0, 0, 0);
    }
    float mx = NEGBIG;
    const int lim = ((s - 31) >> 4) - 4 * gq;
#pragma unroll
    for (int kt = 0; kt < 8; ++kt)
#pragma unroll
        for (int jj = 0; jj < 4; ++jj) { const bool v = (16 * kt + jj <= lim); sacc[kt][jj] = v ? sacc[kt][jj] : NEGBIG; mx = fmaxf(mx, sacc[kt][jj]); }
    mx = fmaxf(mx, __shfl_xor(mx, 16)); mx = fmaxf(mx, __shfl_xor(mx, 32));
    mx = fmaxf(mx, -1e20f);
    float ps = 0.f;
#pragma unroll
    for (int kt = 0; kt < 8; ++kt)
#pragma unroll
        for (int jj = 0; jj < 4; ++jj) { const float e = fast_exp2(sacc[kt][jj] - mx); sacc[kt][jj] = e; ps += e; }
    ps += __shfl_xor(ps, 16); ps += __shfl_xor(ps, 32);
    const float inv = ps > 0.f ? 1.f / ps : 0.f;
#pragma unroll
    for (int kt = 0; kt < 8; ++kt) {
        f32x4 pp;
#pragma unroll
        for (int jj = 0; jj < 4; ++jj) { sacc[kt][jj] *= inv; float t = sacc[kt][jj]; t += dpp_mov<0xB1>(t); t += dpp_mov<0x4E>(t); pp[jj] = t; }
        if (r == 0) *(LAS f32x4*)(lds + AL_PS + ((w * 4 + tl) * 128 + 16 * kt + 4 * gq) * 4) = pp;
    }
    f32x4 otot[4];
#pragma unroll
    for (int dt = 0; dt < 4; ++dt) otot[dt] = (f32x4){0.f, 0.f, 0.f, 0.f};
#pragma unroll
    for (int p = 0; p < 4; ++p) {
        const fp8x8 pf = mk8(pk4p(sacc[2 * p][0], sacc[2 * p][1], sacc[2 * p][2], sacc[2 * p][3]), pk4p(sacc[2 * p + 1][0], sacc[2 * p + 1][1], sacc[2 * p + 1][2], sacc[2 * p + 1][3]));
#pragma unroll
        for (int dt = 0; dt < 4; ++dt) {
            const fp8x8 vf = *(const LAS fp8x8*)(lds + AL_VC + (16 * dt + n) * 144 + 32 * p + 8 * gq);
            otot[dt] = __builtin_amdgcn_mfma_f32_16x16x32_fp8_fp8(vf, pf, otot[dt], 0, 0, 0);
        }
    }
#pragma unroll
    for (int dt = 0; dt < 4; ++dt) otl[dt * 64] = otot[dt] * g0;
    asm volatile("s_waitcnt lgkmcnt(0)" ::: "memory");
    __builtin_amdgcn_wave_barrier();
    const int tl2 = lane >> 4, q = lane & 15, s2 = sbase + tl2, blkq = s2 >> 6;
    const LAS float* psr = (const LAS float*)(lds + AL_PS + ((w * 4 + tl2) * 128) * 4);
    const f32x4 xa = *(const LAS f32x4*)(psr + 8 * q), xb = *(const LAS f32x4*)(psr + 8 * q + 4);
    const float prev = q > 0 ? psr[8 * q - 1] : 0.f;
    float a0 = prev + xa[0] + xa[1] + xa[2] + xa[3], a1 = xa[3] + xb[0] + xb[1] + xb[2] + xb[3];
    const int m0 = 2 * q, m1 = 2 * q + 1;
    { const int rel0 = blkq - m0, rel1 = blkq - m1;
        if (rel0 < 0) a0 = -1.f;
        if (rel1 < 0) a1 = -1.f;
        if (m0 == 0 || rel0 == 0 || rel0 == 1) a0 = 1e6f;
        if (rel1 == 0 || rel1 == 1) a1 = 1e6f; }
    const unsigned key0 = a0 < 0.f ? 0u : ((__float_as_uint(a0) & ~31u) | (unsigned)(31 - m0)) + 64u, key1 = a1 < 0.f ? 0u : ((__float_as_uint(a1) & ~31u) | (unsigned)(31 - m1)) + 64u;
    LAS unsigned* impw = (LAS unsigned*)(lds + AL_IMP + ((w * 4 + tl2) * 32) * 4);
    *(LAS u32x2*)(impw + 2 * q) = (u32x2){key0, key1};
    asm volatile("s_waitcnt lgkmcnt(0)" ::: "memory");
    __builtin_amdgcn_wave_barrier();
    int rk0 = 0, rk1 = 0;
#pragma unroll
    for (int i4 = 0; i4 < 8; ++i4) { const u32x4 v = *(const LAS u32x4*)(impw + 4 * i4);
#pragma unroll
        for (int j = 0; j < 4; ++j) { rk0 += v[j] > key0 ? 1 : 0; rk1 += v[j] > key1 ? 1 : 0; } }
    unsigned bits = (rk0 < 16 ? (1u << m0) : 0u) | (rk1 < 16 ? (1u << m1) : 0u);
    bits |= dpp_movu<0xB1>(bits); bits |= dpp_movu<0x4E>(bits); bits |= dpp_movu<0x141>(bits); bits |= dpp_movu<0x140>(bits);
    LAS unsigned* selw = (LAS unsigned*)(lds + AL_SEL + (w * 4) * 4);
    if (q == 0) selw[tl2] = bits;
    asm volatile("s_waitcnt lgkmcnt(0)" ::: "memory");
    __builtin_amdgcn_wave_barrier();
    const unsigned selm = selw[tl];
    asm volatile("s_waitcnt lgkmcnt(0)" ::: "memory");
    __builtin_amdgcn_wave_barrier();
    return selm;
}

__device__ __forceinline__ void nsa_attn_phase(LAS unsigned char* lds, const AttnArgs& A) {
    const int tid0 = tid_opaque();
    u32x4 pfk, pfv, pfs; fp8x8 nqf[2][2]; bool havepf = false;
    for (int u = blockIdx.x; u < 4096; u += gridDim.x) {
        int tid = tid0; asm volatile("" : "+v"(tid));
        const int lane = tid & 63, w = tid >> 6, n = lane & 15, gq = lane >> 4, tl = n >> 2, r = n & 3;
        const int kq = u >> 8, c = 2 * kq + ((((u >> 7) & 1) ^ kq) & 1), bgi = u & 127, b = bgi >> 2, g = bgi & 3, s0 = c * 64;
        int sq[2]; fp8x8 qf[2][2]; const float* gp[2];
#pragma unroll
        for (int ti = 0; ti < 2; ++ti) {
            sq[ti] = s0 + 8 * w + 4 * ti + tl;
            const size_t qrow = (size_t)b * SEQ + sq[ti];
            const unsigned char* qp = A.Q + qrow * 1024 + g * 256 + r * 64 + 8 * gq;
            if (havepf) { qf[ti][0] = nqf[ti][0]; qf[ti][1] = nqf[ti][1]; }
            else { qf[ti][0] = *(const fp8x8*)qp; qf[ti][1] = *(const fp8x8*)(qp + 32); }
            gp[ti] = A.GATES + qrow * 48 + (g * 4 + r) * 3;
        }
        const unsigned char* KSg = A.KS + (size_t)b * SEQ * 256 + g * 64; const unsigned char* VSg = A.VST + (size_t)(b * 4 + g) * 64 * SEQ;
        const unsigned char* KWg = A.KW + (size_t)b * SEQ * 256 + g * 64; const unsigned char* VWg = A.VWT + (size_t)(b * 4 + g) * 64 * SEQ;
        __syncthreads();
        if (!havepf) {
            { const int key = tid >> 2, pc = tid & 3; pfk = ld16(A.KCMP + ((size_t)(b * 128 + key) * 4 + g) * 64 + pc * 16); }
            { const int d = tid >> 3, pc = tid & 7; pfv = ld16(A.VCMPT + ((size_t)(b * 4 + g) * 64 + d) * 128 + pc * 16); }
            { const bool isv = tid >= 256; const int st = tid & 255, srow = st >> 2, spc = st & 3; pfs = ld16(isv ? VSg + (size_t)srow * SEQ + spc * 16 : KSg + (size_t)srow * 256 + spc * 16); }
        }
        { const int key = tid >> 2, pc = tid & 3; *(LAS u32x4*)(lds + AL_KC + key * 80 + pc * 16) = pfk; }
        { const int d = tid >> 3, pc = tid & 7; *(LAS u32x4*)(lds + AL_VC + d * 144 + pc * 16) = pfv; }
        { const bool isv = tid >= 256; const int st = tid & 255, srow = st >> 2, spc = st & 3; *(LAS u32x4*)(lds + (isv ? AL_VR : AL_KB) + srow * 80 + spc * 16) = pfs; }
        __syncthreads();
        LAS f32x4* otl = (LAS f32x4*)(lds + AL_OT) + w * 512 + lane;
        unsigned selm[2];
#pragma unroll
        for (int ti = 0; ti < 2; ++ti) { selm[ti] = attn_cmp_tile(lds, qf[ti][0], qf[ti][1], sq[ti], s0 + 8 * w + 4 * ti, gp[ti][0], otl + ti * 256, lane, w, n, gq, tl, r); }
#if defined(EXP_ATT_NOSEL)
        if (!A.exp_)
#endif
        attn_branch<0>(lds, KSg, VSg, 0, c, true, qf, sq, selm, gp, otl, n, gq, tid);
        { const int un = u + gridDim.x; havepf = un < 4096;
            if (havepf) { const int bgn = un & 127, bn = bgn >> 2, gn = bgn & 3;
                { const int kqn = un >> 8, cn = 2 * kqn + ((((un >> 7) & 1) ^ kqn) & 1);
#pragma unroll
                    for (int ti = 0; ti < 2; ++ti) { const unsigned char* qp = A.Q + ((size_t)bn * SEQ + cn * 64 + 8 * w + 4 * ti + tl) * 1024 + gn * 256 + r * 64 + 8 * gq;
                        nqf[ti][0] = *(const fp8x8*)qp; nqf[ti][1] = *(const fp8x8*)(qp + 32); } }
                { const int key = tid >> 2, pc = tid & 3; pfk = ld16(A.KCMP + ((size_t)(bn * 128 + key) * 4 + gn) * 64 + pc * 16); }
                { const int d = tid >> 3, pc = tid & 7; pfv = ld16(A.VCMPT + ((size_t)(bn * 4 + gn) * 64 + d) * 128 + pc * 16); }
                { const bool isv = tid >= 256; const int st = tid & 255, srow = st >> 2, spc = st & 3;
                    pfs = ld16(isv ? A.VST + (size_t)(bn * 4 + gn) * 64 * SEQ + (size_t)srow * SEQ + spc * 16 : A.KS + (size_t)bn * SEQ * 256 + gn * 64 + (size_t)srow * 256 + spc * 16); } } }
#if defined(EXP_ATT_NOWIN)
        if (!A.exp_)
#endif
        attn_branch<1>(lds, KWg, VWg, c >= 8 ? c - 8 : 0, c, false, qf, sq, selm, gp, otl, n, gq, tid);
#pragma unroll
        for (int ti = 0; ti < 2; ++ti) {
            unsigned char* op = A.O + ((size_t)b * SEQ + sq[ti]) * 1024 + g * 256 + r * 64 + 4 * gq;
#pragma unroll
            for (int dt = 0; dt < 4; ++dt) { const f32x4 o = otl[(ti * 4 + dt) * 64] * S8_O; unsigned pk = 0u;
                pk = __builtin_amdgcn_cvt_pk_fp8_f32(clamp8(o[0]), clamp8(o[1]), pk, false); pk = __builtin_amdgcn_cvt_pk_fp8_f32(clamp8(o[2]), clamp8(o[3]), pk, true);
                *(unsigned*)(op + 16 * dt) = pk; }
        }
    }
    __syncthreads();
}
#ifndef DBG_ZERO_KIND
#define DBG_ZERO_KIND -1
#endif
#ifndef F8IN_MASK
#define F8IN_MASK 7
#endif
struct Params { const float* in[31]; float* out; unsigned char* ws; int ph_lo, ph_hi; };
constexpr int N_PHASES = 38;

#ifndef DUP_MASK
#define DUP_MASK 0ull
#endif
#define PH_BEGIN(k) if ((k) >= p.ph_lo && (k) < p.ph_hi) { for (int rep_ = 0; rep_ < (((DUP_MASK >> (k)) & 1ull) ? 2 : 1); ++rep_) {
#define PH_END(k) } if ((k) + 1 < p.ph_hi) xcd_barrier<(int)((WAIT_MASK >> (k)) & 1ull) + 2 * (int)((BUSY_MASK >> (k)) & 1ull)>(bar); }

template <int LAYER>
__device__ __forceinline__ void layer_body(const Params& p, LAS unsigned char* lds, const XcdBarrier& bar) {
    constexpr int kind = LAYER % 3, j = LAYER / 3;
    constexpr int PB = LAYER == 0 ? 1 : (LAYER == 1 ? 10 : (LAYER == 2 ? 18 : 29));
    constexpr int NMIX = kind == 0 ? 4 : (kind == 1 ? 3 : 6);
    unsigned char* ws = p.ws;
    const int G = gridDim.x, cblk = blockIdx.x;
    const int* positions = (const int*)p.in[1];
    unsigned char* XA = ws + WS_XA; bf16_t* MB = (bf16_t*)(ws + B_MB);
    bf16_t* XR = (bf16_t*)p.out;
    bf16_t* X1 = LAYER == DEPTH - 1 ? (bf16_t*)(ws + WS_XA) : (bf16_t*)p.out + (size_t)T_TOK * DM;
    int* route_e = (int*)(ws + WS_ROUTE_E); float* route_w = (float*)(ws + WS_ROUTE_W); int* posb = (int*)(ws + WS_POS); int* cnt = (int*)(ws + WS_CNT);
    int4* tiles = (int4*)(ws + WS_TILE); float* bias1 = (float*)(ws + WS_BIAS1);
    if constexpr (kind == 0) {
        unsigned char* Q = ws + B_Q; bf16_t* KC = (bf16_t*)(ws + B_KC); bf16_t* VC = (bf16_t*)(ws + B_VC); unsigned char* KS = ws + B_KS; unsigned char* VST = ws + B_VST;
        unsigned char* KW = ws + B_KW; unsigned char* VWT = ws + B_VWT; unsigned char* OB = ws + B_O;
        float* GATES = (float*)(ws + WS_GATES); unsigned char* KCMP = ws + WS_KCMP; unsigned char* VCMPT = ws + WS_VCMPT;
        PH_BEGIN(PB + 0)
            EpiNsaIn E{Q, KC, VC, KS, VST, KW, VWT, GATES, positions, p.in[3] + j * 48, (F8IN_MASK & 1) ? 1.f / (S8_X * S8_WI) : 1.f, LAYER == 3};
            if constexpr (F8IN_MASK & 1) { DenseSched8 S{XA, ws + W_NSA_IN + (size_t)j * NSA_NP * 1024, 1024, 1024, T_TOK / 256, NSA_NP / 256, G, cblk};
                gemm_phase<true>(lds, 1024, 1024, 1024, S, E); }
            else { DenseSched S{XR, (const bf16_t*)(ws + W_NSA_IN) + (size_t)j * NSA_NP * 1024, 1024, 1024, T_TOK / 256, NSA_NP / 256, G, cblk};
                gemm_phase<false>(lds, 1024, 1024, 1024, S, E); }
        PH_END(PB + 0)
        PH_BEGIN(PB + 1)
            nsa_compress_phase(lds, KC, VC, (const bf16_t*)(ws + W_CMP1) + (size_t)j * 2 * 64 * 2048, p.in[6] + j * 4096, p.in[9] + j * 4096, bias1 + j * 128, positions, KCMP, VCMPT);
        PH_END(PB + 1)
        PH_BEGIN(PB + 2)
            AttnArgs A{Q, KS, VST, KW, VWT, KCMP, VCMPT, GATES, OB, LAYER == 3 ? 1 : 0};
            nsa_attn_phase(lds, A);
        PH_END(PB + 2)
        PH_BEGIN(PB + 3)
            DenseSched8 S{OB, ws + W_NSA_OUT + (size_t)j * 1024 * 1024, 1024, 1024, T_TOK / 256, 4, G, cblk};
            EpiPlain<false> E{MB, 1024, 1.f / (S8_O * S8_WO)};
            gemm_phase<true>(lds, 1024, 1024, 1024, S, E);
        PH_END(PB + 3)
    } else if constexpr (kind == 1) {
        bf16_t* P = (bf16_t*)(ws + B_P); bf16_t* BGb = (bf16_t*)(ws + B_BG); bf16_t* Y = (bf16_t*)(ws + B_Y);
        PH_BEGIN(PB + 0)
            EpiScIn E{P, BGb, (F8IN_MASK & 2) ? 1.f / (S8_X * S8_WI) : 1.f};
            if constexpr (F8IN_MASK & 2) { DenseSched8 S{XA, ws + W_SC_IN, 1024, 1024, T_TOK / 256, 12, G, cblk};
                gemm_phase<true>(lds, 1024, 1024, 1024, S, E); }
            else { DenseSched S{XR, (const bf16_t*)(ws + W_SC_IN), 1024, 1024, T_TOK / 256, 12, G, cblk};
                gemm_phase<false>(lds, 1024, 1024, 1024, S, E); }
        PH_END(PB + 0)
        PH_BEGIN(PB + 1)
            sc_conv_phase(lds, P, BGb, Y, p.in[12], p.in[13]);
        PH_END(PB + 1)
        PH_BEGIN(PB + 2)
            DenseSched S{Y, (const bf16_t*)(ws + W_SC_OUT), 1024, 1024, T_TOK / 256, 4, G, cblk};
            EpiPlain<false> E{MB, 1024, 1.f};
            gemm_phase<false>(lds, 1024, 1024, 1024, S, E);
        PH_END(PB + 2)
    } else {
        bf16_t* GG = (bf16_t*)(ws + B_GG); bf16_t* R1 = (bf16_t*)(ws + B_R1); bf16_t* R2 = (bf16_t*)(ws + B_R2); bf16_t* R3 = (bf16_t*)(ws + B_R3);
        f32x4* carry = (f32x4*)(ws + WS_CARRY);
        PH_BEGIN(PB + 0)
            EpiLruIn E{GG, R1, (F8IN_MASK & 4) ? 1.f / (S8_X * S8_WI) : 1.f};
            if constexpr (F8IN_MASK & 4) { DenseSched8 S{XA, ws + W_LRU_IN, 1024, 1024, T_TOK / 256, 10, G, cblk};
                gemm_phase<true>(lds, 1024, 1024, 1024, S, E); }
            else { DenseSched S{XR, (const bf16_t*)(ws + W_LRU_IN), 1024, 1024, T_TOK / 256, 10, G, cblk};
                gemm_phase<false>(lds, 1024, 1024, 1024, S, E); }
        PH_END(PB + 0)
        PH_BEGIN(PB + 1)
            lru_conv_phase(lds, R1, R2, p.in[16], p.in[17]);
        PH_END(PB + 1)
        PH_BEGIN(PB + 2)
            BandSched S{R2, (const bf16_t*)(ws + W_LRU_G), LRU_W, LRU_W, T_TOK / 256, 10, G, cblk};
            EpiLruGate E{R2, R1, R3, p.in[19], p.in[21], p.in[22]};
            gemm_phase<false>(lds, 384, LRU_W, LRU_W, S, E);
        PH_END(PB + 2)
        PH_BEGIN(PB + 3)
            lru_scan1_phase(R1, R3, carry);
        PH_END(PB + 3)
        PH_BEGIN(PB + 4)
            lru_scan2_phase(R1, R3, GG, carry, R2);
        PH_END(PB + 4)
        PH_BEGIN(PB + 5)
            DenseSched S{R2, (const bf16_t*)(ws + W_LRU_OUT), LRU_W, LRU_W, T_TOK / 256, 4, G, cblk};
            EpiPlain<false> E{MB, 1024, 1.f};
            gemm_phase<false>(lds, LRU_W, LRU_W, LRU_W, S, E);
        PH_END(PB + 5)
    }
    constexpr int FB = PB + NMIX;
    unsigned char* X8 = ws + B_XG; int* invb = (int*)(ws + WS_INV); unsigned char* HID = ws + B_HID; unsigned char* YM = ws + B_YM; unsigned char* WGU = ws + B_WMOE + WMOE_GU; unsigned char* WDN = ws + B_WMOE + WMOE_DN;
    const float* lng = p.in[29] + (size_t)LAYER * 2048; const float* lnb = p.in[30] + (size_t)LAYER * 2048;
    PH_BEGIN(FB + 0)
        ln1_router_phase<LAYER == 0>(lds, LAYER == 0 ? (const void*)p.in[0] : (const void*)XR, MB, X1, X8, lng, lnb, p.in[24], p.in[25], route_e, route_w, cnt);
    PH_END(FB + 0)
    PH_BEGIN(FB + 1)
        moe_gather_phase(lds, route_e, cnt, posb, invb, tiles);
#if defined(EXP_F2_NOCONV)
        if (LAYER != 3)
#endif
        {
        convert_wt<true>(lds, WGU, 16, 2048, 1024, FetchPair{p.in[26] + (size_t)LAYER * 16 * 1048576, (long)(p.in[27] - p.in[26]), 1024, (size_t)1048576}, S8_WGU);
        convert_wt<true>(lds, WDN, 16, 1024, 1024, FetchPlain16{p.in[28] + (size_t)LAYER * 16 * 1048576, 1024, (size_t)1048576}, S8_WD);
        }
    PH_END(FB + 1)
    PH_BEGIN(FB + 2)
        const int NT = __builtin_amdgcn_readfirstlane(tiles[0].x);
        const int nu = moe_sched_fill<true>(lds, tiles, invb, NT, 8, G, cblk);
        MoeSchedL S{X8, WGU, (const LAS u32x4*)(lds + MOE_LDS_DESC), (const LAS int*)(lds + MOE_LDS_ROWS), nu, 2048, 1024, false};
        EpiMoeGU E{HID};
        gemm_phase<true, true>(lds, 1024, 1024, 1024, S, E);
    PH_END(FB + 2)
    PH_BEGIN(FB + 3)
        const int NT = __builtin_amdgcn_readfirstlane(tiles[0].x);
        const int nu = moe_sched_fill<false>(lds, tiles, invb, NT, 4, G, cblk);
        MoeSchedL S{HID, WDN, (const LAS u32x4*)(lds + MOE_LDS_DESC), (const LAS int*)(lds + MOE_LDS_ROWS), nu, 1024, 1024, LAYER == 3};
        EpiMoeDown16 E{YM, S8_Y / (S8_H * S8_WD)};
        gemm_phase<true>(lds, 1024, 1024, 1024, S, E);
    PH_END(FB + 3)
    PH_BEGIN(FB + 4)
        ln2_combine_phase<LAYER == DEPTH - 1, ((F8IN_MASK >> ((LAYER + 1) % 3)) & 1) != 0>(X1, LAYER == DEPTH - 1 ? (void*)p.out : (void*)XR, YM, posb, route_w, lng + 1024, lnb + 1024, XA);
    PH_END(FB + 4)
}

__global__ void __launch_bounds__(NTHR, 2) hybrid_fwd(Params p) {
    extern __shared__ __attribute__((aligned(16))) unsigned char lds_raw[];
    LAS unsigned char* lds = (LAS unsigned char*)lds_raw;
    volatile LAS unsigned* bst = (volatile LAS unsigned*)(lds + LDS_BYTES - 16);
    const bool use_bar = (p.ph_hi - p.ph_lo) > 1;
    if (threadIdx.x == 0) { bst[0] = 0u; bst[1] = 0u; bst[2] = 0u; bst[3] = 0u; }
    __syncthreads();
    XcdBarrier bar; bar.bar = (unsigned*)(p.ws + WS_CTL); bar.x = 0; bar.st = bst;
    if (use_bar) bar = xcd_barrier_post((unsigned*)(p.ws + WS_CTL), bst);
#ifdef PROBE_WAIT
    if (threadIdx.x == 0) bst[3] = (unsigned)__builtin_amdgcn_s_memrealtime();
#endif
    PH_BEGIN(0)
        unsigned char* ws = p.ws;
        convert_x<(F8IN_MASK & 1) != 0>(p.in[0], ws + WS_XA);
        for (int j = 0; j < 2; ++j) {
            const int bo = j * 128;
            if constexpr (F8IN_MASK & 1) convert_wt<true>(lds, ws + W_NSA_IN + (size_t)j * NSA_NP * 1024, 1, NSA_NP, 1024, FetchNsaIn{p.in[2] + (size_t)j * 1024 * 2608}, S8_WI, bo);
            else convert_wt(lds, (bf16_t*)(ws + W_NSA_IN) + (size_t)j * NSA_NP * 1024, 1, NSA_NP, 1024, FetchNsaIn{p.in[2] + (size_t)j * 1024 * 2608}, 1.f, bo);
            convert_wt<true>(lds, ws + W_NSA_OUT + (size_t)j * 1024 * 1024, 1, 1024, 1024, FetchPlain{p.in[10] + (size_t)j * 1024 * 1024, 1024, 0}, S8_WO, bo + 88);
            convert_wt(lds, (bf16_t*)(ws + W_CMP1) + (size_t)(j * 2 + 0) * 64 * 2048, 1, 64, 2048, FetchIdent{p.in[5] + (size_t)j * 2048 * 64, 64, 0}, 1.f, bo + 120);
            convert_wt(lds, (bf16_t*)(ws + W_CMP1) + (size_t)(j * 2 + 1) * 64 * 2048, 1, 64, 2048, FetchIdent{p.in[8] + (size_t)j * 2048 * 64, 64, 0}, 1.f, bo + 124);
        }
        if constexpr (F8IN_MASK & 2) convert_wt<true>(lds, ws + W_SC_IN, 1, 3072, 1024, FetchScIn{p.in[11]}, S8_WI, 0); else convert_wt(lds, (bf16_t*)(ws + W_SC_IN), 1, 3072, 1024, FetchScIn{p.in[11]}, 1.f, 0);
        convert_wt(lds, (bf16_t*)(ws + W_SC_OUT), 1, 1024, 1024, FetchPlain{p.in[14], 1024, 0}, 1.f, 96);
        if constexpr (F8IN_MASK & 4) convert_wt<true>(lds, ws + W_LRU_IN, 1, 2560, 1024, FetchPlain{p.in[15], 2560, 0}, S8_WI, 128); else convert_wt(lds, (bf16_t*)(ws + W_LRU_IN), 1, 2560, 1024, FetchPlain{p.in[15], 2560, 0}, 1.f, 128);
        convert_wt(lds, (bf16_t*)(ws + W_LRU_G), 1, 2560, 1280, FetchLruGate{p.in[18], (long)(p.in[20] - p.in[18])}, 1.f, 208);
        convert_wt(lds, (bf16_t*)(ws + W_LRU_OUT), 1, 1024, 1280, FetchPlain{p.in[23], 1024, 0}, 1.f, 52);
        cmp_bias_phase(lds, p.in[4], p.in[5], p.in[7], p.in[8], (float*)(ws + WS_BIAS1));
    PH_END(0)
    layer_body<0>(p, lds, bar);
    layer_body<1>(p, lds, bar);
    layer_body<2>(p, lds, bar);
    layer_body<3>(p, lds, bar);
#ifdef PROBE_WAIT
    __syncthreads();
    if (threadIdx.x == 0) { if ((BUSY_MASK >> 37) & 1ull) bst[2] = bst[2] + ((unsigned)__builtin_amdgcn_s_memrealtime() - bst[3]); atomicAdd((unsigned*)(p.ws + WS_CTL + 32768), bst[2]); }
    xcd_barrier(bar);
#ifdef PROBE_FILL
    {
        const unsigned tot = __hip_atomic_load((unsigned*)(p.ws + WS_CTL + 32768), __ATOMIC_RELAXED, __HIP_MEMORY_SCOPE_AGENT);
        const float vk = (float)(((tot >> 8) + (PROBE_Q / 2)) / PROBE_Q);
        for (size_t i = (size_t)blockIdx.x * NTHR + threadIdx.x; i < (size_t)T_TOK * DM; i += (size_t)gridDim.x * NTHR) p.out[i] = vk;
    }
    if (false) {
        const unsigned tot = 0;
#else
    if (blockIdx.x == 0 && threadIdx.x == 0) {
        const unsigned tot = __hip_atomic_load((unsigned*)(p.ws + WS_CTL + 32768), __ATOMIC_RELAXED, __HIP_MEMORY_SCOPE_AGENT);
#endif
        p.out[0] = (float)((((tot >> 8) + (PROBE_Q / 2)) / PROBE_Q) * PROBE_Q);
    }
#endif
}
#undef PH_BEGIN
#undef PH_END

#ifndef MK_SPLIT
#define MK_SPLIT 0
#endif
extern "C" void kernel_launch(void* const* d_in, const int* in_sizes, int n_in, void* d_out, int out_size, void* d_ws, size_t ws_size, hipStream_t stream) {
    static int grid = 0;
    if (grid == 0) {
        int dev = 0, cus = 0, per_cu = 0;
        if (n_in != 31 || ws_size < WS_END) { fprintf(stderr, "kernel_launch: unexpected n_in %d or ws_size %zu (need %zu)\n", n_in, ws_size, (size_t)WS_END); grid = -1; return; }
        if (hipGetDevice(&dev) != hipSuccess || hipDeviceGetAttribute(&cus, hipDeviceAttributeMultiprocessorCount, dev) != hipSuccess) { grid = -1; return; }
        if (hipFuncSetAttribute((const void*)hybrid_fwd, hipFuncAttributeMaxDynamicSharedMemorySize, LDS_BYTES) != hipSuccess) { fprintf(stderr, "kernel_launch: hipFuncSetAttribute failed\n"); grid = -1; return; }
        if (hipOccupancyMaxActiveBlocksPerMultiprocessor(&per_cu, (const void*)hybrid_fwd, NTHR, LDS_BYTES) != hipSuccess || per_cu < 1) fprintf(stderr, "kernel_launch: occupancy query says %d\n", per_cu);
        (void)hipGetLastError();
        grid = cus;
    }
    if (grid < 0) return;
    (void)hipMemsetAsync((char*)d_ws + WS_CTL, 0, 64 * 1024, stream);
    Params p{};
    for (int i = 0; i < 31; ++i) p.in[i] = (const float*)d_in[i];
    p.out = (float*)d_out; p.ws = (unsigned char*)d_ws;
#if MK_SPLIT
    for (int ph = 0; ph < N_PHASES; ++ph) { p.ph_lo = ph; p.ph_hi = ph + 1; hipLaunchKernelGGL(hybrid_fwd, dim3(grid), dim3(NTHR), LDS_BYTES, stream, p); }
#else
    p.ph_lo = 0; p.ph_hi = N_PHASES;
    hipLaunchKernelGGL(hybrid_fwd, dim3(grid), dim3(NTHR), LDS_BYTES, stream, p);
#endif
    const hipError_t le = hipPeekAtLastError();
    if (le != hipSuccess) fprintf(stderr, "kernel_launch: launch failed: %s\n", hipGetErrorName(le));
}
```

```cpp
#include <hip/hip_runtime.h>
#include <stdint.h>
#include <stdio.h>

#define LAS __attribute__((address_space(3)))
typedef unsigned short bf16_t;
typedef short bf16x8 __attribute__((ext_vector_type(8)));
typedef float f32x4 __attribute__((ext_vector_type(4)));
typedef float f32x2 __attribute__((ext_vector_type(2)));
typedef unsigned u32x4 __attribute__((ext_vector_type(4)));
typedef unsigned u32x2 __attribute__((ext_vector_type(2)));
typedef int i32x8 __attribute__((ext_vector_type(8)));

constexpr int T_TOK = 65536, DM = 1024, SEQ = 2048, NBATCH = 32, DEPTH = 4;
constexpr int NTHR = 512;
constexpr int NSA_NP = 2816;
constexpr int LRU_W = 1280;
constexpr int NEXP = 16;
constexpr float DN_ALPHA = 1.6817928305074292f;
constexpr float LN_EPS = 1e-5f;
constexpr float NEGBIG = -1e30f;
constexpr float LOG2E = 1.4426950408889634f;

constexpr size_t KiB = 1024, MiB = 1024 * 1024;
constexpr size_t WS_CTL = 0;
constexpr size_t WS_ROUTE_E = 64 * KiB;
constexpr size_t WS_ROUTE_W = WS_ROUTE_E + 256 * KiB;
constexpr size_t WS_POS = WS_ROUTE_W + 512 * KiB;
constexpr size_t WS_CNT = WS_POS + 512 * KiB;
constexpr size_t WS_TILE = WS_CNT + 16 * KiB;
constexpr size_t WS_BIAS1 = WS_TILE + 16 * KiB;
constexpr size_t WS_INV = 1408 * KiB;
constexpr size_t WS_KCMP = 2 * MiB;
constexpr size_t WS_VCMPT = 4 * MiB;
constexpr size_t WS_CARRY = 6 * MiB;
constexpr size_t WS_GATES = 16 * MiB;
constexpr size_t WS_W = 28 * MiB;
constexpr size_t W_NSA_IN = WS_W;
constexpr size_t W_NSA_OUT = W_NSA_IN + 2 * (size_t)NSA_NP * 1024 * 2;
constexpr size_t W_SC_IN = W_NSA_OUT + 2 * (size_t)1024 * 1024 * 2;
constexpr size_t W_SC_OUT = W_SC_IN + (size_t)3072 * 1024 * 2;
constexpr size_t W_LRU_IN = W_SC_OUT + (size_t)1024 * 1024 * 2;
constexpr size_t W_LRU_G = W_LRU_IN + (size_t)2560 * 1024 * 2;
constexpr size_t W_LRU_OUT = W_LRU_G + (size_t)2560 * 1280 * 2;
constexpr size_t W_CMP1 = W_LRU_OUT + (size_t)1024 * 1280 * 2;
constexpr size_t W_END = W_CMP1 + 4 * (size_t)64 * 2048 * 2;
constexpr size_t WS_XA = 66 * MiB;
constexpr size_t WS_WMOE = WS_XA + 128 * MiB;
constexpr size_t WS_BIG = WS_WMOE + 96 * MiB;
constexpr size_t WS_END = WS_BIG + 642 * MiB;
static_assert(W_END <= WS_XA, "weights overflow");
constexpr size_t B_Q = WS_BIG, B_KC = B_Q + 128 * MiB, B_VC = B_KC + 32 * MiB, B_KS = B_VC + 32 * MiB, B_VST = B_KS + 32 * MiB, B_KW = B_VST + 32 * MiB,
                 B_VWT = B_KW + 32 * MiB, B_O = B_VWT + 32 * MiB;
constexpr size_t B_P = WS_BIG, B_BG = B_P + 128 * MiB, B_Y = B_BG + 128 * MiB;
constexpr size_t B_GG = WS_BIG, B_R1 = B_GG + 160 * MiB, B_R2 = B_R1 + 160 * MiB, B_R3 = B_R2 + 160 * MiB;
constexpr size_t B_MB = WS_BIG;
constexpr size_t B_XG = WS_BIG + 128 * MiB, B_HID = B_XG + 64 * MiB, B_YM = B_HID + 128 * MiB, B_WMOE = WS_WMOE;
constexpr size_t WMOE_GU = 0, WMOE_DN = (size_t)16 * 2048 * 1024;
constexpr float S8_X = 16.f, S8_WGU = 256.f, S8_H = 16.f, S8_WD = 512.f, S8_Y = 128.f, S8_WI = 256.f, S8_O = 32.f, S8_WO = 512.f, S8_Q = 4.f, S8_K = 0.25f;

constexpr int LDS_BYTES = 163840;

__device__ __forceinline__ unsigned cvt_pk_bf16(float lo, float hi) { unsigned r; asm volatile("v_cvt_pk_bf16_f32 %0, %1, %2" : "=v"(r) : "v"(lo), "v"(hi)); return r; }
__device__ __forceinline__ float bf_lo(unsigned u) { return __uint_as_float(u << 16); }
__device__ __forceinline__ float bf_hi(unsigned u) { return __uint_as_float(u & 0xffff0000u); }
__device__ __forceinline__ float bf2f(bf16_t h) { return __uint_as_float(((unsigned)h) << 16); }
__device__ __forceinline__ bf16_t f2bf(float f) { return (bf16_t)(cvt_pk_bf16(f, 0.f) & 0xffffu); }
__device__ __forceinline__ float fast_exp2(float x) { return __builtin_amdgcn_exp2f(x); }
__device__ __forceinline__ float fast_exp(float x) { return __builtin_amdgcn_exp2f(x * LOG2E); }
__device__ __forceinline__ float fast_rcp(float x) { return __builtin_amdgcn_rcpf(x); }
__device__ __forceinline__ float sigmoidf_(float x) { return fast_rcp(1.f + fast_exp(-x)); }
__device__ __forceinline__ float gelu_tanh(float x) { const float u = 0.7978845608028654f * (x + 0.044715f * x * x * x); return x * fast_rcp(1.f + fast_exp(-2.f * u)); }
__device__ __forceinline__ float silu_(float x) { return x * fast_rcp(1.f + fast_exp(-x)); }
__device__ __forceinline__ void sincos_rad(float ang, float& s, float& c) {
    float r = ang * 0.15915494309189535f; r = __builtin_amdgcn_fractf(r); s = __builtin_amdgcn_sinf(r); c = __builtin_amdgcn_cosf(r); }
__device__ __forceinline__ float wave_sum(float v) {
#pragma unroll
    for (int o = 32; o >= 1; o >>= 1) v += __shfl_xor(v, o);
    return v; }
template <int CTRL> __device__ __forceinline__ float dpp_mov(float v) { return __builtin_bit_cast(float, __builtin_amdgcn_update_dpp(0, __builtin_bit_cast(int, v), CTRL, 0xf, 0xf, false)); }
template <int CTRL> __device__ __forceinline__ unsigned dpp_movu(unsigned v) { return (unsigned)__builtin_amdgcn_update_dpp(0, (int)v, CTRL, 0xf, 0xf, false); }
__device__ __forceinline__ float row16_sum(float v) { v += dpp_mov<0xB1>(v); v += dpp_mov<0x4E>(v); v += dpp_mov<0x141>(v); v += dpp_mov<0x140>(v); return v; }
__device__ __forceinline__ float wave_sum_dpp(float v) { v = row16_sum(v); v += __shfl_xor(v, 16); v += __shfl_xor(v, 32); return v; }
__device__ __forceinline__ void lds_barrier() { asm volatile("s_waitcnt lgkmcnt(0)" ::: "memory"); __builtin_amdgcn_s_barrier(); asm volatile("" ::: "memory"); }
__device__ __forceinline__ int tid_opaque() { int t = threadIdx.x; asm volatile("" : "+v"(t)); return t; }
__device__ __forceinline__ u32x4 ld16(const void* p) { return *(const u32x4*)p; }
__device__ __forceinline__ void st16(void* p, u32x4 v) { *(u32x4*)p = v; }

#ifndef BAR_FIRST_WB
#define BAR_FIRST_WB 0
#endif
#ifndef BAR_EARLY_WB
#define BAR_EARLY_WB 0
#endif
#define XB_TMO      128
#define XB_XCNT(j)  (256  + 64 * (j))
#define XB_XSUB(j)  (1280 + 64 * (j))
#define XB_XGEN(j)  (2304 + 64 * (j))
#define XB_TOP      3328
#define XB_TOPGEN   3392
#define XCD_BAR_WORDS 3456
#define XB_SPIN_CAP (1u << 22)
__device__ __forceinline__ unsigned xb_ld(unsigned* p)              { return __hip_atomic_load(p, __ATOMIC_RELAXED, __HIP_MEMORY_SCOPE_AGENT); }
__device__ __forceinline__ unsigned xb_add(unsigned* p, unsigned v) { return __hip_atomic_fetch_add(p, v, __ATOMIC_RELAXED, __HIP_MEMORY_SCOPE_AGENT); }
__device__ __forceinline__ unsigned xb_xcc_id() { return (unsigned)__builtin_amdgcn_s_getreg((3 << 11) | 20) & 0xFu; }
#define XB_SPIN(cond, bar) do { unsigned _sp = 0; while (cond) { __builtin_amdgcn_s_sleep(1); \
    if ((++_sp & 255u) == 0u) { if (xb_ld(&(bar)[XB_TMO])) break; if (_sp > XB_SPIN_CAP) { atomicAdd(&(bar)[XB_TMO], 1u); break; } } } } while (0)
struct XcdBarrier { unsigned* bar; unsigned x; volatile LAS unsigned* st; };
__device__ __forceinline__ XcdBarrier xcd_barrier_post(unsigned* bar, volatile LAS unsigned* st) {
    XcdBarrier b; b.bar = bar; b.x = xb_xcc_id(); b.st = st;
    if (threadIdx.x == 0) (void)xb_add(&bar[XB_XCNT(b.x)], 1u);
    return b;
}
__device__ __forceinline__ void xcd_barrier_complete(unsigned* bar, unsigned x, unsigned& nloc, unsigned& nx) {
    const unsigned G = gridDim.x * gridDim.y * gridDim.z;
    unsigned sum, cnt, mine, sp = 0u;
    for (;;) {
        sum = 0u; cnt = 0u; mine = 0u;
#pragma unroll
        for (unsigned j = 0; j < 16; ++j) { const unsigned c = xb_ld(&bar[XB_XCNT(j)]); sum += c; cnt += (c > 0u) ? 1u : 0u; mine = (j == x) ? c : mine; }
        if (sum == G) break;
        __builtin_amdgcn_s_sleep(1);
        if ((++sp & 255u) == 0u) { if (xb_ld(&bar[XB_TMO])) break; if (sp > XB_SPIN_CAP) { atomicAdd(&bar[XB_TMO], 1u); break; } }
    }
    nloc = mine > 0u ? mine : 1u; nx = cnt > 0u ? cnt : 1u;
}
#ifndef WAIT_MASK
#define WAIT_MASK 0ull
#endif
#ifndef BUSY_MASK
#define BUSY_MASK 0ull
#endif
template <int TIMED = 0>
__device__ __forceinline__ void xcd_barrier(const XcdBarrier& b) {
    asm volatile("s_waitcnt vmcnt(0)" ::: "memory");
    __syncthreads();
    if (threadIdx.x == 0) {
        unsigned* bar = b.bar;
        __builtin_amdgcn_s_waitcnt(0);
#ifdef PROBE_WAIT
        const unsigned t0_ = (unsigned)__builtin_amdgcn_s_memrealtime();
        if constexpr (TIMED & 2) b.st[2] = b.st[2] + (t0_ - b.st[3]);
#endif
        unsigned nloc = b.st[0], nx = b.st[1];
        if (nloc == 0u) { xcd_barrier_complete(bar, b.x, nloc, nx); b.st[0] = nloc; b.st[1] = nx; }
#if BAR_EARLY_WB
        __builtin_amdgcn_fence(__ATOMIC_RELEASE, "agent");
        asm volatile("s_waitcnt vmcnt(0)" ::: "memory");
#endif
        const unsigned old = xb_add(&bar[XB_XSUB(b.x)], 1u);
        const unsigned gen = old / nloc;
#if BAR_FIRST_WB
        if (old == gen * nloc && nloc > 1u) {
            __builtin_amdgcn_fence(__ATOMIC_RELEASE, "agent");
            asm volatile("s_waitcnt vmcnt(0)" ::: "memory");
        }
#endif
        if (old + 1u == (gen + 1u) * nloc) {
            __builtin_amdgcn_fence(__ATOMIC_RELEASE, "agent");
            asm volatile("s_waitcnt vmcnt(0)" ::: "memory");
            const unsigned og = xb_add(&bar[XB_TOP], 1u);
            const unsigned tg = og / nx;
            if (og + 1u == (tg + 1u) * nx) xb_add(&bar[XB_TOPGEN], 1u);
            else XB_SPIN(xb_ld(&bar[XB_TOPGEN]) == tg, bar);
            __builtin_amdgcn_fence(__ATOMIC_ACQUIRE, "agent");
            xb_add(&bar[XB_XGEN(b.x)], 1u);
            asm volatile("s_waitcnt vmcnt(0)" ::: "memory");
        } else {
            XB_SPIN(xb_ld(&bar[XB_XGEN(b.x)]) == gen, bar);
            __builtin_amdgcn_fence(__ATOMIC_ACQUIRE, "agent");
            asm volatile("s_waitcnt vmcnt(0)" ::: "memory");
        }
#ifdef PROBE_WAIT
        { const unsigned t1_ = (unsigned)__builtin_amdgcn_s_memrealtime(); if constexpr (TIMED & 1) b.st[2] = b.st[2] + (t1_ - t0_); b.st[3] = t1_; }
#endif
    }
    __syncthreads();
}

#ifndef GEMM_SKEW
#define GEMM_SKEW 0
#endif
#ifndef GEMM_SKEW_NG
#define GEMM_SKEW_NG 2u
#endif
constexpr int BM = 256, BK = 64, HALF = 128, HTB = HALF * BK * 2, STAGE_BYTES = 8 * HTB, NXCD = 8, WGM = 8;
__host__ __device__ __forceinline__ int lds_byte(int r, int c) { const int st = (r >> 4) * 2 + (c >> 5), rr = r & 15, cc = c & 31, ob = rr * 64 + cc * 2; return st * 1024 + (ob ^ (((ob >> 9) & 1) << 5)); }
__host__ __device__ __forceinline__ void stage_rc(int b, int& R, int& C) { const int st = b / 1024, sb = b % 1024, swz = sb ^ (((sb >> 9) & 1) << 5); R = (st >> 1) * 16 + swz / 64; C = (st & 1) * 32 + (swz % 64) / 2; }

struct GUnit { const char* a; const char* b; int pn; int row0; int nrows; int aux; };
__device__ __forceinline__ void map_unit(int L, int nM, int nN, int& pm, int& pn) {
    const int nwg = nM * nN; int wgid = L;
    { const int q = nwg / NXCD, r = nwg % NXCD, xcd = wgid % NXCD, off = wgid / NXCD; wgid = (xcd < r ? xcd * (q + 1) : r * (q + 1) + (xcd - r) * q) + off; }
    const int nig = WGM * nN, gid = wgid / nig, fm = gid * WGM, gsz = (nM - fm) < WGM ? (nM - fm) : WGM;
    pm = fm + ((wgid % nig) % gsz); pn = (wgid % nig) / gsz;
}
struct DenseSched {
    const bf16_t* A; const bf16_t* Bt; int lda, K, nM, nN, G, c;
    __device__ __forceinline__ bool next(int i, GUnit& u) const {
        const long L = (long)i * G + c; if (L >= (long)nM * nN) return false;
        int pm, pn; map_unit((int)L, nM, nN, pm, pn);
        u.a = (const char*)(A + (size_t)pm * BM * lda); u.b = (const char*)(Bt + (size_t)pn * BM * K); u.pn = pn; u.row0 = pm * BM; u.nrows = BM; u.aux = 0; return true;
    }
};
struct DenseSched8 {
    const unsigned char* A; const unsigned char* Bt; int lda, K, nM, nN, G, c;
    __device__ __forceinline__ bool next(int i, GUnit& u) const {
        const long L = (long)i * G + c; if (L >= (long)nM * nN) return false;
        int pm, pn; map_unit((int)L, nM, nN, pm, pn);
        u.a = (const char*)(A + (size_t)pm * BM * lda); u.b = (const char*)(Bt + (size_t)pn * BM * K); u.pn = pn; u.row0 = pm * BM; u.nrows = BM; u.aux = 0; return true;
    }
};
struct BandSched {
    const bf16_t* A; const bf16_t* Bt; int lda, ldb, nM, nN, G, c;
    __device__ __forceinline__ bool next(int i, GUnit& u) const {
        const long L = (long)i * G + c; if (L >= (long)nM * nN) return false;
        int pm, pn; map_unit((int)L, nM, nN, pm, pn);
        int k0 = ((128 * pn / 80) * 80 / 64) * 64; k0 = k0 > ldb - 384 ? ldb - 384 : k0;
        u.a = (const char*)(A + (size_t)pm * BM * lda + k0); u.b = (const char*)(Bt + (size_t)pn * BM * ldb + k0); u.pn = pn; u.row0 = pm * BM; u.nrows = BM; u.aux = 0; return true;
    }
};
struct MoeSched {
    const unsigned char* A; const unsigned char* W; const int4* tiles; const int* inv; int NT, nN, N, K, G, c;
    __device__ __forceinline__ bool next(int i, GUnit& u) const {
        const long L = (long)i * G + c; if (L >= (long)NT * nN) return false;
        int pm, pn; map_unit((int)L, NT, nN, pm, pn);
        const int4 t = tiles[1 + pm];
        const int e = __builtin_amdgcn_readfirstlane(t.x), r0 = __builtin_amdgcn_readfirstlane(t.y), nr = __builtin_amdgcn_readfirstlane(t.z);
        u.a = (const char*)(A + (size_t)r0 * K); u.b = (const char*)(W + ((size_t)e * N + (size_t)pn * BM) * K); u.pn = pn; u.row0 = r0; u.nrows = nr; u.aux = e; return true;
    }
};

constexpr int MOE_MAXU = 18, MOE_LDS_DESC = 131072, MOE_LDS_ROWS = 131072 + 512;
struct MoeSchedL {
    const unsigned char* A; const unsigned char* W; const LAS u32x4* desc; const LAS int* rows; int nu, N, K; bool fix;
    __device__ __forceinline__ bool next(int i, GUnit& u) const {
        if (i >= nu) return false;
        const u32x4 t = desc[i];
        const int e = __builtin_amdgcn_readfirstlane((int)t[0]), r0 = __builtin_amdgcn_readfirstlane((int)t[1]), nr = __builtin_amdgcn_readfirstlane((int)t[2]), pn = __builtin_amdgcn_readfirstlane((int)t[3]);
        u.a = (const char*)(A + (size_t)r0 * K); u.b = (const char*)(W + ((size_t)e * N + (size_t)pn * BM) * K); u.pn = pn; u.row0 = r0; u.nrows = nr; u.aux = i;
#if defined(EXP_FIXA)
        if (nu < 0) { }
        if (fix) { u.a = (const char*)A; }
#endif
#if defined(EXP_FIXB)
        if (fix) { u.b = (const char*)W; }
#endif
        return true;
    }
    __device__ __forceinline__ int arow(const GUnit& u, int r) const { return rows[u.aux * 256 + r]; }
};
template <bool GATHER>
__device__ __forceinline__ int moe_sched_fill(LAS unsigned char* lds, const int4* tiles, const int* inv, int NT, int nN, int G, int c) {
    const int tid = tid_opaque();
    const int total = NT * nN;
    int nu = c < total ? (total - c + G - 1) / G : 0; nu = nu > MOE_MAXU ? MOE_MAXU : nu;
    LAS u32x4* desc = (LAS u32x4*)(lds + MOE_LDS_DESC); LAS int* rows = (LAS int*)(lds + MOE_LDS_ROWS);
#pragma unroll
    for (int k = 0; k < MOE_MAXU * 256 / NTHR; ++k) {
        const int x = tid + k * NTHR, i = x >> 8, r = x & 255;
        if (i < nu) {
            int pm, pn; map_unit(i * G + c, NT, nN, pm, pn);
            const int4 t = tiles[1 + pm];
            if (r == 0) desc[i] = (u32x4){(unsigned)t.x, (unsigned)t.y, (unsigned)t.z, (unsigned)pn};
            if constexpr (GATHER) rows[x] = inv[t.y + r];
        }
    }
    __syncthreads();
    return nu;
}

template <bool F8, bool GATHER = false, class Epi, class Sched>
__device__ __forceinline__ void gemm_phase(LAS unsigned char* lds, const int K  , const int lda, const int ldb  , const Sched& S, const Epi& E, const float accs = 1.f  ) {
    const int tid = tid_opaque(), wid = __builtin_amdgcn_readfirstlane(tid >> 6), lane = tid & 63, wr = wid >> 2, wc = wid & 3, fr = lane & 15, fq = lane >> 4;
    const int nt = F8 ? K / 128 : K / BK;
    unsigned voffA[2], voffB[2];
#pragma unroll
    for (int i = 0; i < 2; ++i) { int R, C; stage_rc(tid * 16 + i * 8192, R, C); voffA[i] = F8 ? (unsigned)(R * lda + 2 * C) : (unsigned)(R * lda + C) * 2u; voffB[i] = F8 ? (unsigned)(R * ldb + 2 * C) : (unsigned)(R * ldb + C) * 2u; }
    int gR[2]; unsigned gC[2]; unsigned vc[2][2], vn[2][2];
#pragma unroll
    for (int i = 0; i < 2; ++i) { int R, C; stage_rc(tid * 16 + i * 8192, R, C); gR[i] = R; gC[i] = 2u * (unsigned)C; }
#define PG8_GLOAD(dst, unit) do { if constexpr (GATHER) { _Pragma("unroll") for (int _h = 0; _h < 2; ++_h) _Pragma("unroll") for (int _i = 0; _i < 2; ++_i) \
        dst[_h][_i] = (unsigned)S.arow((unit), _h * HALF + gR[_i]) * (unsigned)lda + gC[_i]; } } while (0)
#define PG8_STAGE_A(bufoff, h, kofs, unext) do { if constexpr (GATHER) { _Pragma("unroll") for (int _i = 0; _i < 2; ++_i) \
        __builtin_amdgcn_global_load_lds((const unsigned*)((const char*)S.A + (kofs) + ((unext) ? vn[h][_i] : vc[h][_i])), (LAS unsigned*)(lds + (bufoff) + ldsw + _i * 8192), 16, 0, 0); } \
        else PG8_STAGE(bufoff, ((unext) ? nA : cA) + (h) * hstepA + (kofs), voffA); } while (0)
    const size_t kstep = (size_t)(BK * 2);
    const size_t hstepA = (size_t)HALF * lda * (F8 ? 1 : 2), hstepB = (size_t)HALF * ldb * (F8 ? 1 : 2);
    const unsigned ldsw = (unsigned)wid * 1024u;
    const int aoff = lds_byte(wr * 64 + fr, fq * 8), boff = lds_byte(wc * 32 + fr, fq * 8);
    const LAS unsigned char* ldsA = lds + aoff; const LAS unsigned char* ldsB = lds + 65536 + boff;
#define PG8_SA(b, h) (((b) * 2 + (h)) * HTB)
#define PG8_SB(b, h) ((4 + (b) * 2 + (h)) * HTB)
#define PG8_STAGE(bufoff, gbase, voff) do { _Pragma("unroll") for (int _i = 0; _i < 2; ++_i) \
        __builtin_amdgcn_global_load_lds((const unsigned*)((const char*)(gbase) + (voff)[_i]), (LAS unsigned*)(lds + (bufoff) + ldsw + _i * 8192), 16, 0, 0); } while (0)
#define PG8_LD16(off) (*(const LAS u32x4*)(lds + (off)))
#define PG8_LDA16(off) (*(const LAS u32x4*)(ldsA + (off)))
#define PG8_LDB16(off) (*(const LAS u32x4*)(ldsB + (off)))
#define PG8_LDA(dst, b, h) do { _Pragma("unroll") for (int m = 0; m < 4; ++m) { \
        if constexpr (F8) dst##8[m] = __builtin_shufflevector(PG8_LDA16(PG8_SA(b, h) + m * 2048), PG8_LDA16(PG8_SA(b, h) + m * 2048 + 1024), 0, 1, 2, 3, 4, 5, 6, 7); \
        else { _Pragma("unroll") for (int k = 0; k < 2; ++k) dst[m][k] = *(const LAS bf16x8*)(lds + PG8_SA(b, h) + aoff + m * 2048 + k * 1024); } } } while (0)
#define PG8_LDB(dst, b, h) do { _Pragma("unroll") for (int n = 0; n < 2; ++n) { \
        if constexpr (F8) dst##8[n] = __builtin_shufflevector(PG8_LDB16(PG8_SB(b, h) - 65536 + n * 2048), PG8_LDB16(PG8_SB(b, h) - 65536 + n * 2048 + 1024), 0, 1, 2, 3, 4, 5, 6, 7); \
        else { _Pragma("unroll") for (int k = 0; k < 2; ++k) dst[n][k] = *(const LAS bf16x8*)(lds + PG8_SB(b, h) + boff + n * 2048 + k * 1024); } } } while (0)
#define PG8_MMA(ai, bj, At, Bt) do { __builtin_amdgcn_s_setprio(1); _Pragma("unroll") for (int m = 0; m < 4; ++m) _Pragma("unroll") for (int n = 0; n < 2; ++n) { \
        if constexpr (F8) asm("v_mfma_f32_16x16x128_f8f6f4 %0, %1, %2, %0" : "+v"(acc[ai][bj][m][n]) : "v"(Bt##8[n]), "v"(At##8[m])); \
        else { _Pragma("unroll") for (int k = 0; k < 2; ++k) acc[ai][bj][m][n] = __builtin_amdgcn_mfma_f32_16x16x32_bf16(Bt[n][k], At[m][k], acc[ai][bj][m][n], 0, 0, 0); } } \
        __builtin_amdgcn_s_setprio(0); } while (0)
#define PG8_WAIT_V(n) asm volatile("s_waitcnt vmcnt(" #n ")" ::: "memory")
#define PG8_WAIT_L(n) asm volatile("s_waitcnt lgkmcnt(" #n ")" ::: "memory")
#define PG8_BAR __builtin_amdgcn_s_barrier()
#define PG8_SCHED __builtin_amdgcn_sched_barrier(0)
    GUnit cur, nxt; int ui = 0;
    if (!S.next(0, cur)) return;
#if GEMM_SKEW
    {
        const unsigned g_ = ((unsigned)blockIdx.x >> 3) % GEMM_SKEW_NG;
        if (g_ != 0u) { const unsigned long long t0_ = __builtin_amdgcn_s_memrealtime(); const unsigned long long dl_ = (unsigned long long)(g_ * (unsigned)(F8 ? GEMM_SKEW : GEMM_SKEW * 3 / 2));
            while (__builtin_amdgcn_s_memrealtime() - t0_ < dl_) __builtin_amdgcn_s_sleep(8); }
    }
#endif
    f32x4 acc[2][2][4][2];
#pragma unroll
    for (int a = 0; a < 2; ++a)
#pragma unroll
        for (int b = 0; b < 2; ++b)
#pragma unroll
            for (int m = 0; m < 4; ++m)
#pragma unroll
                for (int n = 0; n < 2; ++n) acc[a][b][m][n] = (f32x4){0.f, 0.f, 0.f, 0.f};
    bf16x8 At[4][2], B0[2][2], B1[2][2];
    typedef unsigned u32x8 __attribute__((ext_vector_type(8)));
    u32x8 At8[4], B08[2], B18[2];
    const char* cA = cur.a; const char* cB = cur.b; const char* nA = cA;
    PG8_GLOAD(vc, cur);
    PG8_STAGE(PG8_SB(0, 0), cB, voffB); PG8_STAGE_A(PG8_SA(0, 0), 0, (size_t)0, false); PG8_STAGE(PG8_SB(0, 1), cB + hstepB, voffB); PG8_STAGE_A(PG8_SA(0, 1), 1, (size_t)0, false);
    if (wr == 1) PG8_BAR;
    PG8_WAIT_V(4); PG8_BAR;
    PG8_STAGE(PG8_SB(1, 0), cB + kstep, voffB); PG8_STAGE_A(PG8_SA(1, 0), 0, kstep, false); PG8_STAGE(PG8_SB(1, 1), cB + hstepB + kstep, voffB);
    PG8_WAIT_V(6); PG8_BAR;
    for (;;) {
        const bool has_next = S.next(ui + 1, nxt);
        nA = has_next ? nxt.a : cA; const char* nB = has_next ? nxt.b : cB;
        if (has_next) PG8_GLOAD(vn, nxt); else { _Pragma("unroll") for (int _h = 0; _h < 2; ++_h) _Pragma("unroll") for (int _i = 0; _i < 2; ++_i) vn[_h][_i] = vc[_h][_i]; }
#pragma unroll 1
        for (int t = 0; t < nt; t += 2) {
            const bool last = (t == nt - 2);
            const size_t ka1 = (size_t)(t + 1) * kstep, ka2 = last ? (size_t)0 : (size_t)(t + 2) * kstep, ka3 = ka2 + kstep;
            const char* b2 = last ? nB : cB + (size_t)(t + 2) * kstep;
            const char* b3 = b2 + kstep;
            PG8_LDB(B0, 0, 0); PG8_SCHED; PG8_LDA(At, 0, 0); PG8_STAGE_A(PG8_SA(1, 1), 1, ka1, false);
            PG8_WAIT_L(8); PG8_BAR; PG8_WAIT_L(0); PG8_MMA(0, 0, At, B0); PG8_BAR; PG8_SCHED;
            PG8_LDB(B1, 0, 1); PG8_STAGE(PG8_SB(0, 0), b2, voffB);
            PG8_BAR; PG8_WAIT_L(0); PG8_MMA(0, 1, At, B1); PG8_BAR;
            PG8_LDA(At, 0, 1); PG8_STAGE_A(PG8_SA(0, 0), 0, ka2, last);
            PG8_BAR; PG8_WAIT_L(0); PG8_MMA(1, 0, At, B0); PG8_BAR; PG8_SCHED;
            PG8_STAGE(PG8_SB(0, 1), b2 + hstepB, voffB);
            PG8_WAIT_V(6); PG8_BAR; PG8_MMA(1, 1, At, B1); PG8_BAR;
            PG8_LDB(B0, 1, 0); PG8_SCHED; PG8_LDA(At, 1, 0); PG8_STAGE_A(PG8_SA(0, 1), 1, ka2, last);
            PG8_WAIT_L(8); PG8_BAR; PG8_WAIT_L(0); PG8_MMA(0, 0, At, B0); PG8_BAR; PG8_SCHED;
            PG8_LDB(B1, 1, 1); PG8_STAGE(PG8_SB(1, 0), b3, voffB);
            PG8_BAR; PG8_WAIT_L(0); PG8_MMA(0, 1, At, B1); PG8_BAR;
            PG8_LDA(At, 1, 1); PG8_STAGE_A(PG8_SA(1, 0), 0, ka3, last);
            PG8_BAR; PG8_WAIT_L(0); PG8_MMA(1, 0, At, B0); PG8_BAR; PG8_SCHED;
            PG8_STAGE(PG8_SB(1, 1), b3 + hstepB, voffB);
            PG8_WAIT_V(6); PG8_BAR; PG8_MMA(1, 1, At, B1); PG8_BAR;
        }
        if constexpr (F8) asm volatile("s_nop 15\n\ts_nop 15" ::: "memory");
        if (accs != 1.f) {
#pragma unroll
            for (int a = 0; a < 2; ++a)
#pragma unroll
                for (int b = 0; b < 2; ++b)
#pragma unroll
                    for (int m = 0; m < 4; ++m)
#pragma unroll
                        for (int n = 0; n < 2; ++n) acc[a][b][m][n] *= accs;
        }
        E(acc, cur, wr, wc, fr, fq);
        if (!has_next) break;
#pragma unroll
        for (int a = 0; a < 2; ++a)
#pragma unroll
            for (int b = 0; b < 2; ++b)
#pragma unroll
                for (int m = 0; m < 4; ++m)
#pragma unroll
                    for (int n = 0; n < 2; ++n) acc[a][b][m][n] = (f32x4){0.f, 0.f, 0.f, 0.f};
        cur = nxt; cA = nA; cB = nB; ++ui;
#pragma unroll
        for (int _h = 0; _h < 2; ++_h)
#pragma unroll
            for (int _i = 0; _i < 2; ++_i) vc[_h][_i] = vn[_h][_i];
    }
    PG8_WAIT_V(0);
    if (wr == 0) PG8_BAR;
    PG8_BAR;
#undef PG8_SA
#undef PG8_SB
#undef PG8_STAGE
#undef PG8_STAGE_A
#undef PG8_GLOAD
#undef PG8_LDA
#undef PG8_LDB
#undef PG8_MMA
#undef PG8_LD16
#undef PG8_LDA16
#undef PG8_LDB16
#undef PG8_WAIT_V
#undef PG8_WAIT_L
#undef PG8_BAR
#undef PG8_SCHED
}
typedef f32x4 acc_t[2][2][4][2];
#ifndef EPI_NT
#define EPI_NT 0
#endif
__device__ __forceinline__ void est16(void* p, u32x4 v) { if (EPI_NT == 2) { __hip_atomic_store((unsigned long long*)p, ((unsigned long long)v[1] << 32) | v[0], __ATOMIC_RELAXED, __HIP_MEMORY_SCOPE_AGENT); __hip_atomic_store((unsigned long long*)p + 1, ((unsigned long long)v[3] << 32) | v[2], __ATOMIC_RELAXED, __HIP_MEMORY_SCOPE_AGENT); } else if (EPI_NT) __builtin_nontemporal_store(v, (u32x4*)p); else *(u32x4*)p = v; }
__device__ __forceinline__ void est8(void* p, u32x2 v) { if (EPI_NT == 2) __hip_atomic_store((unsigned long long*)p, ((unsigned long long)v[1] << 32) | v[0], __ATOMIC_RELAXED, __HIP_MEMORY_SCOPE_AGENT); else if (EPI_NT) __builtin_nontemporal_store(v, (u32x2*)p); else *(u32x2*)p = v; }
__device__ __forceinline__ void est4(void* p, unsigned v) { if (EPI_NT == 2) __hip_atomic_store((unsigned*)p, v, __ATOMIC_RELAXED, __HIP_MEMORY_SCOPE_AGENT); else if (EPI_NT) __builtin_nontemporal_store(v, (unsigned*)p); else *(unsigned*)p = v; }

__device__ __forceinline__ u32x4 pack8(f32x4 a, f32x4 b) { return (u32x4){cvt_pk_bf16(a[0], a[1]), cvt_pk_bf16(a[2], a[3]), cvt_pk_bf16(b[0], b[1]), cvt_pk_bf16(b[2], b[3])}; }
__device__ __forceinline__ void unpack8(u32x4 v, float* f) { f[0] = bf_lo(v[0]); f[1] = bf_hi(v[0]); f[2] = bf_lo(v[1]); f[3] = bf_hi(v[1]); f[4] = bf_lo(v[2]); f[5] = bf_hi(v[2]); f[6] = bf_lo(v[3]); f[7] = bf_hi(v[3]); }

template <bool MASK> struct EpiPlain {
    bf16_t* O; int ldo; float scale;
    __device__ __forceinline__ void operator()(const acc_t& acc, const GUnit& u, int wr, int wc, int fr, int fq) const {
        const int colb = u.pn * 256 + wc * 32 + fq * 8;
#pragma unroll
        for (int ai = 0; ai < 2; ++ai)
#pragma unroll
            for (int m = 0; m < 4; ++m) {
                const int r = ai * 128 + wr * 64 + m * 16 + fr;
                if (MASK && r >= u.nrows) continue;
                bf16_t* rowp = O + (size_t)(u.row0 + r) * ldo + colb;
#pragma unroll
                for (int bj = 0; bj < 2; ++bj) est16(rowp + bj * 128, pack8(acc[ai][bj][m][0] * scale, acc[ai][bj][m][1] * scale));
            }
    }
};

struct EpiResid {
    float* XF; const float* XR;
    __device__ __forceinline__ void operator()(const acc_t& acc, const GUnit& u, int wr, int wc, int fr, int fq) const {
        const int colb = u.pn * 256 + wc * 32 + fq * 8;
#pragma unroll
        for (int ai = 0; ai < 2; ++ai)
#pragma unroll
            for (int m = 0; m < 4; ++m) {
                const int r = ai * 128 + wr * 64 + m * 16 + fr;
                float* rowp = XF + (size_t)(u.row0 + r) * 1024 + colb; const float* rrow = XR + (size_t)(u.row0 + r) * 1024 + colb;
                asm volatile("" ::: "memory");
#pragma unroll
                for (int bj = 0; bj < 2; ++bj) {
                    const f32x4 x0 = *(const f32x4*)(rrow + bj * 128), x1 = *(const f32x4*)(rrow + bj * 128 + 4);
                    *(f32x4*)(rowp + bj * 128) = x0 * DN_ALPHA + acc[ai][bj][m][0]; *(f32x4*)(rowp + bj * 128 + 4) = x1 * DN_ALPHA + acc[ai][bj][m][1];
                }
            }
    }
};

__device__ __forceinline__ float clamp8(float x) { return __builtin_amdgcn_fmed3f(x, -448.f, 448.f); }
__device__ __forceinline__ u32x2 pack8_fp8(const float* f) {
    unsigned a = 0u, b = 0u;
    a = __builtin_amdgcn_cvt_pk_fp8_f32(clamp8(f[0]), clamp8(f[1]), a, false); a = __builtin_amdgcn_cvt_pk_fp8_f32(clamp8(f[2]), clamp8(f[3]), a, true);
    b = __builtin_amdgcn_cvt_pk_fp8_f32(clamp8(f[4]), clamp8(f[5]), b, false); b = __builtin_amdgcn_cvt_pk_fp8_f32(clamp8(f[6]), clamp8(f[7]), b, true);
    return (u32x2){a, b};
}
__device__ __forceinline__ void unpack8_fp8(u32x2 v, float* f) {
    const f32x2 a = __builtin_amdgcn_cvt_pk_f32_fp8(v[0], false), b = __builtin_amdgcn_cvt_pk_f32_fp8(v[0], true), c = __builtin_amdgcn_cvt_pk_f32_fp8(v[1], false), d = __builtin_amdgcn_cvt_pk_f32_fp8(v[1], true);
    f[0] = a[0]; f[1] = a[1]; f[2] = b[0]; f[3] = b[1]; f[4] = c[0]; f[5] = c[1]; f[6] = d[0]; f[7] = d[1]; }
__device__ __forceinline__ unsigned pack4_fp8(float a, float b, float c, float d) { unsigned r = 0u;
    r = __builtin_amdgcn_cvt_pk_fp8_f32(clamp8(a), clamp8(b), r, false); r = __builtin_amdgcn_cvt_pk_fp8_f32(clamp8(c), clamp8(d), r, true); return r; }
__device__ __forceinline__ int vperm32(int s) { const int k = s & 31; return (s & ~31) + 8 * ((k >> 2) & 3) + 4 * (k >> 4) + (k & 3); }
struct EpiMoeDown8 {
    unsigned char* O; float scale; bool skip;
    __device__ __forceinline__ void operator()(const acc_t& acc, const GUnit& u, int wr, int wc, int fr, int fq) const {
#if defined(EXP_F4_NOEPI)
        if (skip) {
        _Pragma("unroll") for (int ai = 0; ai < 2; ++ai) _Pragma("unroll") for (int bj = 0; bj < 2; ++bj) _Pragma("unroll") for (int m = 0; m < 4; ++m) _Pragma("unroll") for (int n = 0; n < 2; ++n) asm volatile("" :: "v"(acc[ai][bj][m][n]));
        return; }
#endif
        const int colb = u.pn * 256 + wc * 32 + fq * 8;
#pragma unroll
        for (int ai = 0; ai < 2; ++ai)
#pragma unroll
            for (int m = 0; m < 4; ++m) {
                const int r = ai * 128 + wr * 64 + m * 16 + fr;
                if (r >= u.nrows) continue;
                unsigned char* rowp = O + (size_t)(u.row0 + r) * 1024 + colb;
#pragma unroll
                for (int bj = 0; bj < 2; ++bj) { const f32x4 v0 = acc[ai][bj][m][0] * scale, v1 = acc[ai][bj][m][1] * scale;
                    const float f[8] = {v0[0], v0[1], v0[2], v0[3], v1[0], v1[1], v1[2], v1[3]};
#if defined(EXP_F4_NOSTORE)
                    if (skip) { const u32x2 pk_ = pack8_fp8(f); asm volatile("" :: "v"(pk_), "v"(rowp)); continue; }
#endif
                    est8(rowp + bj * 128, pack8_fp8(f)); }
            }
    }
};
struct EpiMoeDown16 {
    unsigned char* O; float scale;
    __device__ __forceinline__ void operator()(const acc_t& acc, const GUnit& u, int wr, int wc, int fr, int fq) const {
        const int colb = u.pn * 256 + wc * 64 + fq * 16;
#pragma unroll
        for (int ai = 0; ai < 2; ++ai)
#pragma unroll
            for (int m = 0; m < 4; ++m) {
                const int r = ai * 128 + wr * 64 + m * 16 + fr;
                if (r >= u.nrows) continue;
                u32x4 pk;
#pragma unroll
                for (int bj = 0; bj < 2; ++bj)
#pragma unroll
                    for (int n = 0; n < 2; ++n) { const f32x4 v = acc[ai][bj][m][n] * scale; pk[2 * bj + n] = pack4_fp8(v[0], v[1], v[2], v[3]); }
                est16(O + (size_t)(u.row0 + r) * 1024 + colb, pk);
            }
    }
};
struct EpiMoeGU {
    unsigned char* O;
    __device__ __forceinline__ void operator()(const acc_t& acc, const GUnit& u, int wr, int wc, int fr, int fq) const {
        const int colb = u.pn * 128 + wc * 32 + fq * 8;
#pragma unroll
        for (int ai = 0; ai < 2; ++ai)
#pragma unroll
            for (int m = 0; m < 4; ++m) {
                const int r = ai * 128 + wr * 64 + m * 16 + fr;
                if (r >= u.nrows) continue;
                float h[8];
                constexpr float DS = 1.f / (S8_X * S8_WGU), C1 = -DS * LOG2E, IC2 = 1.f / (DS * DS * S8_H);
#pragma unroll
                for (int bj = 0; bj < 2; ++bj)
#pragma unroll
                    for (int jp = 0; jp < 2; ++jp) {
                        const f32x2 g = {acc[ai][bj][m][0][2 * jp], acc[ai][bj][m][0][2 * jp + 1]}, uu = {acc[ai][bj][m][1][2 * jp], acc[ai][bj][m][1][2 * jp + 1]};
                        const f32x2 t = g * uu, a = g * (f32x2){C1, C1};
                        const f32x2 e = {__builtin_amdgcn_exp2f(a[0]), __builtin_amdgcn_exp2f(a[1])};
                        const f32x2 d = __builtin_elementwise_fma(e, (f32x2){IC2, IC2}, (f32x2){IC2, IC2});
                        const f32x2 rr = {__builtin_amdgcn_rcpf(d[0]), __builtin_amdgcn_rcpf(d[1])};
                        const f32x2 hh = t * rr;
                        h[bj * 4 + 2 * jp] = hh[0]; h[bj * 4 + 2 * jp + 1] = hh[1];
                    }
                est8(O + (size_t)(u.row0 + r) * 1024 + colb, pack8_fp8(h));
            }
    }
};

struct EpiScIn {
    bf16_t* P; bf16_t* BG; float sc;
    __device__ __forceinline__ void operator()(const acc_t& acc, const GUnit& u, int wr, int wc, int fr, int fq) const {
        if (u.pn < 8) {
            const int colb = u.pn * 128 + wc * 32 + fq * 8;
            const float s2 = sc * sc;
#pragma unroll
            for (int ai = 0; ai < 2; ++ai)
#pragma unroll
                for (int m = 0; m < 4; ++m) {
                    const int r = ai * 128 + wr * 64 + m * 16 + fr;
                    est16(P + (size_t)(u.row0 + r) * 1024 + colb, pack8(acc[ai][0][m][0] * acc[ai][0][m][1] * s2, acc[ai][1][m][0] * acc[ai][1][m][1] * s2));
                }
        } else {
            const int colb = (u.pn - 8) * 256 + wc * 32 + fq * 8;
#pragma unroll
            for (int ai = 0; ai < 2; ++ai)
#pragma unroll
                for (int m = 0; m < 4; ++m) {
                    const int r = ai * 128 + wr * 64 + m * 16 + fr;
                    bf16_t* rowp = BG + (size_t)(u.row0 + r) * 1024 + colb;
#pragma unroll
                    for (int bj = 0; bj < 2; ++bj) est16(rowp + bj * 128, pack8(acc[ai][bj][m][0] * sc, acc[ai][bj][m][1] * sc));
                }
        }
    }
};

struct EpiLruIn {
    bf16_t* GG; bf16_t* REC; float sc;
    __device__ __forceinline__ void operator()(const acc_t& acc, const GUnit& u, int wr, int wc, int fr, int fq) const {
        const bool isg = u.pn < 5;
        bf16_t* O = GG + (isg ? 0l : (REC - GG));
        const int colb = (isg ? u.pn : u.pn - 5) * 256 + wc * 32 + fq * 8;
        constexpr float CG = -2.f * 0.7978845608028654f * LOG2E, CG3 = CG * 0.044715f;
        const f32x2 sc2 = {sc, sc};
#pragma unroll
        for (int ai = 0; ai < 2; ++ai)
#pragma unroll
            for (int m = 0; m < 4; ++m) {
                const int r = ai * 128 + wr * 64 + m * 16 + fr;
                bf16_t* rowp = O + (size_t)(u.row0 + r) * LRU_W + colb;
#pragma unroll
                for (int bj = 0; bj < 2; ++bj) {
                    f32x4 v[2];
#pragma unroll
                    for (int n = 0; n < 2; ++n)
#pragma unroll
                        for (int jp = 0; jp < 2; ++jp) {
                            f32x2 x = (f32x2){acc[ai][bj][m][n][2 * jp], acc[ai][bj][m][n][2 * jp + 1]} * sc2;
                            if (isg) {
                                const f32x2 p = __builtin_elementwise_fma(x * x, (f32x2){CG3, CG3}, (f32x2){CG, CG});
                                const f32x2 a = p * x;
                                const f32x2 d = (f32x2){__builtin_amdgcn_exp2f(a[0]), __builtin_amdgcn_exp2f(a[1])} + (f32x2){1.f, 1.f};
                                x = x * (f32x2){__builtin_amdgcn_rcpf(d[0]), __builtin_amdgcn_rcpf(d[1])};
                            }
                            v[n][2 * jp] = x[0]; v[n][2 * jp + 1] = x[1];
                        }
                    est16(rowp + bj * 128, pack8(v[0], v[1]));
                }
            }
    }
};

struct EpiLruGate {
    const bf16_t* U; bf16_t* LOGA; bf16_t* BIN; const float* ba; const float* bx; const float* lam;
    __device__ __forceinline__ void operator()(const acc_t& acc, const GUnit& u, int wr, int wc, int fr, int fq) const {
        const int ch0 = u.pn * 128 + wc * 32 + fq * 8;
        float ba8[8], bx8[8], ls8[8];
#pragma unroll
        for (int i = 0; i < 8; ++i) { ba8[i] = -LOG2E * ba[ch0 + i]; bx8[i] = -LOG2E * bx[ch0 + i]; const float l = lam[ch0 + i]; ls8[i] = -8.f * log1pf(__expf(-l)); }
        const f32x2 nl2 = {-LOG2E, -LOG2E}, one2 = {1.f, 1.f}, l22 = {2.f * LOG2E, 2.f * LOG2E};
#pragma unroll
        for (int ai = 0; ai < 2; ++ai)
#pragma unroll
            for (int m = 0; m < 4; ++m) {
                const int r = ai * 128 + wr * 64 + m * 16 + fr;
                const size_t off = (size_t)(u.row0 + r) * LRU_W + ch0;
                float u8[8]; unpack8(ld16(U + off), u8);
                f32x4 la[2], bi[2];
#pragma unroll
                for (int bj = 0; bj < 2; ++bj)
#pragma unroll
                    for (int jp = 0; jp < 2; ++jp) {
                        const int i = bj * 4 + 2 * jp;
                        const f32x2 a0 = __builtin_elementwise_fma((f32x2){acc[ai][bj][m][0][2 * jp], acc[ai][bj][m][0][2 * jp + 1]}, nl2, (f32x2){ba8[i], ba8[i + 1]});
                        const f32x2 a1 = __builtin_elementwise_fma((f32x2){acc[ai][bj][m][1][2 * jp], acc[ai][bj][m][1][2 * jp + 1]}, nl2, (f32x2){bx8[i], bx8[i + 1]});
                        const f32x2 d0 = (f32x2){__builtin_amdgcn_exp2f(a0[0]), __builtin_amdgcn_exp2f(a0[1])} + one2;
                        const f32x2 d1 = (f32x2){__builtin_amdgcn_exp2f(a1[0]), __builtin_amdgcn_exp2f(a1[1])} + one2;
                        const f32x2 rg = {__builtin_amdgcn_rcpf(d0[0]), __builtin_amdgcn_rcpf(d0[1])}, ig = {__builtin_amdgcn_rcpf(d1[0]), __builtin_amdgcn_rcpf(d1[1])};
                        const f32x2 l = rg * (f32x2){ls8[i], ls8[i + 1]};
                        const f32x2 e2 = l * l22;
                        const f32x2 om = one2 - (f32x2){__builtin_amdgcn_exp2f(e2[0]), __builtin_amdgcn_exp2f(e2[1])};
                        const f32x2 sq = {__builtin_sqrtf(fmaxf(om[0], 0.f)), __builtin_sqrtf(fmaxf(om[1], 0.f))};
                        const f32x2 b = sq * ig * (f32x2){u8[i], u8[i + 1]};
                        la[bj][2 * jp] = l[0]; la[bj][2 * jp + 1] = l[1]; bi[bj][2 * jp] = b[0]; bi[bj][2 * jp + 1] = b[1];
                    }
                est16(LOGA + off, pack8(la[0], la[1]));
                est16(BIN + off, pack8(bi[0], bi[1]));
            }
    }
};

struct EpiNsaIn {
    unsigned char* Q; bf16_t* KC; bf16_t* VC; unsigned char* KS; unsigned char* VST; unsigned char* KW; unsigned char* VWT; float* GATES; const int* pos; const float* bgate; float sc; bool exp_;
    __device__ __forceinline__ void operator()(const acc_t& acc, const GUnit& u, int wr, int wc, int fr, int fq) const {
        const int pn = u.pn;
        if (pn <= 3 || pn == 6 || pn == 8) {
            unsigned char* O = Q + (pn <= 3 ? 0l : (pn == 6 ? (KS - Q) : (KW - Q)));
            const int ldo = pn <= 3 ? 1024 : 256;
            const int colbase = pn <= 3 ? pn * 256 : 0;
            const float scale = (pn <= 3 ? 0.125f * LOG2E * S8_Q : S8_K) * sc;
            float invf[4];
#pragma unroll
            for (int jj = 0; jj < 4; ++jj) invf[jj] = exp2f(-(float)(16 * (wc & 1) + 4 * fq + jj) * (13.287712379549449f / 32.f));
#pragma unroll
            for (int ai = 0; ai < 2; ++ai)
#pragma unroll
                for (int m = 0; m < 4; ++m) {
                    const int row = u.row0 + ai * 128 + wr * 64 + m * 16 + fr;
                    const float p = (float)pos[row];
                    float sn[4], cs[4];
#pragma unroll
                    for (int jj = 0; jj < 4; ++jj) { sincos_rad(p * invf[jj], sn[jj], cs[jj]); sn[jj] *= scale; cs[jj] *= scale; }
#pragma unroll
                    for (int bj = 0; bj < 2; ++bj) {
                        const f32x4 x1 = acc[ai][bj][m][0], x2 = acc[ai][bj][m][1];
                        float o1[4], o2[4];
#pragma unroll
                        for (int jp = 0; jp < 2; ++jp) {
                            const f32x2 a1 = {x1[2 * jp], x1[2 * jp + 1]}, a2 = {x2[2 * jp], x2[2 * jp + 1]}, c2 = {cs[2 * jp], cs[2 * jp + 1]}, s2 = {sn[2 * jp], sn[2 * jp + 1]};
                            const f32x2 r1 = __builtin_elementwise_fma(a1, c2, -(a2 * s2)), r2 = __builtin_elementwise_fma(a1, s2, a2 * c2);
                            o1[2 * jp] = r1[0]; o1[2 * jp + 1] = r1[1]; o2[2 * jp] = r2[0]; o2[2 * jp + 1] = r2[1];
                        }
                        unsigned char* p1 = O + (size_t)row * ldo + colbase + 64 * (2 * bj + (wc >> 1)) + 16 * (wc & 1) + 4 * fq;
                        est4(p1, pack4_fp8(o1[0], o1[1], o1[2], o1[3]));
                        est4(p1 + 32, pack4_fp8(o2[0], o2[1], o2[2], o2[3]));
                    }
                }
        } else if (pn == 4 || pn == 5) {
            bf16_t* O = KC + (pn == 4 ? 0l : (VC - KC));
            const int colb = wc * 32 + fq * 8;
#pragma unroll
            for (int ai = 0; ai < 2; ++ai)
#pragma unroll
                for (int m = 0; m < 4; ++m) {
                    const int row = u.row0 + ai * 128 + wr * 64 + m * 16 + fr;
#pragma unroll
                    for (int bj = 0; bj < 2; ++bj) est16(O + (size_t)row * 256 + colb + bj * 128, pack8(acc[ai][bj][m][0] * sc, acc[ai][bj][m][1] * sc));
                }
        } else if (pn == 7 || pn == 9) {
            unsigned char* O = VST + (pn == 7 ? 0l : (VWT - VST));
#pragma unroll
            for (int ai = 0; ai < 2; ++ai)
#pragma unroll
                for (int m = 0; m < 4; ++m) {
                    const int row = u.row0 + ai * 128 + wr * 64 + m * 16 + fr;
                    const int b = row >> 11, s = vperm32(row & 2047);
#pragma unroll
                    for (int bj = 0; bj < 2; ++bj) {
                        const int g = 2 * bj + (wc >> 1);
                        unsigned char* base = O + ((size_t)(b * 4 + g) * 64 + 32 * (wc & 1) + 8 * fq) * SEQ + s;
#pragma unroll
                        for (int n = 0; n < 2; ++n) { const f32x4 vv = acc[ai][bj][m][n] * sc; const unsigned pk = pack4_fp8(vv[0], vv[1], vv[2], vv[3]);
#pragma unroll
                            for (int jj = 0; jj < 4; ++jj) {
#if defined(EXP_N1_NOVT)
                                if (exp_) { asm volatile("" :: "v"(pk), "v"(base)); continue; }
#endif
                                base[(size_t)(4 * n + jj) * SEQ] = (unsigned char)((pk >> (8 * jj)) & 0xffu); } }
                    }
                }
        } else {
            if (wc < 2 && (wc == 0 || fq < 2)) {
                const int c0 = 32 * wc + 8 * fq;
                f32x4 bg[2];
#pragma unroll
                for (int n = 0; n < 2; ++n) bg[n] = *(const f32x4*)(bgate + c0 + 4 * n);
#pragma unroll
                for (int ai = 0; ai < 2; ++ai)
#pragma unroll
                    for (int m = 0; m < 4; ++m) {
                        const int row = u.row0 + ai * 128 + wr * 64 + m * 16 + fr;
#pragma unroll
                        for (int n = 0; n < 2; ++n) {
                            f32x4 v;
#pragma unroll
                            for (int jj = 0; jj < 4; ++jj) v[jj] = sigmoidf_(acc[ai][0][m][n][jj] * sc + bg[n][jj]);
                            *(f32x4*)(GATES + (size_t)row * 48 + c0 + 4 * n) = v;
                        }
                    }
            }
        }
    }
};
__device__ __forceinline__ int map_plain8(int cc) { const int bj = cc >> 7, wc = (cc >> 5) & 3, n = (cc >> 4) & 1, fq = (cc >> 2) & 3; return 128 * bj + 32 * wc + 8 * fq + 4 * n; }
__device__ __forceinline__ int map_rope(int cc) { const int bj = cc >> 7, wc = (cc >> 5) & 3, n = (cc >> 4) & 1, fq = (cc >> 2) & 3; return 64 * (2 * bj + (wc >> 1)) + 32 * n + 16 * (wc & 1) + 4 * fq; }
__device__ __forceinline__ void map_pair(int cc, int& n, int& ch) { const int bj = cc >> 7, wc = (cc >> 5) & 3, fq = (cc >> 2) & 3; n = (cc >> 4) & 1; ch = 32 * wc + 8 * fq + 4 * bj; }
constexpr f32x4 F4ZERO = {0.f, 0.f, 0.f, 0.f};

struct FetchNsaIn { const float* W;
    __device__ __forceinline__ f32x4 operator()(int, int c4, int k) const { const int pn = c4 >> 8, cc = c4 & 255; const bool rope = (pn <= 3 || pn == 6 || pn == 8);
        const int col = pn * 256 + (rope ? map_rope(cc) : map_plain8(cc)); if (col >= 2608) return F4ZERO; return *(const f32x4*)(W + (size_t)k * 2608 + col); } };
struct FetchPlain { const float* W; int ld; size_t bstride;
    __device__ __forceinline__ f32x4 operator()(int bt, int c4, int k) const { const int col = (c4 & ~255) + map_plain8(c4 & 255); return *(const f32x4*)(W + (size_t)bt * bstride + (size_t)k * ld + col); } };
__device__ __forceinline__ int map_plain16(int cc) { const int bj = cc >> 7, wc = (cc >> 5) & 3, n = (cc >> 4) & 1, fq = (cc >> 2) & 3; return 64 * wc + 16 * fq + 8 * bj + 4 * n; }
struct FetchPlain16 { const float* W; int ld; size_t bstride;
    __device__ __forceinline__ f32x4 operator()(int bt, int c4, int k) const { const int col = (c4 & ~255) + map_plain16(c4 & 255); return *(const f32x4*)(W + (size_t)bt * bstride + (size_t)k * ld + col); } };
struct FetchPair { const float* W0; long d01; int ld; size_t bstride;
    __device__ __forceinline__ f32x4 operator()(int bt, int c4, int k) const { int n, ch; map_pair(c4 & 255, n, ch); ch += (c4 >> 8) * 128; return *(const f32x4*)(W0 + (n ? d01 : 0l) + (long)((size_t)bt * bstride + (size_t)k * ld + ch)); } };
struct FetchScIn { const float* W;
    __device__ __forceinline__ f32x4 operator()(int, int c4, int k) const { const int pn = c4 >> 8, cc = c4 & 255;
        if (pn < 8) { int n, ch; map_pair(cc, n, ch); ch += pn * 128; return *(const f32x4*)(W + (size_t)k * 3072 + (n ? 2048 : 0) + ch); }
        return *(const f32x4*)(W + (size_t)k * 3072 + 1024 + (pn - 8) * 256 + map_plain8(cc)); } };
struct FetchLruGate { const float* wa; long dax;
    __device__ __forceinline__ f32x4 operator()(int, int c4, int k) const { int n, ch; map_pair(c4 & 255, n, ch); ch += (c4 >> 8) * 128; const int h = ch / 80; if (k / 80 != h) return F4ZERO;
        return *(const f32x4*)(wa + (n ? dax : 0l) + (long)(h * 6400 + (k - 80 * h) * 80 + (ch - 80 * h))); } };
struct FetchIdent { const float* W; int ld; size_t bstride;
    __device__ __forceinline__ f32x4 operator()(int bt, int c4, int k) const { return *(const f32x4*)(W + (size_t)bt * bstride + (size_t)k * ld + c4); } };

template <bool OUT8 = false, class F>
__device__ __forceinline__ void convert_wt(LAS unsigned char* lds, void* dstv, int nbatch, int Nd, int K, const F& fetch, const float scale = 1.f, const int boff = 0  ) {
    constexpr int GRP = 8;
    LAS float* tile = (LAS float*)lds;
    const int tid = tid_opaque();
    const int ntk = K / 64, ntc = Nd / 64, per = ntc * ntk, total = per * nbatch;
    const bool split = (Nd & 255) == 0;
    const int c4i = tid & 15, kk = tid >> 4, rr4 = 4 * c4i, row = tid >> 3, k8 = (tid & 7) * 8;
    const int bid = (int)((blockIdx.x + (unsigned)boff) % gridDim.x);
    for (int t0 = bid * GRP; t0 < total; t0 += gridDim.x * GRP) {
        f32x4 v[GRP][2];
#pragma unroll
        for (int gi = 0; gi < GRP; ++gi) {
            const int t = t0 + gi;
            if (t < total) {
                const int bt = t / per, tt = t - bt * per, tc = tt / ntk, tk = tt - tc * ntk, k0 = tk * 64;
                const int cbase = split ? (tc >> 2) * 256 + (tc & 3) * 32 : tc * 64;
                const int crow4 = cbase + (split ? ((rr4 & 31) + (rr4 >> 5) * 128) : rr4);
#pragma unroll
                for (int p = 0; p < 2; ++p) v[gi][p] = fetch(bt, crow4, k0 + kk + 32 * p);
            }
        }
        __syncthreads();
#pragma unroll
        for (int gi = 0; gi < GRP; ++gi)
            if (t0 + gi < total) {
#pragma unroll
                for (int p = 0; p < 2; ++p)
#pragma unroll
                    for (int j = 0; j < 4; ++j) tile[gi * 4160 + (4 * c4i + j) * 65 + kk + 32 * p] = v[gi][p][j];
            }
        __syncthreads();
#pragma unroll
        for (int gi = 0; gi < GRP; ++gi) {
            const int t = t0 + gi;
            if (t < total) {
                const int bt = t / per, tt = t - bt * per, tc = tt / ntk, tk = tt - tc * ntk, k0 = tk * 64;
                const int cbase = split ? (tc >> 2) * 256 + (tc & 3) * 32 : tc * 64;
                const int crow = cbase + (split ? ((row & 31) + (row >> 5) * 128) : row);
                float f[8];
#pragma unroll
                for (int i = 0; i < 8; ++i) f[i] = tile[gi * 4160 + row * 65 + k8 + i];
                if constexpr (OUT8) {
#pragma unroll
                    for (int i = 0; i < 8; ++i) f[i] *= scale;
                    *(u32x2*)((unsigned char*)dstv + ((size_t)bt * Nd + crow) * K + k0 + k8) = pack8_fp8(f);
                } else st16((bf16_t*)dstv + ((size_t)bt * Nd + crow) * K + k0 + k8, (u32x4){cvt_pk_bf16(f[0], f[1]), cvt_pk_bf16(f[2], f[3]), cvt_pk_bf16(f[4], f[5]), cvt_pk_bf16(f[6], f[7])});
            }
        }
    }
    __syncthreads();
}

template <bool X8OUT>
__device__ __forceinline__ void convert_x(const float* x, unsigned char* XA) {
    const size_t n8 = (size_t)T_TOK * DM / 8;
    const int tidx = tid_opaque();
    const size_t step = (size_t)gridDim.x * NTHR;
    size_t i = (size_t)blockIdx.x * NTHR + tidx;
    for (; i + 7 * step < n8; i += 8 * step) {
        f32x4 a[8], b[8];
#pragma unroll
        for (int j = 0; j < 8; ++j) { a[j] = *(const f32x4*)(x + (i + j * step) * 8); b[j] = *(const f32x4*)(x + (i + j * step) * 8 + 4); }
#pragma unroll
        for (int j = 0; j < 8; ++j) {
            if constexpr (X8OUT) { const f32x4 aa = a[j] * S8_X, bb = b[j] * S8_X; const float f[8] = {aa[0], aa[1], aa[2], aa[3], bb[0], bb[1], bb[2], bb[3]}; *(u32x2*)(XA + (i + j * step) * 8) = pack8_fp8(f); }
            else st16((bf16_t*)XA + (i + j * step) * 8, pack8(a[j], b[j]));
        }
    }
    for (; i < n8; i += step) {
        if constexpr (X8OUT) {
            const f32x4 a = *(const f32x4*)(x + i * 8) * S8_X, b = *(const f32x4*)(x + i * 8 + 4) * S8_X;
            const float f[8] = {a[0], a[1], a[2], a[3], b[0], b[1], b[2], b[3]};
            *(u32x2*)(XA + i * 8) = pack8_fp8(f);
        } else { const f32x4 a = *(const f32x4*)(x + i * 8), b = *(const f32x4*)(x + i * 8 + 4); st16((bf16_t*)XA + i * 8, pack8(a, b)); }
    }
}
__device__ __forceinline__ void cmp_bias_phase(LAS unsigned char* lds, const float* pek, const float* w1k, const float* pev, const float* w1v, float* bias1) {
    LAS float* red = (LAS float*)lds;
    const int tidx = tid_opaque();
    for (int blk = (int)((blockIdx.x + 160u) % gridDim.x); blk < 32; blk += gridDim.x) {
        const int v = blk >> 3, j = v >> 1, kv = v & 1, hid = (blk & 7) * 8 + (tidx & 7), part = tidx >> 3;
        const float* pe = pek + (kv ? (pev - pek) : 0l) + j * 2048; const float* w1 = w1k + (kv ? (w1v - w1k) : 0l) + (size_t)j * 2048 * 64;
        float s = 0.f;
#pragma unroll 8
        for (int i = part * 32; i < part * 32 + 32; ++i) s += pe[i] * w1[i * 64 + hid];
        __syncthreads();
        red[part * 8 + (tidx & 7)] = s;
        __syncthreads();
        if (tidx < 8) { float t = 0.f; for (int q = 0; q < 64; ++q) t += red[q * 8 + tidx]; bias1[v * 64 + (blk & 7) * 8 + tidx] = t; }
    }
    __syncthreads();
}

template <bool F32IN>
__device__ __forceinline__ void ln1_router_phase(LAS unsigned char* lds, const void* XRv  , const bf16_t* MBm, bf16_t* XW  , unsigned char* X8, const float* gam, const float* bet,
                                                 const float* rw, const float* rb, int* route_e, float* route_w, int* cnt) {
    LAS f32x4* rwl = (LAS f32x4*)lds;
    LAS int* lcnt = (LAS int*)(lds + 65536);
    const int tid = tid_opaque(), lane = tid & 63, w = tid >> 6;
    const float rbl = rb[lane >> 2];
    __syncthreads();
    for (int i = tid; i < 4096; i += NTHR) { const int col = i >> 2, q = i & 3; const int seg = col >> 9, ln = (col >> 3) & 63, j = col & 7;
        rwl[((q * 2 + seg) * 8 + j) * 64 + ln] = *(const f32x4*)(rw + col * 16 + 4 * q); }
    f32x4 gmr[2][2], btr[2][2];
#pragma unroll
    for (int sg = 0; sg < 2; ++sg) { gmr[sg][0] = *(const f32x4*)(gam + sg * 512 + lane * 8); gmr[sg][1] = *(const f32x4*)(gam + sg * 512 + lane * 8 + 4);
        btr[sg][0] = *(const f32x4*)(bet + sg * 512 + lane * 8); btr[sg][1] = *(const f32x4*)(bet + sg * 512 + lane * 8 + 4); }
    for (int chunk = blockIdx.x; chunk < 256; chunk += gridDim.x) {
        __syncthreads();
        if (tid < 16) lcnt[tid] = 0;
        __syncthreads();
        const size_t row0 = (size_t)chunk * 256 + w * 32;
        const float* XF = (const float*)XRv; const bf16_t* XH = (const bf16_t*)XRv;
        f32x4 nx[2][4]; u32x4 nh[2][2], nm[2][2];
#pragma unroll
        for (int rr = 0; rr < 2; ++rr)
#pragma unroll
            for (int sg = 0; sg < 2; ++sg) {
                if constexpr (F32IN) { nx[rr][sg * 2] = *(const f32x4*)(XF + (row0 + rr) * DM + sg * 512 + lane * 8); nx[rr][sg * 2 + 1] = *(const f32x4*)(XF + (row0 + rr) * DM + sg * 512 + lane * 8 + 4); }
                else nh[rr][sg] = ld16(XH + (row0 + rr) * DM + sg * 512 + lane * 8);
                nm[rr][sg] = ld16(MBm + (row0 + rr) * DM + sg * 512 + lane * 8); }
        for (int i = 0; i < 32; i += 2) {
            f32x2 y2[16];
            {
                float xv[2][16];
#pragma unroll
                for (int rr = 0; rr < 2; ++rr) {
#pragma unroll
                    for (int sg = 0; sg < 2; ++sg) { float mv[8]; unpack8(nm[rr][sg], mv);
                        if constexpr (F32IN) {
#pragma unroll
                            for (int j = 0; j < 4; ++j) { xv[rr][sg * 8 + j] = DN_ALPHA * nx[rr][sg * 2][j] + mv[j]; xv[rr][sg * 8 + 4 + j] = DN_ALPHA * nx[rr][sg * 2 + 1][j] + mv[4 + j]; }
                        } else { float hv[8]; unpack8(nh[rr][sg], hv);
#pragma unroll
                            for (int j = 0; j < 8; ++j) xv[rr][sg * 8 + j] = DN_ALPHA * hv[j] + mv[j]; } }
                }
                if (i + 2 < 32) {
#pragma unroll
                    for (int rr = 0; rr < 2; ++rr)
#pragma unroll
                        for (int sg = 0; sg < 2; ++sg) {
                            if constexpr (F32IN) { nx[rr][sg * 2] = *(const f32x4*)(XF + (row0 + i + 2 + rr) * DM + sg * 512 + lane * 8); nx[rr][sg * 2 + 1] = *(const f32x4*)(XF + (row0 + i + 2 + rr) * DM + sg * 512 + lane * 8 + 4); }
                            else nh[rr][sg] = ld16(XH + (row0 + i + 2 + rr) * DM + sg * 512 + lane * 8);
                            nm[rr][sg] = ld16(MBm + (row0 + i + 2 + rr) * DM + sg * 512 + lane * 8); }
                }
                float mean[2], rstd[2];
#pragma unroll
                for (int rr = 0; rr < 2; ++rr) { float s = 0.f;
#pragma unroll
                    for (int j = 0; j < 16; ++j) s += xv[rr][j];
                    mean[rr] = wave_sum_dpp(s) * (1.f / 1024.f); }
#pragma unroll
                for (int rr = 0; rr < 2; ++rr) { float q = 0.f;
#pragma unroll
                    for (int j = 0; j < 16; ++j) { const float d = xv[rr][j] - mean[rr]; q += d * d; }
                    rstd[rr] = rsqrtf(wave_sum_dpp(q) * (1.f / 1024.f) + LN_EPS); }
#pragma unroll
                for (int sg = 0; sg < 2; ++sg) {
                    const f32x4 ga = gmr[sg][0], gb = gmr[sg][1], ba = btr[sg][0], bb = btr[sg][1];
#pragma unroll
                    for (int rr = 0; rr < 2; ++rr) {
                        f32x4 o0, o1;
#pragma unroll
                        for (int j = 0; j < 4; ++j) { o0[j] = (xv[rr][sg * 8 + j] - mean[rr]) * rstd[rr] * ga[j] + ba[j]; o1[j] = (xv[rr][sg * 8 + 4 + j] - mean[rr]) * rstd[rr] * gb[j] + bb[j];
                            y2[sg * 8 + j][rr] = o0[j]; y2[sg * 8 + 4 + j][rr] = o1[j]; }
                        st16(XW + (row0 + i + rr) * DM + sg * 512 + lane * 8, pack8(o0, o1));
                        { const f32x4 a8 = o0 * S8_X, b8 = o1 * S8_X; const float f8[8] = {a8[0], a8[1], a8[2], a8[3], b8[0], b8[1], b8[2], b8[3]};
                          *(u32x2*)(X8 + (row0 + i + rr) * DM + sg * 512 + lane * 8) = pack8_fp8(f8); }
                    }
                }
            }
            f32x2 lg2[16];
#pragma unroll
            for (int e = 0; e < 16; ++e) lg2[e] = (f32x2){0.f, 0.f};
            f32x4 wc[2][4], wn[2][4];
#pragma unroll
            for (int jj = 0; jj < 2; ++jj)
#pragma unroll
                for (int q = 0; q < 4; ++q) wc[jj][q] = rwl[((q * 2 + 0) * 8 + jj) * 64 + lane];
#pragma unroll
            for (int sgm = 0; sgm < 8; ++sgm) {
                const int sg = sgm >> 2, j2 = sgm & 3;
                __builtin_amdgcn_sched_barrier(0);
                if (sgm + 1 < 8) { const int sgn = (sgm + 1) >> 2, jn = (sgm + 1) & 3;
#pragma unroll
                    for (int jj = 0; jj < 2; ++jj)
#pragma unroll
                        for (int q = 0; q < 4; ++q) wn[jj][q] = rwl[((q * 2 + sgn) * 8 + 2 * jn + jj) * 64 + lane]; }
#pragma unroll
                for (int jj = 0; jj < 2; ++jj)
#pragma unroll
                    for (int q = 0; q < 4; ++q)
#pragma unroll
                        for (int e = 0; e < 4; ++e) lg2[q * 4 + e] += y2[sg * 8 + 2 * j2 + jj] * (f32x2){wc[jj][q][e], wc[jj][q][e]};
                __builtin_amdgcn_sched_barrier(0);
#pragma unroll
                for (int jj = 0; jj < 2; ++jj)
#pragma unroll
                    for (int q = 0; q < 4; ++q) wc[jj][q] = wn[jj][q];
            }
            f32x2 lgf;
            {
                f32x2 r8[8], r4[4], r2[2];
#pragma unroll
                for (int e = 0; e < 8; ++e)
#pragma unroll
                    for (int rr = 0; rr < 2; ++rr) { const auto sw = __builtin_amdgcn_permlane32_swap(__float_as_uint(lg2[e][rr]), __float_as_uint(lg2[e + 8][rr]), false, false);
                        r8[e][rr] = __uint_as_float(sw[0]) + __uint_as_float(sw[1]); }
#pragma unroll
                for (int e = 0; e < 4; ++e)
#pragma unroll
                    for (int rr = 0; rr < 2; ++rr) { const auto sw = __builtin_amdgcn_permlane16_swap(__float_as_uint(r8[e][rr]), __float_as_uint(r8[e + 4][rr]), false, false);
                        r4[e][rr] = __uint_as_float(sw[0]) + __uint_as_float(sw[1]); }
                const bool b3 = (lane & 8) != 0, b2 = (lane & 4) != 0;
#pragma unroll
                for (int e = 0; e < 2; ++e)
#pragma unroll
                    for (int rr = 0; rr < 2; ++rr) { const float kp = b3 ? r4[e + 2][rr] : r4[e][rr], gv = b3 ? r4[e][rr] : r4[e + 2][rr]; r2[e][rr] = kp + dpp_mov<0x128>(gv); }
#pragma unroll
                for (int rr = 0; rr < 2; ++rr) { const float kp = b2 ? r2[1][rr] : r2[0][rr], gv = b2 ? r2[0][rr] : r2[1][rr]; float v = kp + dpp_mov<0x141>(gv);
                    v += dpp_mov<0x4E>(v); v += dpp_mov<0xB1>(v); lgf[rr] = v; }
            }
#pragma unroll
            for (int rr = 0; rr < 2; ++rr) {
                const float scl = 1.f / (1.f + __expf(-lgf[rr])), bil = scl + rbl;
                const float a = bil, b = dpp_mov<0x124>(bil), c = dpp_mov<0x128>(bil), d = dpp_mov<0x12C>(bil);
                const float gsl = fmaxf(fmaxf(fmaxf(a + b, a + c), fmaxf(a + d, b + c)), fmaxf(b + d, c + d));
                float gs[4];
#pragma unroll
                for (int g = 0; g < 4; ++g) gs[g] = __uint_as_float((unsigned)__builtin_amdgcn_readlane((int)__float_as_uint(gsl), 16 * g));
                int bg = 0; float bgs = gs[0];
#pragma unroll
                for (int g = 1; g < 4; ++g) if (gs[g] > bgs) { bgs = gs[g]; bg = g; }
                bg = __builtin_amdgcn_readfirstlane(bg);
                float vb[4], vs[4];
#pragma unroll
                for (int k = 0; k < 4; ++k) { vb[k] = __uint_as_float((unsigned)__builtin_amdgcn_readlane((int)__float_as_uint(bil), 16 * bg + 4 * k)); vs[k] = __uint_as_float((unsigned)__builtin_amdgcn_readlane((int)__float_as_uint(scl), 16 * bg + 4 * k)); }
                int i1 = 0; float b1 = vb[0], s1 = vs[0];
#pragma unroll
                for (int k = 1; k < 4; ++k) if (vb[k] > b1) { b1 = vb[k]; s1 = vs[k]; i1 = k; }
                int i2 = -1; float b2v = -3e38f, s2 = 0.f;
#pragma unroll
                for (int k = 0; k < 4; ++k) if (k != i1 && vb[k] > b2v) { b2v = vb[k]; s2 = vs[k]; i2 = k; }
                const float inv = 1.f / (s1 + s2);
                if (lane == 0) {
                    const size_t row = row0 + i + rr;
                    const int e0 = bg * 4 + i1, e1 = bg * 4 + i2;
                    route_e[row] = e0 | (e1 << 8); route_w[row * 2] = s1 * inv; route_w[row * 2 + 1] = s2 * inv;
                    atomicAdd((int*)&lcnt[e0], 1); atomicAdd((int*)&lcnt[e1], 1);
                }
            }
        }
        __syncthreads();
        if (tid < 16) cnt[chunk * 16 + tid] = lcnt[tid];
    }
    __syncthreads();
}

__device__ __forceinline__ void moe_gather_phase(LAS unsigned char* lds, const int* route_e, const int* cnt, int* pos_out, int* inv, int4* tiles) {
    LAS int* s_tot = (LAS int*)lds; LAS int* s_pre = s_tot + 16; LAS int* s_off = s_pre + 16; LAS int* s_wcnt = s_off + 16; LAS int* s_lpos = s_wcnt + 128;
    const int tid = tid_opaque(), lane = tid & 63, w = tid >> 6;
    for (int chunk = blockIdx.x; chunk < 256; chunk += gridDim.x) {
        __syncthreads();
        { const int e = tid >> 5, j = tid & 31; int tot = 0, pre = 0;
            for (int c = j; c < 256; c += 32) { const int v = cnt[c * 16 + e]; tot += v; pre += (c < chunk) ? v : 0; }
#pragma unroll
            for (int o = 16; o >= 1; o >>= 1) { tot += __shfl_xor(tot, o); pre += __shfl_xor(pre, o); }
            if (j == 0) { s_tot[e] = tot; s_pre[e] = pre; } }
        __syncthreads();
        if (tid == 0) { int off = 0; for (int e = 0; e < 16; ++e) { s_off[e] = off; off += s_tot[e]; } }
        const int token = chunk * 256 + (tid >> 1), slot = tid & 1;
        const int re = route_e[token]; const int e = slot ? ((re >> 8) & 255) : (re & 255);
        int rk = 0;
#pragma unroll
        for (int e2 = 0; e2 < 16; ++e2) { const unsigned long long mk = __ballot(e == e2); if (e == e2) rk = __popcll(mk & ((1ull << lane) - 1ull)); if (lane == 0) s_wcnt[w * 16 + e2] = __popcll(mk); }
        __syncthreads();
        int base = s_off[e] + s_pre[e];
        for (int w2 = 0; w2 < w; ++w2) base += s_wcnt[w2 * 16 + e];
        const int p = base + rk;
        pos_out[token * 2 + slot] = p; inv[p] = token;
        if (chunk == 0 && tid == 0) {
            int nt = 0;
            for (int e2 = 0; e2 < 16; ++e2) { const int n = s_tot[e2]; for (int r = 0; r < n; r += 256) { tiles[1 + nt] = make_int4(e2, s_off[e2] + r, (n - r) < 256 ? (n - r) : 256, 0); ++nt; } }
            tiles[0] = make_int4(nt, 0, 0, 0);
        }
        if (chunk == 0 && tid < 256) inv[2 * T_TOK + tid] = 0;
    }
    __syncthreads();
}

template <bool LAST, bool X8OUT>
__device__ __forceinline__ void ln2_combine_phase(const bf16_t* X1, void* XWv  , const unsigned char* YM, const int* pos, const float* route_w, const float* gam, const float* bet, unsigned char* XO) {
    const int tid = tid_opaque(), lane = tid & 63, w = tid >> 6;
    float gm[16], bt[16];
#pragma unroll
    for (int s = 0; s < 2; ++s)
#pragma unroll
        for (int j = 0; j < 8; ++j) { gm[s * 8 + j] = gam[s * 512 + lane * 8 + j]; bt[s * 8 + j] = bet[s * 512 + lane * 8 + j]; }
    const size_t rstep = (size_t)gridDim.x * 8;
    int np0 = 0, np1 = 0; float nw0 = 0.f, nw1 = 0.f;
    { const size_t r0 = (size_t)blockIdx.x * 8 + w; if (r0 < (size_t)T_TOK) { np0 = pos[r0 * 2]; np1 = pos[r0 * 2 + 1]; nw0 = route_w[r0 * 2]; nw1 = route_w[r0 * 2 + 1]; } }
    for (size_t row = (size_t)blockIdx.x * 8 + w; row < (size_t)T_TOK; row += rstep) {
        const int p0 = np0, p1 = np1; const float w0 = nw0, w1 = nw1;
        { const size_t rn = row + rstep; if (rn < (size_t)T_TOK) { np0 = pos[rn * 2]; np1 = pos[rn * 2 + 1]; nw0 = route_w[rn * 2]; nw1 = route_w[rn * 2 + 1]; } }
        float xv[16], a[16], b[16];
#pragma unroll
        for (int sg = 0; sg < 2; ++sg) unpack8(ld16(X1 + row * DM + sg * 512 + lane * 8), xv + sg * 8);
        unpack8_fp8(*(const u32x2*)(YM + (size_t)p0 * DM + lane * 8), a); unpack8_fp8(*(const u32x2*)(YM + (size_t)p0 * DM + 512 + lane * 8), a + 8);
        unpack8_fp8(*(const u32x2*)(YM + (size_t)p1 * DM + lane * 8), b); unpack8_fp8(*(const u32x2*)(YM + (size_t)p1 * DM + 512 + lane * 8), b + 8);
        float s = 0.f;
#pragma unroll
        for (int j = 0; j < 16; ++j) { xv[j] = DN_ALPHA * xv[j] + (w0 * a[j] + w1 * b[j]) * (1.f / S8_Y); s += xv[j]; }
        const float mean = wave_sum_dpp(s) * (1.f / 1024.f);
        float q = 0.f;
#pragma unroll
        for (int j = 0; j < 16; ++j) { const float d = xv[j] - mean; q += d * d; }
        const float rstd = rsqrtf(wave_sum_dpp(q) * (1.f / 1024.f) + LN_EPS);
        float y[16];
#pragma unroll
        for (int j = 0; j < 16; ++j) y[j] = (xv[j] - mean) * rstd * gm[j] + bt[j];
        if constexpr (LAST) {
            float* outf = (float*)XWv;
            *(f32x4*)(outf + row * DM + lane * 8) = (f32x4){y[0], y[1], y[2], y[3]}; *(f32x4*)(outf + row * DM + lane * 8 + 4) = (f32x4){y[4], y[5], y[6], y[7]};
            *(f32x4*)(outf + row * DM + 512 + lane * 8) = (f32x4){y[8], y[9], y[10], y[11]}; *(f32x4*)(outf + row * DM + 512 + lane * 8 + 4) = (f32x4){y[12], y[13], y[14], y[15]};
        } else {
            bf16_t* xw = (bf16_t*)XWv;
            st16(xw + row * DM + lane * 8, (u32x4){cvt_pk_bf16(y[0], y[1]), cvt_pk_bf16(y[2], y[3]), cvt_pk_bf16(y[4], y[5]), cvt_pk_bf16(y[6], y[7])});
            st16(xw + row * DM + 512 + lane * 8, (u32x4){cvt_pk_bf16(y[8], y[9]), cvt_pk_bf16(y[10], y[11]), cvt_pk_bf16(y[12], y[13]), cvt_pk_bf16(y[14], y[15])});
            if constexpr (X8OUT) {
                float ys[16];
#pragma unroll
                for (int j = 0; j < 16; ++j) ys[j] = y[j] * S8_X;
                *(u32x2*)(XO + row * DM + lane * 8) = pack8_fp8(ys); *(u32x2*)(XO + row * DM + 512 + lane * 8) = pack8_fp8(ys + 8);
            }
        }
    }
}

template <int TAPS, int CW, bool GATE>
__device__ __forceinline__ void conv_phase(LAS unsigned char* lds, const bf16_t* X, const bf16_t* BG, bf16_t* Y, const float* cw, const float* cb) {
    LAS float* wl = (LAS float*)lds;
    const int tidx = tid_opaque();
    __syncthreads();
    for (int i = tidx; i < (TAPS + 1) * CW; i += NTHR) wl[i] = i < TAPS * CW ? cw[i] : cb[i - TAPS * CW];
    __syncthreads();
    constexpr int NCG = CW / 8, HL = TAPS - 1;
    const int items = (T_TOK / 16) * NCG, stride = gridDim.x * NTHR;
    int it = blockIdx.x * NTHR + tidx;
    if (it < items) {
        u32x4 cx[8], cg[8], nx[8], ng[8], hl[HL], nhl[HL];
        int c0 = (it % NCG) * 8; size_t t0 = (size_t)(it / NCG) * 16;
#pragma unroll
        for (int i = 0; i < 8; ++i) { cx[i] = ld16(X + (t0 + i) * CW + c0); if constexpr (GATE) cg[i] = ld16(BG + (t0 + i) * CW + c0); }
#pragma unroll
        for (int k = 0; k < HL; ++k) hl[k] = (t0 & 2047) == 0 ? (u32x4){0u, 0u, 0u, 0u} : ld16(X + (t0 - HL + k) * CW + c0);
        for (;;) {
            float wt[TAPS][8], b8[8], pv[HL][8];
#pragma unroll
            for (int k = 0; k < TAPS; ++k) { const f32x4 a = *(const LAS f32x4*)(wl + k * CW + c0), b = *(const LAS f32x4*)(wl + k * CW + c0 + 4);
#pragma unroll
                for (int j = 0; j < 4; ++j) { wt[k][j] = a[j]; wt[k][4 + j] = b[j]; } }
            { const f32x4 a = *(const LAS f32x4*)(wl + TAPS * CW + c0), b = *(const LAS f32x4*)(wl + TAPS * CW + c0 + 4);
#pragma unroll
                for (int j = 0; j < 4; ++j) { b8[j] = a[j]; b8[4 + j] = b[j]; } }
#pragma unroll
            for (int k = 0; k < HL; ++k) unpack8(hl[k], pv[k]);
            const int nit = it + stride; const bool has_next = nit < items;
            const int nc0 = (nit % NCG) * 8; const size_t nt0 = (size_t)(nit / NCG) * 16;
#pragma unroll
            for (int g = 0; g < 2; ++g) {
                if (g == 0) {
#pragma unroll
                    for (int i = 0; i < 8; ++i) { nx[i] = ld16(X + (t0 + 8 + i) * CW + c0); if constexpr (GATE) ng[i] = ld16(BG + (t0 + 8 + i) * CW + c0); }
                } else if (has_next) {
#pragma unroll
                    for (int i = 0; i < 8; ++i) { nx[i] = ld16(X + (nt0 + i) * CW + nc0); if constexpr (GATE) ng[i] = ld16(BG + (nt0 + i) * CW + nc0); }
#pragma unroll
                    for (int k = 0; k < HL; ++k) nhl[k] = (nt0 & 2047) == 0 ? (u32x4){0u, 0u, 0u, 0u} : ld16(X + (nt0 - HL + k) * CW + nc0);
                }
#pragma unroll
                for (int i = 0; i < 8; ++i) {
                    float cur[8], y[8]; unpack8(cx[i], cur);
#pragma unroll
                    for (int j = 0; j < 8; ++j) { float a = b8[j] + wt[TAPS - 1][j] * cur[j];
#pragma unroll
                        for (int k = 0; k < HL; ++k) a += wt[k][j] * pv[k][j];
                        y[j] = a; }
                    if constexpr (GATE) { float gv[8]; unpack8(cg[i], gv);
#pragma unroll
                        for (int j = 0; j < 8; ++j) y[j] *= gv[j]; }
#pragma unroll
                    for (int j = 0; j < 8; ++j) {
#pragma unroll
                        for (int k = 0; k + 1 < HL; ++k) pv[k][j] = pv[k + 1][j];
                        pv[HL - 1][j] = cur[j]; }
                    st16(Y + (t0 + g * 8 + i) * CW + c0, (u32x4){cvt_pk_bf16(y[0], y[1]), cvt_pk_bf16(y[2], y[3]), cvt_pk_bf16(y[4], y[5]), cvt_pk_bf16(y[6], y[7])});
                }
#pragma unroll
                for (int i = 0; i < 8; ++i) { cx[i] = nx[i]; if constexpr (GATE) cg[i] = ng[i]; }
            }
            if (!has_next) break;
            it = nit; c0 = nc0; t0 = nt0;
#pragma unroll
            for (int k = 0; k < HL; ++k) hl[k] = nhl[k];
        }
    }
}
__device__ __forceinline__ void sc_conv_phase(LAS unsigned char* lds, const bf16_t* P, const bf16_t* BG, bf16_t* Y, const float* cw, const float* cb) { conv_phase<3, 1024, true>(lds, P, BG, Y, cw, cb); }
__device__ __forceinline__ void lru_conv_phase(LAS unsigned char* lds, const bf16_t* REC, bf16_t* U, const float* cw, const float* cb) { conv_phase<4, LRU_W, false>(lds, REC, nullptr, U, cw, cb); }

#define LRU_LD16(dl, db, dg, bs, g) do { _Pragma("unroll") for (int t_ = 0; t_ < 16; ++t_) { const size_t o_ = (bs) + (size_t)((g) * 16 + t_) * LRU_W; \
        dl[t_] = *(const unsigned*)(LOGA + o_); db[t_] = *(const unsigned*)(BIN + o_); if constexpr (P2) dg[t_] = *(const unsigned*)(GG + o_); } } while (0)
template <bool P2>
__device__ __forceinline__ void lru_scan_phase(const bf16_t* LOGA, const bf16_t* BIN, const bf16_t* GG, f32x4* carry, bf16_t* Y) {
    const int tidx = tid_opaque(); const int lane = tidx & 63, w = tidx >> 6;
    const int istep = gridDim.x * 8;
    int it = blockIdx.x * 8 + w;
    if (it >= 10240) return;
    unsigned la[16], bi[16], gg[16], nla[16], nbi[16], ngg[16];
    size_t base; { const int cgp = it % 10, ck = (it / 10) & 31, b = it / 320; base = ((size_t)b * SEQ + ck * 64) * LRU_W + cgp * 128 + lane * 2; }
    LRU_LD16(la, bi, gg, base, 0);
    for (;;) {
        const int cgp = it % 10, ck = (it / 10) & 31, b = it / 320, ch = cgp * 128 + lane * 2;
        float h0 = 0.f, h1 = 0.f, s0 = 0.f, s1 = 0.f;
        if constexpr (P2) {
            for (int c0 = 0; c0 < ck; c0 += 16) {
                f32x4 cv[16];
#pragma unroll
                for (int j = 0; j < 16; ++j) { const int c2 = (c0 + j) < ck ? (c0 + j) : (ck - 1); cv[j] = carry[(((size_t)b * 32 + c2) * LRU_W + ch) >> 1]; }
#pragma unroll
                for (int j = 0; j < 16; ++j) if (c0 + j < ck) { h0 = fast_exp(cv[j][0]) * h0 + cv[j][1]; h1 = fast_exp(cv[j][2]) * h1 + cv[j][3]; }
            }
        }
        const int nit = it + istep; const bool has_next = nit < 10240;
        size_t nbase = base; if (has_next) { const int cgp2 = nit % 10, ck2 = (nit / 10) & 31, b2 = nit / 320; nbase = ((size_t)b2 * SEQ + ck2 * 64) * LRU_W + cgp2 * 128 + lane * 2; }
#pragma unroll
        for (int g = 0; g < 4; ++g) {
            if (g < 3) LRU_LD16(nla, nbi, ngg, base, g + 1); else if (has_next) LRU_LD16(nla, nbi, ngg, nbase, 0);
#pragma unroll
            for (int t = 0; t < 16; ++t) {
                const float l0 = bf_lo(la[t]), l1 = bf_hi(la[t]);
                h0 = fast_exp(l0) * h0 + bf_lo(bi[t]); h1 = fast_exp(l1) * h1 + bf_hi(bi[t]);
                if constexpr (P2) *(unsigned*)(Y + base + (size_t)(g * 16 + t) * LRU_W) = cvt_pk_bf16(bf_lo(gg[t]) * h0, bf_hi(gg[t]) * h1);
                else { s0 += l0; s1 += l1; }
            }
#pragma unroll
            for (int t = 0; t < 16; ++t) { la[t] = nla[t]; bi[t] = nbi[t]; if constexpr (P2) gg[t] = ngg[t]; }
        }
        if constexpr (!P2) carry[(((size_t)b * 32 + ck) * LRU_W + ch) >> 1] = (f32x4){s0, h0, s1, h1};
        if (!has_next) break;
        it = nit; base = nbase;
    }
}
#undef LRU_LD16
__device__ __forceinline__ void lru_scan1_phase(const bf16_t* LOGA, const bf16_t* BIN, f32x4* carry) { lru_scan_phase<false>(LOGA, BIN, nullptr, carry, nullptr); }
__device__ __forceinline__ void lru_scan2_phase(const bf16_t* LOGA, const bf16_t* BIN, const bf16_t* GG, const f32x4* carry, bf16_t* Y) { lru_scan_phase<true>(LOGA, BIN, GG, (f32x4*)carry, Y); }
__device__ __forceinline__ bf16x8 pack8s(const float* f) {
    const unsigned a = cvt_pk_bf16(f[0], f[1]), b = cvt_pk_bf16(f[2], f[3]), c = cvt_pk_bf16(f[4], f[5]), d = cvt_pk_bf16(f[6], f[7]);
    u32x4 v = {a, b, c, d}; return __builtin_bit_cast(bf16x8, v);
}
__device__ __forceinline__ void nsa_compress_phase(LAS unsigned char* lds, const bf16_t* KC, const bf16_t* VC, const bf16_t* W1T, const float* w2k, const float* w2v, const float* bias1,
                                                   const int* pos, unsigned char* KCMP, unsigned char* VCMPT) {
    constexpr int WROW = 528, WBUF = 64 * WROW;
    const int tidx = tid_opaque(); const int lane = tidx & 63, w = tidx >> 6, rowi = lane & 15, gq = lane >> 4;
    const int srow = tidx >> 3, spc = tidx & 7;
    for (int tb = blockIdx.x; tb < 256; tb += gridDim.x) {
        const int task = tb * 8 + w;
        const int kv = task >> 10, tt = task & 1023, rho = tt * 16 + rowi, b = rho >> 9, n = (rho >> 2) & 127, g = rho & 3;
        const bf16_t* src = KC + (kv ? (VC - KC) : 0l) + (size_t)b * SEQ * 256 + g * 64 + 8 * gq;
        const bf16_t* wsrc = W1T + (size_t)kv * 64 * 2048 + (size_t)srow * 2048 + spc * 8;
        f32x4 hacc[4];
#pragma unroll
        for (int ht = 0; ht < 4; ++ht) hacc[ht] = (f32x4){0.f, 0.f, 0.f, 0.f};
        u32x4 wr[4]; bf16x8 naf[8];
        __syncthreads();
#pragma unroll
        for (int i = 0; i < 4; ++i) wr[i] = ld16(wsrc + i * 64);
#pragma unroll
        for (int i = 0; i < 4; ++i) *(LAS u32x4*)(lds + srow * WROW + (spc + 8 * i) * 16) = wr[i];
        __syncthreads();
        for (int sl = 0; sl < 8; ++sl) {
            const int buf = sl & 1;
            if (sl < 7) {
#pragma unroll
                for (int i = 0; i < 4; ++i) wr[i] = ld16(wsrc + (sl + 1) * 256 + i * 64);
            }
            if (sl == 0) {
#pragma unroll
                for (int k8 = 0; k8 < 8; ++k8) { const int kk = k8; int tok = 16 * n + (kk >> 1); tok = tok > 2047 ? 2047 : tok;
                    naf[k8] = *(const bf16x8*)(src + (size_t)tok * 256 + 32 * (kk & 1)); }
            }
            bf16x8 af[8];
#pragma unroll
            for (int k8 = 0; k8 < 8; ++k8) af[k8] = naf[k8];
            if (sl < 7) {
#pragma unroll
                for (int k8 = 0; k8 < 8; ++k8) { const int kk = (sl + 1) * 8 + k8; int tok = 16 * n + (kk >> 1); tok = tok > 2047 ? 2047 : tok;
                    naf[k8] = *(const bf16x8*)(src + (size_t)tok * 256 + 32 * (kk & 1)); }
            }
#pragma unroll
            for (int k8 = 0; k8 < 8; ++k8)
#pragma unroll
                for (int ht = 0; ht < 4; ++ht) { const bf16x8 wf = *(const LAS bf16x8*)(lds + buf * WBUF + (16 * ht + rowi) * WROW + k8 * 64 + gq * 16);
                    hacc[ht] = __builtin_amdgcn_mfma_f32_16x16x32_bf16(wf, af[k8], hacc[ht], 0, 0, 0); }
            if (sl < 7) {
#pragma unroll
                for (int i = 0; i < 4; ++i) *(LAS u32x4*)(lds + (buf ^ 1) * WBUF + srow * WROW + (spc + 8 * i) * 16) = wr[i];
            }
            __syncthreads();
        }
        bf16x8 pf[2];
#pragma unroll
        for (int p = 0; p < 2; ++p) { float hv[8];
#pragma unroll
            for (int jj = 0; jj < 4; ++jj) { hv[jj] = gelu_tanh(hacc[2 * p][jj] + bias1[kv * 64 + 32 * p + 4 * gq + jj]); hv[4 + jj] = gelu_tanh(hacc[2 * p + 1][jj] + bias1[kv * 64 + 32 * p + 16 + 4 * gq + jj]); }
            pf[p] = pack8s(hv); }
        const float* w2 = w2k + (kv ? (w2v - w2k) : 0l);
        f32x4 oacc[4];
#pragma unroll
        for (int dt = 0; dt < 4; ++dt) { oacc[dt] = (f32x4){0.f, 0.f, 0.f, 0.f};
#pragma unroll
            for (int p = 0; p < 2; ++p) { float wv[8]; const int dout = 16 * dt + rowi;
#pragma unroll
                for (int i = 0; i < 4; ++i) { wv[i] = w2[(32 * p + 4 * gq + i) * 64 + dout]; wv[4 + i] = w2[(32 * p + 16 + 4 * gq + i) * 64 + dout]; }
                oacc[dt] = __builtin_amdgcn_mfma_f32_16x16x32_bf16(pack8s(wv), pf[p], oacc[dt], 0, 0, 0); } }
        const bool padrow = (n == 127);
        if (kv == 0) {
            int pidx = 16 * n + 31; pidx = pidx > 2047 ? 2047 : pidx;
            const float pp = (float)pos[b * SEQ + pidx];
            unsigned char* dst = KCMP + ((size_t)(b * 128 + n) * 4 + g) * 64;
#pragma unroll
            for (int dt = 0; dt < 2; ++dt) { float o1[4], o2[4];
#pragma unroll
                for (int jj = 0; jj < 4; ++jj) { const float inv = exp2f(-(float)(16 * dt + 4 * gq + jj) * (13.287712379549449f / 32.f)); float sn, cs; sincos_rad(pp * inv, sn, cs);
                    const float x1 = oacc[dt][jj], x2 = oacc[dt + 2][jj]; o1[jj] = padrow ? 0.f : (x1 * cs - x2 * sn) * S8_K; o2[jj] = padrow ? 0.f : (x1 * sn + x2 * cs) * S8_K; }
                *(unsigned*)(dst + 16 * dt + 4 * gq) = pack4_fp8(o1[0], o1[1], o1[2], o1[3]);
                *(unsigned*)(dst + 32 + 16 * dt + 4 * gq) = pack4_fp8(o2[0], o2[1], o2[2], o2[3]); }
        } else {
            unsigned char* dst = VCMPT + ((size_t)(b * 4 + g) * 64) * 128 + vperm32(n);
#pragma unroll
            for (int dt = 0; dt < 4; ++dt) { const unsigned pk = pack4_fp8(oacc[dt][0], oacc[dt][1], oacc[dt][2], oacc[dt][3]);
#pragma unroll
                for (int jj = 0; jj < 4; ++jj) dst[(size_t)(16 * dt + 4 * gq + jj) * 128] = padrow ? (unsigned char)0 : (unsigned char)((pk >> (8 * jj)) & 0xffu); }
        }
    }
}

struct AttnArgs { const unsigned char* Q; const unsigned char* KS; const unsigned char* VST; const unsigned char* KW; const unsigned char* VWT; const unsigned char* KCMP; const unsigned char* VCMPT; const float* GATES; unsigned char* O; int exp_; };
constexpr int AL_KC = 0, AL_VC = 10240, AL_KB = 19456, AL_VB = 29696, AL_PS = 39936, AL_IMP = 56320, AL_SEL = 60416, AL_OT = 60544, AL_VR = 126080;
typedef long fp8x8;
__device__ __forceinline__ unsigned pk4p(float a, float b, float c, float d) { unsigned r = 0u; r = __builtin_amdgcn_cvt_pk_fp8_f32(a, b, r, false); r = __builtin_amdgcn_cvt_pk_fp8_f32(c, d, r, true); return r; }
__device__ __forceinline__ fp8x8 mk8(unsigned lo, unsigned hi) { return (fp8x8)(((unsigned long long)hi << 32) | (unsigned long long)lo); }
constexpr float ATT_THR = 8.f;

__device__ __forceinline__ float max16(const f32x4 (&a)[4]) {
    float m0 = fmaxf(fmaxf(a[0][0], a[0][1]), a[0][2]), m1 = fmaxf(fmaxf(a[0][3], a[1][0]), a[1][1]), m2 = fmaxf(fmaxf(a[1][2], a[1][3]), a[2][0]);
    float m3 = fmaxf(fmaxf(a[2][1], a[2][2]), a[2][3]), m4 = fmaxf(fmaxf(a[3][0], a[3][1]), a[3][2]);
    return fmaxf(fmaxf(fmaxf(m0, m1), fmaxf(m2, m3)), fmaxf(m4, a[3][3]));
}

template <int MODE>
__device__ __forceinline__ void attn_branch(LAS unsigned char* lds, const unsigned char* Kg, const unsigned char* Vg, const int kb_lo, const int kb_hi, const bool first_staged,
                                            const fp8x8 (&qf)[2][2], const int (&sq)[2], const unsigned (&selm)[2], const float* const (&gatep)[2], LAS f32x4* otl  ,
                                            const int n, const int gq, const int tid) {
    const bool isv = tid >= 256; const int st = tid & 255, srow = st >> 2, spc = st & 3;
    const unsigned char* sgp = isv ? Vg + (size_t)srow * SEQ + spc * 16 : Kg + (size_t)srow * 256 + spc * 16;
    const size_t sstep = isv ? (size_t)64 : (size_t)64 * 256;
    const int soff = (isv ? AL_VR : AL_KB) + srow * 80 + spc * 16;
    u32x4 sr;
    if (!first_staged) {
        sr = ld16(sgp + (size_t)kb_lo * sstep);
        *(LAS u32x4*)(lds + soff) = sr;
        __syncthreads();
    }
    typedef unsigned u32x2_t __attribute__((ext_vector_type(2)));
    fp8x8 pfA[2][2]; bool pend = false; int vi = 0, vp = 0;
#define ATT_PV128(vX, PX, vY, PY, HASY) do { _Pragma("unroll") for (int dt = 0; dt < 4; ++dt) { \
        const u32x2_t a0 = *(const LAS u32x2_t*)((vX) + (16 * dt + n) * 80 + 8 * gq), a1 = *(const LAS u32x2_t*)((vX) + (16 * dt + n) * 80 + 32 + 8 * gq); \
        u32x2_t b0 = {0u, 0u}, b1 = {0u, 0u}; if (HASY) { b0 = *(const LAS u32x2_t*)((vY) + (16 * dt + n) * 80 + 8 * gq); b1 = *(const LAS u32x2_t*)((vY) + (16 * dt + n) * 80 + 32 + 8 * gq); } \
        const i32x8 va = {(int)a0[0], (int)a0[1], (int)a1[0], (int)a1[1], (int)b0[0], (int)b0[1], (int)b1[0], (int)b1[1]}; \
        _Pragma("unroll") for (int ti = 0; ti < 2; ++ti) { \
            const unsigned long long x0 = (unsigned long long)PX[ti][0], x1 = (unsigned long long)PX[ti][1], y0 = (HASY) ? (unsigned long long)PY[ti][0] : 0ull, y1 = (HASY) ? (unsigned long long)PY[ti][1] : 0ull; \
            const i32x8 vb = {(int)(unsigned)x0, (int)(unsigned)(x0 >> 32), (int)(unsigned)x1, (int)(unsigned)(x1 >> 32), (int)(unsigned)y0, (int)(unsigned)(y0 >> 32), (int)(unsigned)y1, (int)(unsigned)(y1 >> 32)}; \
            oacc[ti][dt] = __builtin_amdgcn_mfma_scale_f32_16x16x128_f8f6f4(va, vb, oacc[ti][dt], 0, 0, 0, 0, 0, 0); } } } while (0)
    float m_run[2] = {0.f, 0.f}, l_run[2] = {0.f, 0.f};
    const float gate[2] = {gatep[0][MODE + 1], gatep[1][MODE + 1]};
    f32x4 oacc[2][4];
#pragma unroll
    for (int ti = 0; ti < 2; ++ti)
#pragma unroll
        for (int dt = 0; dt < 4; ++dt) oacc[ti][dt] = (f32x4){0.f, 0.f, 0.f, 0.f};
    for (int kb = kb_lo; kb <= kb_hi; ++kb) {
        const int buf = (kb - kb_lo) & 1;
        if (kb < kb_hi) sr = ld16(sgp + (size_t)(kb + 1) * sstep);
        const LAS unsigned char* kbuf = lds + AL_KB + buf * 5120; const LAS unsigned char* vbuf = lds + AL_VR + vi * 5120; const LAS unsigned char* vprev = lds + AL_VR + vp * 5120;
        const int vn = vi == 2 ? 0 : vi + 1;
        f32x4 sacc[2][4];
        bool selb[2];
#pragma unroll
        for (int ti = 0; ti < 2; ++ti) selb[ti] = MODE == 0 ? (((selm[ti] >> kb) & 1u) != 0u) : true;
#pragma unroll
        for (int kt = 0; kt < 4; ++kt) {
            const fp8x8 k0 = *(const LAS fp8x8*)(kbuf + (16 * kt + n) * 80 + gq * 8), k1 = *(const LAS fp8x8*)(kbuf + (16 * kt + n) * 80 + 32 + gq * 8);
#pragma unroll
            for (int ti = 0; ti < 2; ++ti) {
                sacc[ti][kt] = __builtin_amdgcn_mfma_f32_16x16x32_fp8_fp8(k0, qf[ti][0], (f32x4){0.f, 0.f, 0.f, 0.f}, 0, 0, 0);
                sacc[ti][kt] = __builtin_amdgcn_mfma_f32_16x16x32_fp8_fp8(k1, qf[ti][1], sacc[ti][kt], 0, 0, 0);
            }
        }
        const bool need_mask = (kb == kb_hi) || (MODE == 1 && kb == kb_lo);
        if (need_mask) {
#pragma unroll
            for (int ti = 0; ti < 2; ++ti) {
                const int rel = sq[ti] - kb * 64 - 4 * gq;
#pragma unroll
                for (int kt = 0; kt < 4; ++kt)
#pragma unroll
                    for (int jj = 0; jj < 4; ++jj) { const int tt = 16 * kt + jj; const bool v = MODE == 0 ? (tt <= rel) : (tt <= rel && tt > rel - 512); sacc[ti][kt][jj] = v ? sacc[ti][kt][jj] : NEGBIG; }
            }
        }
        float mx[2];
#pragma unroll
        for (int ti = 0; ti < 2; ++ti) { mx[ti] = max16(sacc[ti]) - m_run[ti]; mx[ti] = selb[ti] ? mx[ti] : NEGBIG; }
        const bool slow = (mx[0] > ATT_THR) || (mx[1] > ATT_THR) || (l_run[0] == 0.f && mx[0] > -1e29f && mx[0] < -ATT_THR) || (l_run[1] == 0.f && mx[1] > -1e29f && mx[1] < -ATT_THR);
        if (__any(slow)) {
            if (pend) { ATT_PV128(vprev, pfA, vprev, pfA, false); pend = false; }
#pragma unroll
            for (int ti = 0; ti < 2; ++ti) {
                float mr = fmaxf(mx[ti], __shfl_xor(mx[ti], 16)); mr = fmaxf(mr, __shfl_xor(mr, 32));
                float lr = l_run[ti] + __shfl_xor(l_run[ti], 16); lr += __shfl_xor(lr, 32);
                const bool has = mr > -1e29f;
                const float delta = !has ? 0.f : (lr == 0.f ? mr : fmaxf(mr, 0.f));
                const float alpha = lr == 0.f ? 1.f : fast_exp2(-delta);
                l_run[ti] *= alpha; m_run[ti] += delta;
#pragma unroll
                for (int dt = 0; dt < 4; ++dt) oacc[ti][dt] *= alpha;
            }
        }
        if (__any(m_run[0] != 0.f || m_run[1] != 0.f)) {
#pragma unroll
            for (int ti = 0; ti < 2; ++ti)
#pragma unroll
                for (int kt = 0; kt < 4; ++kt) sacc[ti][kt] -= m_run[ti];
        }
        fp8x8 pf[2][2];
#pragma unroll
        for (int ti = 0; ti < 2; ++ti) {
            float ps = 0.f;
#pragma unroll
            for (int kt = 0; kt < 4; ++kt)
#pragma unroll
                for (int jj = 0; jj < 4; ++jj) { const float e = fast_exp2(sacc[ti][kt][jj]); sacc[ti][kt][jj] = e; ps += e; }
            l_run[ti] += selb[ti] ? ps : 0.f;
#pragma unroll
            for (int p = 0; p < 2; ++p) { unsigned lo = pk4p(sacc[ti][2 * p][0], sacc[ti][2 * p][1], sacc[ti][2 * p][2], sacc[ti][2 * p][3]), hi = pk4p(sacc[ti][2 * p + 1][0], sacc[ti][2 * p + 1][1], sacc[ti][2 * p + 1][2], sacc[ti][2 * p + 1][3]);
                if (MODE == 0) { lo = selb[ti] ? lo : 0u; hi = selb[ti] ? hi : 0u; }
                pf[ti][p] = mk8(lo, hi); }
        }
        if (pend) { ATT_PV128(vprev, pfA, vbuf, pf, true); pend = false; }
        else if (kb == kb_hi) { ATT_PV128(vbuf, pf, vbuf, pf, false); }
        else {
#pragma unroll
            for (int ti = 0; ti < 2; ++ti) { pfA[ti][0] = pf[ti][0]; pfA[ti][1] = pf[ti][1]; }
            pend = true;
        }
        if (kb < kb_hi) *(LAS u32x4*)(lds + (isv ? vn * 5120 : (buf ^ 1) * 5120) + soff) = sr;
        __syncthreads();
        vp = vi; vi = vn;
    }
#undef ATT_PV128
#pragma unroll
    for (int ti = 0; ti < 2; ++ti) {
        float lt = l_run[ti] + __shfl_xor(l_run[ti], 16); lt += __shfl_xor(lt, 32);
        const float inv = lt > 0.f ? gate[ti] / lt : 0.f;
#pragma unroll
        for (int dt = 0; dt < 4; ++dt) otl[(ti * 4 + dt) * 64] += oacc[ti][dt] * inv;
    }
}

__device__ __forceinline__ unsigned attn_cmp_tile(LAS unsigned char* lds, const fp8x8 qf0, const fp8x8 qf1, const int s, const int sbase  , const float g0,
                                                  LAS f32x4* otl  , const int lane, const int w, const int n, const int gq, const int tl, const int r) {
    f32x4 sacc[8];
#pragma unroll
    for (int kt = 0; kt < 8; ++kt) {
        const fp8x8 k0 = *(const LAS fp8x8*)(lds + AL_KC + (16 * kt + n) * 80 + gq * 8), k1 = *(const LAS fp8x8*)(lds + AL_KC + (16 * kt + n) * 80 + 32 + gq * 8);
        sacc[kt] = __builtin_amdgcn_mfma_f32_16x16x32_fp8_fp8(k0, qf0, (f32x4){0.f, 0.f, 0.f, 0.f}, 0, 0, 0);
        sacc[kt] = __builtin_amdgcn_mfma_f32_16x16x32_fp8_fp8(k1, qf1, sacc[kt], 0, 0, 0);
    }
    float mx = NEGBIG;
    const int lim = ((s - 31) >> 4) - 4 * gq;
#pragma unroll
    for (int kt = 0; kt < 8; ++kt)
#pragma unroll
        for (int jj = 0; jj < 4; ++jj) { const bool v = (16 * kt + jj <= lim); sacc[kt][jj] = v ? sacc[kt][jj] : NEGBIG; mx = fmaxf(mx, sacc[kt][jj]); }
    mx = fmaxf(mx, __shfl_xor(mx, 16)); mx = fmaxf(mx, __shfl_xor(mx, 32));
    mx = fmaxf(mx, -1e20f);
    float ps = 0.f;
#pragma unroll
    for (int kt = 0; kt < 8; ++kt)
#pragma unroll
        for (int jj = 0; jj < 4; ++jj) { const float e = fast_exp2(sacc[kt][jj] - mx); sacc[kt][jj] = e; ps += e; }
    ps += __shfl_xor(ps, 16); ps += __shfl_xor(ps, 32);
    const float inv = ps > 0.f ? 1.f / ps : 0.f;
#pragma unroll
    for (int kt = 0; kt < 8; ++kt) {
        f32x4 pp;
#pragma unroll
        for (int jj = 0; jj < 4; ++jj) { sacc[kt][jj] *= inv; float t = sacc[kt][jj]; t += dpp_mov<0xB1>(t); t += dpp_mov<0x4E>(t); pp[jj] = t; }
        if (r == 0) *(LAS f32x4*)(lds + AL_PS + ((w * 4 + tl) * 128 + 16 * kt + 4 * gq) * 4) = pp;
    }
    f32x4 otot[4];
#pragma unroll
    for (int dt = 0; dt < 4; ++dt) otot[dt] = (f32x4){0.f, 0.f, 0.f, 0.f};
#pragma unroll
    for (int p = 0; p < 4; ++p) {
        const fp8x8 pf = mk8(pk4p(sacc[2 * p][0], sacc[2 * p][1], sacc[2 * p][2], sacc[2 * p][3]), pk4p(sacc[2 * p + 1][0], sacc[2 * p + 1][1], sacc[2 * p + 1][2], sacc[2 * p + 1][3]));
#pragma unroll
        for (int dt = 0; dt < 4; ++dt) {
            const fp8x8 vf = *(const LAS fp8x8*)(lds + AL_VC + (16 * dt + n) * 144 + 32 * p + 8 * gq);
            otot[dt] = __builtin_amdgcn_mfma_f32_16x16x32_fp8_fp8(vf, pf, otot[dt], 0, 0, 0);
        }
    }
#pragma unroll
    for (int dt = 0; dt < 4; ++dt) otl[dt * 64] = otot[dt] * g0;
    asm volatile("s_waitcnt lgkmcnt(0)" ::: "memory");
    __builtin_amdgcn_wave_barrier();
    const int tl2 = lane >> 4, q = lane & 15, s2 = sbase + tl2, blkq = s2 >> 6;
    const LAS float* psr = (const LAS float*)(lds + AL_PS + ((w * 4 + tl2) * 128) * 4);
    const f32x4 xa = *(const LAS f32x4*)(psr + 8 * q), xb = *(const LAS f32x4*)(psr + 8 * q + 4);
    const float prev = q > 0 ? psr[8 * q - 1] : 0.f;
    float a0 = prev + xa[0] + xa[1] + xa[2] + xa[3], a1 = xa[3] + xb[0] + xb[1] + xb[2] + xb[3];
    const int m0 = 2 * q, m1 = 2 * q + 1;
    { const int rel0 = blkq - m0, rel1 = blkq - m1;
        if (rel0 < 0) a0 = -1.f;
        if (rel1 < 0) a1 = -1.f;
        if (m0 == 0 || rel0 == 0 || rel0 == 1) a0 = 1e6f;
        if (rel1 == 0 || rel1 == 1) a1 = 1e6f; }
    const unsigned key0 = a0 < 0.f ? 0u : ((__float_as_uint(a0) & ~31u) | (unsigned)(31 - m0)) + 64u, key1 = a1 < 0.f ? 0u : ((__float_as_uint(a1) & ~31u) | (unsigned)(31 - m1)) + 64u;
    LAS unsigned* impw = (LAS unsigned*)(lds + AL_IMP + ((w * 4 + tl2) * 32) * 4);
    *(LAS u32x2*)(impw + 2 * q) = (u32x2){key0, key1};
    asm volatile("s_waitcnt lgkmcnt(0)" ::: "memory");
    __builtin_amdgcn_wave_barrier();
    int rk0 = 0, rk1 = 0;
#pragma unroll
    for (int i4 = 0; i4 < 8; ++i4) { const u32x4 v = *(const LAS u32x4*)(impw + 4 * i4);
#pragma unroll
        for (int j = 0; j < 4; ++j) { rk0 += v[j] > key0 ? 1 : 0; rk1 += v[j] > key1 ? 1 : 0; } }
    unsigned bits = (rk0 < 16 ? (1u << m0) : 0u) | (rk1 < 16 ? (1u << m1) : 0u);
    bits |= dpp_movu<0xB1>(bits); bits |= dpp_movu<0x4E>(bits); bits |= dpp_movu<0x141>(bits); bits |= dpp_movu<0x140>(bits);
    LAS unsigned* selw = (LAS unsigned*)(lds + AL_SEL + (w * 4) * 4);
    if (q == 0) selw[tl2] = bits;
    asm volatile("s_waitcnt lgkmcnt(0)" ::: "memory");
    __builtin_amdgcn_wave_barrier();
    const unsigned selm = selw[tl];
    asm volatile("s_waitcnt lgkmcnt(0)" ::: "memory");
    __builtin_amdgcn_wave_barrier();
    return selm;
}

__device__ __forceinline__ void nsa_attn_phase(LAS unsigned char* lds, const AttnArgs& A) {
    const int tid0 = tid_opaque();
    u32x4 pfk, pfv, pfs; fp8x8 nqf[2][2]; bool havepf = false;
    for (int u = blockIdx.x; u < 4096; u += gridDim.x) {
        int tid = tid0; asm volatile("" : "+v"(tid));
        const int lane = tid & 63, w = tid >> 6, n = lane & 15, gq = lane >> 4, tl = n >> 2, r = n & 3;
        const int kq = u >> 8, c = 2 * kq + ((((u >> 7) & 1) ^ kq) & 1), bgi = u & 127, b = bgi >> 2, g = bgi & 3, s0 = c * 64;
        int sq[2]; fp8x8 qf[2][2]; const float* gp[2];
#pragma unroll
        for (int ti = 0; ti < 2; ++ti) {
            sq[ti] = s0 + 8 * w + 4 * ti + tl;
            const size_t qrow = (size_t)b * SEQ + sq[ti];
            const unsigned char* qp = A.Q + qrow * 1024 + g * 256 + r * 64 + 8 * gq;
            if (havepf) { qf[ti][0] = nqf[ti][0]; qf[ti][1] = nqf[ti][1]; }
            else { qf[ti][0] = *(const fp8x8*)qp; qf[ti][1] = *(const fp8x8*)(qp + 32); }
            gp[ti] = A.GATES + qrow * 48 + (g * 4 + r) * 3;
        }
        const unsigned char* KSg = A.KS + (size_t)b * SEQ * 256 + g * 64; const unsigned char* VSg = A.VST + (size_t)(b * 4 + g) * 64 * SEQ;
        const unsigned char* KWg = A.KW + (size_t)b * SEQ * 256 + g * 64; const unsigned char* VWg = A.VWT + (size_t)(b * 4 + g) * 64 * SEQ;
        __syncthreads();
        if (!havepf) {
            { const int key = tid >> 2, pc = tid & 3; pfk = ld16(A.KCMP + ((size_t)(b * 128 + key) * 4 + g) * 64 + pc * 16); }
            { const int d = tid >> 3, pc = tid & 7; pfv = ld16(A.VCMPT + ((size_t)(b * 4 + g) * 64 + d) * 128 + pc * 16); }
            { const bool isv = tid >= 256; const int st = tid & 255, srow = st >> 2, spc = st & 3; pfs = ld16(isv ? VSg + (size_t)srow * SEQ + spc * 16 : KSg + (size_t)srow * 256 + spc * 16); }
        }
        { const int key = tid >> 2, pc = tid & 3; *(LAS u32x4*)(lds + AL_KC + key * 80 + pc * 16) = pfk; }
        { const int d = tid >> 3, pc = tid & 7; *(LAS u32x4*)(lds + AL_VC + d * 144 + pc * 16) = pfv; }
        { const bool isv = tid >= 256; const int st = tid & 255, srow = st >> 2, spc = st & 3; *(LAS u32x4*)(lds + (isv ? AL_VR : AL_KB) + srow * 80 + spc * 16) = pfs; }
        __syncthreads();
        LAS f32x4* otl = (LAS f32x4*)(lds + AL_OT) + w * 512 + lane;
        unsigned selm[2];
#pragma unroll
        for (int ti = 0; ti < 2; ++ti) { selm[ti] = attn_cmp_tile(lds, qf[ti][0], qf[ti][1], sq[ti], s0 + 8 * w + 4 * ti, gp[ti][0], otl + ti * 256, lane, w, n, gq, tl, r); }
#if defined(EXP_ATT_NOSEL)
        if (!A.exp_)
#endif
        attn_branch<0>(lds, KSg, VSg, 0, c, true, qf, sq, selm, gp, otl, n, gq, tid);
        { const int un = u + gridDim.x; havepf = un < 4096;
            if (havepf) { const int bgn = un & 127, bn = bgn >> 2, gn = bgn & 3;
                { const int kqn = un >> 8, cn = 2 * kqn + ((((un >> 7) & 1) ^ kqn) & 1);
#pragma unroll
                    for (int ti = 0; ti < 2; ++ti) { const unsigned char* qp = A.Q + ((size_t)bn * SEQ + cn * 64 + 8 * w + 4 * ti + tl) * 1024 + gn * 256 + r * 64 + 8 * gq;
                        nqf[ti][0] = *(const fp8x8*)qp; nqf[ti][1] = *(const fp8x8*)(qp + 32); } }
                { const int key = tid >> 2, pc = tid & 3; pfk = ld16(A.KCMP + ((size_t)(bn * 128 + key) * 4 + gn) * 64 + pc * 16); }
                { const int d = tid >> 3, pc = tid & 7; pfv = ld16(A.VCMPT + ((size_t)(bn * 4 + gn) * 64 + d) * 128 + pc * 16); }
                { const bool isv = tid >= 256; const int st = tid & 255, srow = st >> 2, spc = st & 3;
                    pfs = ld16(isv ? A.VST + (size_t)(bn * 4 + gn) * 64 * SEQ + (size_t)srow * SEQ + spc * 16 : A.KS + (size_t)bn * SEQ * 256 + gn * 64 + (size_t)srow * 256 + spc * 16); } } }
#if defined(EXP_ATT_NOWIN)
        if (!A.exp_)
#endif
        attn_branch<1>(lds, KWg, VWg, c >= 8 ? c - 8 : 0, c, false, qf, sq, selm, gp, otl, n, gq, tid);
#pragma unroll
        for (int ti = 0; ti < 2; ++ti) {
            unsigned char* op = A.O + ((size_t)b * SEQ + sq[ti]) * 1024 + g * 256 + r * 64 + 4 * gq;
#pragma unroll
            for (int dt = 0; dt < 4; ++dt) { const f32x4 o = otl[(ti * 4 + dt) * 64] * S8_O; unsigned pk = 0u;
                pk = __builtin_amdgcn_cvt_pk_fp8_f32(clamp8(o[0]), clamp8(o[1]), pk, false); pk = __builtin_amdgcn_cvt_pk_fp8_f32(clamp8(o[2]), clamp8(o[3]), pk, true);
                *(unsigned*)(op + 16 * dt) = pk; }
        }
    }
    __syncthreads();
}
#ifndef DBG_ZERO_KIND
#define DBG_ZERO_KIND -1
#endif
#ifndef F8IN_MASK
#define F8IN_MASK 7
#endif
struct Params { const float* in[31]; float* out; unsigned char* ws; int ph_lo, ph_hi; };
constexpr int N_PHASES = 38;

#ifndef DUP_MASK
#define DUP_MASK 0ull
#endif
#define PH_BEGIN(k) if ((k) >= p.ph_lo && (k) < p.ph_hi) { for (int rep_ = 0; rep_ < (((DUP_MASK >> (k)) & 1ull) ? 2 : 1); ++rep_) {
#define PH_END(k) } if ((k) + 1 < p.ph_hi) xcd_barrier<(int)((WAIT_MASK >> (k)) & 1ull) + 2 * (int)((BUSY_MASK >> (k)) & 1ull)>(bar); }

template <int LAYER>
__device__ __forceinline__ void layer_body(const Params& p, LAS unsigned char* lds, const XcdBarrier& bar) {
    constexpr int kind = LAYER % 3, j = LAYER / 3;
    constexpr int PB = LAYER == 0 ? 1 : (LAYER == 1 ? 10 : (LAYER == 2 ? 18 : 29));
    constexpr int NMIX = kind == 0 ? 4 : (kind == 1 ? 3 : 6);
    unsigned char* ws = p.ws;
    const int G = gridDim.x, cblk = blockIdx.x;
    const int* positions = (const int*)p.in[1];
    unsigned char* XA = ws + WS_XA; bf16_t* MB = (bf16_t*)(ws + B_MB);
    bf16_t* XR = (bf16_t*)p.out;
    bf16_t* X1 = LAYER == DEPTH - 1 ? (bf16_t*)(ws + WS_XA) : (bf16_t*)p.out + (size_t)T_TOK * DM;
    int* route_e = (int*)(ws + WS_ROUTE_E); float* route_w = (float*)(ws + WS_ROUTE_W); int* posb = (int*)(ws + WS_POS); int* cnt = (int*)(ws + WS_CNT);
    int4* tiles = (int4*)(ws + WS_TILE); float* bias1 = (float*)(ws + WS_BIAS1);
    if constexpr (kind == 0) {
        unsigned char* Q = ws + B_Q; bf16_t* KC = (bf16_t*)(ws + B_KC); bf16_t* VC = (bf16_t*)(ws + B_VC); unsigned char* KS = ws + B_KS; unsigned char* VST = ws + B_VST;
        unsigned char* KW = ws + B_KW; unsigned char* VWT = ws + B_VWT; unsigned char* OB = ws + B_O;
        float* GATES = (float*)(ws + WS_GATES); unsigned char* KCMP = ws + WS_KCMP; unsigned char* VCMPT = ws + WS_VCMPT;
        PH_BEGIN(PB + 0)
            EpiNsaIn E{Q, KC, VC, KS, VST, KW, VWT, GATES, positions, p.in[3] + j * 48, (F8IN_MASK & 1) ? 1.f / (S8_X * S8_WI) : 1.f, LAYER == 3};
            if constexpr (F8IN_MASK & 1) { DenseSched8 S{XA, ws + W_NSA_IN + (size_t)j * NSA_NP * 1024, 1024, 1024, T_TOK / 256, NSA_NP / 256, G, cblk};
                gemm_phase<true>(lds, 1024, 1024, 1024, S, E); }
            else { DenseSched S{XR, (const bf16_t*)(ws + W_NSA_IN) + (size_t)j * NSA_NP * 1024, 1024, 1024, T_TOK / 256, NSA_NP / 256, G, cblk};
                gemm_phase<false>(lds, 1024, 1024, 1024, S, E); }
        PH_END(PB + 0)
        PH_BEGIN(PB + 1)
            nsa_compress_phase(lds, KC, VC, (const bf16_t*)(ws + W_CMP1) + (size_t)j * 2 * 64 * 2048, p.in[6] + j * 4096, p.in[9] + j * 4096, bias1 + j * 128, positions, KCMP, VCMPT);
        PH_END(PB + 1)
        PH_BEGIN(PB + 2)
            AttnArgs A{Q, KS, VST, KW, VWT, KCMP, VCMPT, GATES, OB, LAYER == 3 ? 1 : 0};
            nsa_attn_phase(lds, A);
        PH_END(PB + 2)
        PH_BEGIN(PB + 3)
            DenseSched8 S{OB, ws + W_NSA_OUT + (size_t)j * 1024 * 1024, 1024, 1024, T_TOK / 256, 4, G, cblk};
            EpiPlain<false> E{MB, 1024, 1.f / (S8_O * S8_WO)};
            gemm_phase<true>(lds, 1024, 1024, 1024, S, E);
        PH_END(PB + 3)
    } else if constexpr (kind == 1) {
        bf16_t* P = (bf16_t*)(ws + B_P); bf16_t* BGb = (bf16_t*)(ws + B_BG); bf16_t* Y = (bf16_t*)(ws + B_Y);
        PH_BEGIN(PB + 0)
            EpiScIn E{P, BGb, (F8IN_MASK & 2) ? 1.f / (S8_X * S8_WI) : 1.f};
            if constexpr (F8IN_MASK & 2) { DenseSched8 S{XA, ws + W_SC_IN, 1024, 1024, T_TOK / 256, 12, G, cblk};
                gemm_phase<true>(lds, 1024, 1024, 1024, S, E); }
            else { DenseSched S{XR, (const bf16_t*)(ws + W_SC_IN), 1024, 1024, T_TOK / 256, 12, G, cblk};
                gemm_phase<false>(lds, 1024, 1024, 1024, S, E); }
        PH_END(PB + 0)
        PH_BEGIN(PB + 1)
            sc_conv_phase(lds, P, BGb, Y, p.in[12], p.in[13]);
        PH_END(PB + 1)
        PH_BEGIN(PB + 2)
            DenseSched S{Y, (const bf16_t*)(ws + W_SC_OUT), 1024, 1024, T_TOK / 256, 4, G, cblk};
            EpiPlain<false> E{MB, 1024, 1.f};
            gemm_phase<false>(lds, 1024, 1024, 1024, S, E);
        PH_END(PB + 2)
    } else {
        bf16_t* GG = (bf16_t*)(ws + B_GG); bf16_t* R1 = (bf16_t*)(ws + B_R1); bf16_t* R2 = (bf16_t*)(ws + B_R2); bf16_t* R3 = (bf16_t*)(ws + B_R3);
        f32x4* carry = (f32x4*)(ws + WS_CARRY);
        PH_BEGIN(PB + 0)
            EpiLruIn E{GG, R1, (F8IN_MASK & 4) ? 1.f / (S8_X * S8_WI) : 1.f};
            if constexpr (F8IN_MASK & 4) { DenseSched8 S{XA, ws + W_LRU_IN, 1024, 1024, T_TOK / 256, 10, G, cblk};
                gemm_phase<true>(lds, 1024, 1024, 1024, S, E); }
            else { DenseSched S{XR, (const bf16_t*)(ws + W_LRU_IN), 1024, 1024, T_TOK / 256, 10, G, cblk};
                gemm_phase<false>(lds, 1024, 1024, 1024, S, E); }
        PH_END(PB + 0)
        PH_BEGIN(PB + 1)
            lru_conv_phase(lds, R1, R2, p.in[16], p.in[17]);
        PH_END(PB + 1)
        PH_BEGIN(PB + 2)
            BandSched S{R2, (const bf16_t*)(ws + W_LRU_G), LRU_W, LRU_W, T_TOK / 256, 10, G, cblk};
            EpiLruGate E{R2, R1, R3, p.in[19], p.in[21], p.in[22]};
            gemm_phase<false>(lds, 384, LRU_W, LRU_W, S, E);
        PH_END(PB + 2)
        PH_BEGIN(PB + 3)
            lru_scan1_phase(R1, R3, carry);
        PH_END(PB + 3)
        PH_BEGIN(PB + 4)
            lru_scan2_phase(R1, R3, GG, carry, R2);
        PH_END(PB + 4)
        PH_BEGIN(PB + 5)
            DenseSched S{R2, (const bf16_t*)(ws + W_LRU_OUT), LRU_W, LRU_W, T_TOK / 256, 4, G, cblk};
            EpiPlain<false> E{MB, 1024, 1.f};
            gemm_phase<false>(lds, LRU_W, LRU_W, LRU_W, S, E);
        PH_END(PB + 5)
    }
    constexpr int FB = PB + NMIX;
    unsigned char* X8 = ws + B_XG; int* invb = (int*)(ws + WS_INV); unsigned char* HID = ws + B_HID; unsigned char* YM = ws + B_YM; unsigned char* WGU = ws + B_WMOE + WMOE_GU; unsigned char* WDN = ws + B_WMOE + WMOE_DN;
    const float* lng = p.in[29] + (size_t)LAYER * 2048; const float* lnb = p.in[30] + (size_t)LAYER * 2048;
    PH_BEGIN(FB + 0)
        ln1_router_phase<LAYER == 0>(lds, LAYER == 0 ? (const void*)p.in[0] : (const void*)XR, MB, X1, X8, lng, lnb, p.in[24], p.in[25], route_e, route_w, cnt);
    PH_END(FB + 0)
    PH_BEGIN(FB + 1)
        moe_gather_phase(lds, route_e, cnt, posb, invb, tiles);
#if defined(EXP_F2_NOCONV)
        if (LAYER != 3)
#endif
        {
        convert_wt<true>(lds, WGU, 16, 2048, 1024, FetchPair{p.in[26] + (size_t)LAYER * 16 * 1048576, (long)(p.in[27] - p.in[26]), 1024, (size_t)1048576}, S8_WGU);
        convert_wt<true>(lds, WDN, 16, 1024, 1024, FetchPlain16{p.in[28] + (size_t)LAYER * 16 * 1048576, 1024, (size_t)1048576}, S8_WD);
        }
    PH_END(FB + 1)
    PH_BEGIN(FB + 2)
        const int NT = __builtin_amdgcn_readfirstlane(tiles[0].x);
        const int nu = moe_sched_fill<true>(lds, tiles, invb, NT, 8, G, cblk);
        MoeSchedL S{X8, WGU, (const LAS u32x4*)(lds + MOE_LDS_DESC), (const LAS int*)(lds + MOE_LDS_ROWS), nu, 2048, 1024, false};
        EpiMoeGU E{HID};
        gemm_phase<true, true>(lds, 1024, 1024, 1024, S, E);
    PH_END(FB + 2)
    PH_BEGIN(FB + 3)
        const int NT = __builtin_amdgcn_readfirstlane(tiles[0].x);
        const int nu = moe_sched_fill<false>(lds, tiles, invb, NT, 4, G, cblk);
        MoeSchedL S{HID, WDN, (const LAS u32x4*)(lds + MOE_LDS_DESC), (const LAS int*)(lds + MOE_LDS_ROWS), nu, 1024, 1024, LAYER == 3};
        EpiMoeDown16 E{YM, S8_Y / (S8_H * S8_WD)};
        gemm_phase<true>(lds, 1024, 1024, 1024, S, E);
    PH_END(FB + 3)
    PH_BEGIN(FB + 4)
        ln2_combine_phase<LAYER == DEPTH - 1, ((F8IN_MASK >> ((LAYER + 1) % 3)) & 1) != 0>(X1, LAYER == DEPTH - 1 ? (void*)p.out : (void*)XR, YM, posb, route_w, lng + 1024, lnb + 1024, XA);
    PH_END(FB + 4)
}

__global__ void __launch_bounds__(NTHR, 2) hybrid_fwd(Params p) {
    extern __shared__ __attribute__((aligned(16))) unsigned char lds_raw[];
    LAS unsigned char* lds = (LAS unsigned char*)lds_raw;
    volatile LAS unsigned* bst = (volatile LAS unsigned*)(lds + LDS_BYTES - 16);
    const bool use_bar = (p.ph_hi - p.ph_lo) > 1;
    if (threadIdx.x == 0) { bst[0] = 0u; bst[1] = 0u; bst[2] = 0u; bst[3] = 0u; }
    __syncthreads();
    XcdBarrier bar; bar.bar = (unsigned*)(p.ws + WS_CTL); bar.x = 0; bar.st = bst;
    if (use_bar) bar = xcd_barrier_post((unsigned*)(p.ws + WS_CTL), bst);
#ifdef PROBE_WAIT
    if (threadIdx.x == 0) bst[3] = (unsigned)__builtin_amdgcn_s_memrealtime();
#endif
    PH_BEGIN(0)
        unsigned char* ws = p.ws;
        convert_x<(F8IN_MASK & 1) != 0>(p.in[0], ws + WS_XA);
        for (int j = 0; j < 2; ++j) {
            const int bo = j * 128;
            if constexpr (F8IN_MASK & 1) convert_wt<true>(lds, ws + W_NSA_IN + (size_t)j * NSA_NP * 1024, 1, NSA_NP, 1024, FetchNsaIn{p.in[2] + (size_t)j * 1024 * 2608}, S8_WI, bo);
            else convert_wt(lds, (bf16_t*)(ws + W_NSA_IN) + (size_t)j * NSA_NP * 1024, 1, NSA_NP, 1024, FetchNsaIn{p.in[2] + (size_t)j * 1024 * 2608}, 1.f, bo);
            convert_wt<true>(lds, ws + W_NSA_OUT + (size_t)j * 1024 * 1024, 1, 1024, 1024, FetchPlain{p.in[10] + (size_t)j * 1024 * 1024, 1024, 0}, S8_WO, bo + 88);
            convert_wt(lds, (bf16_t*)(ws + W_CMP1) + (size_t)(j * 2 + 0) * 64 * 2048, 1, 64, 2048, FetchIdent{p.in[5] + (size_t)j * 2048 * 64, 64, 0}, 1.f, bo + 120);
            convert_wt(lds, (bf16_t*)(ws + W_CMP1) + (size_t)(j * 2 + 1) * 64 * 2048, 1, 64, 2048, FetchIdent{p.in[8] + (size_t)j * 2048 * 64, 64, 0}, 1.f, bo + 124);
        }
        if constexpr (F8IN_MASK & 2) convert_wt<true>(lds, ws + W_SC_IN, 1, 3072, 1024, FetchScIn{p.in[11]}, S8_WI, 0); else convert_wt(lds, (bf16_t*)(ws + W_SC_IN), 1, 3072, 1024, FetchScIn{p.in[11]}, 1.f, 0);
        convert_wt(lds, (bf16_t*)(ws + W_SC_OUT), 1, 1024, 1024, FetchPlain{p.in[14], 1024, 0}, 1.f, 96);
        if constexpr (F8IN_MASK & 4) convert_wt<true>(lds, ws + W_LRU_IN, 1, 2560, 1024, FetchPlain{p.in[15], 2560, 0}, S8_WI, 128); else convert_wt(lds, (bf16_t*)(ws + W_LRU_IN), 1, 2560, 1024, FetchPlain{p.in[15], 2560, 0}, 1.f, 128);
        convert_wt(lds, (bf16_t*)(ws + W_LRU_G), 1, 2560, 1280, FetchLruGate{p.in[18], (long)(p.in[20] - p.in[18])}, 1.f, 208);
        convert_wt(lds, (bf16_t*)(ws + W_LRU_OUT), 1, 1024, 1280, FetchPlain{p.in[23], 1024, 0}, 1.f, 52);
        cmp_bias_phase(lds, p.in[4], p.in[5], p.in[7], p.in[8], (float*)(ws + WS_BIAS1));
    PH_END(0)
    layer_body<0>(p, lds, bar);
    layer_body<1>(p, lds, bar);
    layer_body<2>(p, lds, bar);
    layer_body<3>(p, lds, bar);
#ifdef PROBE_WAIT
    __syncthreads();
    if (threadIdx.x == 0) { if ((BUSY_MASK >> 37) & 1ull) bst[2] = bst[2] + ((unsigned)__builtin_amdgcn_s_memrealtime() - bst[3]); atomicAdd((unsigned*)(p.ws + WS_CTL + 32768), bst[2]); }
    xcd_barrier(bar);
#ifdef PROBE_FILL
    {
        const unsigned tot = __hip_atomic_load((unsigned*)(p.ws + WS_CTL + 32768), __ATOMIC_RELAXED, __HIP_MEMORY_SCOPE_AGENT);
        const float vk = (float)(((tot >> 8) + (PROBE_Q / 2)) / PROBE_Q);
        for (size_t i = (size_t)blockIdx.x * NTHR + threadIdx.x; i < (size_t)T_TOK * DM; i += (size_t)gridDim.x * NTHR) p.out[i] = vk;
    }
    if (false) {
        const unsigned tot = 0;
#else
    if (blockIdx.x == 0 && threadIdx.x == 0) {
        const unsigned tot = __hip_atomic_load((unsigned*)(p.ws + WS_CTL + 32768), __ATOMIC_RELAXED, __HIP_MEMORY_SCOPE_AGENT);
#endif
        p.out[0] = (float)((((tot >> 8) + (PROBE_Q / 2)) / PROBE_Q) * PROBE_Q);
    }
#endif
}
#undef PH_BEGIN
#undef PH_END

#ifndef MK_SPLIT
#define MK_SPLIT 0
#endif
extern "C" void kernel_launch(void* const* d_in, const int* in_sizes, int n_in, void* d_out, int out_size, void* d_ws, size_t ws_size, hipStream_t stream) {
    static int grid = 0;
    if (grid == 0) {
        int dev = 0, cus = 0, per_cu = 0;
        if (n_in != 31 || ws_size < WS_END) { fprintf(stderr, "kernel_launch: unexpected n_in %d or ws_size %zu (need %zu)\n", n_in, ws_size, (size_t)WS_END); grid = -1; return; }
        if (hipGetDevice(&dev) != hipSuccess || hipDeviceGetAttribute(&cus, hipDeviceAttributeMultiprocessorCount, dev) != hipSuccess) { grid = -1; return; }
        if (hipFuncSetAttribute((const void*)hybrid_fwd, hipFuncAttributeMaxDynamicSharedMemorySize, LDS_BYTES) != hipSuccess) { fprintf(stderr, "kernel_launch: hipFuncSetAttribute failed\n"); grid = -1; return; }
        if (hipOccupancyMaxActiveBlocksPerMultiprocessor(&per_cu, (const void*)hybrid_fwd, NTHR, LDS_BYTES) != hipSuccess || per_cu < 1) fprintf(stderr, "kernel_launch: occupancy query says %d\n", per_cu);
        (void)hipGetLastError();
        grid = cus;
    }
    if (grid < 0) return;
    (void)hipMemsetAsync((char*)d_ws + WS_CTL, 0, 64 * 1024, stream);
    Params p{};
    for (int i = 0; i < 31; ++i) p.in[i] = (const float*)d_in[i];
    p.out = (float*)d_out; p.ws = (unsigned char*)d_ws;
#if MK_SPLIT
    for (int ph = 0; ph < N_PHASES; ++ph) { p.ph_lo = ph; p.ph_hi = ph + 1; hipLaunchKernelGGL(hybrid_fwd, dim3(grid), dim3(NTHR), LDS_BYTES, stream, p); }
#else
    p.ph_lo = 0; p.ph_hi = N_PHASES;
    hipLaunchKernelGGL(hybrid_fwd, dim3(grid), dim3(NTHR), LDS_BYTES, stream, p);
#endif
    const hipError_t le = hipPeekAtLastError();
    if (le != hipSuccess) fprintf(stderr, "kernel_launch: launch failed: %s\n", hipGetErrorName(le));
}
```
